# Optimizing an MI355X kernel written in HIP

```python
import jax, jax.numpy as jnp
from jax import lax
import numpy as np

D_MODEL = 1024
BATCH = 2
SEQ = 16384
DEPTH = 2

GRID_W = 64
CTX_LEN = 256
N_MIXERS = 2
N_GLA_LAYERS = (DEPTH + 1) // 2
N_CONV_LAYERS = DEPTH // 2

GLA_HEADS = 4
GLA_DK = D_MODEL // 2
GLA_DV = D_MODEL
GLA_HK = GLA_DK // GLA_HEADS
GLA_HV = GLA_DV // GLA_HEADS
GLA_RANK = 16
GLA_TAU = 16.0
GLA_CHUNK = 64

CONV_WIDTH = 3

N_EXPERTS = 16
EC_CAPACITY_FACTOR = 2
D_EXPERT = 2 * D_MODEL

EPS = 1e-6

kernel_name = "hybrid_gla_shortconv_ecmoe_diffusion_prefix"


def rmsnorm(x, g):
    xf = x.astype(jnp.float32)
    y = xf * lax.rsqrt(jnp.mean(xf * xf, axis=-1, keepdims=True) + EPS)
    return (y * g.astype(jnp.float32)).astype(x.dtype)


def modulate(h, shift, scale):
    return h * (1 + scale) + shift


def _to_chunks(t):
    b, t_len, h, d = t.shape
    return t.reshape(b, t_len // GLA_CHUNK, GLA_CHUNK, h, d).transpose(1, 0, 3, 2, 4)


def gla_chunk_scan(q, k, v, log_a, s0):
    b, t_len, h, _ = q.shape
    qc, kc, vc, gc = _to_chunks(q), _to_chunks(k), _to_chunks(v), _to_chunks(log_a)
    tri = jnp.tril(jnp.ones((GLA_CHUNK, GLA_CHUNK), dtype=bool))[:, :, None]

    def step(state, inp):
        qi, ki, vi, gi = inp
        a_cum = jnp.cumsum(gi.astype(jnp.float32), axis=2)
        a_last = a_cum[:, :, -1:, :]
        diff = a_cum[:, :, :, None, :] - a_cum[:, :, None, :, :]
        decay = jnp.exp(jnp.where(tri, diff, -jnp.inf))
        scores = jnp.einsum('bhid,bhjd,bhijd->bhij', qi, ki, decay)
        o_intra = jnp.einsum('bhij,bhjv->bhiv', scores, vi)
        o_inter = jnp.einsum('bhid,bhdv->bhiv', qi * jnp.exp(a_cum), state)
        k_dec = ki * jnp.exp(a_last - a_cum)
        new_state = state * jnp.exp(a_last)[:, :, 0, :, None] + jnp.einsum('bhjd,bhjv->bhdv', k_dec, vi)
        return new_state, (o_intra + o_inter)

    s_final, o = lax.scan(step, s0, (qc, kc, vc, gc))
    o = o.transpose(1, 0, 3, 2, 4).reshape(b, t_len, h, GLA_HV)
    return o.astype(v.dtype), s_final


def gla_bidirectional(q, k, v, la_f, la_b, s0_f, s0_b):
    o_f, s_f = gla_chunk_scan(q, k, v, la_f, s0_f)
    flip = lambda t: jnp.flip(t, axis=1)
    o_b, s_b = gla_chunk_scan(flip(q), flip(k), flip(v), flip(la_b), s0_b)
    return o_f + flip(o_b), s_f, s_b


def gla_project(h, w_in, w_a2, b_a2):
    b, t_len, _ = h.shape
    sizes = [GLA_DK, GLA_DK, GLA_DV, GLA_DV, GLA_RANK, GLA_RANK]
    q, k, v, r, a_f, a_b = jnp.split(h @ w_in, list(np.cumsum(sizes)[:-1]), axis=-1)
    q = q.reshape(b, t_len, GLA_HEADS, GLA_HK) * (GLA_HK ** -0.5)
    k = k.reshape(b, t_len, GLA_HEADS, GLA_HK)
    v = v.reshape(b, t_len, GLA_HEADS, GLA_HV)

    def log_gate(a, d):
        z = (a @ w_a2[d] + b_a2[d]).astype(jnp.float32)
        return (jax.nn.log_sigmoid(z) / GLA_TAU).reshape(b, t_len, GLA_HEADS, GLA_HK)

    return q, k, v, r, log_gate(a_f, 0), log_gate(a_b, 1)


def gla_finish(o, r, g_norm, w_out):
    b, t_len = o.shape[:2]
    o = rmsnorm(o, g_norm) * jax.nn.silu(r).reshape(b, t_len, GLA_HEADS, GLA_HV)
    return o.reshape(b, t_len, GLA_DV) @ w_out


def gla_mixer(h_x, h_c, w_in, w_a2, b_a2, g_norm, w_out, need_ctx_out):
    b = h_x.shape[0]
    qc, kc, vc, rc, lfc, lbc = gla_project(h_c, w_in, w_a2, b_a2)
    s0 = jnp.zeros((b, GLA_HEADS, GLA_HK, GLA_HV), jnp.float32)
    o_c, s_cf, s_cb = gla_bidirectional(qc, kc, vc, lfc, lbc, s0, s0)
    qx, kx, vx, rx, lfx, lbx = gla_project(h_x, w_in, w_a2, b_a2)
    o_x, _, _ = gla_bidirectional(qx, kx, vx, lfx, lbx, s_cf, s_cb)
    y_x = gla_finish(o_x, rx, g_norm, w_out)
    y_c = gla_finish(o_c, rc, g_norm, w_out) if need_ctx_out else None
    return y_x, y_c


def shortconv_mixer(h, w_in, conv_k, w_out, n_seq, seg_len):
    bg, cg, v = jnp.split(h @ w_in, 3, axis=-1)
    u = (cg * v).reshape(n_seq, seg_len, D_MODEL)
    u = lax.conv_general_dilated(
        u, conv_k.reshape(CONV_WIDTH, 1, D_MODEL).astype(u.dtype),
        window_strides=(1,), padding=[((CONV_WIDTH - 1) // 2, (CONV_WIDTH - 1) // 2)],
        dimension_numbers=('NWC', 'WIO', 'NWC'), feature_group_count=D_MODEL)
    return (bg * u.reshape(h.shape)) @ w_out


def ec_moe(h, w_router, w_gate, w_up, w_down):
    b, t_len, d = h.shape
    cap = EC_CAPACITY_FACTOR * t_len // N_EXPERTS
    aff = jax.nn.softmax((h @ w_router).astype(jnp.float32), axis=-1)
    vals, idx = lax.top_k(jnp.swapaxes(aff, 1, 2), cap)
    idx_flat = idx.reshape(b, N_EXPERTS * cap)
    xe = jnp.take_along_axis(h, idx_flat[..., None], axis=1).reshape(b, N_EXPERTS, cap, d)
    hid = jax.nn.silu(jnp.einsum('becd,edf->becf', xe, w_gate)) * jnp.einsum('becd,edf->becf', xe, w_up)
    ye = jnp.einsum('becf,efd->becd', hid, w_down) * vals[..., None].astype(h.dtype)
    scatter = lambda y, i: jnp.zeros((t_len, d), y.dtype).at[i].add(y)
    return jax.vmap(scatter)(ye.reshape(b, N_EXPERTS * cap, d), idx_flat)


def setup_inputs(seed: int = 0) -> dict:
    key = jax.random.key(seed)
    ks = jax.random.split(key, 24)
    nrm = lambda k, shape, scale: jax.random.normal(k, shape, jnp.float32) * scale
    d = D_MODEL
    gla_in_width = 2 * GLA_DK + 2 * GLA_DV + 2 * GLA_RANK
    return {
        "x": nrm(ks[0], (BATCH, SEQ, d), 1.0),
        "c": nrm(ks[1], (BATCH, d), 1.0),
        "ctx": nrm(ks[2], (BATCH, CTX_LEN, d), 1.0),
        "c_ctx": nrm(ks[3], (d,), 1.0),
        "ada_w": nrm(ks[4], (DEPTH, d, 6 * d), 0.5 * d ** -0.5),
        "ada_b": nrm(ks[5], (DEPTH, 6 * d), 0.01),
        "norm_g": 1.0 + nrm(ks[6], (DEPTH, 2, d), 0.05),
        "gla_w_in": nrm(ks[7], (N_GLA_LAYERS, d, gla_in_width), d ** -0.5),
        "gla_w_a2": nrm(ks[8], (N_GLA_LAYERS, 2, GLA_RANK, GLA_DK), GLA_RANK ** -0.5),
        "gla_b_a2": nrm(ks[9], (N_GLA_LAYERS, 2, GLA_DK), 0.1),
        "gla_norm_g": 1.0 + nrm(ks[10], (N_GLA_LAYERS, GLA_HV), 0.05),
        "gla_w_out": nrm(ks[11], (N_GLA_LAYERS, GLA_DV, d), GLA_DV ** -0.5),
        "conv_w_in": nrm(ks[12], (N_CONV_LAYERS, d, 3 * d), d ** -0.5),
        "conv_k": nrm(ks[13], (N_CONV_LAYERS, CONV_WIDTH, d), CONV_WIDTH ** -0.5),
        "conv_w_out": nrm(ks[14], (N_CONV_LAYERS, d, d), d ** -0.5),
        "router_w": nrm(ks[15], (DEPTH, d, N_EXPERTS), d ** -0.5),
        "expert_w_gate": nrm(ks[16], (DEPTH, N_EXPERTS, d, D_EXPERT), d ** -0.5),
        "expert_w_up": nrm(ks[17], (DEPTH, N_EXPERTS, d, D_EXPERT), d ** -0.5),
        "expert_w_down": nrm(ks[18], (DEPTH, N_EXPERTS, D_EXPERT, d), D_EXPERT ** -0.5),
        "final_norm_g": 1.0 + nrm(ks[19], (d,), 0.05),
    }


def reference(x, c, ctx, c_ctx, ada_w, ada_b, norm_g, gla_w_in, gla_w_a2, gla_b_a2, gla_norm_g,
              gla_w_out, conv_w_in, conv_k, conv_w_out, router_w, expert_w_gate, expert_w_up,
              expert_w_down, final_norm_g):
    b, t_len, d = x.shape
    rows = t_len // GRID_W
    ctx_len = ctx.shape[1]
    for i in range(DEPTH):
        last = i == DEPTH - 1
        j = i // N_MIXERS
        is_gla = (i % N_MIXERS) == 0
        ctx_needed = is_gla or not last
        mod_x = jax.nn.silu(c) @ ada_w[i] + ada_b[i]
        mod_c = jax.nn.silu(c_ctx) @ ada_w[i] + ada_b[i]
        sh1x, sc1x, g1x, sh2x, sc2x, g2x = jnp.split(mod_x[:, None, :], 6, axis=-1)
        sh1c, sc1c, g1c, sh2c, sc2c, g2c = jnp.split(mod_c, 6, axis=-1)

        h_x = modulate(rmsnorm(x, norm_g[i, 0]), sh1x, sc1x)
        h_c = modulate(rmsnorm(ctx, norm_g[i, 0]), sh1c, sc1c) if ctx_needed else None
        if is_gla:
            y_x, y_c = gla_mixer(h_x, h_c, gla_w_in[j], gla_w_a2[j], gla_b_a2[j], gla_norm_g[j],
                                 gla_w_out[j], need_ctx_out=not last)
        else:
            y_x = shortconv_mixer(h_x, conv_w_in[j], conv_k[j], conv_w_out[j], b * rows, GRID_W)
            y_c = (shortconv_mixer(h_c, conv_w_in[j], conv_k[j], conv_w_out[j], b, ctx_len)
                   if not last else None)
        x = x + g1x * y_x

        h2x = modulate(rmsnorm(x, norm_g[i, 1]), sh2x, sc2x)
        x = x + g2x * ec_moe(h2x, router_w[i], expert_w_gate[i], expert_w_up[i], expert_w_down[i])

        if not last:
            ctx = ctx + g1c * y_c
            h2c = modulate(rmsnorm(ctx, norm_g[i, 1]), sh2c, sc2c)
            ctx = ctx + g2c * ec_moe(h2c, router_w[i], expert_w_gate[i], expert_w_up[i], expert_w_down[i])
    return rmsnorm(x, final_norm_g)
```

```cpp
#include <hip/hip_runtime.h>
#include <hip/hip_cooperative_groups.h>
#include <cstdio>
#include <cstdint>
namespace cg = cooperative_groups;

#ifndef MK_MULTI
#define MK_MULTI 1
#endif

#define LAS __attribute__((address_space(3)))
#define GAS __attribute__((address_space(1)))
typedef unsigned short bf16_t;
typedef short bf16x8 __attribute__((ext_vector_type(8)));
typedef float f32x4 __attribute__((ext_vector_type(4)));
typedef float f32x2 __attribute__((ext_vector_type(2)));
typedef unsigned u32x4 __attribute__((ext_vector_type(4)));
typedef unsigned u32x2 __attribute__((ext_vector_type(2)));

constexpr int D = 1024, NB = 2, T = 16384, NLAT = NB * T, CTXL = 256, NCTX = NB * CTXL, NROW = NLAT + NCTX;
constexpr int NE = 16, CAP = 2048, DEXP = 2048;
constexpr int HEADS = 4, HK = 128, HV = 256, DK = 512, DV = 1024, RANK = 16;
constexpr int NIN0 = 3104, NIN0P = 3328;
constexpr int NCIN = 3072;
constexpr float EPS = 1e-6f;
constexpr int NWAVES = 8, NTHR = 512;

constexpr size_t MiB = 1u << 20;
constexpr size_t WS_CTL = 0;
constexpr size_t WS_MOD = 1 * MiB;
constexpr size_t WS_WIN0T = 2 * MiB;
constexpr size_t WS_WOUT0T = 9 * MiB;
constexpr size_t WS_WCINT = 11 * MiB;
constexpr size_t WS_WCOUTT = 17 * MiB;
constexpr size_t WS_AFF = 19 * MiB;
constexpr size_t WS_SLOT = 21 * MiB;
constexpr size_t WS_ROWLIST = 23 * MiB;
constexpr size_t WS_SELVAL = 23 * MiB + 512 * 1024;
constexpr size_t WS_AFB = 24 * MiB;
constexpr size_t WS_WGU = 32 * MiB;
constexpr size_t WS_WD = 160 * MiB;
constexpr size_t WS_X = 224 * MiB;
constexpr size_t WS_H = 354 * MiB;
constexpr size_t WS_ARENA = 420 * MiB;
constexpr size_t WS_PROJ = WS_ARENA;
constexpr size_t WS_DECF = WS_ARENA + 212 * MiB;
constexpr size_t WS_DECB = WS_ARENA + 277 * MiB;
constexpr size_t WS_OF = WS_ARENA + 342 * MiB;
constexpr size_t WS_OB = WS_ARENA + 406 * MiB;
constexpr size_t WS_HID = WS_ARENA;
constexpr size_t WS_YE = WS_ARENA + 256 * MiB;
constexpr size_t WS_BCV = WS_ARENA;
constexpr size_t WS_END = WS_ARENA + 470 * MiB;

__device__ __forceinline__ float wave_sum(float v) {
#pragma unroll
    for (int o = 1; o < 64; o <<= 1) v += __shfl_xor(v, o);
    return v;
}
__device__ __forceinline__ int wave_sum_i(int v) {
#pragma unroll
    for (int o = 1; o < 64; o <<= 1) v += __shfl_xor(v, o);
    return v;
}
__device__ __forceinline__ unsigned f2bf(float f) { unsigned u = __builtin_bit_cast(unsigned, f); return (u + 0x7fffu + ((u >> 16) & 1u)) >> 16; }
__device__ __forceinline__ unsigned pk2(float lo, float hi) { return f2bf(lo) | (f2bf(hi) << 16); }
__device__ __forceinline__ float bflo(unsigned u) { return __builtin_bit_cast(float, u << 16); }
__device__ __forceinline__ float bfhi(unsigned u) { return __builtin_bit_cast(float, u & 0xffff0000u); }
__device__ __forceinline__ float silu_f(float x) { return x / (1.f + __expf(-x)); }
#define LDS_WAIT() asm volatile("s_waitcnt lgkmcnt(0)" ::: "memory")

namespace eng {
constexpr int BM = 256, BK = 64, HALF = 128, HTB = HALF * BK * 2, STAGE_BYTES = 8 * HTB, NXCD = 8, WGM = 8;
__host__ __device__ __forceinline__ int lds_byte(int r, int c) { const int st = (r >> 4) * 2 + (c >> 5), rr = r & 15, cc = c & 31, ob = rr * 64 + cc * 2; return st * 1024 + (ob ^ (((ob >> 9) & 1) << 5)); }
__host__ __device__ __forceinline__ void stage_rc(int b, int& R, int& C) { const int st = b / 1024, sb = b % 1024, swz = sb ^ (((sb >> 9) & 1) << 5); R = (st >> 1) * 16 + swz / 64; C = (st & 1) * 32 + (swz % 64) / 2; }
__host__ __device__ __forceinline__ int perm32(int rho) { const int n = rho >> 4, i = rho & 15; return 8 * (i >> 2) + 4 * n + (i & 3); }

struct Unit { int e, pm, pn; };
struct Gemm {
    const char* A;
    const char* Bt;
    const int* rows;
    size_t bstride;
    int K, nM, nN, ngroups;
};
__device__ __forceinline__ bool next_unit(const Gemm& g, int i, int G, int c, Unit& u) {
    const int per = g.nM * g.nN;
    const long L = (long)i * G + c; if (L >= (long)per * g.ngroups) return false;
    u.e = (int)(L / per); int wgid = (int)(L % per);
    { const int nwg = per, q = nwg / NXCD, r = nwg % NXCD, xcd = wgid % NXCD, off = wgid / NXCD; wgid = (xcd < r ? xcd * (q + 1) : r * (q + 1) + (xcd - r) * q) + off; }
    const int nig = WGM * g.nN, gid = wgid / nig, fm = gid * WGM, gsz = (g.nM - fm) < WGM ? (g.nM - fm) : WGM;
    u.pm = fm + ((wgid % nig) % gsz); u.pn = (wgid % nig) / gsz; return true;
}
__device__ __forceinline__ unsigned cvt_pk_bf16(float lo, float hi) { unsigned r; asm volatile("v_cvt_pk_bf16_f32 %0, %1, %2" : "=v"(r) : "v"(lo), "v"(hi)); return r; }

template <class Epi>
__device__ __forceinline__ void gemm_phase(LAS unsigned char* lds, const Gemm g, const Epi& E, int G, int c) {
    const int tid = threadIdx.x, wid = __builtin_amdgcn_readfirstlane(tid >> 6), lane = tid & 63, wr = wid >> 2, wc = wid & 3, fr = lane & 15, fq = lane >> 4;
    const int K = g.K, nt = K / BK;
    int R0, C0; stage_rc(tid * 16, R0, C0);
    const int Rb0 = Epi::PERM ? ((R0 & ~31) + perm32(R0 & 31)) : R0;
    unsigned voffB[2]; voffB[0] = (unsigned)(Rb0 * K + C0) * 2u; voffB[1] = (unsigned)((Rb0 + 64) * K + C0) * 2u;
    const size_t hstepB = (size_t)HALF * K * 2;
    const unsigned ldsw = (unsigned)wid * 1024u;
    const int aoff = lds_byte(wr * 64 + fr, fq * 8), boff = lds_byte(wc * 32 + fr, fq * 8);
#define PG8_SA(b, h) (((b) * 2 + (h)) * HTB)
#define PG8_SB(b, h) ((4 + (b) * 2 + (h)) * HTB)
#define PG8_GLDS(gp, bufoff, i) __builtin_amdgcn_global_load_lds((const unsigned*)(gp), (LAS unsigned*)(lds + (bufoff) + ldsw + (i) * 8192), 16, 0, 0)
#define PG8_STAGE_B(bufoff, bp, h, kt) do { const char* _p = (bp) + (size_t)(h) * hstepB + (size_t)(kt) * 128; PG8_GLDS(_p + voffB[0], bufoff, 0); PG8_GLDS(_p + voffB[1], bufoff, 1); } while (0)
#define PG8_STAGE_A(bufoff, v0, v1, kt) do { const char* _p = g.A + (size_t)(kt) * 128; PG8_GLDS(_p + (v0), bufoff, 0); PG8_GLDS(_p + (v1), bufoff, 1); } while (0)
#define PG8_LDA(dst, b, h) do { _Pragma("unroll") for (int m = 0; m < 4; ++m) _Pragma("unroll") for (int k = 0; k < 2; ++k) dst[m][k] = *(const LAS bf16x8*)(lds + PG8_SA(b, h) + aoff + m * 2048 + k * 1024); } while (0)
#define PG8_LDB(dst, b, h) do { _Pragma("unroll") for (int n = 0; n < 2; ++n) _Pragma("unroll") for (int k = 0; k < 2; ++k) dst[n][k] = *(const LAS bf16x8*)(lds + PG8_SB(b, h) + boff + n * 2048 + k * 1024); } while (0)
#define PG8_MMA(ai, bj, At, Bt) do { __builtin_amdgcn_s_setprio(1); _Pragma("unroll") for (int m = 0; m < 4; ++m) _Pragma("unroll") for (int n = 0; n < 2; ++n) _Pragma("unroll") for (int k = 0; k < 2; ++k) \
        acc[ai][bj][m][n] = __builtin_amdgcn_mfma_f32_16x16x32_bf16(Bt[n][k], At[m][k], acc[ai][bj][m][n], 0, 0, 0); __builtin_amdgcn_s_setprio(0); } while (0)
#define PG8_WAIT_V(n) asm volatile("s_waitcnt vmcnt(" #n ")" ::: "memory")
#define PG8_WAIT_L(n) asm volatile("s_waitcnt lgkmcnt(" #n ")" ::: "memory")
#define PG8_BAR __builtin_amdgcn_s_barrier()
#define PG8_SCHED __builtin_amdgcn_sched_barrier(0)
#define PG8_ROWOFF(u, h, i) ((unsigned)(((g.rows ? g.rows[((u).e * g.nM + (u).pm) * 256 + (h) * 128 + R0 + 64 * (i)] : (((u).e * g.nM + (u).pm) * 256 + (h) * 128 + R0 + 64 * (i))) * K + C0)) * 2u)
    Unit cur, nxt; int ui = 0;
    if (!next_unit(g, 0, G, c, cur)) return;
    f32x4 acc[2][2][4][2];
#pragma unroll
    for (int a = 0; a < 2; ++a)
#pragma unroll
        for (int b = 0; b < 2; ++b)
#pragma unroll
            for (int m = 0; m < 4; ++m)
#pragma unroll
                for (int n = 0; n < 2; ++n) acc[a][b][m][n] = (f32x4){0.f, 0.f, 0.f, 0.f};
    bf16x8 At[4][2], B0[2][2], B1[2][2];
    unsigned c00 = PG8_ROWOFF(cur, 0, 0), c01 = PG8_ROWOFF(cur, 0, 1), c10 = PG8_ROWOFF(cur, 1, 0), c11 = PG8_ROWOFF(cur, 1, 1);
    const char* cB = g.Bt + (size_t)cur.e * g.bstride + (size_t)cur.pn * 2 * hstepB;
    PG8_STAGE_B(PG8_SB(0, 0), cB, 0, 0); PG8_STAGE_A(PG8_SA(0, 0), c00, c01, 0); PG8_STAGE_B(PG8_SB(0, 1), cB, 1, 0); PG8_STAGE_A(PG8_SA(0, 1), c10, c11, 0);
    if (wr == 1) PG8_BAR;
    PG8_WAIT_V(4); PG8_BAR;
    PG8_STAGE_B(PG8_SB(1, 0), cB, 0, 1); PG8_STAGE_A(PG8_SA(1, 0), c00, c01, 1); PG8_STAGE_B(PG8_SB(1, 1), cB, 1, 1);
    PG8_WAIT_V(6); PG8_BAR;
    for (;;) {
        const bool has_next = next_unit(g, ui + 1, G, c, nxt);
        unsigned n00 = c00, n01 = c01, n10 = c10, n11 = c11; const char* nB = cB;
        if (has_next) { n00 = PG8_ROWOFF(nxt, 0, 0); n01 = PG8_ROWOFF(nxt, 0, 1); n10 = PG8_ROWOFF(nxt, 1, 0); n11 = PG8_ROWOFF(nxt, 1, 1);
                        nB = g.Bt + (size_t)nxt.e * g.bstride + (size_t)nxt.pn * 2 * hstepB; }
        for (int t = 0; t < nt; t += 2) {
            const bool last = (t == nt - 2);
            const int kt2 = last ? 0 : t + 2, kt3 = kt2 + 1;
            const char* b2 = last ? nB : cB;
            const unsigned s00 = last ? n00 : c00, s01 = last ? n01 : c01, s10 = last ? n10 : c10, s11 = last ? n11 : c11;
            PG8_LDB(B0, 0, 0); PG8_SCHED; PG8_LDA(At, 0, 0); PG8_STAGE_A(PG8_SA(1, 1), c10, c11, t + 1);
            PG8_WAIT_L(8); PG8_BAR; PG8_WAIT_L(0); PG8_MMA(0, 0, At, B0); PG8_BAR; PG8_SCHED;
            PG8_LDB(B1, 0, 1); PG8_STAGE_B(PG8_SB(0, 0), b2, 0, kt2);
            PG8_BAR; PG8_WAIT_L(0); PG8_MMA(0, 1, At, B1); PG8_BAR;
            PG8_LDA(At, 0, 1); PG8_STAGE_A(PG8_SA(0, 0), s00, s01, kt2);
            PG8_BAR; PG8_WAIT_L(0); PG8_MMA(1, 0, At, B0); PG8_BAR; PG8_SCHED;
            PG8_STAGE_B(PG8_SB(0, 1), b2, 1, kt2);
            PG8_WAIT_V(6); PG8_BAR; PG8_MMA(1, 1, At, B1); PG8_BAR;
            PG8_LDB(B0, 1, 0); PG8_SCHED; PG8_LDA(At, 1, 0); PG8_STAGE_A(PG8_SA(0, 1), s10, s11, kt2);
            PG8_WAIT_L(8); PG8_BAR; PG8_WAIT_L(0); PG8_MMA(0, 0, At, B0); PG8_BAR; PG8_SCHED;
            PG8_LDB(B1, 1, 1); PG8_STAGE_B(PG8_SB(1, 0), b2, 0, kt3);
            PG8_BAR; PG8_WAIT_L(0); PG8_MMA(0, 1, At, B1); PG8_BAR;
            PG8_LDA(At, 1, 1); PG8_STAGE_A(PG8_SA(1, 0), s00, s01, kt3);
            PG8_BAR; PG8_WAIT_L(0); PG8_MMA(1, 0, At, B0); PG8_BAR; PG8_SCHED;
            PG8_STAGE_B(PG8_SB(1, 1), b2, 1, kt3);
            PG8_WAIT_V(6); PG8_BAR; PG8_MMA(1, 1, At, B1); PG8_BAR;
        }
        E(acc, cur, wr, wc, fr, fq);
        if (!has_next) break;
#pragma unroll
        for (int a = 0; a < 2; ++a)
#pragma unroll
            for (int b = 0; b < 2; ++b)
#pragma unroll
                for (int m = 0; m < 4; ++m)
#pragma unroll
                    for (int n = 0; n < 2; ++n) acc[a][b][m][n] = (f32x4){0.f, 0.f, 0.f, 0.f};
        cur = nxt; cB = nB; c00 = n00; c01 = n01; c10 = n10; c11 = n11; ++ui;
    }
    PG8_WAIT_V(0);
    if (wr == 0) PG8_BAR;
    PG8_BAR;
#undef PG8_SA
#undef PG8_SB
#undef PG8_GLDS
#undef PG8_STAGE_A
#undef PG8_STAGE_B
#undef PG8_LDA
#undef PG8_LDB
#undef PG8_MMA
#undef PG8_WAIT_V
#undef PG8_WAIT_L
#undef PG8_BAR
#undef PG8_SCHED
#undef PG8_ROWOFF
}

struct EpiProj0 {
    static constexpr bool PERM = true;
    bf16_t* proj; float* afb;
    __device__ __forceinline__ void operator()(const f32x4 (&acc)[2][2][4][2], const Unit& u, int wr, int wc, int fr, int fq) const {
        const int row0 = u.pm * BM + wr * 64 + fr;
        if (u.pn < 12) {
            const float sc = (u.pn < 2) ? 0.08838834764831845f : 1.f;
            const int col0 = u.pn * BM + wc * 32 + 8 * fq;
#pragma unroll
            for (int ai = 0; ai < 2; ++ai)
#pragma unroll
                for (int m = 0; m < 4; ++m) { bf16_t* rowp = proj + (size_t)(row0 + ai * HALF + m * 16) * NIN0P + col0;
#pragma unroll
                    for (int bj = 0; bj < 2; ++bj) { const f32x4 v0 = acc[ai][bj][m][0] * sc, v1 = acc[ai][bj][m][1] * sc;
                        u32x4 w; w.x = cvt_pk_bf16(v0[0], v0[1]); w.y = cvt_pk_bf16(v0[2], v0[3]); w.z = cvt_pk_bf16(v1[0], v1[1]); w.w = cvt_pk_bf16(v1[2], v1[3]);
                        *(u32x4*)(rowp + bj * HALF) = w; } }
        } else if (wc == 0) {
#pragma unroll
            for (int ai = 0; ai < 2; ++ai)
#pragma unroll
                for (int m = 0; m < 4; ++m) { float* rowp = afb + (size_t)(row0 + ai * HALF + m * 16) * 32 + 8 * fq;
                    *(f32x4*)(rowp) = acc[ai][0][m][0]; *(f32x4*)(rowp + 4) = acc[ai][0][m][1]; }
        }
    }
};
struct EpiResid {
    static constexpr bool PERM = false;
    const float* src; float* dst; const float* gate;
    __device__ __forceinline__ void operator()(const f32x4 (&acc)[2][2][4][2], const Unit& u, int wr, int wc, int fr, int fq) const {
        const int row0 = u.pm * BM + wr * 64 + fr, col0 = u.pn * BM + wc * 32 + 4 * fq;
        const int b = (u.pm * BM) >> 14;
        f32x4 gv[2][2];
#pragma unroll
        for (int bj = 0; bj < 2; ++bj)
#pragma unroll
            for (int n = 0; n < 2; ++n) gv[bj][n] = *(const f32x4*)(gate + (size_t)b * 6 * D + col0 + bj * HALF + n * 16);
#pragma unroll
        for (int ai = 0; ai < 2; ++ai)
#pragma unroll
            for (int m = 0; m < 4; ++m) { const size_t ro = (size_t)(row0 + ai * HALF + m * 16) * D + col0;
#pragma unroll
                for (int bj = 0; bj < 2; ++bj)
#pragma unroll
                    for (int n = 0; n < 2; ++n) { const f32x4 s = *(const f32x4*)(src + ro + bj * HALF + n * 16);
                        *(f32x4*)(dst + ro + bj * HALF + n * 16) = s + gv[bj][n] * acc[ai][bj][m][n]; } }
    }
};
struct EpiBf16Plain {
    static constexpr bool PERM = true;
    bf16_t* O; int ldc;
    __device__ __forceinline__ void operator()(const f32x4 (&acc)[2][2][4][2], const Unit& u, int wr, int wc, int fr, int fq) const {
        const int row0 = u.pm * BM + wr * 64 + fr, col0 = u.pn * BM + wc * 32 + 8 * fq;
#pragma unroll
        for (int ai = 0; ai < 2; ++ai)
#pragma unroll
            for (int m = 0; m < 4; ++m) { bf16_t* rowp = O + (size_t)(row0 + ai * HALF + m * 16) * ldc + col0;
#pragma unroll
                for (int bj = 0; bj < 2; ++bj) { const f32x4 v0 = acc[ai][bj][m][0], v1 = acc[ai][bj][m][1];
                    u32x4 w; w.x = cvt_pk_bf16(v0[0], v0[1]); w.y = cvt_pk_bf16(v0[2], v0[3]); w.z = cvt_pk_bf16(v1[0], v1[1]); w.w = cvt_pk_bf16(v1[2], v1[3]);
                    *(u32x4*)(rowp + bj * HALF) = w; } }
    }
};
struct EpiSwiglu {
    static constexpr bool PERM = true;
    bf16_t* hid;
    __device__ __forceinline__ void operator()(const f32x4 (&acc)[2][2][4][2], const Unit& u, int wr, int wc, int fr, int fq) const {
        const int row0 = u.e * 4096 + u.pm * BM + wr * 64 + fr, col0 = u.pn * HALF + wc * 32 + 8 * fq;
#pragma unroll
        for (int ai = 0; ai < 2; ++ai)
#pragma unroll
            for (int m = 0; m < 4; ++m) { bf16_t* rowp = hid + (size_t)(row0 + ai * HALF + m * 16) * DEXP + col0;
                float h[8];
#pragma unroll
                for (int n = 0; n < 2; ++n)
#pragma unroll
                    for (int j = 0; j < 4; ++j) { const float gt = acc[ai][0][m][n][j], up = acc[ai][1][m][n][j]; h[n * 4 + j] = gt * up * __builtin_amdgcn_rcpf(1.f + __expf(-gt)); }
                u32x4 w; w.x = cvt_pk_bf16(h[0], h[1]); w.y = cvt_pk_bf16(h[2], h[3]); w.z = cvt_pk_bf16(h[4], h[5]); w.w = cvt_pk_bf16(h[6], h[7]);
                *(u32x4*)(rowp) = w; }
    }
};
struct EpiDown {
    static constexpr bool PERM = true;
    bf16_t* ye; const float* val;
    __device__ __forceinline__ void operator()(const f32x4 (&acc)[2][2][4][2], const Unit& u, int wr, int wc, int fr, int fq) const {
        const int row0 = u.e * 4096 + u.pm * BM + wr * 64 + fr, col0 = u.pn * BM + wc * 32 + 8 * fq;
#pragma unroll
        for (int ai = 0; ai < 2; ++ai)
#pragma unroll
            for (int m = 0; m < 4; ++m) { const int row = row0 + ai * HALF + m * 16; const float s = val[row]; bf16_t* rowp = ye + (size_t)row * D + col0;
#pragma unroll
                for (int bj = 0; bj < 2; ++bj) { const f32x4 v0 = acc[ai][bj][m][0] * s, v1 = acc[ai][bj][m][1] * s;
                    u32x4 w; w.x = cvt_pk_bf16(v0[0], v0[1]); w.y = cvt_pk_bf16(v0[2], v0[3]); w.z = cvt_pk_bf16(v1[0], v1[1]); w.w = cvt_pk_bf16(v1[2], v1[3]);
                    *(u32x4*)(rowp + bj * HALF) = w; } }
    }
};
}

constexpr int RING_BYTES = 131072, LDS_BYTES = 147456;
struct Args { const float* in[20]; float* out; unsigned char* ws; int ph_lo, ph_hi; };
struct Frame {
    LAS unsigned char* lds;
    int tid, lane, wave, gw, ngw, G;
    const float* in[20]; float* out; unsigned char* ws;
};
#define P_X 0
#define P_C 1
#define P_CTX 2
#define P_CCTX 3
#define P_ADAW 4
#define P_ADAB 5
#define P_NORMG 6
#define P_GWIN 7
#define P_GWA2 8
#define P_GBA2 9
#define P_GNORMG 10
#define P_GWOUT 11
#define P_CWIN 12
#define P_CK 13
#define P_CWOUT 14
#define P_ROUTER 15
#define P_EGATE 16
#define P_EUP 17
#define P_EDOWN 18
#define P_FINALG 19

__device__ __forceinline__ void tr_item(const float* W, int ldw, int k0, int n0, bf16_t* WT, int ldo, int drow0, LAS float* scr, int lane) {
#pragma unroll 8
    for (int i = 0; i < 32; ++i) { const int kk = 2 * i + (lane >> 5); scr[kk * 33 + (lane & 31)] = W[(size_t)(k0 + kk) * ldw + n0 + (lane & 31)]; }
    LDS_WAIT(); asm volatile("" ::: "memory");
    const int c = lane & 7;
#pragma unroll
    for (int j = 0; j < 4; ++j) { const int n = (lane >> 3) + 8 * j; const LAS float* s = scr + (8 * c) * 33 + n;
        u32x4 o; o.x = pk2(s[0 * 33], s[1 * 33]); o.y = pk2(s[2 * 33], s[3 * 33]); o.z = pk2(s[4 * 33], s[5 * 33]); o.w = pk2(s[6 * 33], s[7 * 33]);
        *(u32x4*)(WT + (size_t)(drow0 + n) * ldo + k0 + 8 * c) = o; }
    LDS_WAIT(); asm volatile("" ::: "memory");
}
__device__ __forceinline__ void tr_plain(Frame& F, const float* W, int K, int N, bf16_t* WT, int item, LAS float* scr) {
    const int nblk = N / 32, kb = item / nblk, nb = item % nblk;
    tr_item(W, N, 64 * kb, 32 * nb, WT, K, 32 * nb, scr, F.lane);
}
__device__ __forceinline__ void convert_experts(Frame& F, int l) {
    LAS float* scr = (LAS float*)(F.lds + F.wave * 16384);
    bf16_t* wgu = (bf16_t*)(F.ws + WS_WGU); bf16_t* wd = (bf16_t*)(F.ws + WS_WD);
    constexpr int I_G = (D / 64) * (DEXP / 32);
    constexpr int I_D = (DEXP / 64) * (D / 32);
    constexpr int PER_E = 2 * I_G + I_D;
    for (int it = F.gw; it < NE * PER_E; it += F.ngw) {
        const int e = it / PER_E; int r = it % PER_E;
        if (r < 2 * I_G) {
            const int up = r / I_G; r %= I_G;
            const float* W = F.in[up ? P_EUP : P_EGATE] + ((size_t)l * NE + e) * D * DEXP;
            const int nblk = DEXP / 32, kb = r / nblk, nb = r % nblk, h0 = 32 * nb;
            const int drow = 256 * (h0 / 128) + (h0 % 128) + 128 * up;
            tr_item(W, DEXP, 64 * kb, h0, wgu + (size_t)e * 4096 * D, D, drow, scr, F.lane);
        } else {
            r -= 2 * I_G;
            const float* W = F.in[P_EDOWN] + ((size_t)l * NE + e) * DEXP * D;
            const int nblk = D / 32, kb = r / nblk, nb = r % nblk;
            tr_item(W, D, 64 * kb, 32 * nb, wd + (size_t)e * D * DEXP, DEXP, 32 * nb, scr, F.lane);
        }
    }
}

__device__ __forceinline__ void ph_prep(Frame& F) {
    LAS float* scr = (LAS float*)(F.lds + F.wave * 16384);
    bf16_t* win0 = (bf16_t*)(F.ws + WS_WIN0T); bf16_t* wout0 = (bf16_t*)(F.ws + WS_WOUT0T); bf16_t* wcin = (bf16_t*)(F.ws + WS_WCINT); bf16_t* wcout = (bf16_t*)(F.ws + WS_WCOUTT);
    {
        float* mod = (float*)(F.ws + WS_MOD);
        for (int it = F.gw; it < 2 * 96; it += F.ngw) {
            const int l = it / 96, n = (it % 96) * 64 + F.lane;
            const float* w = F.in[P_ADAW] + (size_t)l * D * 6 * D + n;
            float a0 = 0.f, a1 = 0.f, a2 = 0.f;
#pragma unroll 8
            for (int k = 0; k < D; ++k) { const float wv = w[(size_t)k * 6 * D];
                a0 += silu_f(F.in[P_C][k]) * wv; a1 += silu_f(F.in[P_C][D + k]) * wv; a2 += silu_f(F.in[P_CCTX][k]) * wv; }
            const float bb = F.in[P_ADAB][l * 6 * D + n];
            mod[(l * 3 + 0) * 6 * D + n] = a0 + bb; mod[(l * 3 + 1) * 6 * D + n] = a1 + bb; mod[(l * 3 + 2) * 6 * D + n] = a2 + bb;
        }
    }
    constexpr int I0 = (D / 64) * (NIN0 / 32), I1 = (D / 64) * (D / 32), I2 = (D / 64) * (NCIN / 32), I3 = I1;
    for (int it = F.gw; it < I0 + I1 + I2 + I3; it += F.ngw) {
        int r = it;
        if (r < I0) { tr_plain(F, F.in[P_GWIN], D, NIN0, win0, r, scr); continue; } r -= I0;
        if (r < I1) { tr_plain(F, F.in[P_GWOUT], D, D, wout0, r, scr); continue; } r -= I1;
        if (r < I2) { tr_plain(F, F.in[P_CWIN], D, NCIN, wcin, r, scr); continue; } r -= I2;
        tr_plain(F, F.in[P_CWOUT], D, D, wcout, r, scr);
    }
    { u32x4* z = (u32x4*)(win0 + (size_t)NIN0 * D); const int n16 = (NIN0P - NIN0) * D * 2 / 16;
      for (int i = F.gw * 64 + F.lane; i < n16; i += F.ngw * 64) z[i] = (u32x4){0u, 0u, 0u, 0u}; }
    convert_experts(F, 0);
}

__device__ __forceinline__ void normmod_row(const f32x4 (&v)[4], const float* g, const float* sh, const float* sc, bf16_t* orow, int lane) {
    float s = 0.f;
#pragma unroll
    for (int j = 0; j < 4; ++j) s += (v[j].x * v[j].x + v[j].y * v[j].y) + (v[j].z * v[j].z + v[j].w * v[j].w);
    const float rstd = rsqrtf(wave_sum(s) * (1.f / D) + EPS);
#pragma unroll
    for (int j = 0; j < 4; ++j) { const int c = 4 * lane + 256 * j;
        const f32x4 gg = *(const f32x4*)(g + c), s1 = *(const f32x4*)(sh + c), s2 = *(const f32x4*)(sc + c);
        const f32x4 y = v[j] * rstd * gg * (s2 + 1.f) + s1;
        u32x2 w; w.x = pk2(y.x, y.y); w.y = pk2(y.z, y.w);
        *(u32x2*)(orow + c) = w; }
}
__device__ __forceinline__ void ph_norm0(Frame& F) {
    const float* mod = (const float*)(F.ws + WS_MOD); bf16_t* H = (bf16_t*)(F.ws + WS_H);
    for (int row = F.gw; row < NROW; row += F.ngw) {
        const float* xr = row < NLAT ? F.in[P_X] + (size_t)row * D : F.in[P_CTX] + (size_t)(row - NLAT) * D;
        const int s = row < NLAT ? (row >> 14) : 2;
        f32x4 v[4];
#pragma unroll
        for (int j = 0; j < 4; ++j) v[j] = *(const f32x4*)(xr + 4 * F.lane + 256 * j);
        normmod_row(v, F.in[P_NORMG] + 0 * D, mod + (0 * 3 + s) * 6 * D + 0 * D, mod + (0 * 3 + s) * 6 * D + 1 * D, H + (size_t)row * D, F.lane);
    }
}

__device__ __forceinline__ void ph_gates(Frame& F) {
    LAS float* w = (LAS float*)F.lds;
    for (int i = F.tid; i < 2 * 16 * 512; i += NTHR) w[i] = F.in[P_GWA2][i];
    __syncthreads();
    const float* afb = (const float*)(F.ws + WS_AFB);
    for (int row = F.gw; row < NROW; row += F.ngw) {
        const float* ar = afb + (size_t)row * 32;
#pragma unroll 1
        for (int dir = 0; dir < 2; ++dir) {
            float* dst = (float*)(F.ws + (dir ? WS_DECB : WS_DECF)) + (size_t)row * DK;
            float a[16];
#pragma unroll
            for (int r = 0; r < 16; ++r) a[r] = ar[dir * 16 + r];
#pragma unroll 1
            for (int j = 0; j < 2; ++j) {
                const int c = 4 * F.lane + 256 * j;
                f32x4 z = *(const f32x4*)(F.in[P_GBA2] + dir * DK + c);
#pragma unroll
                for (int r = 0; r < 16; ++r) z += *(const LAS f32x4*)(w + (dir * 16 + r) * 512 + c) * a[r];
                f32x4 o;
#pragma unroll
                for (int i = 0; i < 4; ++i) { const float zz = z[i]; const float ls = fminf(zz, 0.f) - log1pf(__expf(-fabsf(zz))); o[i] = __expf(ls * (1.f / 16.f)); }
                *(f32x4*)(dst + c) = o;
            }
        }
    }
    __syncthreads();
}

__device__ __forceinline__ void ph_gla_naive(Frame& F) {
    const bf16_t* proj = (const bf16_t*)(F.ws + WS_PROJ);
    const int c = F.lane & 1, dg = F.lane >> 1;
    for (int it = F.gw; it < 16 * 128; it += F.ngw) {
        const int chain = it >> 7, cp = it & 127, b = chain >> 3, h = (chain >> 1) & 3, dir = chain & 1;
        const float* dec = (const float*)(F.ws + (dir ? WS_DECB : WS_DECF));
        bf16_t* O = (bf16_t*)(F.ws + (dir ? WS_OB : WS_OF));
        const int col = h * HV + cp * 2 + c;
        float S0 = 0.f, S1 = 0.f, S2 = 0.f, S3 = 0.f;
        for (int step0 = 0; step0 < CTXL + T; step0 += 8) {
            const bool lat = step0 >= CTXL;
            f32x4 a[8]; u32x2 qq[8], kk[8]; float v[8]; int rows[8];
#pragma unroll
            for (int u = 0; u < 8; ++u) {
                const int step = step0 + u;
                const int row = lat ? (b * T + (dir ? (T - 1 - (step - CTXL)) : (step - CTXL))) : (NLAT + b * CTXL + (dir ? (CTXL - 1 - step) : step));
                rows[u] = row;
                a[u] = *(const f32x4*)(dec + (size_t)row * DK + h * HK + 4 * dg);
                qq[u] = *(const u32x2*)(proj + (size_t)row * NIN0P + h * HK + 4 * dg);
                kk[u] = *(const u32x2*)(proj + (size_t)row * NIN0P + DK + h * HK + 4 * dg);
                v[u] = bflo((unsigned)proj[(size_t)row * NIN0P + 2 * DK + col]);
            }
#pragma unroll
            for (int u = 0; u < 8; ++u) {
                S0 = a[u].x * S0 + bflo(kk[u].x) * v[u]; S1 = a[u].y * S1 + bfhi(kk[u].x) * v[u]; S2 = a[u].z * S2 + bflo(kk[u].y) * v[u]; S3 = a[u].w * S3 + bfhi(kk[u].y) * v[u];
                if (lat) {
                    float o = (bflo(qq[u].x) * S0 + bfhi(qq[u].x) * S1) + (bflo(qq[u].y) * S2 + bfhi(qq[u].y) * S3);
#pragma unroll
                    for (int m = 2; m < 64; m <<= 1) o += __shfl_xor(o, m);
                    if (dg == 0) O[(size_t)rows[u] * DV + col] = (bf16_t)f2bf(o);
                }
            }
        }
    }
}

__device__ __forceinline__ void ph_gla_finish(Frame& F) {
    const bf16_t* proj = (const bf16_t*)(F.ws + WS_PROJ); const bf16_t* OFp = (const bf16_t*)(F.ws + WS_OF); const bf16_t* OBp = (const bf16_t*)(F.ws + WS_OB);
    bf16_t* Hh = (bf16_t*)(F.ws + WS_H);
    const f32x4 gn = *(const f32x4*)(F.in[P_GNORMG] + 4 * F.lane);
    for (int row = F.gw; row < NLAT; row += F.ngw) {
#pragma unroll
        for (int j = 0; j < 4; ++j) {
            const int cc = 4 * F.lane + 256 * j;
            const u32x2 a = *(const u32x2*)(OFp + (size_t)row * DV + cc), bq = *(const u32x2*)(OBp + (size_t)row * DV + cc);
            const u32x2 rr = *(const u32x2*)(proj + (size_t)row * NIN0P + 2 * DK + DV + cc);
            f32x4 o; o.x = bflo(a.x) + bflo(bq.x); o.y = bfhi(a.x) + bfhi(bq.x); o.z = bflo(a.y) + bflo(bq.y); o.w = bfhi(a.y) + bfhi(bq.y);
            const float ss = wave_sum((o.x * o.x + o.y * o.y) + (o.z * o.z + o.w * o.w));
            const float rstd = rsqrtf(ss * (1.f / HV) + EPS);
            f32x4 r; r.x = bflo(rr.x); r.y = bfhi(rr.x); r.z = bflo(rr.y); r.w = bfhi(rr.y);
            f32x4 y;
#pragma unroll
            for (int i = 0; i < 4; ++i) y[i] = o[i] * rstd * gn[i] * silu_f(r[i]);
            u32x2 w; w.x = pk2(y.x, y.y); w.y = pk2(y.z, y.w);
            *(u32x2*)(Hh + (size_t)row * D + cc) = w;
        }
    }
}

__device__ __forceinline__ void router_row(Frame& F, const f32x4 (&hv)[4], const LAS float* wl, float* aff, int b, int t) {
    float p[16];
#pragma unroll
    for (int e = 0; e < 16; ++e) p[e] = 0.f;
#pragma unroll
    for (int j = 0; j < 4; ++j)
#pragma unroll
        for (int i = 0; i < 4; ++i) { const LAS f32x4* wp = (const LAS f32x4*)(wl + ((j * 4 + i) * 64 + F.lane) * 16); const float x = hv[j][i];
            asm volatile("" ::: "memory");
#pragma unroll
            for (int q = 0; q < 4; ++q) { const f32x4 wv = wp[q]; p[4 * q + 0] += x * wv.x; p[4 * q + 1] += x * wv.y; p[4 * q + 2] += x * wv.z; p[4 * q + 3] += x * wv.w; } }
    float mx = -3.0e38f;
#pragma unroll
    for (int e = 0; e < 16; ++e) { p[e] = wave_sum(p[e]); mx = fmaxf(mx, p[e]); }
    float den = 0.f, mine = 0.f;
#pragma unroll
    for (int e = 0; e < 16; ++e) { const float ex = __expf(p[e] - mx); den += ex; mine = (F.lane == e) ? ex : mine; }
    if (F.lane < 16) aff[((size_t)b * NE + F.lane) * T + t] = mine / den;
}
__device__ __forceinline__ void stage_router(Frame& F, int l) {
    LAS float* wl = (LAS float*)F.lds;
    const float* rw = F.in[P_ROUTER] + (size_t)l * D * NE;
    for (int idx = F.tid; idx < D * NE; idx += NTHR) { const int k = idx >> 4, e = idx & 15, j = k >> 8, ln = (k & 255) >> 2, i = k & 3; wl[((j * 4 + i) * 64 + ln) * 16 + e] = rw[idx]; }
    __syncthreads();
}
__device__ __forceinline__ void ph_norm2_router(Frame& F, int l) {
    stage_router(F, l);
    const float* mod = (const float*)(F.ws + WS_MOD); bf16_t* H = (bf16_t*)(F.ws + WS_H); const float* X = (const float*)(F.ws + WS_X); float* aff = (float*)(F.ws + WS_AFF);
    const float* g = F.in[P_NORMG] + (l * 2 + 1) * D;
    for (int row = F.gw; row < NLAT; row += F.ngw) {
        const int b = row >> 14; const float* sh = mod + (l * 3 + b) * 6 * D + 3 * D; const float* sc = mod + (l * 3 + b) * 6 * D + 4 * D;
        f32x4 v[4]; float s = 0.f;
#pragma unroll
        for (int j = 0; j < 4; ++j) { v[j] = *(const f32x4*)(X + (size_t)row * D + 4 * F.lane + 256 * j); s += (v[j].x * v[j].x + v[j].y * v[j].y) + (v[j].z * v[j].z + v[j].w * v[j].w); }
        const float rstd = rsqrtf(wave_sum(s) * (1.f / D) + EPS);
#pragma unroll
        for (int j = 0; j < 4; ++j) { const int c = 4 * F.lane + 256 * j;
            const f32x4 gg = *(const f32x4*)(g + c), s1 = *(const f32x4*)(sh + c), s2 = *(const f32x4*)(sc + c);
            v[j] = v[j] * rstd * gg * (s2 + 1.f) + s1;
            u32x2 w; w.x = pk2(v[j].x, v[j].y); w.y = pk2(v[j].z, v[j].w);
            *(u32x2*)(H + (size_t)row * D + c) = w; }
        router_row(F, v, (const LAS float*)F.lds, aff, b, row & (T - 1));
    }
    __syncthreads();
}

__device__ __forceinline__ void ph_topk(Frame& F) {
    LAS int* red = (LAS int*)F.lds;
    const float* aff = (const float*)(F.ws + WS_AFF); int* slot = (int*)(F.ws + WS_SLOT); int* rowlist = (int*)(F.ws + WS_ROWLIST); float* selval = (float*)(F.ws + WS_SELVAL);
    for (int item = blockIdx.x; item < NB * NE; item += F.G) {
        const int b = item / NE, e = item % NE;
        const float* a = aff + ((size_t)b * NE + e) * T + F.tid * 32;
        unsigned v[32];
#pragma unroll
        for (int q = 0; q < 8; ++q) { const u32x4 x = *(const u32x4*)(a + 4 * q); v[4 * q] = x.x; v[4 * q + 1] = x.y; v[4 * q + 2] = x.z; v[4 * q + 3] = x.w; }
        unsigned prefix = 0u; int par = 0;
        for (int bit = 30; bit >= 0; --bit) {
            const unsigned cand = prefix | (1u << bit); int cnt = 0;
#pragma unroll
            for (int i = 0; i < 32; ++i) cnt += (v[i] >= cand) ? 1 : 0;
            cnt = wave_sum_i(cnt);
            if (F.lane == 0) red[par * 16 + F.wave] = cnt;
            __syncthreads();
            int tot = 0;
#pragma unroll
            for (int w8 = 0; w8 < 8; ++w8) tot += red[par * 16 + w8];
            if (tot >= CAP) prefix = cand;
            par ^= 1;
        }
        __syncthreads();
        int mgt = 0, meq = 0;
#pragma unroll
        for (int i = 0; i < 32; ++i) { mgt += (v[i] > prefix) ? 1 : 0; meq += (v[i] == prefix) ? 1 : 0; }
        int igt = mgt, ieq = meq;
#pragma unroll
        for (int o = 1; o < 64; o <<= 1) { const int ug = __shfl_up(igt, o), ue = __shfl_up(ieq, o); if (F.lane >= o) { igt += ug; ieq += ue; } }
        if (F.lane == 63) { red[F.wave] = igt; red[16 + F.wave] = ieq; }
        __syncthreads();
        int bgt = 0, beq = 0, totgt = 0;
#pragma unroll
        for (int w8 = 0; w8 < 8; ++w8) { const int xg = red[w8], xe = red[16 + w8]; if (w8 < F.wave) { bgt += xg; beq += xe; } totgt += xg; }
        const int need_eq = CAP - totgt;
        int gtb = bgt + igt - mgt, eqb = beq + ieq - meq;
        const int t0 = F.tid * 32;
#pragma unroll
        for (int q = 0; q < 2; ++q) {
            int sl[16];
#pragma unroll
            for (int i = 0; i < 16; ++i) {
                const unsigned x = v[q * 16 + i]; const bool gt = x > prefix, eq = x == prefix; const bool sel = gt || (eq && eqb < need_eq);
                const int pos = gtb + (eqb < need_eq ? eqb : need_eq);
                sl[i] = sel ? pos : -1;
                if (sel) { rowlist[e * 4096 + b * CAP + pos] = b * T + t0 + q * 16 + i; selval[e * 4096 + b * CAP + pos] = __builtin_bit_cast(float, x); }
                gtb += gt ? 1 : 0; eqb += eq ? 1 : 0;
            }
#pragma unroll
            for (int i = 0; i < 16; ++i) slot[((size_t)b * T + t0 + q * 16 + i) * NE + e] = sl[i];
        }
        __syncthreads();
    }
}

__device__ __forceinline__ void ph_combine(Frame& F, int l) {
    const float* mod = (const float*)(F.ws + WS_MOD); float* X = (float*)(F.ws + WS_X); bf16_t* H = (bf16_t*)(F.ws + WS_H);
    const int* slot = (const int*)(F.ws + WS_SLOT); const bf16_t* ye = (const bf16_t*)(F.ws + WS_YE);
    for (int row = F.gw; row < NLAT; row += F.ngw) {
        const int b = row >> 14;
        const int sv = (F.lane < 16) ? slot[(size_t)row * NE + F.lane] : -1;
        f32x4 acc[4];
#pragma unroll
        for (int j = 0; j < 4; ++j) acc[j] = (f32x4){0.f, 0.f, 0.f, 0.f};
        for (int e = 0; e < NE; ++e) {
            const int s = __builtin_amdgcn_readlane(sv, e);
            if (s >= 0) {
                const bf16_t* yr = ye + ((size_t)e * 4096 + b * CAP + s) * D + 4 * F.lane;
#pragma unroll
                for (int j = 0; j < 4; ++j) { const u32x2 y = *(const u32x2*)(yr + 256 * j); acc[j].x += bflo(y.x); acc[j].y += bfhi(y.x); acc[j].z += bflo(y.y); acc[j].w += bfhi(y.y); }
            }
        }
        const float* g2 = mod + (l * 3 + b) * 6 * D + 5 * D;
        f32x4 v[4];
#pragma unroll
        for (int j = 0; j < 4; ++j) { const int c = 4 * F.lane + 256 * j; v[j] = *(const f32x4*)(X + (size_t)row * D + c) + *(const f32x4*)(g2 + c) * acc[j]; }
        if (l == 0) {
#pragma unroll
            for (int j = 0; j < 4; ++j) *(f32x4*)(X + (size_t)row * D + 4 * F.lane + 256 * j) = v[j];
            normmod_row(v, F.in[P_NORMG] + (1 * 2 + 0) * D, mod + (1 * 3 + b) * 6 * D + 0 * D, mod + (1 * 3 + b) * 6 * D + 1 * D, H + (size_t)row * D, F.lane);
        } else {
            float s = 0.f;
#pragma unroll
            for (int j = 0; j < 4; ++j) s += (v[j].x * v[j].x + v[j].y * v[j].y) + (v[j].z * v[j].z + v[j].w * v[j].w);
            const float rstd = rsqrtf(wave_sum(s) * (1.f / D) + EPS);
#pragma unroll
            for (int j = 0; j < 4; ++j) { const int c = 4 * F.lane + 256 * j; *(f32x4*)(F.out + (size_t)row * D + c) = v[j] * rstd * *(const f32x4*)(F.in[P_FINALG] + c); }
        }
    }
}

__device__ __forceinline__ void ph_conv(Frame& F) {
    const bf16_t* bcv = (const bf16_t*)(F.ws + WS_BCV); bf16_t* Hh = (bf16_t*)(F.ws + WS_H); const float* ck = F.in[P_CK];
    for (int row = F.gw; row < NLAT; row += F.ngw) {
        const int w = row & 63; const bool hp = w != 0, hn = w != 63;
#pragma unroll
        for (int j = 0; j < 4; ++j) {
            const int c = 4 * F.lane + 256 * j;
            const bf16_t* r0 = bcv + (size_t)row * NCIN;
            const u32x2 bg = *(const u32x2*)(r0 + c), c1 = *(const u32x2*)(r0 + D + c), v1 = *(const u32x2*)(r0 + 2 * D + c);
            u32x2 c0 = (u32x2){0u, 0u}, v0 = c0, c2 = c0, v2 = c0;
            if (hp) { c0 = *(const u32x2*)(r0 - NCIN + D + c); v0 = *(const u32x2*)(r0 - NCIN + 2 * D + c); }
            if (hn) { c2 = *(const u32x2*)(r0 + NCIN + D + c); v2 = *(const u32x2*)(r0 + NCIN + 2 * D + c); }
            const f32x4 k0 = *(const f32x4*)(ck + c), k1 = *(const f32x4*)(ck + D + c), k2 = *(const f32x4*)(ck + 2 * D + c);
            f32x4 y;
            y.x = bflo(bg.x) * (k0.x * bflo(c0.x) * bflo(v0.x) + k1.x * bflo(c1.x) * bflo(v1.x) + k2.x * bflo(c2.x) * bflo(v2.x));
            y.y = bfhi(bg.x) * (k0.y * bfhi(c0.x) * bfhi(v0.x) + k1.y * bfhi(c1.x) * bfhi(v1.x) + k2.y * bfhi(c2.x) * bfhi(v2.x));
            y.z = bflo(bg.y) * (k0.z * bflo(c0.y) * bflo(v0.y) + k1.z * bflo(c1.y) * bflo(v1.y) + k2.z * bflo(c2.y) * bflo(v2.y));
            y.w = bfhi(bg.y) * (k0.w * bfhi(c0.y) * bfhi(v0.y) + k1.w * bfhi(c1.y) * bfhi(v1.y) + k2.w * bfhi(c2.y) * bfhi(v2.y));
            u32x2 wv; wv.x = pk2(y.x, y.y); wv.y = pk2(y.z, y.w);
            *(u32x2*)(Hh + (size_t)row * D + c) = wv;
        }
    }
}

constexpr int N_PHASES = 20;
__global__ void __launch_bounds__(NTHR, 2) fwd_kernel(Args args) {
    extern __shared__ __attribute__((aligned(16))) unsigned char lds_raw[];
    Frame F;
    F.lds = (LAS unsigned char*)lds_raw;
    F.tid = threadIdx.x; F.lane = F.tid & 63; F.wave = __builtin_amdgcn_readfirstlane(F.tid >> 6);
    F.G = gridDim.x; F.gw = blockIdx.x * NWAVES + F.wave; F.ngw = F.G * NWAVES;
#pragma unroll
    for (int i = 0; i < 20; ++i) F.in[i] = args.in[i];
    F.out = args.out; F.ws = args.ws;
    const int lo = args.ph_lo, hi = args.ph_hi;
#ifdef ONLY_PH
#define IN(k) ((k) == ONLY_PH && lo <= (k) && (k) < hi)
#else
#define IN(k) (lo <= (k) && (k) < hi)
#endif
#if MK_MULTI
#define SEAM(k) do { } while (0)
#else
    cg::grid_group grid = cg::this_grid();
#define SEAM(k) do { if (IN(k) && IN((k) + 1)) { __threadfence(); grid.sync(); } } while (0)
#endif
    const int c = blockIdx.x;
    bf16_t* H = (bf16_t*)(F.ws + WS_H); float* X = (float*)(F.ws + WS_X); const float* mod = (const float*)(F.ws + WS_MOD);

    if (IN(0)) ph_prep(F);
    SEAM(0);
    if (IN(1)) ph_norm0(F);
    SEAM(1);
    if (IN(2)) { eng::Gemm g{(const char*)H, (const char*)(F.ws + WS_WIN0T), nullptr, 0, D, NROW / 256, NIN0P / 256, 1};
        eng::EpiProj0 E{(bf16_t*)(F.ws + WS_PROJ), (float*)(F.ws + WS_AFB)}; eng::gemm_phase(F.lds, g, E, F.G, c); }
    SEAM(2);
    if (IN(3)) ph_gates(F);
    SEAM(3);
    if (IN(4)) ph_gla_naive(F);
    SEAM(4);
    if (IN(5)) ph_gla_finish(F);
    SEAM(5);
    if (IN(6)) { eng::Gemm g{(const char*)H, (const char*)(F.ws + WS_WOUT0T), nullptr, 0, D, NLAT / 256, D / 256, 1};
        eng::EpiResid E{F.in[P_X], X, mod + (0 * 3) * 6 * D + 2 * D}; eng::gemm_phase(F.lds, g, E, F.G, c); }
    SEAM(6);
    if (IN(7)) ph_norm2_router(F, 0);
    SEAM(7);
    if (IN(8)) ph_topk(F);
    SEAM(8);
    if (IN(9)) { eng::Gemm g{(const char*)H, (const char*)(F.ws + WS_WGU), (const int*)(F.ws + WS_ROWLIST), (size_t)4096 * D * 2, D, 16, 16, NE};
        eng::EpiSwiglu E{(bf16_t*)(F.ws + WS_HID)}; eng::gemm_phase(F.lds, g, E, F.G, c); }
    SEAM(9);
    if (IN(10)) { eng::Gemm g{(const char*)(F.ws + WS_HID), (const char*)(F.ws + WS_WD), nullptr, (size_t)D * DEXP * 2, DEXP, 16, 4, NE};
        eng::EpiDown E{(bf16_t*)(F.ws + WS_YE), (const float*)(F.ws + WS_SELVAL)}; eng::gemm_phase(F.lds, g, E, F.G, c); }
    SEAM(10);
    if (IN(11)) { ph_combine(F, 0); convert_experts(F, 1); }
    SEAM(11);
    if (IN(12)) { eng::Gemm g{(const char*)H, (const char*)(F.ws + WS_WCINT), nullptr, 0, D, NLAT / 256, NCIN / 256, 1};
        eng::EpiBf16Plain E{(bf16_t*)(F.ws + WS_BCV), NCIN}; eng::gemm_phase(F.lds, g, E, F.G, c); }
    SEAM(12);
    if (IN(13)) ph_conv(F);
    SEAM(13);
    if (IN(14)) { eng::Gemm g{(const char*)H, (const char*)(F.ws + WS_WCOUTT), nullptr, 0, D, NLAT / 256, D / 256, 1};
        eng::EpiResid E{X, X, mod + (1 * 3) * 6 * D + 2 * D}; eng::gemm_phase(F.lds, g, E, F.G, c); }
    SEAM(14);
    if (IN(15)) ph_norm2_router(F, 1);
    SEAM(15);
    if (IN(16)) ph_topk(F);
    SEAM(16);
    if (IN(17)) { eng::Gemm g{(const char*)H, (const char*)(F.ws + WS_WGU), (const int*)(F.ws + WS_ROWLIST), (size_t)4096 * D * 2, D, 16, 16, NE};
        eng::EpiSwiglu E{(bf16_t*)(F.ws + WS_HID)}; eng::gemm_phase(F.lds, g, E, F.G, c); }
    SEAM(17);
    if (IN(18)) { eng::Gemm g{(const char*)(F.ws + WS_HID), (const char*)(F.ws + WS_WD), nullptr, (size_t)D * DEXP * 2, DEXP, 16, 4, NE};
        eng::EpiDown E{(bf16_t*)(F.ws + WS_YE), (const float*)(F.ws + WS_SELVAL)}; eng::gemm_phase(F.lds, g, E, F.G, c); }
    SEAM(18);
    if (IN(19)) ph_combine(F, 1);
#undef IN
#undef SEAM
}

extern "C" void kernel_launch(void* const* d_in, const int* in_sizes, int n_in, void* d_out, int out_size, void* d_ws, size_t ws_size, hipStream_t stream) {
    static int grid = 0;
    if (grid == 0) {
        if (n_in != 20 || in_sizes[0] != NLAT * D || out_size != NLAT * D || ws_size < WS_END) {
            fprintf(stderr, "kernel_launch: unexpected problem: n_in %d in0 %d out %d ws %zu (need %zu)\n", n_in, n_in > 0 ? in_sizes[0] : -1, out_size, ws_size, (size_t)WS_END); grid = -1; return; }
        int dev = 0, cus = 0, per_cu = 0;
        if (hipGetDevice(&dev) != hipSuccess || hipDeviceGetAttribute(&cus, hipDeviceAttributeMultiprocessorCount, dev) != hipSuccess) { grid = -1; return; }
        if (hipFuncSetAttribute((const void*)fwd_kernel, hipFuncAttributeMaxDynamicSharedMemorySize, LDS_BYTES) != hipSuccess) { fprintf(stderr, "kernel_launch: hipFuncSetAttribute failed\n"); grid = -1; return; }
        if (hipOccupancyMaxActiveBlocksPerMultiprocessor(&per_cu, (const void*)fwd_kernel, NTHR, LDS_BYTES) != hipSuccess || per_cu < 1) { fprintf(stderr, "kernel_launch: occupancy query says %d\n", per_cu); per_cu = 1; }
        (void)hipGetLastError();
        grid = cus;
    }
    if (grid < 0) return;
    Args a{};
    for (int i = 0; i < 20; ++i) a.in[i] = (const float*)d_in[i];
    a.out = (float*)d_out; a.ws = (unsigned char*)d_ws;
#if MK_MULTI
    for (int p = 0; p < N_PHASES; ++p) {
        a.ph_lo = p; a.ph_hi = p + 1;
        hipLaunchKernelGGL(fwd_kernel, dim3(grid), dim3(NTHR), LDS_BYTES, stream, a);
    }
#else
    a.ph_lo = 0; a.ph_hi = N_PHASES;
    void* kargs[] = {&a};
    hipError_t e = hipLaunchCooperativeKernel((const void*)fwd_kernel, dim3(grid), dim3(NTHR), kargs, LDS_BYTES, stream);
    if (e != hipSuccess) fprintf(stderr, "kernel_launch: cooperative launch failed: %s (grid %d)\n", hipGetErrorString(e), grid);
#endif
}
```

```cpp
#include <hip/hip_runtime.h>
#include <hip/hip_cooperative_groups.h>
#include <cstdio>
#include <cstdint>
namespace cg = cooperative_groups;

#ifndef MK_MULTI
#define MK_MULTI 0
#endif

#define LAS __attribute__((address_space(3)))
#define GAS __attribute__((address_space(1)))
typedef unsigned short bf16_t;
typedef short bf16x8 __attribute__((ext_vector_type(8)));
typedef float f32x4 __attribute__((ext_vector_type(4)));
typedef float f32x2 __attribute__((ext_vector_type(2)));
typedef unsigned u32x4 __attribute__((ext_vector_type(4)));
typedef unsigned u32x2 __attribute__((ext_vector_type(2)));
typedef int i32x4 __attribute__((ext_vector_type(4)));
typedef int i32x8 __attribute__((ext_vector_type(8)));

constexpr int D = 1024, NB = 2, T = 16384, NLAT = NB * T, CTXL = 256, NCTX = NB * CTXL, NROW = NLAT + NCTX;
constexpr int NE = 16, CAP = 2048, DEXP = 2048;
constexpr int HEADS = 4, HK = 128, HV = 256, DK = 512, DV = 1024, RANK = 16;
constexpr int NIN0 = 3104, NIN0P = 3328;
constexpr int NCIN = 3072;
constexpr float EPS = 1e-6f;
constexpr int NWAVES = 8, NTHR = 512;

constexpr size_t MiB = 1u << 20;
constexpr size_t WS_CTL = 0;
constexpr size_t WS_MOD = 1 * MiB;
constexpr size_t WS_WIN0T = 2 * MiB;
constexpr size_t WS_WOUT0T = 9 * MiB;
constexpr size_t WS_WCINT = 11 * MiB;
constexpr size_t WS_WCOUTT = 17 * MiB;
constexpr size_t WS_AFF = 19 * MiB;
constexpr size_t WS_SLOT = 21 * MiB;
constexpr size_t WS_ROWLIST = 23 * MiB;
constexpr size_t WS_SELVAL = 23 * MiB + 512 * 1024;
constexpr size_t WS_AFB = 24 * MiB;
constexpr size_t WS_W8 = 32 * MiB;
constexpr size_t W8_LAYER = 96 * MiB, W8_WD = 64 * MiB;
constexpr size_t WS_X = 224 * MiB;
constexpr size_t WS_H = 354 * MiB;
constexpr size_t WS_ARENA = 420 * MiB;
constexpr size_t WS_QK = WS_ARENA;
constexpr size_t WS_V = WS_ARENA + 65 * MiB;
constexpr size_t WS_R = WS_ARENA + 130 * MiB;
constexpr size_t WS_QP = WS_ARENA + 195 * MiB;
constexpr size_t WS_KP = WS_ARENA + 260 * MiB;
constexpr size_t WS_KTP = WS_ARENA + 325 * MiB;
constexpr size_t WS_VTP = WS_ARENA + 390 * MiB;
constexpr size_t WS_OI = WS_ARENA + 455 * MiB;
constexpr size_t WS_GAM = WS_ARENA + 519 * MiB;
constexpr size_t WS_OF = WS_QK;
constexpr size_t WS_OB = WS_V;
constexpr size_t WS_HID = WS_ARENA;
constexpr size_t WS_YE = WS_ARENA + 128 * MiB;
constexpr size_t WS_H2 = WS_ARENA;
constexpr size_t WS_CDUMP = WS_ARENA + 64 * MiB;
constexpr size_t WS_END = WS_ARENA + 522 * MiB;
static_assert(WS_R - WS_QK == 130 * MiB, "EpiProj0 strides");
constexpr size_t BLOB = 16384;
constexpr int NCHUNK = NROW / 64;

__device__ __forceinline__ float wave_sum(float v) {
#pragma unroll
    for (int o = 1; o < 64; o <<= 1) v += __shfl_xor(v, o);
    return v;
}
__device__ __forceinline__ int wave_sum_i(int v) {
#pragma unroll
    for (int o = 1; o < 64; o <<= 1) v += __shfl_xor(v, o);
    return v;
}
__device__ __forceinline__ unsigned f2bf(float f) { unsigned u = __builtin_bit_cast(unsigned, f); return (u + 0x7fffu + ((u >> 16) & 1u)) >> 16; }
typedef __bf16 bf16x2_t __attribute__((ext_vector_type(2)));
__device__ __forceinline__ unsigned pk2(float lo, float hi) { const f32x2 v = {lo, hi}; return __builtin_bit_cast(unsigned, __builtin_convertvector(v, bf16x2_t)); }
__device__ __forceinline__ float bflo(unsigned u) { return __builtin_bit_cast(float, u << 16); }
__device__ __forceinline__ float bfhi(unsigned u) { return __builtin_bit_cast(float, u & 0xffff0000u); }
__device__ __forceinline__ float silu_f(float x) { return x / (1.f + __expf(-x)); }
#define LDS_WAIT() asm volatile("s_waitcnt lgkmcnt(0)" ::: "memory")


#define XB_TMO      128
#define XB_XCNT(j)  (256  + 64 * (j))
#define XB_XSUB(j)  (1280 + 64 * (j))
#define XB_XGEN(j)  (2304 + 64 * (j))
#define XB_TOP      3328
#define XB_TOPGEN   3392
#define XCD_BAR_WORDS 3456
#define XB_SPIN_CAP (1u << 22)
__device__ __forceinline__ unsigned xb_ld(unsigned* p)              { return __hip_atomic_load(p, __ATOMIC_RELAXED, __HIP_MEMORY_SCOPE_AGENT); }
__device__ __forceinline__ unsigned xb_add(unsigned* p, unsigned v) { return __hip_atomic_fetch_add(p, v, __ATOMIC_RELAXED, __HIP_MEMORY_SCOPE_AGENT); }
__device__ __forceinline__ unsigned xb_xcc_id() { return (unsigned)__builtin_amdgcn_s_getreg((3 << 11) | 20) & 0xFu; }
#define XB_SPIN(cond, bar) do { unsigned _sp = 0; while (cond) { \
    if ((++_sp & 255u) == 0u) { if (xb_ld(&(bar)[XB_TMO])) break; if (_sp > XB_SPIN_CAP) { atomicAdd(&(bar)[XB_TMO], 1u); break; } } } } while (0)
struct XcdBarrier { unsigned* bar; unsigned x; volatile LAS unsigned* st; };
__device__ __forceinline__ XcdBarrier xcd_barrier_post(unsigned* bar, volatile LAS unsigned* st) {
    XcdBarrier b; b.bar = bar; b.x = xb_xcc_id(); b.st = st;
    if (threadIdx.x == 0) (void)xb_add(&bar[XB_XCNT(b.x)], 1u);
    return b;
}
__device__ __forceinline__ void xcd_barrier_complete(unsigned* bar, unsigned x, unsigned& nloc, unsigned& nx) {
    const unsigned G = gridDim.x * gridDim.y * gridDim.z;
    unsigned sum, cnt, mine, sp = 0u;
    for (;;) {
        sum = 0u; cnt = 0u; mine = 0u;
#pragma unroll
        for (unsigned j = 0; j < 16; ++j) { const unsigned c = xb_ld(&bar[XB_XCNT(j)]); sum += c; cnt += (c > 0u) ? 1u : 0u; mine = (j == x) ? c : mine; }
        if (sum == G) break;
        __builtin_amdgcn_s_sleep(1);
        if ((++sp & 255u) == 0u) { if (xb_ld(&bar[XB_TMO])) break; if (sp > XB_SPIN_CAP) { atomicAdd(&bar[XB_TMO], 1u); break; } }
    }
    nloc = mine > 0u ? mine : 1u; nx = cnt > 0u ? cnt : 1u;
}
__device__ __forceinline__ void xcd_barrier(const XcdBarrier& b) {
    asm volatile("s_waitcnt vmcnt(0)" ::: "memory");
    __syncthreads();
    if (threadIdx.x == 0) {
        unsigned* bar = b.bar;
        __builtin_amdgcn_s_waitcnt(0);
        unsigned nloc = b.st[0], nx = b.st[1];
        if (nloc == 0u) { xcd_barrier_complete(bar, b.x, nloc, nx); b.st[0] = nloc; b.st[1] = nx; }
        const unsigned old = xb_add(&bar[XB_XSUB(b.x)], 1u);
        const unsigned gen = old / nloc;
        if (old + 1u == (gen + 1u) * nloc) {
            __builtin_amdgcn_fence(__ATOMIC_RELEASE, "agent");
            asm volatile("s_waitcnt vmcnt(0)" ::: "memory");
            const unsigned og = xb_add(&bar[XB_TOP], 1u);
            const unsigned tg = og / nx;
            __builtin_amdgcn_fence(__ATOMIC_ACQUIRE, "agent");
            if (og + 1u == (tg + 1u) * nx) xb_add(&bar[XB_TOPGEN], 1u);
            else XB_SPIN(xb_ld(&bar[XB_TOPGEN]) == tg, bar);
            xb_add(&bar[XB_XGEN(b.x)], 1u);
            asm volatile("s_waitcnt vmcnt(0)" ::: "memory");
        } else {
            __builtin_amdgcn_fence(__ATOMIC_ACQUIRE, "agent");
            XB_SPIN(xb_ld(&bar[XB_XGEN(b.x)]) == gen, bar);
            asm volatile("s_waitcnt vmcnt(0)" ::: "memory");
        }
    }
    __syncthreads();
}

namespace eng {
constexpr int BM = 256, BK = 64, HALF = 128, HTB = HALF * BK * 2, STAGE_BYTES = 8 * HTB, NXCD = 8, WGM = 8;
__host__ __device__ __forceinline__ int lds_byte(int r, int c) { const int st = (r >> 4) * 2 + (c >> 5), rr = r & 15, cc = c & 31, ob = rr * 64 + cc * 2; return st * 1024 + (ob ^ (((ob >> 9) & 1) << 5)); }
__host__ __device__ __forceinline__ void stage_rc(int b, int& R, int& C) { const int st = b / 1024, sb = b % 1024, swz = sb ^ (((sb >> 9) & 1) << 5); R = (st >> 1) * 16 + swz / 64; C = (st & 1) * 32 + (swz % 64) / 2; }
__host__ __device__ __forceinline__ int perm32(int rho) { const int n = rho >> 4, i = rho & 15; return 8 * (i >> 2) + 4 * n + (i & 3); }

struct Unit { int e, pm, pn; };
struct Gemm {
    const char* A;
    const char* Bt;
    const int* rows;
    size_t bstride;
    int K, nM, nN, ngroups;
    int trip = 0;
};
__device__ __forceinline__ bool next_unit(const Gemm& g, int i, int G, int c, Unit& u) {
    if (g.trip) {
        const int per3 = g.nM * (g.nN / 3), j = i / 3, sec = i - 3 * j; int s = j * G + c; if (s >= per3) return false;
        { const int q = per3 / NXCD, r = per3 % NXCD, xcd = s % NXCD, off = s / NXCD; s = (xcd < r ? xcd * (q + 1) : r * (q + 1) + (xcd - r) * q) + off; }
        const int ncb = g.nN / 3; u.e = 0; u.pm = s / ncb; u.pn = 3 * (s % ncb) + sec; return true;
    }
    const int per = g.nM * g.nN;
    const long L = (long)i * G + c; if (L >= (long)per * g.ngroups) return false;
    u.e = (int)(L / per); int wgid = (int)(L % per);
    { const int nwg = per, q = nwg / NXCD, r = nwg % NXCD, xcd = wgid % NXCD, off = wgid / NXCD; wgid = (xcd < r ? xcd * (q + 1) : r * (q + 1) + (xcd - r) * q) + off; }
    const int nig = WGM * g.nN, gid = wgid / nig, fm = gid * WGM, gsz = (g.nM - fm) < WGM ? (g.nM - fm) : WGM;
    u.pm = fm + ((wgid % nig) % gsz); u.pn = (wgid % nig) / gsz; return true;
}
__device__ __forceinline__ bf16x8 lo8(const i32x8& f) { return __builtin_bit_cast(bf16x8, (i32x4)__builtin_shufflevector(f, f, 0, 1, 2, 3)); }
__device__ __forceinline__ bf16x8 hi8(const i32x8& f) { return __builtin_bit_cast(bf16x8, (i32x4)__builtin_shufflevector(f, f, 4, 5, 6, 7)); }
__device__ __forceinline__ i32x8 cat8(bf16x8 lo, bf16x8 hi) { const i32x4 a = __builtin_bit_cast(i32x4, lo), b = __builtin_bit_cast(i32x4, hi); return __builtin_shufflevector(a, b, 0, 1, 2, 3, 4, 5, 6, 7); }
__device__ __forceinline__ unsigned cvt_pk_bf16(float lo, float hi) { unsigned r; asm volatile("v_cvt_pk_bf16_f32 %0, %1, %2" : "=v"(r) : "v"(lo), "v"(hi)); return r; }

#ifndef ENG_SP2
#define ENG_SP2 true
#endif
#ifndef ENG_ALIGN
#define ENG_ALIGN true
#endif
template <class Epi, bool SP2 = ENG_SP2, bool ALIGN_EPI = ENG_ALIGN>
__device__ __forceinline__ void gemm_phase(LAS unsigned char* lds, const Gemm g, const Epi& E, int G, int c) {
    int tid = threadIdx.x; asm volatile("" : "+v"(tid));
    const int wid = __builtin_amdgcn_readfirstlane(tid >> 6), lane = tid & 63, wr = wid >> 2, wc = wid & 3, fr = lane & 15, fq = lane >> 4;
    const int K = g.K, nt = K / BK;
    int R0, C0; stage_rc(tid * 16, R0, C0);
    const int Rb0 = Epi::PERM ? ((R0 & ~31) + perm32(R0 & 31)) : R0;
    unsigned voffB[2]; voffB[0] = (unsigned)(Rb0 * K + C0) * 2u; voffB[1] = (unsigned)((Rb0 + 64) * K + C0) * 2u;
    constexpr bool SW = Epi::SWAPV;
    const char* const abase = SW ? g.Bt : g.A;
    const unsigned adelta = SW ? (unsigned)(size_t)(g.A - g.Bt) : 0u;
    const unsigned dltB = SW ? (unsigned)((R0 - Rb0) * K) * 2u : 0u;
    const size_t hstepB = (size_t)HALF * K * 2;
    const unsigned ldsw = (unsigned)wid * 1024u;
    const int aoff = lds_byte(wr * 64 + fr, fq * 8), boff = lds_byte(wc * 32 + fr, fq * 8);
#define PG8_SA(b, h) (((b) * 2 + (h)) * HTB)
#define PG8_SB(b, h) ((4 + (b) * 2 + (h)) * HTB)
#define PG8_GLDS(gp, bufoff, i) __builtin_amdgcn_global_load_lds((const unsigned*)(gp), (LAS unsigned*)(lds + (bufoff) + ldsw + (i) * 8192), 16, 0, 0)
#define PG8_STAGE_B(bufoff, bp, h, kt) do { const char* _p = (bp) + (size_t)(h) * hstepB + (size_t)(kt) * 128; asm volatile("" : "+s"(_p)); PG8_GLDS(_p + (voffB[0] + (SW ? dselB : 0u)), bufoff, 0); PG8_GLDS(_p + (voffB[1] + (SW ? dselB : 0u)), bufoff, 1); } while (0)
#define PG8_STAGE_A(bufoff, v0, v1, kt) do { const char* _p = abase + (size_t)(kt) * 128; asm volatile("" : "+s"(_p)); PG8_GLDS(_p + (v0), bufoff, 0); PG8_GLDS(_p + (v1), bufoff, 1); } while (0)
#define PG8_LDA(dst, b, h) do { _Pragma("unroll") for (int m = 0; m < 4; ++m) dst[m] = cat8(*(const LAS bf16x8*)(lds + PG8_SA(b, h) + aoff + m * 2048), *(const LAS bf16x8*)(lds + PG8_SA(b, h) + aoff + m * 2048 + 1024)); } while (0)
#define PG8_LDB(dst, b, h) do { _Pragma("unroll") for (int n = 0; n < 2; ++n) dst[n] = cat8(*(const LAS bf16x8*)(lds + PG8_SB(b, h) + boff + n * 2048), *(const LAS bf16x8*)(lds + PG8_SB(b, h) + boff + n * 2048 + 1024)); } while (0)
#define PG8_MMA(ai, bj, At, Bt) do { __builtin_amdgcn_s_setprio(1); \
        if constexpr (Epi::FP8) { _Pragma("unroll") for (int m = 0; m < 4; ++m) _Pragma("unroll") for (int n = 0; n < 2; ++n) \
            asm volatile("v_mfma_scale_f32_16x16x128_f8f6f4 %0, %1, %2, %0, %3, %4 op_sel_hi:[0,0,0]" : "+v"(acc[ai][bj][m][n]) : "v"(Bt[n]), "v"(At[m]), "v"(sc_w), "v"(sc_a)); } \
        else { _Pragma("unroll") for (int m = 0; m < 4; ++m) _Pragma("unroll") for (int n = 0; n < 2; ++n) { \
            acc[ai][bj][m][n] = __builtin_amdgcn_mfma_f32_16x16x32_bf16(lo8(Bt[n]), lo8(At[m]), acc[ai][bj][m][n], 0, 0, 0); \
            acc[ai][bj][m][n] = __builtin_amdgcn_mfma_f32_16x16x32_bf16(hi8(Bt[n]), hi8(At[m]), acc[ai][bj][m][n], 0, 0, 0); } } \
        __builtin_amdgcn_s_setprio(0); } while (0)
#define PG8_WAIT_V(n) asm volatile("s_waitcnt vmcnt(" #n ")" ::: "memory")
#define PG8_WAIT_L(n) asm volatile("s_waitcnt lgkmcnt(" #n ")" ::: "memory")
#define PG8_BAR __builtin_amdgcn_s_barrier()
#define PG8_SCHED __builtin_amdgcn_sched_barrier(0)
#define PG8_ROWOFF(u, h, i) ((SW && E.swapv(u)) ? (unsigned)(((u).pn * 256 + (h) * 128 + R0 + 64 * (i)) * K + C0) * 2u : adelta + ((unsigned)(((g.rows ? g.rows[((u).e * g.nM + (u).pm) * 256 + (h) * 128 + R0 + 64 * (i)] : (((u).e * g.nM + (u).pm) * 256 + (h) * 128 + R0 + 64 * (i))) * K + C0)) * 2u))
#define PG8_BPTR(u) ((SW && E.swapv(u)) ? g.A + (size_t)(u).pm * 2 * hstepB : g.Bt + (size_t)(u).e * g.bstride + (size_t)(u).pn * 2 * hstepB)
    Unit cur, nxt; int ui = 0;
    if (!next_unit(g, 0, G, c, cur)) return;
    f32x4 acc[2][2][4][2];
#pragma unroll
    for (int a = 0; a < 2; ++a)
#pragma unroll
        for (int b = 0; b < 2; ++b)
#pragma unroll
            for (int m = 0; m < 4; ++m)
#pragma unroll
                for (int n = 0; n < 2; ++n) acc[a][b][m][n] = (f32x4){0.f, 0.f, 0.f, 0.f};
    int sc_w = E.scale_w, sc_a = E.scale_a;
    asm volatile("" : "+v"(sc_w), "+v"(sc_a));
    i32x8 At[4], B0[2], B1[2];
    unsigned c00 = PG8_ROWOFF(cur, 0, 0), c01 = PG8_ROWOFF(cur, 0, 1), c10 = PG8_ROWOFF(cur, 1, 0), c11 = PG8_ROWOFF(cur, 1, 1);
    const char* cB = PG8_BPTR(cur);
    unsigned cD = (SW && E.swapv(cur)) ? dltB : 0u, dselB = cD;
    if constexpr (SP2) {
        PG8_STAGE_B(PG8_SB(0, 0), cB, 0, 0); PG8_STAGE_B(PG8_SB(0, 1), cB, 1, 0); PG8_STAGE_A(PG8_SA(0, 0), c00, c01, 0); PG8_STAGE_A(PG8_SA(0, 1), c10, c11, 0);
        if (wr == 1) PG8_BAR;
        PG8_WAIT_V(2); PG8_BAR;
        PG8_STAGE_B(PG8_SB(1, 0), cB, 0, 1); PG8_STAGE_A(PG8_SA(1, 0), c00, c01, 1); PG8_STAGE_B(PG8_SB(1, 1), cB, 1, 1);
        PG8_WAIT_V(6); PG8_BAR;
    } else {
        PG8_STAGE_B(PG8_SB(0, 0), cB, 0, 0); PG8_STAGE_A(PG8_SA(0, 0), c00, c01, 0); PG8_STAGE_B(PG8_SB(0, 1), cB, 1, 0); PG8_STAGE_A(PG8_SA(0, 1), c10, c11, 0);
        if (wr == 1) PG8_BAR;
        PG8_WAIT_V(4); PG8_BAR;
        PG8_STAGE_B(PG8_SB(1, 0), cB, 0, 1); PG8_STAGE_A(PG8_SA(1, 0), c00, c01, 1); PG8_STAGE_B(PG8_SB(1, 1), cB, 1, 1);
        PG8_WAIT_V(6); PG8_BAR;
    }
    for (;;) {
        const bool has_next = next_unit(g, ui + 1, G, c, nxt);
        unsigned n00 = c00, n01 = c01, n10 = c10, n11 = c11; const char* nB = cB; unsigned nD = cD;
        if (has_next) { n00 = PG8_ROWOFF(nxt, 0, 0); n01 = PG8_ROWOFF(nxt, 0, 1); n10 = PG8_ROWOFF(nxt, 1, 0); n11 = PG8_ROWOFF(nxt, 1, 1);
                        nB = PG8_BPTR(nxt); nD = (SW && E.swapv(nxt)) ? dltB : 0u; }
#pragma unroll 1
        for (int t = 0; t < nt; t += 2) {
            const bool last = (t == nt - 2);
            const int kt2 = last ? 0 : t + 2, kt3 = kt2 + 1;
            const char* b2 = last ? nB : cB; dselB = last ? nD : cD;
            const unsigned s00 = last ? n00 : c00, s01 = last ? n01 : c01, s10 = last ? n10 : c10, s11 = last ? n11 : c11;
            if constexpr (SP2) {
            PG8_LDB(B0, 0, 0); PG8_LDB(B1, 0, 1); PG8_SCHED; PG8_LDA(At, 0, 0); PG8_STAGE_A(PG8_SA(1, 1), c10, c11, t + 1);
            PG8_WAIT_V(8); PG8_WAIT_L(0); PG8_BAR; PG8_MMA(0, 0, At, B0); PG8_MMA(0, 1, At, B1); PG8_BAR; PG8_SCHED;
            PG8_LDA(At, 0, 1); PG8_STAGE_B(PG8_SB(0, 0), b2, 0, kt2); PG8_STAGE_B(PG8_SB(0, 1), b2, 1, kt2); PG8_STAGE_A(PG8_SA(0, 0), s00, s01, kt2);
            PG8_WAIT_V(8); PG8_WAIT_L(0); PG8_BAR; PG8_MMA(1, 0, At, B0); PG8_MMA(1, 1, At, B1); PG8_BAR; PG8_SCHED;
            PG8_LDB(B0, 1, 0); PG8_LDB(B1, 1, 1); PG8_SCHED; PG8_LDA(At, 1, 0); PG8_STAGE_A(PG8_SA(0, 1), s10, s11, kt2);
            PG8_WAIT_V(8); PG8_WAIT_L(0); PG8_BAR; PG8_MMA(0, 0, At, B0); PG8_MMA(0, 1, At, B1); PG8_BAR; PG8_SCHED;
            PG8_LDA(At, 1, 1); PG8_STAGE_B(PG8_SB(1, 0), b2, 0, kt3); PG8_STAGE_B(PG8_SB(1, 1), b2, 1, kt3); PG8_STAGE_A(PG8_SA(1, 0), s00, s01, kt3);
            PG8_WAIT_V(8); PG8_WAIT_L(0); PG8_BAR; PG8_MMA(1, 0, At, B0); PG8_MMA(1, 1, At, B1); PG8_BAR; PG8_SCHED;
            } else {
            PG8_LDB(B0, 0, 0); PG8_SCHED; PG8_LDA(At, 0, 0); PG8_STAGE_A(PG8_SA(1, 1), c10, c11, t + 1);
            PG8_WAIT_L(8); PG8_BAR; PG8_WAIT_L(0); PG8_MMA(0, 0, At, B0); PG8_BAR; PG8_SCHED;
            PG8_LDB(B1, 0, 1); PG8_STAGE_B(PG8_SB(0, 0), b2, 0, kt2);
            PG8_BAR; PG8_WAIT_L(0); PG8_MMA(0, 1, At, B1); PG8_BAR;
            PG8_LDA(At, 0, 1); PG8_STAGE_A(PG8_SA(0, 0), s00, s01, kt2);
            PG8_BAR; PG8_WAIT_L(0); PG8_MMA(1, 0, At, B0); PG8_BAR; PG8_SCHED;
            PG8_STAGE_B(PG8_SB(0, 1), b2, 1, kt2);
            PG8_WAIT_V(6); PG8_BAR; PG8_MMA(1, 1, At, B1); PG8_BAR;
            PG8_LDB(B0, 1, 0); PG8_SCHED; PG8_LDA(At, 1, 0); PG8_STAGE_A(PG8_SA(0, 1), s10, s11, kt2);
            PG8_WAIT_L(8); PG8_BAR; PG8_WAIT_L(0); PG8_MMA(0, 0, At, B0); PG8_BAR; PG8_SCHED;
            PG8_LDB(B1, 1, 1); PG8_STAGE_B(PG8_SB(1, 0), b2, 0, kt3);
            PG8_BAR; PG8_WAIT_L(0); PG8_MMA(0, 1, At, B1); PG8_BAR;
            PG8_LDA(At, 1, 1); PG8_STAGE_A(PG8_SA(1, 0), s00, s01, kt3);
            PG8_BAR; PG8_WAIT_L(0); PG8_MMA(1, 0, At, B0); PG8_BAR; PG8_SCHED;
            PG8_STAGE_B(PG8_SB(1, 1), b2, 1, kt3);
            PG8_WAIT_V(6); PG8_BAR; PG8_MMA(1, 1, At, B1); PG8_BAR;
            }
        }
        if constexpr (Epi::FP8) {
            _Pragma("unroll") for (int a = 0; a < 2; ++a)
                asm volatile("s_nop 15\n\ts_nop 15" : "+v"(acc[a][0][0][0]), "+v"(acc[a][0][0][1]), "+v"(acc[a][0][1][0]), "+v"(acc[a][0][1][1]), "+v"(acc[a][0][2][0]), "+v"(acc[a][0][2][1]), "+v"(acc[a][0][3][0]), "+v"(acc[a][0][3][1]),
                             "+v"(acc[a][1][0][0]), "+v"(acc[a][1][0][1]), "+v"(acc[a][1][1][0]), "+v"(acc[a][1][1][1]), "+v"(acc[a][1][2][0]), "+v"(acc[a][1][2][1]), "+v"(acc[a][1][3][0]), "+v"(acc[a][1][3][1]));
        }
        if constexpr (ALIGN_EPI) { if (wr == 0) PG8_BAR; }
        E(acc, cur, wr, wc, fr, fq);
        if (!has_next) break;
#pragma unroll
        for (int a = 0; a < 2; ++a)
#pragma unroll
            for (int b = 0; b < 2; ++b)
#pragma unroll
                for (int m = 0; m < 4; ++m)
#pragma unroll
                    for (int n = 0; n < 2; ++n) acc[a][b][m][n] = (f32x4){0.f, 0.f, 0.f, 0.f};
        cur = nxt; cB = nB; cD = nD; c00 = n00; c01 = n01; c10 = n10; c11 = n11; ++ui;
        if constexpr (ALIGN_EPI) { if (wr == 1) PG8_BAR; }
    }
    PG8_WAIT_V(0);
    if constexpr (!ALIGN_EPI) { if (wr == 0) PG8_BAR; }
    PG8_BAR;
#undef PG8_SA
#undef PG8_SB
#undef PG8_GLDS
#undef PG8_STAGE_A
#undef PG8_STAGE_B
#undef PG8_LDA
#undef PG8_LDB
#undef PG8_MMA
#undef PG8_WAIT_V
#undef PG8_WAIT_L
#undef PG8_BAR
#undef PG8_SCHED
#undef PG8_ROWOFF
#undef PG8_BPTR
}

struct EpiProj0 {
    static constexpr bool FP8 = false; static constexpr int scale_w = 0, scale_a = 0;
    static constexpr bool PERM = true; static constexpr bool SWAPV = true;
    __device__ __forceinline__ bool swapv(const Unit& u) const { return u.pn >= 4 && u.pn < 8; }
    bf16_t* qk; unsigned char* vtp; bf16_t* r; float* afb;
    __device__ __forceinline__ void operator()(const f32x4 (&acc)[2][2][4][2], const Unit& u, int wr, int wc, int fr, int fq) const {
        const int row0 = u.pm * BM + wr * 64 + fr;
        if (swapv(u)) {
            unsigned char* p0 = vtp + (size_t)(4 * u.pm + (wc >> 1)) * 131072 + (size_t)((((16 * (u.pn - 4) + 4 * wr) * 2 + (wc & 1)) * 64 + fr + 16 * fq) * 16);
#pragma unroll
            for (int ai = 0; ai < 2; ++ai)
#pragma unroll
                for (int m = 0; m < 4; ++m)
#pragma unroll
                    for (int bj = 0; bj < 2; ++bj) { const f32x4 v0 = acc[ai][bj][m][0], v1 = acc[ai][bj][m][1];
                        u32x4 w; w.x = cvt_pk_bf16(v0[0], v0[1]); w.y = cvt_pk_bf16(v0[2], v0[3]); w.z = cvt_pk_bf16(v1[0], v1[1]); w.w = cvt_pk_bf16(v1[2], v1[3]);
                        *(u32x4*)(p0 + (size_t)bj * 2 * 131072 + (size_t)(8 * ai + m) * 2048) = w; }
        } else if (u.pn < 12) {
            const float sc = (u.pn < 2) ? 0.08838834764831845f : 1.f;
            bf16_t* base = qk + (size_t)(u.pn >> 3) * (size_t)(130 * MiB / 2);
            const int col0 = (u.pn & 3) * BM + wc * 32 + 8 * fq;
#pragma unroll
            for (int ai = 0; ai < 2; ++ai)
#pragma unroll
                for (int m = 0; m < 4; ++m) { bf16_t* rowp = base + (size_t)(row0 + ai * HALF + m * 16) * D + col0;
#pragma unroll
                    for (int bj = 0; bj < 2; ++bj) { const f32x4 v0 = acc[ai][bj][m][0] * sc, v1 = acc[ai][bj][m][1] * sc;
                        u32x4 w; w.x = cvt_pk_bf16(v0[0], v0[1]); w.y = cvt_pk_bf16(v0[2], v0[3]); w.z = cvt_pk_bf16(v1[0], v1[1]); w.w = cvt_pk_bf16(v1[2], v1[3]);
                        *(u32x4*)(rowp + bj * HALF) = w; } }
        } else if (wc == 0) {
#pragma unroll
            for (int ai = 0; ai < 2; ++ai)
#pragma unroll
                for (int m = 0; m < 4; ++m) { float* rowp = afb + (size_t)(row0 + ai * HALF + m * 16) * 32 + 8 * fq;
                    *(f32x4*)(rowp) = acc[ai][0][m][0]; *(f32x4*)(rowp + 4) = acc[ai][0][m][1]; }
        }
    }
};
struct EpiResid {
    static constexpr bool FP8 = false; static constexpr int scale_w = 0, scale_a = 0;
    static constexpr bool PERM = false; static constexpr bool SWAPV = false; __device__ __forceinline__ bool swapv(const Unit&) const { return false; }
    const float* src; float* dst; const float* gate;
    __device__ __forceinline__ void operator()(const f32x4 (&acc)[2][2][4][2], const Unit& u, int wr, int wc, int fr, int fq) const {
        const int row0 = u.pm * BM + wr * 64 + fr, col0 = u.pn * BM + wc * 32 + 4 * fq;
        const int b = (u.pm * BM) >> 14;
        f32x4 gv[2][2];
#pragma unroll
        for (int bj = 0; bj < 2; ++bj)
#pragma unroll
            for (int n = 0; n < 2; ++n) gv[bj][n] = *(const f32x4*)(gate + (size_t)b * 6 * D + col0 + bj * HALF + n * 16);
#pragma unroll
        for (int ai = 0; ai < 2; ++ai) {
            f32x4 sv[4][2][2];
#pragma unroll
            for (int m = 0; m < 4; ++m)
#pragma unroll
                for (int bj = 0; bj < 2; ++bj)
#pragma unroll
                    for (int n = 0; n < 2; ++n) sv[m][bj][n] = *(const f32x4*)(src + (size_t)(row0 + ai * HALF + m * 16) * D + col0 + bj * HALF + n * 16);
            asm volatile("" ::: "memory");
#pragma unroll
            for (int m = 0; m < 4; ++m)
#pragma unroll
                for (int bj = 0; bj < 2; ++bj)
#pragma unroll
                    for (int n = 0; n < 2; ++n) *(f32x4*)(dst + (size_t)(row0 + ai * HALF + m * 16) * D + col0 + bj * HALF + n * 16) = sv[m][bj][n] + gv[bj][n] * acc[ai][bj][m][n];
        }
    }
};
struct EpiBf16Plain {
    static constexpr bool FP8 = false; static constexpr int scale_w = 0, scale_a = 0;
    static constexpr bool PERM = true; static constexpr bool SWAPV = false; __device__ __forceinline__ bool swapv(const Unit&) const { return false; }
    bf16_t* O; int ldc;
    __device__ __forceinline__ void operator()(const f32x4 (&acc)[2][2][4][2], const Unit& u, int wr, int wc, int fr, int fq) const {
        const int row0 = u.pm * BM + wr * 64 + fr, col0 = u.pn * BM + wc * 32 + 8 * fq;
#pragma unroll
        for (int ai = 0; ai < 2; ++ai)
#pragma unroll
            for (int m = 0; m < 4; ++m) { bf16_t* rowp = O + (size_t)(row0 + ai * HALF + m * 16) * ldc + col0;
#pragma unroll
                for (int bj = 0; bj < 2; ++bj) { const f32x4 v0 = acc[ai][bj][m][0], v1 = acc[ai][bj][m][1];
                    u32x4 w; w.x = cvt_pk_bf16(v0[0], v0[1]); w.y = cvt_pk_bf16(v0[2], v0[3]); w.z = cvt_pk_bf16(v1[0], v1[1]); w.w = cvt_pk_bf16(v1[2], v1[3]);
                    *(u32x4*)(rowp + bj * HALF) = w; } }
    }
};
__device__ __forceinline__ float dpp_shr1(float oldv, float x) { return __builtin_bit_cast(float, __builtin_amdgcn_update_dpp(__builtin_bit_cast(int, oldv), __builtin_bit_cast(int, x), 0x111, 0xF, 0xF, false)); }
__device__ __forceinline__ float dpp_shl1(float oldv, float x) { return __builtin_bit_cast(float, __builtin_amdgcn_update_dpp(__builtin_bit_cast(int, oldv), __builtin_bit_cast(int, x), 0x101, 0xF, 0xF, false)); }
__device__ __forceinline__ float dpp_ror1(float x) { return __builtin_bit_cast(float, __builtin_amdgcn_update_dpp(0, __builtin_bit_cast(int, x), 0x121, 0xF, 0xF, false)); }
__device__ __forceinline__ float dpp_rol1(float x) { return __builtin_bit_cast(float, __builtin_amdgcn_update_dpp(0, __builtin_bit_cast(int, x), 0x12F, 0xF, 0xF, false)); }
struct EpiConvFused {
    static constexpr bool FP8 = false; static constexpr int scale_w = 0, scale_a = 0;
    static constexpr bool PERM = true; static constexpr bool SWAPV = false; __device__ __forceinline__ bool swapv(const Unit&) const { return false; }
    unsigned char* dump;
    bf16_t* O; const float* ck;
    __device__ __forceinline__ void operator()(const f32x4 (&acc)[2][2][4][2], const Unit& u, int wr, int wc, int fr, int fq) const {
        const int cb = u.pn / 3, sec = u.pn - 3 * cb, tid = threadIdx.x;
        if (sec < 2) {
            const int cc = 256 * cb + 128 * sec + wc * 32 + 8 * fq;
            unsigned char* dp = dump + (size_t)sec * 65536 + tid * 16;
#pragma unroll
            for (int n = 0; n < 2; ++n) {
                const f32x4 k0 = *(const f32x4*)(ck + cc + 4 * n), k1 = *(const f32x4*)(ck + D + cc + 4 * n), k2 = *(const f32x4*)(ck + 2 * D + cc + 4 * n);
#pragma unroll
                for (int ai = 0; ai < 2; ++ai) {
                    f32x4 y[4];
#pragma unroll
                    for (int j = 0; j < 4; ++j) {
                        float x[4];
#pragma unroll
                        for (int m = 0; m < 4; ++m) x[m] = acc[ai][0][m][n][j] * acc[ai][1][m][n][j];
#pragma unroll
                        for (int m = 0; m < 4; ++m) {
                            const float up = dpp_shr1(m > 0 ? dpp_ror1(x[m - 1]) : 0.f, x[m]);
                            const float dn = dpp_shl1(m < 3 ? dpp_rol1(x[m + 1]) : 0.f, x[m]);
                            y[m][j] = k0[j] * up + k1[j] * x[m] + k2[j] * dn; }
                    }
#pragma unroll
                    for (int m = 0; m < 4; ++m) { u32x2 w; w.x = cvt_pk_bf16(y[m][0], y[m][1]); w.y = cvt_pk_bf16(y[m][2], y[m][3]);
                        *(u32x2*)(dp + (ai * 4 + m) * 8192 + n * 8) = w; }
                }
            }
        } else {
            const int row0 = u.pm * BM + wr * 64 + fr, col0 = 256 * cb + wc * 32 + 8 * fq;
            const unsigned loff = (unsigned)tid * 16u;
#pragma unroll
            for (int ai = 0; ai < 2; ++ai)
#pragma unroll
                for (int m = 0; m < 4; ++m) {
                    bf16_t* rowp = O + (size_t)(row0 + ai * HALF + m * 16) * D + col0;
                    const unsigned char* sb = dump + (ai * 4 + m) * 8192; asm volatile("" : "+s"(sb));
                    const u32x4 q0 = *(const u32x4*)(sb + loff), q1 = *(const u32x4*)(sb + 65536 + loff);
#pragma unroll
                    for (int bj = 0; bj < 2; ++bj) { const f32x4 v0 = acc[ai][bj][m][0], v1 = acc[ai][bj][m][1]; const u32x4 q = bj ? q1 : q0;
                        u32x4 w; w.x = cvt_pk_bf16(v0[0] * bflo(q.x), v0[1] * bfhi(q.x)); w.y = cvt_pk_bf16(v0[2] * bflo(q.y), v0[3] * bfhi(q.y));
                        w.z = cvt_pk_bf16(v1[0] * bflo(q.z), v1[1] * bfhi(q.z)); w.w = cvt_pk_bf16(v1[2] * bflo(q.w), v1[3] * bfhi(q.w));
                        *(u32x4*)(rowp + bj * HALF) = w; }
                    asm volatile("" ::: "memory");
                }
        }
    }
};
struct EpiSwiglu {
    static constexpr bool FP8 = true; int scale_w, scale_a;
    static constexpr bool PERM = true; static constexpr bool SWAPV = false; __device__ __forceinline__ bool swapv(const Unit&) const { return false; }
    unsigned char* hid;
    __device__ __forceinline__ void operator()(const f32x4 (&acc)[2][2][4][2], const Unit& u, int wr, int wc, int fr, int fq) const {
        const int row0 = u.e * 4096 + u.pm * BM + wr * 64 + fr, col0 = u.pn * HALF + wc * 32 + 8 * fq;
#pragma unroll
        for (int ai = 0; ai < 2; ++ai)
#pragma unroll
            for (int m = 0; m < 4; ++m) { unsigned char* rowp = hid + (size_t)(row0 + ai * HALF + m * 16) * DEXP + col0;
                float h[8];
#pragma unroll
                for (int n = 0; n < 2; ++n)
#pragma unroll
                    for (int j2 = 0; j2 < 2; ++j2) {
                        const f32x2 gt = {acc[ai][0][m][n][2 * j2], acc[ai][0][m][n][2 * j2 + 1]}, up = {acc[ai][1][m][n][2 * j2], acc[ai][1][m][n][2 * j2 + 1]};
                        const f32x2 a = gt * (f32x2){-1.4426950408889634f, -1.4426950408889634f};
                        f32x2 t; t.x = __builtin_amdgcn_exp2f(a.x); t.y = __builtin_amdgcn_exp2f(a.y);
                        const f32x2 d4 = t * (f32x2){0.25f, 0.25f} + (f32x2){0.25f, 0.25f};
                        f32x2 r4; r4.x = __builtin_amdgcn_rcpf(d4.x); r4.y = __builtin_amdgcn_rcpf(d4.y);
                        const f32x2 hv = (gt * up) * r4;
                        h[n * 4 + 2 * j2] = __builtin_amdgcn_fmed3f(hv.x, -448.f, 448.f); h[n * 4 + 2 * j2 + 1] = __builtin_amdgcn_fmed3f(hv.y, -448.f, 448.f); }
                int w0 = __builtin_amdgcn_cvt_pk_fp8_f32(h[0], h[1], 0, false); w0 = __builtin_amdgcn_cvt_pk_fp8_f32(h[2], h[3], w0, true);
                int w1 = __builtin_amdgcn_cvt_pk_fp8_f32(h[4], h[5], 0, false); w1 = __builtin_amdgcn_cvt_pk_fp8_f32(h[6], h[7], w1, true);
                u32x2 w; w.x = (unsigned)w0; w.y = (unsigned)w1;
                *(u32x2*)(rowp) = w; }
    }
};
struct EpiDown {
    static constexpr bool FP8 = true; int scale_w, scale_a;
    static constexpr bool PERM = true; static constexpr bool SWAPV = false; __device__ __forceinline__ bool swapv(const Unit&) const { return false; }
    unsigned char* ye;
    __device__ __forceinline__ void operator()(const f32x4 (&acc)[2][2][4][2], const Unit& u, int wr, int wc, int fr, int fq) const {
        const int row0 = u.e * 4096 + u.pm * BM + wr * 64 + fr, col0 = u.pn * BM + wc * 32 + 8 * fq;
#pragma unroll
        for (int ai = 0; ai < 2; ++ai)
#pragma unroll
            for (int m = 0; m < 4; ++m) { const int row = row0 + ai * HALF + m * 16; unsigned char* rowp = ye + (size_t)row * D + col0;
#pragma unroll
                for (int bj = 0; bj < 2; ++bj) { f32x4 v0 = acc[ai][bj][m][0] * 32.f, v1 = acc[ai][bj][m][1] * 32.f;
#pragma unroll
                    for (int i = 0; i < 4; ++i) { v0[i] = __builtin_amdgcn_fmed3f(v0[i], -448.f, 448.f); v1[i] = __builtin_amdgcn_fmed3f(v1[i], -448.f, 448.f); }
                    int w0 = __builtin_amdgcn_cvt_pk_fp8_f32(v0[0], v0[1], 0, false); w0 = __builtin_amdgcn_cvt_pk_fp8_f32(v0[2], v0[3], w0, true);
                    int w1 = __builtin_amdgcn_cvt_pk_fp8_f32(v1[0], v1[1], 0, false); w1 = __builtin_amdgcn_cvt_pk_fp8_f32(v1[2], v1[3], w1, true);
                    u32x2 w; w.x = (unsigned)w0; w.y = (unsigned)w1;
                    *(u32x2*)(rowp + bj * HALF) = w; } }
    }
};
}

constexpr int RING_BYTES = 131072, LDS_BYTES = 147456;
struct Args { const float* in[20]; float* out; unsigned char* ws; int ph_lo, ph_hi; };
struct Frame {
    LAS unsigned char* lds;
    int tid, lane, wave, gw, ngw, G;
};
#define P_X 0
#define P_C 1
#define P_CTX 2
#define P_CCTX 3
#define P_ADAW 4
#define P_ADAB 5
#define P_NORMG 6
#define P_GWIN 7
#define P_GWA2 8
#define P_GBA2 9
#define P_GNORMG 10
#define P_GWOUT 11
#define P_CWIN 12
#define P_CK 13
#define P_CWOUT 14
#define P_ROUTER 15
#define P_EGATE 16
#define P_EUP 17
#define P_EDOWN 18
#define P_FINALG 19

constexpr int TR_SCR = 64 * 65 * 4;
__device__ __forceinline__ void tr_item(const float* W, int ldw, int k0, int n0, bf16_t* WT, int ldo, int drow0, LAS float* scr, int lane) {
    f32x4 v[16];
#pragma unroll
    for (int i = 0; i < 16; ++i) v[i] = *(const f32x4*)(W + (size_t)(k0 + 4 * i + (lane >> 4)) * ldw + n0 + 4 * (lane & 15));
#pragma unroll
    for (int i = 0; i < 16; ++i) { LAS float* p = scr + (4 * i + (lane >> 4)) * 65 + 4 * (lane & 15); p[0] = v[i].x; p[1] = v[i].y; p[2] = v[i].z; p[3] = v[i].w; }
    LDS_WAIT(); asm volatile("" ::: "memory");
    const int c = lane & 7;
#pragma unroll
    for (int j = 0; j < 8; ++j) { const int n = (lane >> 3) + 8 * j; const LAS float* sp = scr + (8 * c) * 65 + n;
        u32x4 o; o.x = pk2(sp[0 * 65], sp[1 * 65]); o.y = pk2(sp[2 * 65], sp[3 * 65]); o.z = pk2(sp[4 * 65], sp[5 * 65]); o.w = pk2(sp[6 * 65], sp[7 * 65]);
        *(u32x4*)(WT + (size_t)(drow0 + n) * ldo + k0 + 8 * c) = o; }
    LDS_WAIT(); asm volatile("" ::: "memory");
}
__device__ __forceinline__ void tr_plain(Frame& F, const Args& A, const float* W, int K, int N, bf16_t* WT, int item, LAS float* scr) {
    const int nblk = (N + 63) / 64, kb = item / nblk, nb = item % nblk; int n0 = 64 * nb; if (n0 + 64 > N) n0 = N - 64;
    tr_item(W, N, 64 * kb, n0, WT, K, n0, scr, F.lane);
}
constexpr int TR_SCR8 = 128 * 33 * 4;
static_assert(TR_SCR8 >= TR_SCR, "per-wave scratch stride");
struct Tr8Item { const float* W; unsigned char* WT; int ldw, ldo, rowmap; };
constexpr int I8_G = (D / 128) * (DEXP / 256);
constexpr int I8_D = (DEXP / 128) * (D / 256);
constexpr int N_EXPERT_ITEMS = NE * (2 * I8_G + I8_D);
__device__ __forceinline__ Tr8Item expert_item(const Args& A, int gi) {
    const int l = gi / N_EXPERT_ITEMS, it = gi % N_EXPERT_ITEMS;
    unsigned char* wgu = A.ws + WS_W8 + (size_t)l * W8_LAYER; unsigned char* wd = wgu + W8_WD;
    constexpr int PER_E = 2 * I8_G + I8_D;
    const int e = it / PER_E; int r = it % PER_E;
    Tr8Item t;
    if (r < 2 * I8_G) {
        const int up = r / I8_G; r %= I8_G;
        const float* W = A.in[up ? P_EUP : P_EGATE] + ((size_t)l * NE + e) * D * DEXP;
        const int nblk = DEXP / 256, kb = r / nblk, nb = r % nblk, h0 = 256 * nb;
        t.W = W + (size_t)(128 * kb) * DEXP + h0; t.ldw = DEXP; t.WT = wgu + (size_t)e * 4096 * D + (size_t)(2 * h0 + 128 * up) * D + 128 * kb; t.ldo = D; t.rowmap = 1;
    } else {
        r -= 2 * I8_G;
        const float* W = A.in[P_EDOWN] + ((size_t)l * NE + e) * DEXP * D;
        const int nblk = D / 256, kb = r / nblk, nb = r % nblk;
        t.W = W + (size_t)(128 * kb) * D + 256 * nb; t.ldw = D; t.WT = wd + (size_t)e * D * DEXP + (size_t)(256 * nb) * DEXP + 128 * kb; t.ldo = DEXP; t.rowmap = 0;
    }
    return t;
}
__device__ __forceinline__ void tr8_load(const Tr8Item& t, f32x4 (&v)[16], int wave, int lane) {
#pragma unroll
    for (int i = 0; i < 16; ++i) v[i] = __builtin_nontemporal_load((const f32x4*)(t.W + (size_t)(16 * wave + i) * t.ldw + 4 * lane));
}
__device__ __forceinline__ void tr8_finish(const Tr8Item& t, const f32x4 (&v)[16], LAS unsigned char* tile, int tid, int wave, int lane) {
#pragma unroll
    for (int q = 0; q < 4; ++q) {
        int o[4];
#pragma unroll
        for (int g = 0; g < 4; ++g) { int w = __builtin_amdgcn_cvt_pk_fp8_f32(64.f * v[4 * g][q], 64.f * v[4 * g + 1][q], 0, false);
            o[g] = __builtin_amdgcn_cvt_pk_fp8_f32(64.f * v[4 * g + 2][q], 64.f * v[4 * g + 3][q], w, true); }
        u32x4 ov; ov.x = (unsigned)o[0]; ov.y = (unsigned)o[1]; ov.z = (unsigned)o[2]; ov.w = (unsigned)o[3];
        const int n = 4 * lane + q;
        *(LAS u32x4*)(tile + n * 128 + ((wave ^ (n & 7)) << 4)) = ov; }
    __syncthreads();
#pragma unroll
    for (int j = 0; j < 4; ++j) { const int p = tid + 512 * j, n = p >> 3, c = p & 7;
        const u32x4 ov = *(const LAS u32x4*)(tile + n * 128 + ((c ^ (n & 7)) << 4));
        const int drow = t.rowmap ? (256 * (n >> 7) + (n & 127)) : n;
        *(u32x4*)(t.WT + (size_t)drow * t.ldo + 16 * c) = ov; }
    __syncthreads();
}
__device__ __forceinline__ void convert_expert_dyn(const Args& A, unsigned* ctr, int end, LAS unsigned char* tile, volatile LAS int* slot, int tid, int wave, int lane) {
    if (tid == 0) { slot[0] = (int)__hip_atomic_fetch_add(ctr, 1u, __ATOMIC_RELAXED, __HIP_MEMORY_SCOPE_AGENT); slot[1] = (int)__hip_atomic_fetch_add(ctr, 1u, __ATOMIC_RELAXED, __HIP_MEMORY_SCOPE_AGENT); }
    __syncthreads();
    int ia = slot[0], ib = slot[1];
    if (ia >= end) return;
    f32x4 va[16], vb[16];
    Tr8Item ta = expert_item(A, ia), tb;
    tr8_load(ta, va, wave, lane);
    for (;;) {
        int rc = 0;
        tb = expert_item(A, min(ib, end - 1)); tr8_load(tb, vb, wave, lane);
        if (tid == 0) rc = (int)__hip_atomic_fetch_add(ctr, 1u, __ATOMIC_RELAXED, __HIP_MEMORY_SCOPE_AGENT);
        tr8_finish(ta, va, tile, tid, wave, lane);
        if (tid == 0) slot[0] = rc;
        __syncthreads();
        ia = ib; ib = slot[0];
        if (ia >= end) break;
        ta = expert_item(A, min(ib, end - 1)); tr8_load(ta, va, wave, lane);
        if (tid == 0) rc = (int)__hip_atomic_fetch_add(ctr, 1u, __ATOMIC_RELAXED, __HIP_MEMORY_SCOPE_AGENT);
        tr8_finish(tb, vb, tile, tid, wave, lane);
        if (tid == 0) slot[1] = rc;
        __syncthreads();
        ia = ib; ib = slot[1];
        if (ia >= end) break;
    }
}
template <int N>
__device__ __forceinline__ void convert_expert_fixed(const Args& A, LAS unsigned char* lds, int tid, int wave, int lane) {
    unsigned* ctr = (unsigned*)(A.ws + WS_CTL) + 2048; LAS unsigned char* tile = lds + 49152; volatile LAS int* slot = (volatile LAS int*)(lds + 40960);
    constexpr int end = 2 * N_EXPERT_ITEMS;
    __syncthreads();
    if (tid == 0) slot[0] = (int)__hip_atomic_fetch_add(ctr, (unsigned)N, __ATOMIC_RELAXED, __HIP_MEMORY_SCOPE_AGENT);
    __syncthreads();
    const int base = slot[0];
    if (base >= end) return;
    f32x4 va[16], vb[16];
    Tr8Item ta = expert_item(A, base), tb = ta;
    tr8_load(ta, va, wave, lane);
#pragma unroll
    for (int j = 0; j < N; ++j) {
        if ((j & 1) == 0) { if (j + 1 < N) { tb = expert_item(A, min(base + j + 1, end - 1)); tr8_load(tb, vb, wave, lane); } tr8_finish(ta, va, tile, tid, wave, lane); }
        else              { if (j + 1 < N) { ta = expert_item(A, min(base + j + 1, end - 1)); tr8_load(ta, va, wave, lane); } tr8_finish(tb, vb, tile, tid, wave, lane); }
    }
}

__device__ __forceinline__ void ph_prep(Frame& F, const Args& A) {
    LAS float* scr = (LAS float*)(F.lds + F.wave * TR_SCR8);
    bf16_t* win0 = (bf16_t*)(A.ws + WS_WIN0T); bf16_t* wout0 = (bf16_t*)(A.ws + WS_WOUT0T); bf16_t* wcin = (bf16_t*)(A.ws + WS_WCINT); bf16_t* wcout = (bf16_t*)(A.ws + WS_WCOUTT);
    {
        float* mod = (float*)(A.ws + WS_MOD);
        LAS float* red = (LAS float*)(F.lds + 8 * TR_SCR8);
        for (int it = blockIdx.x; it < 2 * 96; it += F.G) {
            const int l = it / 96, n = (it % 96) * 64 + F.lane;
            const float* w = A.in[P_ADAW] + (size_t)l * D * 6 * D + n;
            float a0 = 0.f, a1 = 0.f, a2 = 0.f;
#pragma unroll 16
            for (int kk = 0; kk < 128; ++kk) { const int k = F.wave * 128 + kk; const float wv = w[(size_t)k * 6 * D];
                a0 += silu_f(A.in[P_C][k]) * wv; a1 += silu_f(A.in[P_C][D + k]) * wv; a2 += silu_f(A.in[P_CCTX][k]) * wv; }
            red[(F.wave * 3 + 0) * 64 + F.lane] = a0; red[(F.wave * 3 + 1) * 64 + F.lane] = a1; red[(F.wave * 3 + 2) * 64 + F.lane] = a2;
            __syncthreads();
            if (F.wave < 3) { float sacc = A.in[P_ADAB][l * 6 * D + n];
#pragma unroll
                for (int w8 = 0; w8 < 8; ++w8) sacc += red[(w8 * 3 + F.wave) * 64 + F.lane];
                mod[(l * 3 + F.wave) * 6 * D + n] = sacc; }
            __syncthreads();
        }
    }
    constexpr int I0 = (D / 64) * ((NIN0 + 63) / 64), I1 = (D / 64) * (D / 64), I2 = (D / 64) * (NCIN / 64), I3 = I1;
    for (int it = F.gw; it < I0 + I1 + I2 + I3; it += F.ngw) {
        int r = it;
        if (r < I0) { tr_plain(F, A, A.in[P_GWIN], D, NIN0, win0, r, scr); continue; } r -= I0;
        if (r < I1) { tr_plain(F, A, A.in[P_GWOUT], D, D, wout0, r, scr); continue; } r -= I1;
        if (r < I2) {
            constexpr int nblk = NCIN / 64; const int kb = r / nblk, n0 = 64 * (r % nblk), sct = n0 >> 10, ch = n0 & 1023, cb = ch >> 8, hf = (ch >> 7) & 1;
            const int drow0 = sct == 0 ? (3 * cb + 2) * 256 + (ch & 255) : (3 * cb + hf) * 256 + 128 * (sct - 1) + (ch & 127);
            tr_item(A.in[P_CWIN], NCIN, 64 * kb, n0, wcin, D, drow0, scr, F.lane); continue; } r -= I2;
        tr_plain(F, A, A.in[P_CWOUT], D, D, wcout, r, scr);
    }
    { u32x4* z = (u32x4*)(win0 + (size_t)NIN0 * D); const int n16 = (NIN0P - NIN0) * D * 2 / 16;
      for (int i = F.gw * 64 + F.lane; i < n16; i += F.ngw * 64) z[i] = (u32x4){0u, 0u, 0u, 0u}; }
}

__device__ __forceinline__ void normmod_row(const f32x4 (&v)[4], const float* g, const float* sh, const float* sc, bf16_t* orow, int lane) {
    float s = 0.f;
#pragma unroll
    for (int j = 0; j < 4; ++j) s += (v[j].x * v[j].x + v[j].y * v[j].y) + (v[j].z * v[j].z + v[j].w * v[j].w);
    const float rstd = rsqrtf(wave_sum(s) * (1.f / D) + EPS);
#pragma unroll
    for (int j = 0; j < 4; ++j) { const int c = 4 * lane + 256 * j;
        const f32x4 gg = *(const f32x4*)(g + c), s1 = *(const f32x4*)(sh + c), s2 = *(const f32x4*)(sc + c);
        const f32x4 y = v[j] * rstd * gg * (s2 + 1.f) + s1;
        u32x2 w; w.x = pk2(y.x, y.y); w.y = pk2(y.z, y.w);
        *(u32x2*)(orow + c) = w; }
}
__device__ __forceinline__ void ph_norm0(Frame& F, const Args& A) {
    const float* mod = (const float*)(A.ws + WS_MOD); bf16_t* H = (bf16_t*)(A.ws + WS_H);
    for (int row = F.gw; row < NROW; row += F.ngw) {
        const float* xr = row < NLAT ? A.in[P_X] + (size_t)row * D : A.in[P_CTX] + (size_t)(row - NLAT) * D;
        const int s = row < NLAT ? (row >> 14) : 2;
        f32x4 v[4];
#pragma unroll
        for (int j = 0; j < 4; ++j) v[j] = *(const f32x4*)(xr + 4 * F.lane + 256 * j);
        normmod_row(v, A.in[P_NORMG] + 0 * D, mod + (0 * 3 + s) * 6 * D + 0 * D, mod + (0 * 3 + s) * 6 * D + 1 * D, H + (size_t)row * D, F.lane);
    }
}

__device__ __forceinline__ int jperm(int ks, int fq, int jj) { return 32 * ks + 16 * (jj >> 2) + 4 * fq + (jj & 3); }
__device__ __forceinline__ bf16x8 ldfrag(const unsigned char* blob, int blk, int lane) { return *(const bf16x8*)(blob + blk * 1024 + lane * 16); }
__device__ __forceinline__ unsigned cvtpk(float lo, float hi) { return pk2(lo, hi); }
__device__ __forceinline__ bf16x8 pack8(const f32x4& a, const f32x4& b) {
    u32x4 w; w.x = cvtpk(a[0], a[1]); w.y = cvtpk(a[2], a[3]); w.z = cvtpk(b[0], b[1]); w.w = cvtpk(b[2], b[3]);
    return __builtin_bit_cast(bf16x8, w);
}
__device__ __forceinline__ void ph_gla_prep(Frame& F, const Args& A) {
    constexpr int LSTR = 1040;
    LAS unsigned char* QS = F.lds; LAS unsigned char* KS = F.lds + 64 * LSTR;
    const bf16_t* qk = (const bf16_t*)(A.ws + WS_QK); const float* afb = (const float*)(A.ws + WS_AFB);
    float* gam = (float*)(A.ws + WS_GAM);
    const bool has_conv = blockIdx.x + 4 * F.G >= 2 * NCHUNK;
    const int pre = has_conv ? (int)(blockIdx.x & 3) : 0;
    if (pre == 1) convert_expert_fixed<1>(A, F.lds, F.tid, F.wave, F.lane);
    else if (pre == 2) convert_expert_fixed<2>(A, F.lds, F.tid, F.wave, F.lane);
    else if (pre == 3) convert_expert_fixed<3>(A, F.lds, F.tid, F.wave, F.lane);
    __syncthreads();
    const int dir = blockIdx.x & 1, d = F.tid;
    f32x2 w2[8];
#pragma unroll
    for (int r = 0; r < 8; ++r) { w2[r].x = A.in[P_GWA2][(dir * 16 + 2 * r) * DK + d]; w2[r].y = A.in[P_GWA2][(dir * 16 + 2 * r + 1) * DK + d]; }
    const float bias = A.in[P_GBA2][dir * DK + d];
    u32x4 t16[16]; f32x4 av = (f32x4){0.f, 0.f, 0.f, 0.f};
#define PREP_LOAD(it_) do { const int row0_ = ((it_) >> 1) * 64; \
        _Pragma("unroll") for (int u = 0; u < 16; ++u) { const int q16 = F.tid + NTHR * u, j = q16 >> 7, cp = q16 & 127; t16[u] = *(const u32x4*)((const unsigned char*)qk + ((size_t)(row0_ + j) * D) * 2 + cp * 16); } \
        if (F.tid < 256) av = *(const f32x4*)(afb + (size_t)(row0_ + (F.tid >> 2)) * 32 + dir * 16 + 4 * (F.tid & 3)); } while (0)
    if ((int)blockIdx.x < 2 * NCHUNK) PREP_LOAD((int)blockIdx.x);
    for (int item = blockIdx.x; item < 2 * NCHUNK; item += F.G) {
        {
            const int ch = item >> 1, row0 = ch * 64; (void)row0;
            LAS float* AFL = (LAS float*)(F.lds + 2 * 64 * LSTR);
            {
#pragma unroll
                for (int u = 0; u < 16; ++u) { const int q16 = F.tid + NTHR * u, j = q16 >> 7, cp = q16 & 127; *(LAS u32x4*)(((cp < 64) ? QS : KS) + j * LSTR + (cp & 63) * 16) = t16[u]; }
                if (F.tid < 256) *(LAS f32x4*)(AFL + (F.tid >> 2) * 16 + 4 * (F.tid & 3)) = av;
            }
            if (item + F.G < 2 * NCHUNK) PREP_LOAD(item + F.G);
            __syncthreads();
            float cum2 = 0.f;
#pragma unroll 1
            for (int jq = 0; jq < 64; jq += 4) {
                f32x4 ar[4][4]; unsigned qv[4], kv[4];
#pragma unroll
                for (int u = 0; u < 4; ++u) { const int j = dir ? 63 - (jq + u) : jq + u;
#pragma unroll
                    for (int r4 = 0; r4 < 4; ++r4) ar[u][r4] = *(const LAS f32x4*)(AFL + j * 16 + 4 * r4); }
#pragma unroll
                for (int u = 0; u < 4; ++u) { const int j = dir ? 63 - (jq + u) : jq + u;
                    qv[u] = *(const LAS bf16_t*)(QS + j * LSTR + d * 2); kv[u] = *(const LAS bf16_t*)(KS + j * LSTR + d * 2); }
                asm volatile("" ::: "memory");
                float ls2[4];
#pragma unroll
                for (int u = 0; u < 4; ++u) {
                    f32x2 za = (f32x2){bias, 0.f}, zb = (f32x2){0.f, 0.f};
#pragma unroll
                    for (int r4 = 0; r4 < 4; ++r4) { za = __builtin_elementwise_fma((f32x2){ar[u][r4].x, ar[u][r4].y}, w2[2 * r4], za); zb = __builtin_elementwise_fma((f32x2){ar[u][r4].z, ar[u][r4].w}, w2[2 * r4 + 1], zb); }
                    const float z = (za.x + za.y) + (zb.x + zb.y);
                    const float zl = z * 1.4426950408889634f;
                    ls2[u] = fminf(zl, 0.f) - __builtin_amdgcn_logf(1.f + __builtin_amdgcn_exp2f(-fabsf(zl)));
                }
                unsigned qk2[4];
#pragma unroll
                for (int u = 0; u < 4; ++u) {
                    cum2 += ls2[u] * (1.f / 16.f);
                    const float e = __builtin_amdgcn_exp2f(cum2), ei = __builtin_amdgcn_exp2f(-cum2);
                    qk2[u] = pk2(bflo(qv[u]) * e, bflo(kv[u]) * ei);
                }
#pragma unroll
                for (int u = 0; u < 4; ++u) { const int j = dir ? 63 - (jq + u) : jq + u;
                    *(LAS bf16_t*)(QS + j * LSTR + d * 2) = (bf16_t)(qk2[u] & 0xffffu); *(LAS bf16_t*)(KS + j * LSTR + d * 2) = (bf16_t)(qk2[u] >> 16); }
            }
            const float cum = cum2 * 0.6931471805599453f;
            gam[((size_t)dir * NCHUNK + ch) * DK + d] = __expf(cum);
            __syncthreads();
            {
                const int fr = F.lane & 15, fq = F.lane >> 4;
                unsigned char* blob0 = A.ws + (((size_t)dir * NCHUNK + ch) * 4) * BLOB + (size_t)F.tid * 16;
#pragma unroll
                for (int typ = 0; typ < 2; ++typ) {
                    const LAS unsigned char* src = (typ == 0) ? QS : KS;
                    u32x4 o[8];
#pragma unroll
                    for (int i8 = 0; i8 < 8; ++i8) { const int h = i8 >> 1, blk = F.wave + 8 * (i8 & 1), it = blk >> 2, sd = blk & 3, i = 16 * it + fr, d0 = h * HK + 32 * sd + 4 * fq;
                        const u32x2 lo = *(const LAS u32x2*)(src + i * LSTR + d0 * 2), hi = *(const LAS u32x2*)(src + i * LSTR + (d0 + 16) * 2);
                        o[i8].x = lo.x; o[i8].y = lo.y; o[i8].z = hi.x; o[i8].w = hi.y; }
                    unsigned char* dst = blob0 + (typ == 0 ? WS_QP : WS_KP);
#pragma unroll
                    for (int i8 = 0; i8 < 8; ++i8) *(u32x4*)(dst + (size_t)(i8 >> 1) * BLOB + (size_t)(i8 & 1) * 8192) = o[i8];
                }
                {
                    u32x4 o[8];
#pragma unroll
                    for (int i8 = 0; i8 < 8; ++i8) { const int h = i8 >> 1, blk = F.wave + 8 * (i8 & 1), mt = blk >> 1, ks = blk & 1, dd = h * HK + 16 * mt + fr; unsigned e[8];
#pragma unroll
                        for (int jj = 0; jj < 8; ++jj) e[jj] = *(const LAS bf16_t*)(KS + jperm(ks, fq, jj) * LSTR + dd * 2);
                        o[i8].x = e[0] | (e[1] << 16); o[i8].y = e[2] | (e[3] << 16); o[i8].z = e[4] | (e[5] << 16); o[i8].w = e[6] | (e[7] << 16); }
                    unsigned char* dst = blob0 + WS_KTP;
#pragma unroll
                    for (int i8 = 0; i8 < 8; ++i8) *(u32x4*)(dst + (size_t)(i8 >> 1) * BLOB + (size_t)(i8 & 1) * 8192) = o[i8];
                }
            }
            __syncthreads();
        }
    }
#undef PREP_LOAD
    if (has_conv) {
        if (pre == 0) convert_expert_fixed<4>(A, F.lds, F.tid, F.wave, F.lane);
        else if (pre == 1) convert_expert_fixed<3>(A, F.lds, F.tid, F.wave, F.lane);
        else if (pre == 2) convert_expert_fixed<2>(A, F.lds, F.tid, F.wave, F.lane);
        else convert_expert_fixed<1>(A, F.lds, F.tid, F.wave, F.lane);
    }
}

#define MFMA16(a, b, c) __builtin_amdgcn_mfma_f32_16x16x32_bf16((a), (b), (c), 0, 0, 0)
__device__ __forceinline__ void gla_intra_item(Frame& F, const Args& A, int item) {
    const int ch = item >> 2, h = item & 3, fr = F.lane & 15, fq = F.lane >> 4;
    const unsigned char* qpf = A.ws + WS_QP + (((size_t)0 * NCHUNK + ch) * 4 + h) * BLOB; const unsigned char* kpf = A.ws + WS_KP + (((size_t)0 * NCHUNK + ch) * 4 + h) * BLOB;
    const unsigned char* qpb = A.ws + WS_QP + (((size_t)1 * NCHUNK + ch) * 4 + h) * BLOB; const unsigned char* kpb = A.ws + WS_KP + (((size_t)1 * NCHUNK + ch) * 4 + h) * BLOB;
    bf16x8 Pf[4][2];
#pragma unroll
    for (int it = 0; it < 4; ++it) {
        f32x4 P[4];
#pragma unroll
        for (int jt = 0; jt < 4; ++jt) P[jt] = (f32x4){0.f, 0.f, 0.f, 0.f};
#pragma unroll
        for (int dirp = 0; dirp < 2; ++dirp) {
            const unsigned char* qp = dirp ? qpb : qpf; const unsigned char* kp = dirp ? kpb : kpf;
            bf16x8 kk[16], qq[4];
#pragma unroll
            for (int sd = 0; sd < 4; ++sd) qq[sd] = ldfrag(qp, it * 4 + sd, F.lane);
#pragma unroll
            for (int jt = 0; jt < 4; ++jt) if (dirp ? (jt >= it) : (jt <= it)) {
#pragma unroll
                for (int sd = 0; sd < 4; ++sd) kk[jt * 4 + sd] = ldfrag(kp, jt * 4 + sd, F.lane); }
#pragma unroll
            for (int jt = 0; jt < 4; ++jt) if (dirp ? (jt >= it) : (jt <= it)) {
                f32x4 a = (f32x4){0.f, 0.f, 0.f, 0.f};
#pragma unroll
                for (int sd = 0; sd < 4; ++sd) a = MFMA16(kk[jt * 4 + sd], qq[sd], a);
                if (jt == it) {
#pragma unroll
                    for (int r = 0; r < 4; ++r) { const int j = 4 * fq + r; const bool keep = dirp ? (j >= fr) : (j <= fr); a[r] = keep ? a[r] : 0.f; }
                }
                P[jt] += a;
            }
        }
        Pf[it][0] = pack8(P[0], P[1]); Pf[it][1] = pack8(P[2], P[3]);
    }
    const unsigned char* vt = A.ws + WS_VTP + (size_t)ch * 131072 + (size_t)(h * 16) * 2048;
    bf16_t* oi = (bf16_t*)(A.ws + WS_OI) + (size_t)(ch * 64 + fr) * DV + h * HV + 4 * fq;
#pragma unroll 1
    for (int ng = 0; ng < 4; ++ng) {
        bf16x8 va[8];
#pragma unroll
        for (int i = 0; i < 8; ++i) va[i] = ldfrag(vt, ng * 8 + i, F.lane);
#pragma unroll
        for (int n4 = 0; n4 < 4; ++n4)
#pragma unroll
            for (int it = 0; it < 4; ++it) {
                f32x4 acc = (f32x4){0.f, 0.f, 0.f, 0.f};
                acc = MFMA16(va[n4 * 2], Pf[it][0], acc); acc = MFMA16(va[n4 * 2 + 1], Pf[it][1], acc);
                u32x2 w; w.x = pk2(acc[0], acc[1]); w.y = pk2(acc[2], acc[3]);
                *(u32x2*)(oi + (size_t)(16 * it) * DV + 16 * (ng * 4 + n4)) = w;
            }
    }
}
struct ScanRegs { bf16x8 q[4], k[4], v[2][2]; f32x4 g[2]; };
__device__ __forceinline__ int scan_chunk(int b, int dir, int step) { return step >= 4 ? (256 * b + (dir ? 255 - (step - 4) : step - 4)) : (512 + 4 * b + (dir ? 3 - step : step)); }
__device__ __forceinline__ void scan_load(const Args& A, ScanRegs& R, int b, int h, int dir, int sp, int w, int step, int lane) {
    const int ch = scan_chunk(b, dir, step), fq = lane >> 4;
    const size_t bo = (((size_t)dir * NCHUNK + ch) * 4 + h) * BLOB;
    const unsigned char* qp = A.ws + WS_QP + bo; const unsigned char* ktp = A.ws + WS_KTP + bo;
    const unsigned char* vt = A.ws + WS_VTP + (size_t)ch * 131072 + (size_t)(h * 16 + 2 * sp) * 2048;
    const float* gp = (const float*)(A.ws + WS_GAM) + ((size_t)dir * NCHUNK + ch) * DK + h * HK + 32 * w + 4 * fq;
#pragma unroll
    for (int sd = 0; sd < 4; ++sd) R.q[sd] = ldfrag(qp, w * 4 + sd, lane);
#pragma unroll
    for (int m = 0; m < 2; ++m)
#pragma unroll
        for (int ks = 0; ks < 2; ++ks) R.k[m * 2 + ks] = ldfrag(ktp, (2 * w + m) * 2 + ks, lane);
#pragma unroll
    for (int s2 = 0; s2 < 2; ++s2) {
        const int o = 8 * ((lane & 15) >> 2) + 4 * s2 + (lane & 3);
        const unsigned char* vp = vt + (o >> 4) * 2048 + ((o & 15) + (lane & 48)) * 16;
        R.v[s2][0] = *(const bf16x8*)(vp); R.v[s2][1] = *(const bf16x8*)(vp + 1024); }
    R.g[0] = *(const f32x4*)(gp); R.g[1] = *(const f32x4*)(gp + 16);
}
#define LDS_ORDER() asm volatile("" ::: "memory")
__device__ __forceinline__ void scan_ds(const ScanRegs& R, f32x4 (&dS)[2][2]) {
#pragma unroll
    for (int s2 = 0; s2 < 2; ++s2)
#pragma unroll
        for (int m = 0; m < 2; ++m) { f32x4 d = (f32x4){0.f, 0.f, 0.f, 0.f}; d = MFMA16(R.k[m * 2], R.v[s2][0], d); d = MFMA16(R.k[m * 2 + 1], R.v[s2][1], d); dS[s2][m] = d; }
}
__device__ __forceinline__ void scan_step(const Args& A, const ScanRegs& R, const ScanRegs& Rn, f32x4 (&S)[2][2], f32x4 (&dS)[2][2], LAS unsigned char* xs, LAS unsigned* flags, bf16_t* O, int b, int h, int dir, int sp, int w, int step, int lane) {
    const int fr = lane & 15, fq = lane >> 4;
#pragma unroll
    for (int s2 = 0; s2 < 2; ++s2) {
        S[s2][0] = R.g[0] * (S[s2][0] + dS[s2][0]); S[s2][1] = R.g[1] * (S[s2][1] + dS[s2][1]);
        *(volatile LAS bf16x8*)(xs + ((step + 1) & 3) * 8192 + (s2 * 4 + w) * 1024 + lane * 16) = pack8(S[s2][0], S[s2][1]);
    }
    LDS_ORDER();
    if (lane == 0) *(volatile LAS unsigned*)(flags + w) = (unsigned)step + 2u;
    LDS_ORDER();
    scan_ds(Rn, dS);
    if (step >= 4) {
        { const unsigned need = (unsigned)step + 1u; unsigned spn = 0;
          for (;;) { const unsigned f = (lane < 4) ? *(volatile LAS unsigned*)(flags + lane) : need;
              if (__all((int)(f >= need))) break; if (++spn > (1u << 26)) break; }
          LDS_ORDER(); }
        const LAS unsigned char* slot = xs + (step & 3) * 8192 + lane * 16;
        bf16x8 sf[2][4];
#pragma unroll
        for (int s2 = 0; s2 < 2; ++s2)
#pragma unroll
            for (int sd = 0; sd < 4; ++sd) sf[s2][sd] = *(const LAS bf16x8*)(slot + (s2 * 4 + sd) * 1024);
        LDS_ORDER();
        const int ch = scan_chunk(b, dir, step);
        f32x4 acc0 = (f32x4){0.f, 0.f, 0.f, 0.f}, acc1 = acc0;
#pragma unroll
        for (int sd = 0; sd < 4; ++sd) { acc0 = MFMA16(sf[0][sd], R.q[sd], acc0); acc1 = MFMA16(sf[1][sd], R.q[sd], acc1); }
        u32x4 wv; wv.x = pk2(acc0[0], acc0[1]); wv.y = pk2(acc0[2], acc0[3]); wv.z = pk2(acc1[0], acc1[1]); wv.w = pk2(acc1[2], acc1[3]);
        *(u32x4*)(O + (size_t)(ch * 64 + 16 * w + fr) * DV + h * HV + 32 * sp + 8 * fq) = wv;
    }
}
__device__ __forceinline__ void gla_scan_item(Frame& F, const Args& A, int item, LAS unsigned char* xs, LAS unsigned* flags) {
    const int chain = item >> 3, sp = item & 7, b = chain >> 3, h = (chain >> 1) & 3, dir = chain & 1, w = F.wave;
    bf16_t* O = (bf16_t*)(A.ws + (dir ? WS_OB : WS_OF));
    f32x4 S[2][2], dS[2][2];
#pragma unroll
    for (int s2 = 0; s2 < 2; ++s2) { S[s2][0] = (f32x4){0.f, 0.f, 0.f, 0.f}; S[s2][1] = S[s2][0];
        *(volatile LAS bf16x8*)(xs + (s2 * 4 + w) * 1024 + F.lane * 16) = pack8(S[s2][0], S[s2][1]); }
    LDS_ORDER();
    if (F.lane == 0) *(volatile LAS unsigned*)(flags + w) = 1u;
    LDS_ORDER();
    ScanRegs Ra, Rb, Rc;
    scan_load(A, Ra, b, h, dir, sp, w, 0, F.lane);
    scan_load(A, Rb, b, h, dir, sp, w, 1, F.lane);
    scan_ds(Ra, dS);
    for (int step = 0; step < 261; step += 3) {
        scan_load(A, Rc, b, h, dir, sp, w, min(step + 2, 259), F.lane);
        scan_step(A, Ra, Rb, S, dS, xs, flags, O, b, h, dir, sp, w, step, F.lane);
        scan_load(A, Ra, b, h, dir, sp, w, min(step + 3, 259), F.lane);
        scan_step(A, Rb, Rc, S, dS, xs, flags, O, b, h, dir, sp, w, step + 1, F.lane);
        scan_load(A, Rb, b, h, dir, sp, w, min(step + 4, 259), F.lane);
        if (step + 2 < 260) scan_step(A, Rc, Ra, S, dS, xs, flags, O, b, h, dir, sp, w, step + 2, F.lane);
    }
}
__device__ __forceinline__ void ph_gla_main(Frame& F, const Args& A) {
    LAS unsigned char* xs = F.lds; LAS unsigned* flags = (LAS unsigned*)(F.lds + 32768);
    if (F.tid < 16) flags[F.tid] = 0u;
    __syncthreads();
    const int bi = blockIdx.x;
    unsigned* ctr = (unsigned*)(A.ws + WS_CTL) + 2048;
    volatile LAS int* slot = (volatile LAS int*)(F.lds + 40960);
    if (bi < 128) {
        if (F.wave < 4) gla_scan_item(F, A, ((2 * (bi & 7) + ((bi >> 3) & 1)) << 3) | ((bi >> 4) & 7), xs, flags);
        __syncthreads();
    } else {
        const int sw = (bi - 128) * NWAVES + F.wave, nsw = (F.G - 128) * NWAVES;
        for (int it = sw; it < 512 * 4; it += nsw) gla_intra_item(F, A, it);
        __syncthreads();
    }
    convert_expert_dyn(A, ctr, 2 * N_EXPERT_ITEMS, F.lds + 49152, slot, F.tid, F.wave, F.lane);
    __syncthreads();
}

__device__ __forceinline__ void ph_gla_finish(Frame& F, const Args& A) {
    const bf16_t* rp = (const bf16_t*)(A.ws + WS_R); const bf16_t* OFp = (const bf16_t*)(A.ws + WS_OF); const bf16_t* OBp = (const bf16_t*)(A.ws + WS_OB); const bf16_t* OIp = (const bf16_t*)(A.ws + WS_OI);
    bf16_t* Hh = (bf16_t*)(A.ws + WS_H);
    const f32x4 gn = *(const f32x4*)(A.in[P_GNORMG] + 4 * F.lane);
    for (int row = F.gw; row < NLAT; row += F.ngw) {
#pragma unroll
        for (int j = 0; j < 4; ++j) {
            const int cc = 4 * F.lane + 256 * j;
            const u32x2 a = *(const u32x2*)(OFp + (size_t)row * DV + cc), bq = *(const u32x2*)(OBp + (size_t)row * DV + cc), ci = *(const u32x2*)(OIp + (size_t)row * DV + cc);
            const u32x2 rr = *(const u32x2*)(rp + (size_t)row * D + cc);
            f32x4 o; o.x = bflo(a.x) + bflo(bq.x) + bflo(ci.x); o.y = bfhi(a.x) + bfhi(bq.x) + bfhi(ci.x); o.z = bflo(a.y) + bflo(bq.y) + bflo(ci.y); o.w = bfhi(a.y) + bfhi(bq.y) + bfhi(ci.y);
            const float ss = wave_sum((o.x * o.x + o.y * o.y) + (o.z * o.z + o.w * o.w));
            const float rstd = rsqrtf(ss * (1.f / HV) + EPS);
            f32x4 r; r.x = bflo(rr.x); r.y = bfhi(rr.x); r.z = bflo(rr.y); r.w = bfhi(rr.y);
            f32x4 y;
#pragma unroll
            for (int i = 0; i < 4; ++i) y[i] = o[i] * rstd * gn[i] * silu_f(r[i]);
            u32x2 w; w.x = pk2(y.x, y.y); w.y = pk2(y.z, y.w);
            *(u32x2*)(Hh + (size_t)row * D + cc) = w;
        }
    }
}

__device__ __forceinline__ void stage_router(Frame& F, const Args& A, int l) {
    LAS float* wl = (LAS float*)F.lds;
    const float* rw = A.in[P_ROUTER] + (size_t)l * D * NE;
    for (int idx = F.tid; idx < D * NE; idx += NTHR) { const int k = idx >> 4, e = idx & 15, j = k >> 8, ln = (k & 255) >> 2, i = k & 3; wl[((((j * 4 + i) * 4 + (e >> 2)) * 64) + ln) * 4 + (e & 3)] = rw[idx]; }
    __syncthreads();
}
template <int N, int M>
__device__ __forceinline__ void rs_step(const float (&v)[N], float (&w)[N / 2], int lane) {
    const bool hi = (lane & M) != 0;
#pragma unroll
    for (int e = 0; e < N / 2; ++e) { const float mine = hi ? v[N / 2 + e] : v[e], other = hi ? v[e] : v[N / 2 + e]; w[e] = mine + __shfl_xor(other, M); }
}
__device__ __forceinline__ void ph_norm2_router(Frame& F, const Args& A, int l) {
    stage_router(F, A, l);
    const LAS float* wl = (const LAS float*)F.lds;
    const float* mod = (const float*)(A.ws + WS_MOD); unsigned char* H8 = A.ws + WS_H; const float* X = (const float*)(A.ws + WS_X); float* aff = (float*)(A.ws + WS_AFF);
    const float* g = A.in[P_NORMG] + (l * 2 + 1) * D;
    for (int rp = F.gw; rp < NLAT / 2; rp += F.ngw) {
        const int row = 2 * rp, b = row >> 14; const float* sh = mod + (l * 3 + b) * 6 * D + 3 * D; const float* sc = mod + (l * 3 + b) * 6 * D + 4 * D;
        const float* Xr = X + (size_t)row * D; unsigned char* Hr = H8 + (size_t)row * D; const float* gr = g; const float* shr = sh; const float* scr_ = sc;
        asm volatile("" : "+s"(Xr), "+s"(Hr), "+s"(gr), "+s"(shr), "+s"(scr_));
        const unsigned lo4 = 4u * (unsigned)F.lane;
        float lg0 = 0.f, lg1 = 0.f;
        f32x4 v[2][4]; float ss[2] = {0.f, 0.f};
#pragma unroll
        for (int r = 0; r < 2; ++r)
#pragma unroll
            for (int j = 0; j < 4; ++j) { v[r][j] = *(const f32x4*)(Xr + r * D + lo4 + 256 * j); ss[r] += (v[r][j].x * v[r][j].x + v[r][j].y * v[r][j].y) + (v[r][j].z * v[r][j].z + v[r][j].w * v[r][j].w); }
        const float rstd0 = rsqrtf(wave_sum(ss[0]) * (1.f / D) + EPS), rstd1 = rsqrtf(wave_sum(ss[1]) * (1.f / D) + EPS);
#pragma unroll
        for (int j = 0; j < 4; ++j) { const unsigned c = lo4 + 256 * j;
            const f32x4 gg = *(const f32x4*)(gr + c), s1 = *(const f32x4*)(shr + c), s2 = *(const f32x4*)(scr_ + c);
#pragma unroll
            for (int r = 0; r < 2; ++r) {
                v[r][j] = v[r][j] * (r ? rstd1 : rstd0) * gg * (s2 + 1.f) + s1;
                const f32x4 cl = __builtin_elementwise_min(__builtin_elementwise_max(v[r][j], (f32x4){-448.f, -448.f, -448.f, -448.f}), (f32x4){448.f, 448.f, 448.f, 448.f});
                int w = __builtin_amdgcn_cvt_pk_fp8_f32(cl.x, cl.y, 0, false); w = __builtin_amdgcn_cvt_pk_fp8_f32(cl.z, cl.w, w, true);
                *(int*)(Hr + r * D + c) = w; } }
#pragma unroll 1
        for (int eh = 0; eh < 2; ++eh) {
            f32x2 pp[8];
#pragma unroll
            for (int e = 0; e < 8; ++e) pp[e] = (f32x2){0.f, 0.f};
#pragma unroll
            for (int j = 0; j < 4; ++j)
#pragma unroll
                for (int i = 0; i < 4; ++i) { const float x0 = v[0][j][i], x1 = v[1][j][i];
                    asm volatile("" ::: "memory");
#pragma unroll
                    for (int q = 0; q < 2; ++q) { const f32x4 wv = *(const LAS f32x4*)(wl + ((((j * 4 + i) * 4 + 2 * eh + q) * 64) + F.lane) * 4);
                        const f32x2 wa = {wv.x, wv.y}, wb = {wv.z, wv.w}, xx0 = {x0, x0}, xx1 = {x1, x1};
                        pp[2 * q] += xx0 * wa; pp[2 * q + 1] += xx0 * wb; pp[4 + 2 * q] += xx1 * wa; pp[4 + 2 * q + 1] += xx1 * wb; } }
            float p[16];
#pragma unroll
            for (int e = 0; e < 8; ++e) { p[2 * e] = pp[e].x; p[2 * e + 1] = pp[e].y; }
            float r8[8], r4[4], r2[2], r1[1];
            rs_step<16, 32>(p, r8, F.lane); rs_step<8, 16>(r8, r4, F.lane); rs_step<4, 8>(r4, r2, F.lane); rs_step<2, 4>(r2, r1, F.lane);
            float lg = r1[0] + __shfl_xor(r1[0], 2); lg += __shfl_xor(lg, 1);
            if (eh == 0) lg0 = lg; else lg1 = lg;
        }
        float mx = fmaxf(lg0, lg1);
#pragma unroll
        for (int o = 4; o < 32; o <<= 1) mx = fmaxf(mx, __shfl_xor(mx, o));
        const float ex0 = __expf(lg0 - mx), ex1 = __expf(lg1 - mx);
        float den = ex0 + ex1;
#pragma unroll
        for (int o = 4; o < 32; o <<= 1) den += __shfl_xor(den, o);
        if ((F.lane & 3) == 0) { const int e8 = (F.lane >> 2) & 7, t = (row + (F.lane >> 5)) & (T - 1); const float inv = 1.f / den;
            aff[((size_t)b * NE + e8) * T + t] = ex0 * inv; aff[((size_t)b * NE + 8 + e8) * T + t] = ex1 * inv; }
    }
    __syncthreads();
}

__device__ __forceinline__ void ph_topk(Frame& F, const Args& A) {
    LAS int* red = (LAS int*)F.lds;
    const float* aff = (const float*)(A.ws + WS_AFF); int* slot = (int*)(A.ws + WS_SLOT); int* rowlist = (int*)(A.ws + WS_ROWLIST); float* selval = (float*)(A.ws + WS_SELVAL);
    for (int item = blockIdx.x; item < NB * NE; item += F.G) {
        const int b = item / NE, e = item % NE;
        const float* a = aff + ((size_t)b * NE + e) * T + F.tid * 32;
        unsigned v[32];
#pragma unroll
        for (int q = 0; q < 8; ++q) { const u32x4 x = *(const u32x4*)(a + 4 * q); v[4 * q] = x.x; v[4 * q + 1] = x.y; v[4 * q + 2] = x.z; v[4 * q + 3] = x.w; }
        unsigned prefix = 0u; int par = 0;
        for (int bit = 30; bit >= 0; --bit) {
            const unsigned cand = prefix | (1u << bit); int cnt = 0;
#pragma unroll
            for (int i = 0; i < 32; ++i) cnt += (v[i] >= cand) ? 1 : 0;
            cnt = wave_sum_i(cnt);
            if (F.lane == 0) red[par * 16 + F.wave] = cnt;
            __syncthreads();
            int tot = 0;
#pragma unroll
            for (int w8 = 0; w8 < 8; ++w8) tot += red[par * 16 + w8];
            if (tot >= CAP) prefix = cand;
            par ^= 1;
        }
        __syncthreads();
        int mgt = 0, meq = 0;
#pragma unroll
        for (int i = 0; i < 32; ++i) { mgt += (v[i] > prefix) ? 1 : 0; meq += (v[i] == prefix) ? 1 : 0; }
        int igt = mgt, ieq = meq;
#pragma unroll
        for (int o = 1; o < 64; o <<= 1) { const int ug = __shfl_up(igt, o), ue = __shfl_up(ieq, o); if (F.lane >= o) { igt += ug; ieq += ue; } }
        if (F.lane == 63) { red[F.wave] = igt; red[16 + F.wave] = ieq; }
        __syncthreads();
        int bgt = 0, beq = 0, totgt = 0;
#pragma unroll
        for (int w8 = 0; w8 < 8; ++w8) { const int xg = red[w8], xe = red[16 + w8]; if (w8 < F.wave) { bgt += xg; beq += xe; } totgt += xg; }
        const int need_eq = CAP - totgt;
        int gtb = bgt + igt - mgt, eqb = beq + ieq - meq;
        const int t0 = F.tid * 32;
#pragma unroll
        for (int q = 0; q < 2; ++q) {
            int sl[16];
#pragma unroll
            for (int i = 0; i < 16; ++i) {
                const unsigned x = v[q * 16 + i]; const bool gt = x > prefix, eq = x == prefix; const bool sel = gt || (eq && eqb < need_eq);
                const int pos = gtb + (eqb < need_eq ? eqb : need_eq);
                sl[i] = sel ? pos : -1;
                if (sel) { rowlist[e * 4096 + b * CAP + pos] = b * T + t0 + q * 16 + i; selval[e * 4096 + b * CAP + pos] = __builtin_bit_cast(float, x); }
                gtb += gt ? 1 : 0; eqb += eq ? 1 : 0;
            }
#pragma unroll
            for (int i4 = 0; i4 < 4; ++i4) *(i32x4*)(slot + ((size_t)b * NE + e) * T + t0 + q * 16 + 4 * i4) = (i32x4){sl[4 * i4], sl[4 * i4 + 1], sl[4 * i4 + 2], sl[4 * i4 + 3]};
        }
        __syncthreads();
    }
}

__device__ __forceinline__ void ph_combine(Frame& F, const Args& A, int l) {
    const float* mod = (const float*)(A.ws + WS_MOD); float* X = (float*)(A.ws + WS_X); bf16_t* H = (bf16_t*)(A.ws + WS_H);
    const int* slot = (const int*)(A.ws + WS_SLOT); const unsigned char* ye = A.ws + WS_YE; const float* selval = (const float*)(A.ws + WS_SELVAL);
    for (int row = F.gw; row < NLAT; row += F.ngw) {
        const int b = row >> 14;
        const int sv = (F.lane < 16) ? slot[((size_t)b * NE + F.lane) * T + (row & (T - 1))] : -1;
        f32x4 acc[4];
#pragma unroll
        for (int j = 0; j < 4; ++j) acc[j] = (f32x4){0.f, 0.f, 0.f, 0.f};
        for (int e = 0; e < NE; ++e) {
            const int s = __builtin_amdgcn_readlane(sv, e);
            if (s >= 0) {
                const int yrow = e * 4096 + b * CAP + s;
                const unsigned char* yr = ye + (size_t)yrow * D + 4 * F.lane; const float wv = selval[yrow] * (1.f / 32);
#pragma unroll
                for (int j = 0; j < 4; ++j) { const int y = *(const int*)(yr + 256 * j); const f32x2 lo = __builtin_amdgcn_cvt_pk_f32_fp8(y, false), hi = __builtin_amdgcn_cvt_pk_f32_fp8(y, true);
                    acc[j].x += wv * lo.x; acc[j].y += wv * lo.y; acc[j].z += wv * hi.x; acc[j].w += wv * hi.y; }
            }
        }
        const float* g2 = mod + (l * 3 + b) * 6 * D + 5 * D;
        f32x4 v[4];
#pragma unroll
        for (int j = 0; j < 4; ++j) { const int c = 4 * F.lane + 256 * j; v[j] = *(const f32x4*)(X + (size_t)row * D + c) + *(const f32x4*)(g2 + c) * acc[j]; }
        if (l == 0) {
#pragma unroll
            for (int j = 0; j < 4; ++j) *(f32x4*)(X + (size_t)row * D + 4 * F.lane + 256 * j) = v[j];
            normmod_row(v, A.in[P_NORMG] + (1 * 2 + 0) * D, mod + (1 * 3 + b) * 6 * D + 0 * D, mod + (1 * 3 + b) * 6 * D + 1 * D, H + (size_t)row * D, F.lane);
        } else {
            float s = 0.f;
#pragma unroll
            for (int j = 0; j < 4; ++j) s += (v[j].x * v[j].x + v[j].y * v[j].y) + (v[j].z * v[j].z + v[j].w * v[j].w);
            const float rstd = rsqrtf(wave_sum(s) * (1.f / D) + EPS);
#pragma unroll
            for (int j = 0; j < 4; ++j) { const int c = 4 * F.lane + 256 * j; *(f32x4*)(A.out + (size_t)row * D + c) = v[j] * rstd * *(const f32x4*)(A.in[P_FINALG] + c); }
        }
    }
}

constexpr int N_PHASES = 20;
__global__ void __launch_bounds__(NTHR, 2) fwd_kernel(Args A) {
    extern __shared__ __attribute__((aligned(16))) unsigned char lds_raw[];
    Frame F;
    F.lds = (LAS unsigned char*)lds_raw;
    F.tid = threadIdx.x; F.lane = F.tid & 63; F.wave = __builtin_amdgcn_readfirstlane(F.tid >> 6);
    F.G = gridDim.x; F.gw = blockIdx.x * NWAVES + F.wave; F.ngw = F.G * NWAVES;
    const int lo = A.ph_lo, hi = A.ph_hi;
#ifdef ONLY_PH
#define IN(k) ((k) == ONLY_PH && lo <= (k) && (k) < hi)
#else
#define IN(k) (lo <= (k) && (k) < hi)
#endif
#if MK_MULTI
#define SEAM(k) do { } while (0)
#else
    cg::grid_group grid = cg::this_grid();
    volatile LAS unsigned* bst = (volatile LAS unsigned*)(F.lds + LDS_BYTES - 64);
    if (F.tid < 16) bst[F.tid] = 0u;
    __syncthreads();
    XcdBarrier xbar = xcd_barrier_post((unsigned*)(A.ws + WS_CTL) + 4096, bst);
    if (lo < 0) { __threadfence(); grid.sync(); }
#define SEAM(k) do { if (IN(k) && IN((k) + 1)) xcd_barrier(xbar); } while (0)
#endif
    const int c = blockIdx.x;
    #define H ((bf16_t*)(A.ws + WS_H))
#define X ((float*)(A.ws + WS_X))
#define mod ((const float*)(A.ws + WS_MOD))
#define MOE_GU(l) { eng::Gemm g{(const char*)(A.ws + WS_H), (const char*)(A.ws + WS_W8 + (size_t)(l) * W8_LAYER), (const int*)(A.ws + WS_ROWLIST), (size_t)4096 * D, D / 2, 16, 16, NE}; \
        eng::EpiSwiglu E{0x79797979, 0x7F7F7F7F, A.ws + WS_HID}; eng::gemm_phase(F.lds, g, E, F.G, c); }
#define MOE_DN(l) { eng::Gemm g{(const char*)(A.ws + WS_HID), (const char*)(A.ws + WS_W8 + (size_t)(l) * W8_LAYER + W8_WD), nullptr, (size_t)D * DEXP, DEXP / 2, 16, 4, NE}; \
        eng::EpiDown E{0x79797979, 0x7D7D7D7D, A.ws + WS_YE}; eng::gemm_phase(F.lds, g, E, F.G, c); }

    if (IN(0)) ph_prep(F, A);
    SEAM(0);
    if (IN(1)) ph_norm0(F, A);
    SEAM(1);
    if (IN(2)) { eng::Gemm g{(const char*)H, (const char*)(A.ws + WS_WIN0T), nullptr, 0, D, NROW / 256, NIN0P / 256, 1};
        eng::EpiProj0 E{(bf16_t*)(A.ws + WS_QK), A.ws + WS_VTP, (bf16_t*)(A.ws + WS_R), (float*)(A.ws + WS_AFB)}; eng::gemm_phase(F.lds, g, E, F.G, c);
        if (6 * F.G + c >= (NROW / 256) * (NIN0P / 256)) convert_expert_fixed<3>(A, F.lds, F.tid, F.wave, F.lane); }
    SEAM(2);
    if (IN(3)) ph_gla_prep(F, A);
    SEAM(3);
    if (IN(4)) ph_gla_main(F, A);
    SEAM(4);
    if (IN(5)) ph_gla_finish(F, A);
    SEAM(5);
    if (IN(6)) { eng::Gemm g{(const char*)H, (const char*)(A.ws + WS_WOUT0T), nullptr, 0, D, NLAT / 256, D / 256, 1};
        eng::EpiResid E{A.in[P_X], X, mod + (0 * 3) * 6 * D + 2 * D}; eng::gemm_phase(F.lds, g, E, F.G, c); }
    SEAM(6);
    if (IN(7)) ph_norm2_router(F, A, 0);
    SEAM(7);
    if (IN(8)) ph_topk(F, A);
    SEAM(8);
    if (IN(9)) MOE_GU(0)
    SEAM(9);
    if (IN(10)) MOE_DN(0)
    SEAM(10);
    if (IN(11)) ph_combine(F, A, 0);
    SEAM(11);
    if (IN(12)) { eng::Gemm g{(const char*)H, (const char*)(A.ws + WS_WCINT), nullptr, 0, D, NLAT / 256, NCIN / 256, 1};
        g.trip = 1;
        eng::EpiConvFused E{A.ws + WS_CDUMP + (size_t)c * 131072, (bf16_t*)(A.ws + WS_H2), A.in[P_CK]}; eng::gemm_phase(F.lds, g, E, F.G, c); }
    SEAM(12);
    if (IN(14)) { eng::Gemm g{(const char*)(A.ws + WS_H2), (const char*)(A.ws + WS_WCOUTT), nullptr, 0, D, NLAT / 256, D / 256, 1};
        eng::EpiResid E{X, X, mod + (1 * 3) * 6 * D + 2 * D}; eng::gemm_phase(F.lds, g, E, F.G, c); }
    SEAM(14);
    if (IN(15)) ph_norm2_router(F, A, 1);
    SEAM(15);
    if (IN(16)) ph_topk(F, A);
    SEAM(16);
    if (IN(17)) MOE_GU(1)
    SEAM(17);
    if (IN(18)) MOE_DN(1)
    SEAM(18);
    if (IN(19)) ph_combine(F, A, 1);
#undef IN
#undef SEAM
#undef H
#undef X
#undef mod
#undef MOE_GU
#undef MOE_DN
}

extern "C" void kernel_launch(void* const* d_in, const int* in_sizes, int n_in, void* d_out, int out_size, void* d_ws, size_t ws_size, hipStream_t stream) {
    static int grid = 0;
    if (grid == 0) {
        if (n_in != 20 || in_sizes[0] != NLAT * D || out_size != NLAT * D || ws_size < WS_END) {
            fprintf(stderr, "kernel_launch: unexpected problem: n_in %d in0 %d out %d ws %zu (need %zu)\n", n_in, n_in > 0 ? in_sizes[0] : -1, out_size, ws_size, (size_t)WS_END); grid = -1; return; }
        int dev = 0, cus = 0, per_cu = 0;
        if (hipGetDevice(&dev) != hipSuccess || hipDeviceGetAttribute(&cus, hipDeviceAttributeMultiprocessorCount, dev) != hipSuccess) { grid = -1; return; }
        if (hipFuncSetAttribute((const void*)fwd_kernel, hipFuncAttributeMaxDynamicSharedMemorySize, LDS_BYTES) != hipSuccess) { fprintf(stderr, "kernel_launch: hipFuncSetAttribute failed\n"); grid = -1; return; }
        if (hipOccupancyMaxActiveBlocksPerMultiprocessor(&per_cu, (const void*)fwd_kernel, NTHR, LDS_BYTES) != hipSuccess || per_cu < 1) { fprintf(stderr, "kernel_launch: occupancy query says %d\n", per_cu); per_cu = 1; }
        (void)hipGetLastError();
        if (cus != 256) { fprintf(stderr, "kernel_launch: built for a 256-CU device (one workgroup per CU); found %d CUs\n", cus); grid = -1; return; }
        grid = cus;
    }
    if (grid < 0) return;
    Args a{};
    for (int i = 0; i < 20; ++i) a.in[i] = (const float*)d_in[i];
    a.out = (float*)d_out; a.ws = (unsigned char*)d_ws;
#if MK_MULTI
    for (int p = 0; p < N_PHASES; ++p) {
        a.ph_lo = p; a.ph_hi = p + 1;
        hipLaunchKernelGGL(fwd_kernel, dim3(grid), dim3(NTHR), LDS_BYTES, stream, a);
    }
#else
    if (hipMemsetAsync((char*)d_ws + WS_CTL, 0, 64 * 1024, stream) != hipSuccess) { fprintf(stderr, "kernel_launch: memset failed\n"); return; }
    a.ph_lo = 0; a.ph_hi = N_PHASES;
    void* kargs[] = {&a};
    hipError_t e = hipLaunchCooperativeKernel((const void*)fwd_kernel, dim3(grid), dim3(NTHR), kargs, LDS_BYTES, stream);
    if (e != hipSuccess) fprintf(stderr, "kernel_launch: cooperative launch failed: %s (grid %d)\n", hipGetErrorString(e), grid);
#endif
}
```

```cpp
#include <hip/hip_runtime.h>
#include <hip/hip_cooperative_groups.h>
#include <cstdio>
#include <cstdint>
namespace cg = cooperative_groups;

#ifndef MK_MULTI
#define MK_MULTI 0
#endif

#define LAS __attribute__((address_space(3)))
#define GAS __attribute__((address_space(1)))
typedef unsigned short bf16_t;
typedef short bf16x8 __attribute__((ext_vector_type(8)));
typedef float f32x4 __attribute__((ext_vector_type(4)));
typedef float f32x2 __attribute__((ext_vector_type(2)));
typedef unsigned u32x4 __attribute__((ext_vector_type(4)));
typedef unsigned u32x2 __attribute__((ext_vector_type(2)));
typedef int i32x4 __attribute__((ext_vector_type(4)));
typedef int i32x8 __attribute__((ext_vector_type(8)));

constexpr int D = 1024, NB = 2, T = 16384, NLAT = NB * T, CTXL = 256, NCTX = NB * CTXL, NROW = NLAT + NCTX;
constexpr int NE = 16, CAP = 2048, DEXP = 2048;
constexpr int HEADS = 4, HK = 128, HV = 256, DK = 512, DV = 1024, RANK = 16;
constexpr int NIN0 = 3104, NIN0P = 3328;
constexpr int NCIN = 3072;
constexpr float EPS = 1e-6f;
constexpr int NWAVES = 8, NTHR = 512;

constexpr size_t MiB = 1u << 20;
constexpr size_t WS_CTL = 0;
constexpr size_t WS_MOD = 1 * MiB;
constexpr size_t WS_WIN0T = 2 * MiB;
constexpr size_t WS_WOUT0T = 9 * MiB;
constexpr size_t WS_WCINT = 11 * MiB;
constexpr size_t WS_WCOUTT = 17 * MiB;
constexpr size_t WS_AFF = 19 * MiB;
constexpr size_t WS_SLOT = 21 * MiB;
constexpr size_t WS_ROWLIST = 23 * MiB;
constexpr size_t WS_SELVAL = 23 * MiB + 512 * 1024;
constexpr size_t WS_AFB = 24 * MiB;
constexpr size_t WS_W8 = 32 * MiB;
constexpr size_t W8_LAYER = 96 * MiB, W8_WD = 64 * MiB;
constexpr size_t WS_X = 224 * MiB;
constexpr size_t WS_H = 354 * MiB;
constexpr size_t WS_ARENA = 420 * MiB;
constexpr size_t WS_QK = WS_ARENA;
constexpr size_t WS_V = WS_ARENA + 65 * MiB;
constexpr size_t WS_R = WS_ARENA + 130 * MiB;
constexpr size_t WS_QP = WS_ARENA + 195 * MiB;
constexpr size_t WS_KP = WS_ARENA + 260 * MiB;
constexpr size_t WS_KTP = WS_ARENA + 325 * MiB;
constexpr size_t WS_VTP = WS_ARENA + 390 * MiB;
constexpr size_t WS_OI = WS_ARENA + 455 * MiB;
constexpr size_t WS_GAM = WS_ARENA + 519 * MiB;
constexpr size_t WS_OF = WS_QK;
constexpr size_t WS_OB = WS_V;
constexpr size_t WS_HID = WS_ARENA;
constexpr size_t WS_YE = WS_ARENA + 128 * MiB;
constexpr size_t WS_H2 = WS_ARENA;
constexpr size_t WS_CDUMP = WS_ARENA + 64 * MiB;
constexpr size_t WS_END = WS_ARENA + 522 * MiB;
static_assert(WS_R - WS_QK == 130 * MiB, "EpiProj0 strides");
constexpr size_t BLOB = 16384;
constexpr int NCHUNK = NROW / 64;

__device__ __forceinline__ float wave_sum(float v) {
#pragma unroll
    for (int o = 1; o < 64; o <<= 1) v += __shfl_xor(v, o);
    return v;
}
__device__ __forceinline__ int wave_sum_i(int v) {
#pragma unroll
    for (int o = 1; o < 64; o <<= 1) v += __shfl_xor(v, o);
    return v;
}
__device__ __forceinline__ unsigned f2bf(float f) { unsigned u = __builtin_bit_cast(unsigned, f); return (u + 0x7fffu + ((u >> 16) & 1u)) >> 16; }
typedef __bf16 bf16x2_t __attribute__((ext_vector_type(2)));
__device__ __forceinline__ unsigned pk2(float lo, float hi) { const f32x2 v = {lo, hi}; return __builtin_bit_cast(unsigned, __builtin_convertvector(v, bf16x2_t)); }
__device__ __forceinline__ float bflo(unsigned u) { return __builtin_bit_cast(float, u << 16); }
__device__ __forceinline__ float bfhi(unsigned u) { return __builtin_bit_cast(float, u & 0xffff0000u); }
__device__ __forceinline__ float silu_f(float x) { return x / (1.f + __expf(-x)); }
#define LDS_WAIT() asm volatile("s_waitcnt lgkmcnt(0)" ::: "memory")


#define XB_TMO      128
#define XB_XCNT(j)  (256  + 64 * (j))
#define XB_XSUB(j)  (1280 + 64 * (j))
#define XB_XGEN(j)  (2304 + 64 * (j))
#define XB_TOP      3328
#define XB_TOPGEN   3392
#define XCD_BAR_WORDS 3456
#define XB_SPIN_CAP (1u << 22)
__device__ __forceinline__ unsigned xb_ld(unsigned* p)              { return __hip_atomic_load(p, __ATOMIC_RELAXED, __HIP_MEMORY_SCOPE_AGENT); }
__device__ __forceinline__ unsigned xb_add(unsigned* p, unsigned v) { return __hip_atomic_fetch_add(p, v, __ATOMIC_RELAXED, __HIP_MEMORY_SCOPE_AGENT); }
__device__ __forceinline__ unsigned xb_xcc_id() { return (unsigned)__builtin_amdgcn_s_getreg((3 << 11) | 20) & 0xFu; }
#define XB_SPIN(cond, bar) do { unsigned _sp = 0; while (cond) { \
    if ((++_sp & 255u) == 0u) { if (xb_ld(&(bar)[XB_TMO])) break; if (_sp > XB_SPIN_CAP) { atomicAdd(&(bar)[XB_TMO], 1u); break; } } } } while (0)
struct XcdBarrier { unsigned* bar; unsigned x; volatile LAS unsigned* st; };
__device__ __forceinline__ XcdBarrier xcd_barrier_post(unsigned* bar, volatile LAS unsigned* st) {
    XcdBarrier b; b.bar = bar; b.x = xb_xcc_id(); b.st = st;
    if (threadIdx.x == 0) (void)xb_add(&bar[XB_XCNT(b.x)], 1u);
    return b;
}
__device__ __forceinline__ void xcd_barrier_complete(unsigned* bar, unsigned x, unsigned& nloc, unsigned& nx) {
    const unsigned G = gridDim.x * gridDim.y * gridDim.z;
    unsigned sum, cnt, mine, sp = 0u;
    for (;;) {
        sum = 0u; cnt = 0u; mine = 0u;
#pragma unroll
        for (unsigned j = 0; j < 16; ++j) { const unsigned c = xb_ld(&bar[XB_XCNT(j)]); sum += c; cnt += (c > 0u) ? 1u : 0u; mine = (j == x) ? c : mine; }
        if (sum == G) break;
        __builtin_amdgcn_s_sleep(1);
        if ((++sp & 255u) == 0u) { if (xb_ld(&bar[XB_TMO])) break; if (sp > XB_SPIN_CAP) { atomicAdd(&bar[XB_TMO], 1u); break; } }
    }
    nloc = mine > 0u ? mine : 1u; nx = cnt > 0u ? cnt : 1u;
}
__device__ __forceinline__ void xcd_barrier(const XcdBarrier& b) {
    asm volatile("s_waitcnt vmcnt(0)" ::: "memory");
    __syncthreads();
    if (threadIdx.x == 0) {
        unsigned* bar = b.bar;
        __builtin_amdgcn_s_waitcnt(0);
        unsigned nloc = b.st[0], nx = b.st[1];
        if (nloc == 0u) { xcd_barrier_complete(bar, b.x, nloc, nx); b.st[0] = nloc; b.st[1] = nx; }
        const unsigned old = xb_add(&bar[XB_XSUB(b.x)], 1u);
        const unsigned gen = old / nloc;
        if (old + 1u == (gen + 1u) * nloc) {
            __builtin_amdgcn_fence(__ATOMIC_RELEASE, "agent");
            asm volatile("s_waitcnt vmcnt(0)" ::: "memory");
            const unsigned og = xb_add(&bar[XB_TOP], 1u);
            const unsigned tg = og / nx;
            __builtin_amdgcn_fence(__ATOMIC_ACQUIRE, "agent");
            if (og + 1u == (tg + 1u) * nx) xb_add(&bar[XB_TOPGEN], 1u);
            else XB_SPIN(xb_ld(&bar[XB_TOPGEN]) == tg, bar);
            xb_add(&bar[XB_XGEN(b.x)], 1u);
            asm volatile("s_waitcnt vmcnt(0)" ::: "memory");
        } else {
            __builtin_amdgcn_fence(__ATOMIC_ACQUIRE, "agent");
            XB_SPIN(xb_ld(&bar[XB_XGEN(b.x)]) == gen, bar);
            asm volatile("s_waitcnt vmcnt(0)" ::: "memory");
        }
    }
    __syncthreads();
}

namespace eng {
constexpr int BM = 256, BK = 64, HALF = 128, HTB = HALF * BK * 2, STAGE_BYTES = 8 * HTB, NXCD = 8, WGM = 8;
__host__ __device__ __forceinline__ int lds_byte(int r, int c) { const int st = (r >> 4) * 2 + (c >> 5), rr = r & 15, cc = c & 31, ob = rr * 64 + cc * 2; return st * 1024 + (ob ^ (((ob >> 9) & 1) << 5)); }
__host__ __device__ __forceinline__ void stage_rc(int b, int& R, int& C) { const int st = b / 1024, sb = b % 1024, swz = sb ^ (((sb >> 9) & 1) << 5); R = (st >> 1) * 16 + swz / 64; C = (st & 1) * 32 + (swz % 64) / 2; }
__host__ __device__ __forceinline__ int perm32(int rho) { const int n = rho >> 4, i = rho & 15; return 8 * (i >> 2) + 4 * n + (i & 3); }

struct Unit { int e, pm, pn; };
struct Gemm {
    const char* A;
    const char* Bt;
    const int* rows;
    size_t bstride;
    int K, nM, nN, ngroups;
    int trip = 0;
};
__device__ __forceinline__ bool next_unit(const Gemm& g, int i, int G, int c, Unit& u) {
    if (g.trip) {
        const int per3 = g.nM * (g.nN / 3), j = i / 3, sec = i - 3 * j; int s = j * G + c; if (s >= per3) return false;
        { const int q = per3 / NXCD, r = per3 % NXCD, xcd = s % NXCD, off = s / NXCD; s = (xcd < r ? xcd * (q + 1) : r * (q + 1) + (xcd - r) * q) + off; }
        const int ncb = g.nN / 3; u.e = 0; u.pm = s / ncb; u.pn = 3 * (s % ncb) + sec; return true;
    }
    const int per = g.nM * g.nN;
    const long L = (long)i * G + c; if (L >= (long)per * g.ngroups) return false;
    u.e = (int)(L / per); int wgid = (int)(L % per);
    { const int nwg = per, q = nwg / NXCD, r = nwg % NXCD, xcd = wgid % NXCD, off = wgid / NXCD; wgid = (xcd < r ? xcd * (q + 1) : r * (q + 1) + (xcd - r) * q) + off; }
    const int nig = WGM * g.nN, gid = wgid / nig, fm = gid * WGM, gsz = (g.nM - fm) < WGM ? (g.nM - fm) : WGM;
    u.pm = fm + ((wgid % nig) % gsz); u.pn = (wgid % nig) / gsz; return true;
}
__device__ __forceinline__ bf16x8 lo8(const i32x8& f) { return __builtin_bit_cast(bf16x8, (i32x4)__builtin_shufflevector(f, f, 0, 1, 2, 3)); }
__device__ __forceinline__ bf16x8 hi8(const i32x8& f) { return __builtin_bit_cast(bf16x8, (i32x4)__builtin_shufflevector(f, f, 4, 5, 6, 7)); }
__device__ __forceinline__ i32x8 cat8(bf16x8 lo, bf16x8 hi) { const i32x4 a = __builtin_bit_cast(i32x4, lo), b = __builtin_bit_cast(i32x4, hi); return __builtin_shufflevector(a, b, 0, 1, 2, 3, 4, 5, 6, 7); }
__device__ __forceinline__ unsigned cvt_pk_bf16(float lo, float hi) { unsigned r; asm volatile("v_cvt_pk_bf16_f32 %0, %1, %2" : "=v"(r) : "v"(lo), "v"(hi)); return r; }

#ifndef ENG_SP2
#define ENG_SP2 true
#endif
#ifndef ENG_ALIGN
#define ENG_ALIGN true
#endif
template <class Epi, bool SP2 = ENG_SP2, bool ALIGN_EPI = ENG_ALIGN>
__device__ __forceinline__ void gemm_phase(LAS unsigned char* lds, const Gemm g, const Epi& E, int G, int c) {
    int tid = threadIdx.x; asm volatile("" : "+v"(tid));
    const int wid = __builtin_amdgcn_readfirstlane(tid >> 6), lane = tid & 63, wr = wid >> 2, wc = wid & 3, fr = lane & 15, fq = lane >> 4;
    const int K = g.K, nt = K / BK;
    int R0, C0; stage_rc(tid * 16, R0, C0);
    const int Rb0 = Epi::PERM ? ((R0 & ~31) + perm32(R0 & 31)) : R0;
    unsigned voffB[2]; voffB[0] = (unsigned)(Rb0 * K + C0) * 2u; voffB[1] = (unsigned)((Rb0 + 64) * K + C0) * 2u;
    constexpr bool SW = Epi::SWAPV;
    const char* const abase = SW ? g.Bt : g.A;
    const unsigned adelta = SW ? (unsigned)(size_t)(g.A - g.Bt) : 0u;
    const unsigned dltB = SW ? (unsigned)((R0 - Rb0) * K) * 2u : 0u;
    const size_t hstepB = (size_t)HALF * K * 2;
    const unsigned ldsw = (unsigned)wid * 1024u;
    const int aoff = lds_byte(wr * 64 + fr, fq * 8), boff = lds_byte(wc * 32 + fr, fq * 8);
#define PG8_SA(b, h) (((b) * 2 + (h)) * HTB)
#define PG8_SB(b, h) ((4 + (b) * 2 + (h)) * HTB)
#define PG8_GLDS(gp, bufoff, i) __builtin_amdgcn_global_load_lds((const unsigned*)(gp), (LAS unsigned*)(lds + (bufoff) + ldsw + (i) * 8192), 16, 0, 0)
#define PG8_STAGE_B(bufoff, bp, h, kt) do { const char* _p = (bp) + (size_t)(h) * hstepB + (size_t)(kt) * 128; asm volatile("" : "+s"(_p)); PG8_GLDS(_p + (voffB[0] + (SW ? dselB : 0u)), bufoff, 0); PG8_GLDS(_p + (voffB[1] + (SW ? dselB : 0u)), bufoff, 1); } while (0)
#define PG8_STAGE_A(bufoff, v0, v1, kt) do { const char* _p = abase + (size_t)(kt) * 128; asm volatile("" : "+s"(_p)); PG8_GLDS(_p + (v0), bufoff, 0); PG8_GLDS(_p + (v1), bufoff, 1); } while (0)
#define PG8_LDA(dst, b, h) do { _Pragma("unroll") for (int m = 0; m < 4; ++m) dst[m] = cat8(*(const LAS bf16x8*)(lds + PG8_SA(b, h) + aoff + m * 2048), *(const LAS bf16x8*)(lds + PG8_SA(b, h) + aoff + m * 2048 + 1024)); } while (0)
#define PG8_LDB(dst, b, h) do { _Pragma("unroll") for (int n = 0; n < 2; ++n) dst[n] = cat8(*(const LAS bf16x8*)(lds + PG8_SB(b, h) + boff + n * 2048), *(const LAS bf16x8*)(lds + PG8_SB(b, h) + boff + n * 2048 + 1024)); } while (0)
#define PG8_MMA(ai, bj, At, Bt) do { __builtin_amdgcn_s_setprio(1); \
        if constexpr (Epi::FP8) { _Pragma("unroll") for (int m = 0; m < 4; ++m) _Pragma("unroll") for (int n = 0; n < 2; ++n) \
            asm volatile("v_mfma_scale_f32_16x16x128_f8f6f4 %0, %1, %2, %0, %3, %4 op_sel_hi:[0,0,0]" : "+v"(acc[ai][bj][m][n]) : "v"(Bt[n]), "v"(At[m]), "v"(sc_w), "v"(sc_a)); } \
        else { _Pragma("unroll") for (int m = 0; m < 4; ++m) _Pragma("unroll") for (int n = 0; n < 2; ++n) { \
            acc[ai][bj][m][n] = __builtin_amdgcn_mfma_f32_16x16x32_bf16(lo8(Bt[n]), lo8(At[m]), acc[ai][bj][m][n], 0, 0, 0); \
            acc[ai][bj][m][n] = __builtin_amdgcn_mfma_f32_16x16x32_bf16(hi8(Bt[n]), hi8(At[m]), acc[ai][bj][m][n], 0, 0, 0); } } \
        __builtin_amdgcn_s_setprio(0); } while (0)
#define PG8_WAIT_V(n) asm volatile("s_waitcnt vmcnt(" #n ")" ::: "memory")
#define PG8_WAIT_L(n) asm volatile("s_waitcnt lgkmcnt(" #n ")" ::: "memory")
#define PG8_BAR __builtin_amdgcn_s_barrier()
#define PG8_SCHED __builtin_amdgcn_sched_barrier(0)
#define PG8_ROWOFF(u, h, i) ((SW && E.swapv(u)) ? (unsigned)(((u).pn * 256 + (h) * 128 + R0 + 64 * (i)) * K + C0) * 2u : adelta + ((unsigned)(((g.rows ? g.rows[((u).e * g.nM + (u).pm) * 256 + (h) * 128 + R0 + 64 * (i)] : (((u).e * g.nM + (u).pm) * 256 + (h) * 128 + R0 + 64 * (i))) * K + C0)) * 2u))
#define PG8_BPTR(u) ((SW && E.swapv(u)) ? g.A + (size_t)(u).pm * 2 * hstepB : g.Bt + (size_t)(u).e * g.bstride + (size_t)(u).pn * 2 * hstepB)
    Unit cur, nxt; int ui = 0;
    if (!next_unit(g, 0, G, c, cur)) return;
    f32x4 acc[2][2][4][2];
#pragma unroll
    for (int a = 0; a < 2; ++a)
#pragma unroll
        for (int b = 0; b < 2; ++b)
#pragma unroll
            for (int m = 0; m < 4; ++m)
#pragma unroll
                for (int n = 0; n < 2; ++n) acc[a][b][m][n] = (f32x4){0.f, 0.f, 0.f, 0.f};
    int sc_w = E.scale_w, sc_a = E.scale_a;
    asm volatile("" : "+v"(sc_w), "+v"(sc_a));
    i32x8 At[4], B0[2], B1[2];
    unsigned c00 = PG8_ROWOFF(cur, 0, 0), c01 = PG8_ROWOFF(cur, 0, 1), c10 = PG8_ROWOFF(cur, 1, 0), c11 = PG8_ROWOFF(cur, 1, 1);
    const char* cB = PG8_BPTR(cur);
    unsigned cD = (SW && E.swapv(cur)) ? dltB : 0u, dselB = cD;
    if constexpr (SP2) {
        PG8_STAGE_B(PG8_SB(0, 0), cB, 0, 0); PG8_STAGE_B(PG8_SB(0, 1), cB, 1, 0); PG8_STAGE_A(PG8_SA(0, 0), c00, c01, 0); PG8_STAGE_A(PG8_SA(0, 1), c10, c11, 0);
        if (wr == 1) PG8_BAR;
        PG8_WAIT_V(2); PG8_BAR;
        PG8_STAGE_B(PG8_SB(1, 0), cB, 0, 1); PG8_STAGE_A(PG8_SA(1, 0), c00, c01, 1); PG8_STAGE_B(PG8_SB(1, 1), cB, 1, 1);
        PG8_WAIT_V(6); PG8_BAR;
    } else {
        PG8_STAGE_B(PG8_SB(0, 0), cB, 0, 0); PG8_STAGE_A(PG8_SA(0, 0), c00, c01, 0); PG8_STAGE_B(PG8_SB(0, 1), cB, 1, 0); PG8_STAGE_A(PG8_SA(0, 1), c10, c11, 0);
        if (wr == 1) PG8_BAR;
        PG8_WAIT_V(4); PG8_BAR;
        PG8_STAGE_B(PG8_SB(1, 0), cB, 0, 1); PG8_STAGE_A(PG8_SA(1, 0), c00, c01, 1); PG8_STAGE_B(PG8_SB(1, 1), cB, 1, 1);
        PG8_WAIT_V(6); PG8_BAR;
    }
    for (;;) {
        const bool has_next = next_unit(g, ui + 1, G, c, nxt);
        unsigned n00 = c00, n01 = c01, n10 = c10, n11 = c11; const char* nB = cB; unsigned nD = cD;
        if (has_next) { n00 = PG8_ROWOFF(nxt, 0, 0); n01 = PG8_ROWOFF(nxt, 0, 1); n10 = PG8_ROWOFF(nxt, 1, 0); n11 = PG8_ROWOFF(nxt, 1, 1);
                        nB = PG8_BPTR(nxt); nD = (SW && E.swapv(nxt)) ? dltB : 0u; }
#pragma unroll 1
        for (int t = 0; t < nt; t += 2) {
            const bool last = (t == nt - 2);
            const int kt2 = last ? 0 : t + 2, kt3 = kt2 + 1;
            const char* b2 = last ? nB : cB; dselB = last ? nD : cD;
            const unsigned s00 = last ? n00 : c00, s01 = last ? n01 : c01, s10 = last ? n10 : c10, s11 = last ? n11 : c11;
            if constexpr (SP2) {
            PG8_LDB(B0, 0, 0); PG8_LDB(B1, 0, 1); PG8_SCHED; PG8_LDA(At, 0, 0); PG8_STAGE_A(PG8_SA(1, 1), c10, c11, t + 1);
            PG8_WAIT_V(8); PG8_WAIT_L(0); PG8_BAR; PG8_MMA(0, 0, At, B0); PG8_MMA(0, 1, At, B1); PG8_BAR; PG8_SCHED;
            PG8_LDA(At, 0, 1); PG8_STAGE_B(PG8_SB(0, 0), b2, 0, kt2); PG8_STAGE_B(PG8_SB(0, 1), b2, 1, kt2); PG8_STAGE_A(PG8_SA(0, 0), s00, s01, kt2);
            PG8_WAIT_V(8); PG8_WAIT_L(0); PG8_BAR; PG8_MMA(1, 0, At, B0); PG8_MMA(1, 1, At, B1); PG8_BAR; PG8_SCHED;
            PG8_LDB(B0, 1, 0); PG8_LDB(B1, 1, 1); PG8_SCHED; PG8_LDA(At, 1, 0); PG8_STAGE_A(PG8_SA(0, 1), s10, s11, kt2);
            PG8_WAIT_V(8); PG8_WAIT_L(0); PG8_BAR; PG8_MMA(0, 0, At, B0); PG8_MMA(0, 1, At, B1); PG8_BAR; PG8_SCHED;
            PG8_LDA(At, 1, 1); PG8_STAGE_B(PG8_SB(1, 0), b2, 0, kt3); PG8_STAGE_B(PG8_SB(1, 1), b2, 1, kt3); PG8_STAGE_A(PG8_SA(1, 0), s00, s01, kt3);
            PG8_WAIT_V(8); PG8_WAIT_L(0); PG8_BAR; PG8_MMA(1, 0, At, B0); PG8_MMA(1, 1, At, B1); PG8_BAR; PG8_SCHED;
            } else {
            PG8_LDB(B0, 0, 0); PG8_SCHED; PG8_LDA(At, 0, 0); PG8_STAGE_A(PG8_SA(1, 1), c10, c11, t + 1);
            PG8_WAIT_L(8); PG8_BAR; PG8_WAIT_L(0); PG8_MMA(0, 0, At, B0); PG8_BAR; PG8_SCHED;
            PG8_LDB(B1, 0, 1); PG8_STAGE_B(PG8_SB(0, 0), b2, 0, kt2);
            PG8_BAR; PG8_WAIT_L(0); PG8_MMA(0, 1, At, B1); PG8_BAR;
            PG8_LDA(At, 0, 1); PG8_STAGE_A(PG8_SA(0, 0), s00, s01, kt2);
            PG8_BAR; PG8_WAIT_L(0); PG8_MMA(1, 0, At, B0); PG8_BAR; PG8_SCHED;
            PG8_STAGE_B(PG8_SB(0, 1), b2, 1, kt2);
            PG8_WAIT_V(6); PG8_BAR; PG8_MMA(1, 1, At, B1); PG8_BAR;
            PG8_LDB(B0, 1, 0); PG8_SCHED; PG8_LDA(At, 1, 0); PG8_STAGE_A(PG8_SA(0, 1), s10, s11, kt2);
            PG8_WAIT_L(8); PG8_BAR; PG8_WAIT_L(0); PG8_MMA(0, 0, At, B0); PG8_BAR; PG8_SCHED;
            PG8_LDB(B1, 1, 1); PG8_STAGE_B(PG8_SB(1, 0), b2, 0, kt3);
            PG8_BAR; PG8_WAIT_L(0); PG8_MMA(0, 1, At, B1); PG8_BAR;
            PG8_LDA(At, 1, 1); PG8_STAGE_A(PG8_SA(1, 0), s00, s01, kt3);
            PG8_BAR; PG8_WAIT_L(0); PG8_MMA(1, 0, At, B0); PG8_BAR; PG8_SCHED;
            PG8_STAGE_B(PG8_SB(1, 1), b2, 1, kt3);
            PG8_WAIT_V(6); PG8_BAR; PG8_MMA(1, 1, At, B1); PG8_BAR;
            }
        }
        if constexpr (Epi::FP8) {
            _Pragma("unroll") for (int a = 0; a < 2; ++a)
                asm volatile("s_nop 15\n\ts_nop 15" : "+v"(acc[a][0][0][0]), "+v"(acc[a][0][0][1]), "+v"(acc[a][0][1][0]), "+v"(acc[a][0][1][1]), "+v"(acc[a][0][2][0]), "+v"(acc[a][0][2][1]), "+v"(acc[a][0][3][0]), "+v"(acc[a][0][3][1]),
                             "+v"(acc[a][1][0][0]), "+v"(acc[a][1][0][1]), "+v"(acc[a][1][1][0]), "+v"(acc[a][1][1][1]), "+v"(acc[a][1][2][0]), "+v"(acc[a][1][2][1]), "+v"(acc[a][1][3][0]), "+v"(acc[a][1][3][1]));
        }
        if constexpr (ALIGN_EPI) { if (wr == 0) PG8_BAR; }
        E(acc, cur, wr, wc, fr, fq);
        if (!has_next) break;
#pragma unroll
        for (int a = 0; a < 2; ++a)
#pragma unroll
            for (int b = 0; b < 2; ++b)
#pragma unroll
                for (int m = 0; m < 4; ++m)
#pragma unroll
                    for (int n = 0; n < 2; ++n) acc[a][b][m][n] = (f32x4){0.f, 0.f, 0.f, 0.f};
        cur = nxt; cB = nB; cD = nD; c00 = n00; c01 = n01; c10 = n10; c11 = n11; ++ui;
        if constexpr (ALIGN_EPI) { if (wr == 1) PG8_BAR; }
    }
    PG8_WAIT_V(0);
    if constexpr (!ALIGN_EPI) { if (wr == 0) PG8_BAR; }
    PG8_BAR;
#undef PG8_SA
#undef PG8_SB
#undef PG8_GLDS
#undef PG8_STAGE_A
#undef PG8_STAGE_B
#undef PG8_LDA
#undef PG8_LDB
#undef PG8_MMA
#undef PG8_WAIT_V
#undef PG8_WAIT_L
#undef PG8_BAR
#undef PG8_SCHED
#undef PG8_ROWOFF
#undef PG8_BPTR
}

struct EpiProj0 {
    static constexpr bool FP8 = false; static constexpr int scale_w = 0, scale_a = 0;
    static constexpr bool PERM = true; static constexpr bool SWAPV = true;
    __device__ __forceinline__ bool swapv(const Unit& u) const { return u.pn >= 4 && u.pn < 8; }
    bf16_t* qk; unsigned char* vtp; bf16_t* r; float* afb;
    __device__ __forceinline__ void operator()(const f32x4 (&acc)[2][2][4][2], const Unit& u, int wr, int wc, int fr, int fq) const {
        const int row0 = u.pm * BM + wr * 64 + fr;
        if (swapv(u)) {
            unsigned char* p0 = vtp + (size_t)(4 * u.pm + (wc >> 1)) * 131072 + (size_t)((((16 * (u.pn - 4) + 4 * wr) * 2 + (wc & 1)) * 64 + fr + 16 * fq) * 16);
#pragma unroll
            for (int ai = 0; ai < 2; ++ai)
#pragma unroll
                for (int m = 0; m < 4; ++m)
#pragma unroll
                    for (int bj = 0; bj < 2; ++bj) { const f32x4 v0 = acc[ai][bj][m][0], v1 = acc[ai][bj][m][1];
                        u32x4 w; w.x = cvt_pk_bf16(v0[0], v0[1]); w.y = cvt_pk_bf16(v0[2], v0[3]); w.z = cvt_pk_bf16(v1[0], v1[1]); w.w = cvt_pk_bf16(v1[2], v1[3]);
                        *(u32x4*)(p0 + (size_t)bj * 2 * 131072 + (size_t)(8 * ai + m) * 2048) = w; }
        } else if (u.pn < 12) {
            const float sc = (u.pn < 2) ? 0.08838834764831845f : 1.f;
            bf16_t* base = qk + (size_t)(u.pn >> 3) * (size_t)(130 * MiB / 2);
            const int col0 = (u.pn & 3) * BM + wc * 32 + 8 * fq;
#pragma unroll
            for (int ai = 0; ai < 2; ++ai)
#pragma unroll
                for (int m = 0; m < 4; ++m) { bf16_t* rowp = base + (size_t)(row0 + ai * HALF + m * 16) * D + col0;
#pragma unroll
                    for (int bj = 0; bj < 2; ++bj) { const f32x4 v0 = acc[ai][bj][m][0] * sc, v1 = acc[ai][bj][m][1] * sc;
                        u32x4 w; w.x = cvt_pk_bf16(v0[0], v0[1]); w.y = cvt_pk_bf16(v0[2], v0[3]); w.z = cvt_pk_bf16(v1[0], v1[1]); w.w = cvt_pk_bf16(v1[2], v1[3]);
                        *(u32x4*)(rowp + bj * HALF) = w; } }
        } else if (wc == 0) {
#pragma unroll
            for (int ai = 0; ai < 2; ++ai)
#pragma unroll
                for (int m = 0; m < 4; ++m) { float* rowp = afb + (size_t)(row0 + ai * HALF + m * 16) * 32 + 8 * fq;
                    *(f32x4*)(rowp) = acc[ai][0][m][0]; *(f32x4*)(rowp + 4) = acc[ai][0][m][1]; }
        }
    }
};
template <bool SRC_F32>
struct EpiResidT {
    static constexpr bool FP8 = false; static constexpr int scale_w = 0, scale_a = 0;
    static constexpr bool PERM = true; static constexpr bool SWAPV = false; __device__ __forceinline__ bool swapv(const Unit&) const { return false; }
    const void* src; bf16_t* dst; const float* gate;
    __device__ __forceinline__ void operator()(const f32x4 (&acc)[2][2][4][2], const Unit& u, int wr, int wc, int fr, int fq) const {
        const int row0 = u.pm * BM + wr * 64 + fr, col0 = u.pn * BM + wc * 32 + 8 * fq;
        const int b = (u.pm * BM) >> 14;
        f32x4 gv[2][2];
#pragma unroll
        for (int bj = 0; bj < 2; ++bj)
#pragma unroll
            for (int n = 0; n < 2; ++n) gv[bj][n] = *(const f32x4*)(gate + (size_t)b * 6 * D + col0 + bj * HALF + n * 4);
#pragma unroll
        for (int ai = 0; ai < 2; ++ai) {
            f32x4 sv[4][2][2];
#pragma unroll
            for (int m = 0; m < 4; ++m)
#pragma unroll
                for (int bj = 0; bj < 2; ++bj) { const size_t off = (size_t)(row0 + ai * HALF + m * 16) * D + col0 + bj * HALF;
                    if constexpr (SRC_F32) { sv[m][bj][0] = *(const f32x4*)((const float*)src + off); sv[m][bj][1] = *(const f32x4*)((const float*)src + off + 4); }
                    else { const u32x4 t = *(const u32x4*)((const bf16_t*)src + off);
                        sv[m][bj][0] = (f32x4){bflo(t.x), bfhi(t.x), bflo(t.y), bfhi(t.y)}; sv[m][bj][1] = (f32x4){bflo(t.z), bfhi(t.z), bflo(t.w), bfhi(t.w)}; } }
            asm volatile("" ::: "memory");
#pragma unroll
            for (int m = 0; m < 4; ++m)
#pragma unroll
                for (int bj = 0; bj < 2; ++bj) { const f32x4 y0 = sv[m][bj][0] + gv[bj][0] * acc[ai][bj][m][0], y1 = sv[m][bj][1] + gv[bj][1] * acc[ai][bj][m][1];
                    u32x4 w; w.x = cvt_pk_bf16(y0[0], y0[1]); w.y = cvt_pk_bf16(y0[2], y0[3]); w.z = cvt_pk_bf16(y1[0], y1[1]); w.w = cvt_pk_bf16(y1[2], y1[3]);
                    *(u32x4*)(dst + (size_t)(row0 + ai * HALF + m * 16) * D + col0 + bj * HALF) = w; }
        }
    }
};
struct EpiBf16Plain {
    static constexpr bool FP8 = false; static constexpr int scale_w = 0, scale_a = 0;
    static constexpr bool PERM = true; static constexpr bool SWAPV = false; __device__ __forceinline__ bool swapv(const Unit&) const { return false; }
    bf16_t* O; int ldc;
    __device__ __forceinline__ void operator()(const f32x4 (&acc)[2][2][4][2], const Unit& u, int wr, int wc, int fr, int fq) const {
        const int row0 = u.pm * BM + wr * 64 + fr, col0 = u.pn * BM + wc * 32 + 8 * fq;
#pragma unroll
        for (int ai = 0; ai < 2; ++ai)
#pragma unroll
            for (int m = 0; m < 4; ++m) { bf16_t* rowp = O + (size_t)(row0 + ai * HALF + m * 16) * ldc + col0;
#pragma unroll
                for (int bj = 0; bj < 2; ++bj) { const f32x4 v0 = acc[ai][bj][m][0], v1 = acc[ai][bj][m][1];
                    u32x4 w; w.x = cvt_pk_bf16(v0[0], v0[1]); w.y = cvt_pk_bf16(v0[2], v0[3]); w.z = cvt_pk_bf16(v1[0], v1[1]); w.w = cvt_pk_bf16(v1[2], v1[3]);
                    *(u32x4*)(rowp + bj * HALF) = w; } }
    }
};
__device__ __forceinline__ float dpp_shr1(float oldv, float x) { return __builtin_bit_cast(float, __builtin_amdgcn_update_dpp(__builtin_bit_cast(int, oldv), __builtin_bit_cast(int, x), 0x111, 0xF, 0xF, false)); }
__device__ __forceinline__ float dpp_shl1(float oldv, float x) { return __builtin_bit_cast(float, __builtin_amdgcn_update_dpp(__builtin_bit_cast(int, oldv), __builtin_bit_cast(int, x), 0x101, 0xF, 0xF, false)); }
__device__ __forceinline__ float dpp_ror1(float x) { return __builtin_bit_cast(float, __builtin_amdgcn_update_dpp(0, __builtin_bit_cast(int, x), 0x121, 0xF, 0xF, false)); }
__device__ __forceinline__ float dpp_rol1(float x) { return __builtin_bit_cast(float, __builtin_amdgcn_update_dpp(0, __builtin_bit_cast(int, x), 0x12F, 0xF, 0xF, false)); }
struct EpiConvFused {
    static constexpr bool FP8 = false; static constexpr int scale_w = 0, scale_a = 0;
    static constexpr bool PERM = true; static constexpr bool SWAPV = false; __device__ __forceinline__ bool swapv(const Unit&) const { return false; }
    unsigned char* dump;
    bf16_t* O; const float* ck;
    __device__ __forceinline__ void operator()(const f32x4 (&acc)[2][2][4][2], const Unit& u, int wr, int wc, int fr, int fq) const {
        const int cb = u.pn / 3, sec = u.pn - 3 * cb, tid = threadIdx.x;
        if (sec < 2) {
            const int cc = 256 * cb + 128 * sec + wc * 32 + 8 * fq;
            unsigned char* dp = dump + (size_t)sec * 65536 + tid * 16;
#pragma unroll
            for (int n = 0; n < 2; ++n) {
                const f32x4 k0 = *(const f32x4*)(ck + cc + 4 * n), k1 = *(const f32x4*)(ck + D + cc + 4 * n), k2 = *(const f32x4*)(ck + 2 * D + cc + 4 * n);
#pragma unroll
                for (int ai = 0; ai < 2; ++ai) {
                    f32x4 y[4];
#pragma unroll
                    for (int j = 0; j < 4; ++j) {
                        float x[4];
#pragma unroll
                        for (int m = 0; m < 4; ++m) x[m] = acc[ai][0][m][n][j] * acc[ai][1][m][n][j];
#pragma unroll
                        for (int m = 0; m < 4; ++m) {
                            const float up = dpp_shr1(m > 0 ? dpp_ror1(x[m - 1]) : 0.f, x[m]);
                            const float dn = dpp_shl1(m < 3 ? dpp_rol1(x[m + 1]) : 0.f, x[m]);
                            y[m][j] = k0[j] * up + k1[j] * x[m] + k2[j] * dn; }
                    }
#pragma unroll
                    for (int m = 0; m < 4; ++m) { u32x2 w; w.x = cvt_pk_bf16(y[m][0], y[m][1]); w.y = cvt_pk_bf16(y[m][2], y[m][3]);
                        *(u32x2*)(dp + (ai * 4 + m) * 8192 + n * 8) = w; }
                }
            }
        } else {
            const int row0 = u.pm * BM + wr * 64 + fr, col0 = 256 * cb + wc * 32 + 8 * fq;
            const unsigned loff = (unsigned)tid * 16u;
#pragma unroll
            for (int ai = 0; ai < 2; ++ai)
#pragma unroll
                for (int m = 0; m < 4; ++m) {
                    bf16_t* rowp = O + (size_t)(row0 + ai * HALF + m * 16) * D + col0;
                    const unsigned char* sb = dump + (ai * 4 + m) * 8192; asm volatile("" : "+s"(sb));
                    const u32x4 q0 = *(const u32x4*)(sb + loff), q1 = *(const u32x4*)(sb + 65536 + loff);
#pragma unroll
                    for (int bj = 0; bj < 2; ++bj) { const f32x4 v0 = acc[ai][bj][m][0], v1 = acc[ai][bj][m][1]; const u32x4 q = bj ? q1 : q0;
                        u32x4 w; w.x = cvt_pk_bf16(v0[0] * bflo(q.x), v0[1] * bfhi(q.x)); w.y = cvt_pk_bf16(v0[2] * bflo(q.y), v0[3] * bfhi(q.y));
                        w.z = cvt_pk_bf16(v1[0] * bflo(q.z), v1[1] * bfhi(q.z)); w.w = cvt_pk_bf16(v1[2] * bflo(q.w), v1[3] * bfhi(q.w));
                        *(u32x4*)(rowp + bj * HALF) = w; }
                    asm volatile("" ::: "memory");
                }
        }
    }
};
struct EpiSwiglu {
    static constexpr bool FP8 = true; int scale_w, scale_a;
    static constexpr bool PERM = true; static constexpr bool SWAPV = false; __device__ __forceinline__ bool swapv(const Unit&) const { return false; }
    unsigned char* hid;
    __device__ __forceinline__ void operator()(const f32x4 (&acc)[2][2][4][2], const Unit& u, int wr, int wc, int fr, int fq) const {
        const int row0 = u.e * 4096 + u.pm * BM + wr * 64 + fr, col0 = u.pn * HALF + wc * 32 + 8 * fq;
#pragma unroll
        for (int ai = 0; ai < 2; ++ai)
#pragma unroll
            for (int m = 0; m < 4; ++m) { unsigned char* rowp = hid + (size_t)(row0 + ai * HALF + m * 16) * DEXP + col0;
                float h[8];
#pragma unroll
                for (int n = 0; n < 2; ++n)
#pragma unroll
                    for (int j2 = 0; j2 < 2; ++j2) {
                        const f32x2 gt = {acc[ai][0][m][n][2 * j2], acc[ai][0][m][n][2 * j2 + 1]}, up = {acc[ai][1][m][n][2 * j2], acc[ai][1][m][n][2 * j2 + 1]};
                        const f32x2 a = gt * (f32x2){-1.4426950408889634f, -1.4426950408889634f};
                        f32x2 t; t.x = __builtin_amdgcn_exp2f(a.x); t.y = __builtin_amdgcn_exp2f(a.y);
                        const f32x2 d4 = t * (f32x2){0.25f, 0.25f} + (f32x2){0.25f, 0.25f};
                        f32x2 r4; r4.x = __builtin_amdgcn_rcpf(d4.x); r4.y = __builtin_amdgcn_rcpf(d4.y);
                        const f32x2 hv = (gt * up) * r4;
                        h[n * 4 + 2 * j2] = __builtin_amdgcn_fmed3f(hv.x, -448.f, 448.f); h[n * 4 + 2 * j2 + 1] = __builtin_amdgcn_fmed3f(hv.y, -448.f, 448.f); }
                int w0 = __builtin_amdgcn_cvt_pk_fp8_f32(h[0], h[1], 0, false); w0 = __builtin_amdgcn_cvt_pk_fp8_f32(h[2], h[3], w0, true);
                int w1 = __builtin_amdgcn_cvt_pk_fp8_f32(h[4], h[5], 0, false); w1 = __builtin_amdgcn_cvt_pk_fp8_f32(h[6], h[7], w1, true);
                u32x2 w; w.x = (unsigned)w0; w.y = (unsigned)w1;
                *(u32x2*)(rowp) = w; }
    }
};
struct EpiDown {
    static constexpr bool FP8 = true; int scale_w, scale_a;
    static constexpr bool PERM = true; static constexpr bool SWAPV = false; __device__ __forceinline__ bool swapv(const Unit&) const { return false; }
    unsigned char* ye;
    __device__ __forceinline__ void operator()(const f32x4 (&acc)[2][2][4][2], const Unit& u, int wr, int wc, int fr, int fq) const {
        const int row0 = u.e * 4096 + u.pm * BM + wr * 64 + fr, col0 = u.pn * BM + wc * 32 + 8 * fq;
#pragma unroll
        for (int ai = 0; ai < 2; ++ai)
#pragma unroll
            for (int m = 0; m < 4; ++m) { const int row = row0 + ai * HALF + m * 16; unsigned char* rowp = ye + (size_t)row * D + col0;
#pragma unroll
                for (int bj = 0; bj < 2; ++bj) { f32x4 v0 = acc[ai][bj][m][0] * 32.f, v1 = acc[ai][bj][m][1] * 32.f;
#pragma unroll
                    for (int i = 0; i < 4; ++i) { v0[i] = __builtin_amdgcn_fmed3f(v0[i], -448.f, 448.f); v1[i] = __builtin_amdgcn_fmed3f(v1[i], -448.f, 448.f); }
                    int w0 = __builtin_amdgcn_cvt_pk_fp8_f32(v0[0], v0[1], 0, false); w0 = __builtin_amdgcn_cvt_pk_fp8_f32(v0[2], v0[3], w0, true);
                    int w1 = __builtin_amdgcn_cvt_pk_fp8_f32(v1[0], v1[1], 0, false); w1 = __builtin_amdgcn_cvt_pk_fp8_f32(v1[2], v1[3], w1, true);
                    u32x2 w; w.x = (unsigned)w0; w.y = (unsigned)w1;
                    *(u32x2*)(rowp + bj * HALF) = w; } }
    }
};
}

constexpr int RING_BYTES = 131072, LDS_BYTES = 147456;
struct Args { const float* in[20]; float* out; unsigned char* ws; int ph_lo, ph_hi; };
struct Frame {
    LAS unsigned char* lds;
    int tid, lane, wave, gw, ngw, G;
};
#define P_X 0
#define P_C 1
#define P_CTX 2
#define P_CCTX 3
#define P_ADAW 4
#define P_ADAB 5
#define P_NORMG 6
#define P_GWIN 7
#define P_GWA2 8
#define P_GBA2 9
#define P_GNORMG 10
#define P_GWOUT 11
#define P_CWIN 12
#define P_CK 13
#define P_CWOUT 14
#define P_ROUTER 15
#define P_EGATE 16
#define P_EUP 17
#define P_EDOWN 18
#define P_FINALG 19

constexpr int TR_SCR = 64 * 65 * 4;
__device__ __forceinline__ void tr_item(const float* W, int ldw, int k0, int n0, bf16_t* WT, int ldo, int drow0, LAS float* scr, int lane) {
    f32x4 v[16];
#pragma unroll
    for (int i = 0; i < 16; ++i) v[i] = *(const f32x4*)(W + (size_t)(k0 + 4 * i + (lane >> 4)) * ldw + n0 + 4 * (lane & 15));
#pragma unroll
    for (int i = 0; i < 16; ++i) { LAS float* p = scr + (4 * i + (lane >> 4)) * 65 + 4 * (lane & 15); p[0] = v[i].x; p[1] = v[i].y; p[2] = v[i].z; p[3] = v[i].w; }
    LDS_WAIT(); asm volatile("" ::: "memory");
    const int c = lane & 7;
#pragma unroll
    for (int j = 0; j < 8; ++j) { const int n = (lane >> 3) + 8 * j; const LAS float* sp = scr + (8 * c) * 65 + n;
        u32x4 o; o.x = pk2(sp[0 * 65], sp[1 * 65]); o.y = pk2(sp[2 * 65], sp[3 * 65]); o.z = pk2(sp[4 * 65], sp[5 * 65]); o.w = pk2(sp[6 * 65], sp[7 * 65]);
        *(u32x4*)(WT + (size_t)(drow0 + n) * ldo + k0 + 8 * c) = o; }
    LDS_WAIT(); asm volatile("" ::: "memory");
}
__device__ __forceinline__ void tr_plain(Frame& F, const Args& A, const float* W, int K, int N, bf16_t* WT, int item, LAS float* scr) {
    const int nblk = (N + 63) / 64, kb = item / nblk, nb = item % nblk; int n0 = 64 * nb; if (n0 + 64 > N) n0 = N - 64;
    tr_item(W, N, 64 * kb, n0, WT, K, n0, scr, F.lane);
}
constexpr int TR_SCR8 = 128 * 33 * 4;
static_assert(TR_SCR8 >= TR_SCR, "per-wave scratch stride");
struct Tr8Item { const float* W; unsigned char* WT; int ldw, ldo, rowmap; };
constexpr int I8_G = (D / 128) * (DEXP / 256);
constexpr int I8_D = (DEXP / 128) * (D / 256);
constexpr int N_EXPERT_ITEMS = NE * (2 * I8_G + I8_D);
__device__ __forceinline__ Tr8Item expert_item(const Args& A, int gi) {
    const int l = gi / N_EXPERT_ITEMS, it = gi % N_EXPERT_ITEMS;
    unsigned char* wgu = A.ws + WS_W8 + (size_t)l * W8_LAYER; unsigned char* wd = wgu + W8_WD;
    constexpr int PER_E = 2 * I8_G + I8_D;
    const int e = it / PER_E; int r = it % PER_E;
    Tr8Item t;
    if (r < 2 * I8_G) {
        const int up = r / I8_G; r %= I8_G;
        const float* W = A.in[up ? P_EUP : P_EGATE] + ((size_t)l * NE + e) * D * DEXP;
        const int nblk = DEXP / 256, kb = r / nblk, nb = r % nblk, h0 = 256 * nb;
        t.W = W + (size_t)(128 * kb) * DEXP + h0; t.ldw = DEXP; t.WT = wgu + (size_t)e * 4096 * D + (size_t)(2 * h0 + 128 * up) * D + 128 * kb; t.ldo = D; t.rowmap = 1;
    } else {
        r -= 2 * I8_G;
        const float* W = A.in[P_EDOWN] + ((size_t)l * NE + e) * DEXP * D;
        const int nblk = D / 256, kb = r / nblk, nb = r % nblk;
        t.W = W + (size_t)(128 * kb) * D + 256 * nb; t.ldw = D; t.WT = wd + (size_t)e * D * DEXP + (size_t)(256 * nb) * DEXP + 128 * kb; t.ldo = DEXP; t.rowmap = 0;
    }
    return t;
}
__device__ __forceinline__ void tr8_load(const Tr8Item& t, f32x4 (&v)[16], int wave, int lane) {
#pragma unroll
    for (int i = 0; i < 16; ++i) v[i] = __builtin_nontemporal_load((const f32x4*)(t.W + (size_t)(16 * wave + i) * t.ldw + 4 * lane));
}
__device__ __forceinline__ void tr8_finish(const Tr8Item& t, const f32x4 (&v)[16], LAS unsigned char* tile, int tid, int wave, int lane) {
#pragma unroll
    for (int q = 0; q < 4; ++q) {
        int o[4];
#pragma unroll
        for (int g = 0; g < 4; ++g) { int w = __builtin_amdgcn_cvt_pk_fp8_f32(64.f * v[4 * g][q], 64.f * v[4 * g + 1][q], 0, false);
            o[g] = __builtin_amdgcn_cvt_pk_fp8_f32(64.f * v[4 * g + 2][q], 64.f * v[4 * g + 3][q], w, true); }
        u32x4 ov; ov.x = (unsigned)o[0]; ov.y = (unsigned)o[1]; ov.z = (unsigned)o[2]; ov.w = (unsigned)o[3];
        const int n = 4 * lane + q;
        *(LAS u32x4*)(tile + n * 128 + ((wave ^ (n & 7)) << 4)) = ov; }
    __syncthreads();
#pragma unroll
    for (int j = 0; j < 4; ++j) { const int p = tid + 512 * j, n = p >> 3, c = p & 7;
        const u32x4 ov = *(const LAS u32x4*)(tile + n * 128 + ((c ^ (n & 7)) << 4));
        const int drow = t.rowmap ? (256 * (n >> 7) + (n & 127)) : n;
        *(u32x4*)(t.WT + (size_t)drow * t.ldo + 16 * c) = ov; }
    __syncthreads();
}
__device__ __forceinline__ void convert_expert_dyn(const Args& A, unsigned* ctr, int end, LAS unsigned char* tile, volatile LAS int* slot, int tid, int wave, int lane) {
    if (tid == 0) { slot[0] = (int)__hip_atomic_fetch_add(ctr, 1u, __ATOMIC_RELAXED, __HIP_MEMORY_SCOPE_AGENT); slot[1] = (int)__hip_atomic_fetch_add(ctr, 1u, __ATOMIC_RELAXED, __HIP_MEMORY_SCOPE_AGENT); }
    __syncthreads();
    int ia = slot[0], ib = slot[1];
    if (ia >= end) return;
    f32x4 va[16], vb[16];
    Tr8Item ta = expert_item(A, ia), tb;
    tr8_load(ta, va, wave, lane);
    for (;;) {
        int rc = 0;
        tb = expert_item(A, min(ib, end - 1)); tr8_load(tb, vb, wave, lane);
        if (tid == 0) rc = (int)__hip_atomic_fetch_add(ctr, 1u, __ATOMIC_RELAXED, __HIP_MEMORY_SCOPE_AGENT);
        tr8_finish(ta, va, tile, tid, wave, lane);
        if (tid == 0) slot[0] = rc;
        __syncthreads();
        ia = ib; ib = slot[0];
        if (ia >= end) break;
        ta = expert_item(A, min(ib, end - 1)); tr8_load(ta, va, wave, lane);
        if (tid == 0) rc = (int)__hip_atomic_fetch_add(ctr, 1u, __ATOMIC_RELAXED, __HIP_MEMORY_SCOPE_AGENT);
        tr8_finish(tb, vb, tile, tid, wave, lane);
        if (tid == 0) slot[1] = rc;
        __syncthreads();
        ia = ib; ib = slot[1];
        if (ia >= end) break;
    }
}
template <int N>
__device__ __forceinline__ void convert_expert_fixed(const Args& A, LAS unsigned char* lds, int tid, int wave, int lane) {
    unsigned* ctr = (unsigned*)(A.ws + WS_CTL) + 2048; LAS unsigned char* tile = lds + 49152; volatile LAS int* slot = (volatile LAS int*)(lds + 40960);
    constexpr int end = 2 * N_EXPERT_ITEMS;
    __syncthreads();
    if (tid == 0) slot[0] = (int)__hip_atomic_fetch_add(ctr, (unsigned)N, __ATOMIC_RELAXED, __HIP_MEMORY_SCOPE_AGENT);
    __syncthreads();
    const int base = slot[0];
    if (base >= end) return;
    f32x4 va[16], vb[16];
    Tr8Item ta = expert_item(A, base), tb = ta;
    tr8_load(ta, va, wave, lane);
#pragma unroll
    for (int j = 0; j < N; ++j) {
        if ((j & 1) == 0) { if (j + 1 < N) { tb = expert_item(A, min(base + j + 1, end - 1)); tr8_load(tb, vb, wave, lane); } tr8_finish(ta, va, tile, tid, wave, lane); }
        else              { if (j + 1 < N) { ta = expert_item(A, min(base + j + 1, end - 1)); tr8_load(ta, va, wave, lane); } tr8_finish(tb, vb, tile, tid, wave, lane); }
    }
}

__device__ __forceinline__ void ph_prep(Frame& F, const Args& A) {
    LAS float* scr = (LAS float*)(F.lds + F.wave * TR_SCR8);
    bf16_t* win0 = (bf16_t*)(A.ws + WS_WIN0T); bf16_t* wout0 = (bf16_t*)(A.ws + WS_WOUT0T); bf16_t* wcin = (bf16_t*)(A.ws + WS_WCINT); bf16_t* wcout = (bf16_t*)(A.ws + WS_WCOUTT);
    {
        float* mod = (float*)(A.ws + WS_MOD);
        LAS float* red = (LAS float*)(F.lds + 8 * TR_SCR8);
        for (int it = blockIdx.x; it < 2 * 96; it += F.G) {
            const int l = it / 96, n = (it % 96) * 64 + F.lane;
            const float* w = A.in[P_ADAW] + (size_t)l * D * 6 * D + n;
            float a0 = 0.f, a1 = 0.f, a2 = 0.f;
#pragma unroll 16
            for (int kk = 0; kk < 128; ++kk) { const int k = F.wave * 128 + kk; const float wv = w[(size_t)k * 6 * D];
                a0 += silu_f(A.in[P_C][k]) * wv; a1 += silu_f(A.in[P_C][D + k]) * wv; a2 += silu_f(A.in[P_CCTX][k]) * wv; }
            red[(F.wave * 3 + 0) * 64 + F.lane] = a0; red[(F.wave * 3 + 1) * 64 + F.lane] = a1; red[(F.wave * 3 + 2) * 64 + F.lane] = a2;
            __syncthreads();
            if (F.wave < 3) { float sacc = A.in[P_ADAB][l * 6 * D + n];
#pragma unroll
                for (int w8 = 0; w8 < 8; ++w8) sacc += red[(w8 * 3 + F.wave) * 64 + F.lane];
                mod[(l * 3 + F.wave) * 6 * D + n] = sacc; }
            __syncthreads();
        }
    }
    constexpr int I0 = (D / 64) * ((NIN0 + 63) / 64), I1 = (D / 64) * (D / 64), I2 = (D / 64) * (NCIN / 64), I3 = I1;
    for (int it = F.gw; it < I0 + I1 + I2 + I3; it += F.ngw) {
        int r = it;
        if (r < I0) { tr_plain(F, A, A.in[P_GWIN], D, NIN0, win0, r, scr); continue; } r -= I0;
        if (r < I1) { tr_plain(F, A, A.in[P_GWOUT], D, D, wout0, r, scr); continue; } r -= I1;
        if (r < I2) {
            constexpr int nblk = NCIN / 64; const int kb = r / nblk, n0 = 64 * (r % nblk), sct = n0 >> 10, ch = n0 & 1023, cb = ch >> 8, hf = (ch >> 7) & 1;
            const int drow0 = sct == 0 ? (3 * cb + 2) * 256 + (ch & 255) : (3 * cb + hf) * 256 + 128 * (sct - 1) + (ch & 127);
            tr_item(A.in[P_CWIN], NCIN, 64 * kb, n0, wcin, D, drow0, scr, F.lane); continue; } r -= I2;
        tr_plain(F, A, A.in[P_CWOUT], D, D, wcout, r, scr);
    }
    { u32x4* z = (u32x4*)(win0 + (size_t)NIN0 * D); const int n16 = (NIN0P - NIN0) * D * 2 / 16;
      for (int i = F.gw * 64 + F.lane; i < n16; i += F.ngw * 64) z[i] = (u32x4){0u, 0u, 0u, 0u}; }
}

__device__ __forceinline__ void normmod_row(const f32x4 (&v)[4], const float* g, const float* sh, const float* sc, bf16_t* orow, int lane) {
    float s = 0.f;
#pragma unroll
    for (int j = 0; j < 4; ++j) s += (v[j].x * v[j].x + v[j].y * v[j].y) + (v[j].z * v[j].z + v[j].w * v[j].w);
    const float rstd = rsqrtf(wave_sum(s) * (1.f / D) + EPS);
#pragma unroll
    for (int j = 0; j < 4; ++j) { const int c = 4 * lane + 256 * j;
        const f32x4 gg = *(const f32x4*)(g + c), s1 = *(const f32x4*)(sh + c), s2 = *(const f32x4*)(sc + c);
        const f32x4 y = v[j] * rstd * gg * (s2 + 1.f) + s1;
        u32x2 w; w.x = pk2(y.x, y.y); w.y = pk2(y.z, y.w);
        *(u32x2*)(orow + c) = w; }
}
__device__ __forceinline__ void ph_norm0(Frame& F, const Args& A) {
    const float* mod = (const float*)(A.ws + WS_MOD); bf16_t* H = (bf16_t*)(A.ws + WS_H);
    for (int row = F.gw; row < NROW; row += F.ngw) {
        const float* xr = row < NLAT ? A.in[P_X] + (size_t)row * D : A.in[P_CTX] + (size_t)(row - NLAT) * D;
        const int s = row < NLAT ? (row >> 14) : 2;
        f32x4 v[4];
#pragma unroll
        for (int j = 0; j < 4; ++j) v[j] = *(const f32x4*)(xr + 4 * F.lane + 256 * j);
        normmod_row(v, A.in[P_NORMG] + 0 * D, mod + (0 * 3 + s) * 6 * D + 0 * D, mod + (0 * 3 + s) * 6 * D + 1 * D, H + (size_t)row * D, F.lane);
    }
}

__device__ __forceinline__ int jperm(int ks, int fq, int jj) { return 32 * ks + 16 * (jj >> 2) + 4 * fq + (jj & 3); }
__device__ __forceinline__ bf16x8 ldfrag(const unsigned char* blob, int blk, int lane) { return *(const bf16x8*)(blob + blk * 1024 + lane * 16); }
__device__ __forceinline__ unsigned cvtpk(float lo, float hi) { return pk2(lo, hi); }
__device__ __forceinline__ bf16x8 pack8(const f32x4& a, const f32x4& b) {
    u32x4 w; w.x = cvtpk(a[0], a[1]); w.y = cvtpk(a[2], a[3]); w.z = cvtpk(b[0], b[1]); w.w = cvtpk(b[2], b[3]);
    return __builtin_bit_cast(bf16x8, w);
}
__device__ __forceinline__ void ph_gla_prep(Frame& F, const Args& A) {
    constexpr int LSTR = 1040;
    LAS unsigned char* QS = F.lds; LAS unsigned char* KS = F.lds + 64 * LSTR;
    const bf16_t* qk = (const bf16_t*)(A.ws + WS_QK); const float* afb = (const float*)(A.ws + WS_AFB);
    float* gam = (float*)(A.ws + WS_GAM);
    const bool has_conv = blockIdx.x + 4 * F.G >= 2 * NCHUNK;
    const int pre = has_conv ? (int)(blockIdx.x & 3) : 0;
    if (pre == 1) convert_expert_fixed<1>(A, F.lds, F.tid, F.wave, F.lane);
    else if (pre == 2) convert_expert_fixed<2>(A, F.lds, F.tid, F.wave, F.lane);
    else if (pre == 3) convert_expert_fixed<3>(A, F.lds, F.tid, F.wave, F.lane);
    __syncthreads();
    const int dir = blockIdx.x & 1, d = F.tid;
    f32x2 w2[8];
#pragma unroll
    for (int r = 0; r < 8; ++r) { w2[r].x = A.in[P_GWA2][(dir * 16 + 2 * r) * DK + d]; w2[r].y = A.in[P_GWA2][(dir * 16 + 2 * r + 1) * DK + d]; }
    const float bias = A.in[P_GBA2][dir * DK + d];
    u32x4 t16[16]; f32x4 av = (f32x4){0.f, 0.f, 0.f, 0.f};
#define PREP_LOAD(it_) do { const int row0_ = ((it_) >> 1) * 64; \
        _Pragma("unroll") for (int u = 0; u < 16; ++u) { const int q16 = F.tid + NTHR * u, j = q16 >> 7, cp = q16 & 127; t16[u] = *(const u32x4*)((const unsigned char*)qk + ((size_t)(row0_ + j) * D) * 2 + cp * 16); } \
        if (F.tid < 256) av = *(const f32x4*)(afb + (size_t)(row0_ + (F.tid >> 2)) * 32 + dir * 16 + 4 * (F.tid & 3)); } while (0)
    if ((int)blockIdx.x < 2 * NCHUNK) PREP_LOAD((int)blockIdx.x);
    for (int item = blockIdx.x; item < 2 * NCHUNK; item += F.G) {
        {
            const int ch = item >> 1, row0 = ch * 64; (void)row0;
            LAS float* AFL = (LAS float*)(F.lds + 2 * 64 * LSTR);
            {
#pragma unroll
                for (int u = 0; u < 16; ++u) { const int q16 = F.tid + NTHR * u, j = q16 >> 7, cp = q16 & 127; *(LAS u32x4*)(((cp < 64) ? QS : KS) + j * LSTR + (cp & 63) * 16) = t16[u]; }
                if (F.tid < 256) *(LAS f32x4*)(AFL + (F.tid >> 2) * 16 + 4 * (F.tid & 3)) = av;
            }
            if (item + F.G < 2 * NCHUNK) PREP_LOAD(item + F.G);
            __syncthreads();
            float cum2 = 0.f;
#pragma unroll 1
            for (int jq = 0; jq < 64; jq += 4) {
                f32x4 ar[4][4]; unsigned qv[4], kv[4];
#pragma unroll
                for (int u = 0; u < 4; ++u) { const int j = dir ? 63 - (jq + u) : jq + u;
#pragma unroll
                    for (int r4 = 0; r4 < 4; ++r4) ar[u][r4] = *(const LAS f32x4*)(AFL + j * 16 + 4 * r4); }
#pragma unroll
                for (int u = 0; u < 4; ++u) { const int j = dir ? 63 - (jq + u) : jq + u;
                    qv[u] = *(const LAS bf16_t*)(QS + j * LSTR + d * 2); kv[u] = *(const LAS bf16_t*)(KS + j * LSTR + d * 2); }
                asm volatile("" ::: "memory");
                float ls2[4];
#pragma unroll
                for (int u = 0; u < 4; ++u) {
                    f32x2 za = (f32x2){bias, 0.f}, zb = (f32x2){0.f, 0.f};
#pragma unroll
                    for (int r4 = 0; r4 < 4; ++r4) { za = __builtin_elementwise_fma((f32x2){ar[u][r4].x, ar[u][r4].y}, w2[2 * r4], za); zb = __builtin_elementwise_fma((f32x2){ar[u][r4].z, ar[u][r4].w}, w2[2 * r4 + 1], zb); }
                    const float z = (za.x + za.y) + (zb.x + zb.y);
                    const float zl = z * 1.4426950408889634f;
                    ls2[u] = fminf(zl, 0.f) - __builtin_amdgcn_logf(1.f + __builtin_amdgcn_exp2f(-fabsf(zl)));
                }
                unsigned qk2[4];
#pragma unroll
                for (int u = 0; u < 4; ++u) {
                    cum2 += ls2[u] * (1.f / 16.f);
                    const float e = __builtin_amdgcn_exp2f(cum2), ei = __builtin_amdgcn_exp2f(-cum2);
                    qk2[u] = pk2(bflo(qv[u]) * e, bflo(kv[u]) * ei);
                }
#pragma unroll
                for (int u = 0; u < 4; ++u) { const int j = dir ? 63 - (jq + u) : jq + u;
                    *(LAS bf16_t*)(QS + j * LSTR + d * 2) = (bf16_t)(qk2[u] & 0xffffu); *(LAS bf16_t*)(KS + j * LSTR + d * 2) = (bf16_t)(qk2[u] >> 16); }
            }
            const float cum = cum2 * 0.6931471805599453f;
            gam[((size_t)dir * NCHUNK + ch) * DK + d] = __expf(cum);
            __syncthreads();
            {
                const int fr = F.lane & 15, fq = F.lane >> 4;
                unsigned char* blob0 = A.ws + (((size_t)dir * NCHUNK + ch) * 4) * BLOB + (size_t)F.tid * 16;
#pragma unroll
                for (int typ = 0; typ < 2; ++typ) {
                    const LAS unsigned char* src = (typ == 0) ? QS : KS;
                    u32x4 o[8];
#pragma unroll
                    for (int i8 = 0; i8 < 8; ++i8) { const int h = i8 >> 1, blk = F.wave + 8 * (i8 & 1), it = blk >> 2, sd = blk & 3, i = 16 * it + fr, d0 = h * HK + 32 * sd + 4 * fq;
                        const u32x2 lo = *(const LAS u32x2*)(src + i * LSTR + d0 * 2), hi = *(const LAS u32x2*)(src + i * LSTR + (d0 + 16) * 2);
                        o[i8].x = lo.x; o[i8].y = lo.y; o[i8].z = hi.x; o[i8].w = hi.y; }
                    unsigned char* dst = blob0 + (typ == 0 ? WS_QP : WS_KP);
#pragma unroll
                    for (int i8 = 0; i8 < 8; ++i8) *(u32x4*)(dst + (size_t)(i8 >> 1) * BLOB + (size_t)(i8 & 1) * 8192) = o[i8];
                }
                {
                    u32x4 o[8];
#pragma unroll
                    for (int i8 = 0; i8 < 8; ++i8) { const int h = i8 >> 1, blk = F.wave + 8 * (i8 & 1), mt = blk >> 1, ks = blk & 1, dd = h * HK + 16 * mt + fr; unsigned e[8];
#pragma unroll
                        for (int jj = 0; jj < 8; ++jj) e[jj] = *(const LAS bf16_t*)(KS + jperm(ks, fq, jj) * LSTR + dd * 2);
                        o[i8].x = e[0] | (e[1] << 16); o[i8].y = e[2] | (e[3] << 16); o[i8].z = e[4] | (e[5] << 16); o[i8].w = e[6] | (e[7] << 16); }
                    unsigned char* dst = blob0 + WS_KTP;
#pragma unroll
                    for (int i8 = 0; i8 < 8; ++i8) *(u32x4*)(dst + (size_t)(i8 >> 1) * BLOB + (size_t)(i8 & 1) * 8192) = o[i8];
                }
            }
            __syncthreads();
        }
    }
#undef PREP_LOAD
    if (has_conv) {
        if (pre == 0) convert_expert_fixed<4>(A, F.lds, F.tid, F.wave, F.lane);
        else if (pre == 1) convert_expert_fixed<3>(A, F.lds, F.tid, F.wave, F.lane);
        else if (pre == 2) convert_expert_fixed<2>(A, F.lds, F.tid, F.wave, F.lane);
        else convert_expert_fixed<1>(A, F.lds, F.tid, F.wave, F.lane);
    }
}

#define MFMA16(a, b, c) __builtin_amdgcn_mfma_f32_16x16x32_bf16((a), (b), (c), 0, 0, 0)
__device__ __forceinline__ void gla_intra_item(Frame& F, const Args& A, int item) {
    const int ch = item >> 2, h = item & 3, fr = F.lane & 15, fq = F.lane >> 4;
    const unsigned char* qpf = A.ws + WS_QP + (((size_t)0 * NCHUNK + ch) * 4 + h) * BLOB; const unsigned char* kpf = A.ws + WS_KP + (((size_t)0 * NCHUNK + ch) * 4 + h) * BLOB;
    const unsigned char* qpb = A.ws + WS_QP + (((size_t)1 * NCHUNK + ch) * 4 + h) * BLOB; const unsigned char* kpb = A.ws + WS_KP + (((size_t)1 * NCHUNK + ch) * 4 + h) * BLOB;
    bf16x8 Pf[4][2];
#pragma unroll
    for (int it = 0; it < 4; ++it) {
        f32x4 P[4];
#pragma unroll
        for (int jt = 0; jt < 4; ++jt) P[jt] = (f32x4){0.f, 0.f, 0.f, 0.f};
#pragma unroll
        for (int dirp = 0; dirp < 2; ++dirp) {
            const unsigned char* qp = dirp ? qpb : qpf; const unsigned char* kp = dirp ? kpb : kpf;
            bf16x8 kk[16], qq[4];
#pragma unroll
            for (int sd = 0; sd < 4; ++sd) qq[sd] = ldfrag(qp, it * 4 + sd, F.lane);
#pragma unroll
            for (int jt = 0; jt < 4; ++jt) if (dirp ? (jt >= it) : (jt <= it)) {
#pragma unroll
                for (int sd = 0; sd < 4; ++sd) kk[jt * 4 + sd] = ldfrag(kp, jt * 4 + sd, F.lane); }
#pragma unroll
            for (int jt = 0; jt < 4; ++jt) if (dirp ? (jt >= it) : (jt <= it)) {
                f32x4 a = (f32x4){0.f, 0.f, 0.f, 0.f};
#pragma unroll
                for (int sd = 0; sd < 4; ++sd) a = MFMA16(kk[jt * 4 + sd], qq[sd], a);
                if (jt == it) {
#pragma unroll
                    for (int r = 0; r < 4; ++r) { const int j = 4 * fq + r; const bool keep = dirp ? (j >= fr) : (j <= fr); a[r] = keep ? a[r] : 0.f; }
                }
                P[jt] += a;
            }
        }
        Pf[it][0] = pack8(P[0], P[1]); Pf[it][1] = pack8(P[2], P[3]);
    }
    const unsigned char* vt = A.ws + WS_VTP + (size_t)ch * 131072 + (size_t)(h * 16) * 2048;
    bf16_t* oi = (bf16_t*)(A.ws + WS_OI) + (size_t)(ch * 64 + fr) * DV + h * HV + 4 * fq;
#pragma unroll 1
    for (int ng = 0; ng < 4; ++ng) {
        bf16x8 va[8];
#pragma unroll
        for (int i = 0; i < 8; ++i) va[i] = ldfrag(vt, ng * 8 + i, F.lane);
#pragma unroll
        for (int n4 = 0; n4 < 4; ++n4)
#pragma unroll
            for (int it = 0; it < 4; ++it) {
                f32x4 acc = (f32x4){0.f, 0.f, 0.f, 0.f};
                acc = MFMA16(va[n4 * 2], Pf[it][0], acc); acc = MFMA16(va[n4 * 2 + 1], Pf[it][1], acc);
                u32x2 w; w.x = pk2(acc[0], acc[1]); w.y = pk2(acc[2], acc[3]);
                *(u32x2*)(oi + (size_t)(16 * it) * DV + 16 * (ng * 4 + n4)) = w;
            }
    }
}
struct ScanRegs { bf16x8 q[4], k[4], v[2][2]; f32x4 g[2]; };
__device__ __forceinline__ int scan_chunk(int b, int dir, int step) { return step >= 4 ? (256 * b + (dir ? 255 - (step - 4) : step - 4)) : (512 + 4 * b + (dir ? 3 - step : step)); }
__device__ __forceinline__ void scan_load(const Args& A, ScanRegs& R, int b, int h, int dir, int sp, int w, int step, int lane) {
    const int ch = scan_chunk(b, dir, step), fq = lane >> 4;
    const size_t bo = (((size_t)dir * NCHUNK + ch) * 4 + h) * BLOB;
    const unsigned char* qp = A.ws + WS_QP + bo; const unsigned char* ktp = A.ws + WS_KTP + bo;
    const unsigned char* vt = A.ws + WS_VTP + (size_t)ch * 131072 + (size_t)(h * 16 + 2 * sp) * 2048;
    const float* gp = (const float*)(A.ws + WS_GAM) + ((size_t)dir * NCHUNK + ch) * DK + h * HK + 32 * w + 4 * fq;
#pragma unroll
    for (int sd = 0; sd < 4; ++sd) R.q[sd] = ldfrag(qp, w * 4 + sd, lane);
#pragma unroll
    for (int m = 0; m < 2; ++m)
#pragma unroll
        for (int ks = 0; ks < 2; ++ks) R.k[m * 2 + ks] = ldfrag(ktp, (2 * w + m) * 2 + ks, lane);
#pragma unroll
    for (int s2 = 0; s2 < 2; ++s2) {
        const int o = 8 * ((lane & 15) >> 2) + 4 * s2 + (lane & 3);
        const unsigned char* vp = vt + (o >> 4) * 2048 + ((o & 15) + (lane & 48)) * 16;
        R.v[s2][0] = *(const bf16x8*)(vp); R.v[s2][1] = *(const bf16x8*)(vp + 1024); }
    R.g[0] = *(const f32x4*)(gp); R.g[1] = *(const f32x4*)(gp + 16);
}
#define LDS_ORDER() asm volatile("" ::: "memory")
__device__ __forceinline__ void scan_ds(const ScanRegs& R, f32x4 (&dS)[2][2]) {
#pragma unroll
    for (int s2 = 0; s2 < 2; ++s2)
#pragma unroll
        for (int m = 0; m < 2; ++m) { f32x4 d = (f32x4){0.f, 0.f, 0.f, 0.f}; d = MFMA16(R.k[m * 2], R.v[s2][0], d); d = MFMA16(R.k[m * 2 + 1], R.v[s2][1], d); dS[s2][m] = d; }
}
__device__ __forceinline__ void scan_step(const Args& A, const ScanRegs& R, const ScanRegs& Rn, f32x4 (&S)[2][2], f32x4 (&dS)[2][2], LAS unsigned char* xs, LAS unsigned* flags, bf16_t* O, int b, int h, int dir, int sp, int w, int step, int lane) {
    const int fr = lane & 15, fq = lane >> 4;
#pragma unroll
    for (int s2 = 0; s2 < 2; ++s2) {
        S[s2][0] = R.g[0] * (S[s2][0] + dS[s2][0]); S[s2][1] = R.g[1] * (S[s2][1] + dS[s2][1]);
        *(volatile LAS bf16x8*)(xs + ((step + 1) & 3) * 8192 + (s2 * 4 + w) * 1024 + lane * 16) = pack8(S[s2][0], S[s2][1]);
    }
    LDS_ORDER();
    if (lane == 0) *(volatile LAS unsigned*)(flags + w) = (unsigned)step + 2u;
    LDS_ORDER();
    scan_ds(Rn, dS);
    if (step >= 4) {
        { const unsigned need = (unsigned)step + 1u; unsigned spn = 0;
          for (;;) { const unsigned f = (lane < 4) ? *(volatile LAS unsigned*)(flags + lane) : need;
              if (__all((int)(f >= need))) break; if (++spn > (1u << 26)) break; }
          LDS_ORDER(); }
        const LAS unsigned char* slot = xs + (step & 3) * 8192 + lane * 16;
        bf16x8 sf[2][4];
#pragma unroll
        for (int s2 = 0; s2 < 2; ++s2)
#pragma unroll
            for (int sd = 0; sd < 4; ++sd) sf[s2][sd] = *(const LAS bf16x8*)(slot + (s2 * 4 + sd) * 1024);
        LDS_ORDER();
        const int ch = scan_chunk(b, dir, step);
        f32x4 acc0 = (f32x4){0.f, 0.f, 0.f, 0.f}, acc1 = acc0;
#pragma unroll
        for (int sd = 0; sd < 4; ++sd) { acc0 = MFMA16(sf[0][sd], R.q[sd], acc0); acc1 = MFMA16(sf[1][sd], R.q[sd], acc1); }
        u32x4 wv; wv.x = pk2(acc0[0], acc0[1]); wv.y = pk2(acc0[2], acc0[3]); wv.z = pk2(acc1[0], acc1[1]); wv.w = pk2(acc1[2], acc1[3]);
        *(u32x4*)(O + (size_t)(ch * 64 + 16 * w + fr) * DV + h * HV + 32 * sp + 8 * fq) = wv;
    }
}
__device__ __forceinline__ void gla_scan_item(Frame& F, const Args& A, int item, LAS unsigned char* xs, LAS unsigned* flags) {
    const int chain = item >> 3, sp = item & 7, b = chain >> 3, h = (chain >> 1) & 3, dir = chain & 1, w = F.wave;
    bf16_t* O = (bf16_t*)(A.ws + (dir ? WS_OB : WS_OF));
    f32x4 S[2][2], dS[2][2];
#pragma unroll
    for (int s2 = 0; s2 < 2; ++s2) { S[s2][0] = (f32x4){0.f, 0.f, 0.f, 0.f}; S[s2][1] = S[s2][0];
        *(volatile LAS bf16x8*)(xs + (s2 * 4 + w) * 1024 + F.lane * 16) = pack8(S[s2][0], S[s2][1]); }
    LDS_ORDER();
    if (F.lane == 0) *(volatile LAS unsigned*)(flags + w) = 1u;
    LDS_ORDER();
    ScanRegs Ra, Rb, Rc;
    scan_load(A, Ra, b, h, dir, sp, w, 0, F.lane);
    scan_load(A, Rb, b, h, dir, sp, w, 1, F.lane);
    scan_ds(Ra, dS);
    for (int step = 0; step < 261; step += 3) {
        scan_load(A, Rc, b, h, dir, sp, w, min(step + 2, 259), F.lane);
        scan_step(A, Ra, Rb, S, dS, xs, flags, O, b, h, dir, sp, w, step, F.lane);
        scan_load(A, Ra, b, h, dir, sp, w, min(step + 3, 259), F.lane);
        scan_step(A, Rb, Rc, S, dS, xs, flags, O, b, h, dir, sp, w, step + 1, F.lane);
        scan_load(A, Rb, b, h, dir, sp, w, min(step + 4, 259), F.lane);
        if (step + 2 < 260) scan_step(A, Rc, Ra, S, dS, xs, flags, O, b, h, dir, sp, w, step + 2, F.lane);
    }
}
__device__ __forceinline__ void ph_gla_main(Frame& F, const Args& A) {
    LAS unsigned char* xs = F.lds; LAS unsigned* flags = (LAS unsigned*)(F.lds + 32768);
    if (F.tid < 16) flags[F.tid] = 0u;
    __syncthreads();
    const int bi = blockIdx.x;
    unsigned* ctr = (unsigned*)(A.ws + WS_CTL) + 2048;
    volatile LAS int* slot = (volatile LAS int*)(F.lds + 40960);
    if (bi < 128) {
        if (F.wave < 4) gla_scan_item(F, A, ((2 * (bi & 7) + ((bi >> 3) & 1)) << 3) | ((bi >> 4) & 7), xs, flags);
        __syncthreads();
    } else {
        const int sw = (bi - 128) * NWAVES + F.wave, nsw = (F.G - 128) * NWAVES;
        for (int it = sw; it < 512 * 4; it += nsw) gla_intra_item(F, A, it);
        __syncthreads();
    }
    convert_expert_dyn(A, ctr, 2 * N_EXPERT_ITEMS, F.lds + 49152, slot, F.tid, F.wave, F.lane);
    __syncthreads();
}

__device__ __forceinline__ void ph_gla_finish(Frame& F, const Args& A) {
    const bf16_t* rp = (const bf16_t*)(A.ws + WS_R); const bf16_t* OFp = (const bf16_t*)(A.ws + WS_OF); const bf16_t* OBp = (const bf16_t*)(A.ws + WS_OB); const bf16_t* OIp = (const bf16_t*)(A.ws + WS_OI);
    bf16_t* Hh = (bf16_t*)(A.ws + WS_H);
    const f32x4 gn = *(const f32x4*)(A.in[P_GNORMG] + 4 * F.lane);
    for (int row = F.gw; row < NLAT; row += F.ngw) {
#pragma unroll
        for (int j = 0; j < 4; ++j) {
            const int cc = 4 * F.lane + 256 * j;
            const u32x2 a = *(const u32x2*)(OFp + (size_t)row * DV + cc), bq = *(const u32x2*)(OBp + (size_t)row * DV + cc), ci = *(const u32x2*)(OIp + (size_t)row * DV + cc);
            const u32x2 rr = *(const u32x2*)(rp + (size_t)row * D + cc);
            f32x4 o; o.x = bflo(a.x) + bflo(bq.x) + bflo(ci.x); o.y = bfhi(a.x) + bfhi(bq.x) + bfhi(ci.x); o.z = bflo(a.y) + bflo(bq.y) + bflo(ci.y); o.w = bfhi(a.y) + bfhi(bq.y) + bfhi(ci.y);
            const float ss = wave_sum((o.x * o.x + o.y * o.y) + (o.z * o.z + o.w * o.w));
            const float rstd = rsqrtf(ss * (1.f / HV) + EPS);
            f32x4 r; r.x = bflo(rr.x); r.y = bfhi(rr.x); r.z = bflo(rr.y); r.w = bfhi(rr.y);
            f32x4 y;
#pragma unroll
            for (int i = 0; i < 4; ++i) y[i] = o[i] * rstd * gn[i] * silu_f(r[i]);
            u32x2 w; w.x = pk2(y.x, y.y); w.y = pk2(y.z, y.w);
            *(u32x2*)(Hh + (size_t)row * D + cc) = w;
        }
    }
}

__device__ __forceinline__ void stage_router(Frame& F, const Args& A, int l) {
    LAS float* wl = (LAS float*)F.lds;
    const float* rw = A.in[P_ROUTER] + (size_t)l * D * NE;
    for (int idx = F.tid; idx < D * NE; idx += NTHR) { const int k = idx >> 4, e = idx & 15, j = k >> 8, ln = (k & 255) >> 2, i = k & 3; wl[((((j * 4 + i) * 4 + (e >> 2)) * 64) + ln) * 4 + (e & 3)] = rw[idx]; }
    __syncthreads();
}
template <int N, int M>
__device__ __forceinline__ void rs_step(const float (&v)[N], float (&w)[N / 2], int lane) {
    const bool hi = (lane & M) != 0;
#pragma unroll
    for (int e = 0; e < N / 2; ++e) { const float mine = hi ? v[N / 2 + e] : v[e], other = hi ? v[e] : v[N / 2 + e]; w[e] = mine + __shfl_xor(other, M); }
}
__device__ __forceinline__ void ph_norm2_router(Frame& F, const Args& A, int l) {
    stage_router(F, A, l);
    const LAS float* wl = (const LAS float*)F.lds;
    const float* mod = (const float*)(A.ws + WS_MOD); unsigned char* H8 = A.ws + WS_H; const bf16_t* X = (const bf16_t*)(A.ws + WS_X); float* aff = (float*)(A.ws + WS_AFF);
    const float* g = A.in[P_NORMG] + (l * 2 + 1) * D;
    for (int rp = F.gw; rp < NLAT / 2; rp += F.ngw) {
        const int row = 2 * rp, b = row >> 14; const float* sh = mod + (l * 3 + b) * 6 * D + 3 * D; const float* sc = mod + (l * 3 + b) * 6 * D + 4 * D;
        const bf16_t* Xr = X + (size_t)row * D; unsigned char* Hr = H8 + (size_t)row * D; const float* gr = g; const float* shr = sh; const float* scr_ = sc;
        asm volatile("" : "+s"(Xr), "+s"(Hr), "+s"(gr), "+s"(shr), "+s"(scr_));
        const unsigned lo4 = 4u * (unsigned)F.lane;
        float lg0 = 0.f, lg1 = 0.f;
        f32x4 v[2][4]; float ss[2] = {0.f, 0.f};
#pragma unroll
        for (int r = 0; r < 2; ++r)
#pragma unroll
            for (int j = 0; j < 4; ++j) { const u32x2 t = *(const u32x2*)(Xr + r * D + lo4 + 256 * j); v[r][j] = (f32x4){bflo(t.x), bfhi(t.x), bflo(t.y), bfhi(t.y)}; ss[r] += (v[r][j].x * v[r][j].x + v[r][j].y * v[r][j].y) + (v[r][j].z * v[r][j].z + v[r][j].w * v[r][j].w); }
        const float rstd0 = rsqrtf(wave_sum(ss[0]) * (1.f / D) + EPS), rstd1 = rsqrtf(wave_sum(ss[1]) * (1.f / D) + EPS);
#pragma unroll
        for (int j = 0; j < 4; ++j) { const unsigned c = lo4 + 256 * j;
            const f32x4 gg = *(const f32x4*)(gr + c), s1 = *(const f32x4*)(shr + c), s2 = *(const f32x4*)(scr_ + c);
#pragma unroll
            for (int r = 0; r < 2; ++r) {
                v[r][j] = v[r][j] * (r ? rstd1 : rstd0) * gg * (s2 + 1.f) + s1;
                const f32x4 cl = __builtin_elementwise_min(__builtin_elementwise_max(v[r][j], (f32x4){-448.f, -448.f, -448.f, -448.f}), (f32x4){448.f, 448.f, 448.f, 448.f});
                int w = __builtin_amdgcn_cvt_pk_fp8_f32(cl.x, cl.y, 0, false); w = __builtin_amdgcn_cvt_pk_fp8_f32(cl.z, cl.w, w, true);
                *(int*)(Hr + r * D + c) = w; } }
#pragma unroll 1
        for (int eh = 0; eh < 2; ++eh) {
            f32x2 pp[8];
#pragma unroll
            for (int e = 0; e < 8; ++e) pp[e] = (f32x2){0.f, 0.f};
#pragma unroll
            for (int j = 0; j < 4; ++j)
#pragma unroll
                for (int i = 0; i < 4; ++i) { const float x0 = v[0][j][i], x1 = v[1][j][i];
                    asm volatile("" ::: "memory");
#pragma unroll
                    for (int q = 0; q < 2; ++q) { const f32x4 wv = *(const LAS f32x4*)(wl + ((((j * 4 + i) * 4 + 2 * eh + q) * 64) + F.lane) * 4);
                        const f32x2 wa = {wv.x, wv.y}, wb = {wv.z, wv.w}, xx0 = {x0, x0}, xx1 = {x1, x1};
                        pp[2 * q] += xx0 * wa; pp[2 * q + 1] += xx0 * wb; pp[4 + 2 * q] += xx1 * wa; pp[4 + 2 * q + 1] += xx1 * wb; } }
            float p[16];
#pragma unroll
            for (int e = 0; e < 8; ++e) { p[2 * e] = pp[e].x; p[2 * e + 1] = pp[e].y; }
            float r8[8], r4[4], r2[2], r1[1];
            rs_step<16, 32>(p, r8, F.lane); rs_step<8, 16>(r8, r4, F.lane); rs_step<4, 8>(r4, r2, F.lane); rs_step<2, 4>(r2, r1, F.lane);
            float lg = r1[0] + __shfl_xor(r1[0], 2); lg += __shfl_xor(lg, 1);
            if (eh == 0) lg0 = lg; else lg1 = lg;
        }
        float mx = fmaxf(lg0, lg1);
#pragma unroll
        for (int o = 4; o < 32; o <<= 1) mx = fmaxf(mx, __shfl_xor(mx, o));
        const float ex0 = __expf(lg0 - mx), ex1 = __expf(lg1 - mx);
        float den = ex0 + ex1;
#pragma unroll
        for (int o = 4; o < 32; o <<= 1) den += __shfl_xor(den, o);
        if ((F.lane & 3) == 0) { const int e8 = (F.lane >> 2) & 7, t = (row + (F.lane >> 5)) & (T - 1); const float inv = 1.f / den;
            aff[((size_t)b * NE + e8) * T + t] = ex0 * inv; aff[((size_t)b * NE + 8 + e8) * T + t] = ex1 * inv; }
    }
    __syncthreads();
}

__device__ __forceinline__ void ph_topk(Frame& F, const Args& A) {
    LAS int* red = (LAS int*)F.lds;
    const float* aff = (const float*)(A.ws + WS_AFF); int* slot = (int*)(A.ws + WS_SLOT); int* rowlist = (int*)(A.ws + WS_ROWLIST); float* selval = (float*)(A.ws + WS_SELVAL);
    for (int item = blockIdx.x; item < NB * NE; item += F.G) {
        const int b = item / NE, e = item % NE;
        const float* a = aff + ((size_t)b * NE + e) * T + F.tid * 32;
        unsigned v[32];
#pragma unroll
        for (int q = 0; q < 8; ++q) { const u32x4 x = *(const u32x4*)(a + 4 * q); v[4 * q] = x.x; v[4 * q + 1] = x.y; v[4 * q + 2] = x.z; v[4 * q + 3] = x.w; }
        unsigned prefix = 0u; int par = 0;
        for (int bit = 30; bit >= 0; --bit) {
            const unsigned cand = prefix | (1u << bit); int cnt = 0;
#pragma unroll
            for (int i = 0; i < 32; ++i) cnt += (v[i] >= cand) ? 1 : 0;
            cnt = wave_sum_i(cnt);
            if (F.lane == 0) red[par * 16 + F.wave] = cnt;
            __syncthreads();
            int tot = 0;
#pragma unroll
            for (int w8 = 0; w8 < 8; ++w8) tot += red[par * 16 + w8];
            if (tot >= CAP) prefix = cand;
            par ^= 1;
        }
        __syncthreads();
        int mgt = 0, meq = 0;
#pragma unroll
        for (int i = 0; i < 32; ++i) { mgt += (v[i] > prefix) ? 1 : 0; meq += (v[i] == prefix) ? 1 : 0; }
        int igt = mgt, ieq = meq;
#pragma unroll
        for (int o = 1; o < 64; o <<= 1) { const int ug = __shfl_up(igt, o), ue = __shfl_up(ieq, o); if (F.lane >= o) { igt += ug; ieq += ue; } }
        if (F.lane == 63) { red[F.wave] = igt; red[16 + F.wave] = ieq; }
        __syncthreads();
        int bgt = 0, beq = 0, totgt = 0;
#pragma unroll
        for (int w8 = 0; w8 < 8; ++w8) { const int xg = red[w8], xe = red[16 + w8]; if (w8 < F.wave) { bgt += xg; beq += xe; } totgt += xg; }
        const int need_eq = CAP - totgt;
        int gtb = bgt + igt - mgt, eqb = beq + ieq - meq;
        const int t0 = F.tid * 32;
#pragma unroll
        for (int q = 0; q < 2; ++q) {
            int sl[16];
#pragma unroll
            for (int i = 0; i < 16; ++i) {
                const unsigned x = v[q * 16 + i]; const bool gt = x > prefix, eq = x == prefix; const bool sel = gt || (eq && eqb < need_eq);
                const int pos = gtb + (eqb < need_eq ? eqb : need_eq);
                sl[i] = sel ? pos : -1;
                if (sel) { rowlist[e * 4096 + b * CAP + pos] = b * T + t0 + q * 16 + i; selval[e * 4096 + b * CAP + pos] = __builtin_bit_cast(float, x); }
                gtb += gt ? 1 : 0; eqb += eq ? 1 : 0;
            }
#pragma unroll
            for (int i4 = 0; i4 < 4; ++i4) *(i32x4*)(slot + ((size_t)b * NE + e) * T + t0 + q * 16 + 4 * i4) = (i32x4){sl[4 * i4], sl[4 * i4 + 1], sl[4 * i4 + 2], sl[4 * i4 + 3]};
        }
        __syncthreads();
    }
}

__device__ __forceinline__ void ph_combine(Frame& F, const Args& A, int l) {
    const float* mod = (const float*)(A.ws + WS_MOD); bf16_t* X = (bf16_t*)(A.ws + WS_X); bf16_t* H = (bf16_t*)(A.ws + WS_H);
    const int* slot = (const int*)(A.ws + WS_SLOT); const unsigned char* ye = A.ws + WS_YE; const float* selval = (const float*)(A.ws + WS_SELVAL);
    for (int row = F.gw; row < NLAT; row += F.ngw) {
        const int b = row >> 14;
        const int sv = (F.lane < 16) ? slot[((size_t)b * NE + F.lane) * T + (row & (T - 1))] : -1;
        f32x4 acc[4];
#pragma unroll
        for (int j = 0; j < 4; ++j) acc[j] = (f32x4){0.f, 0.f, 0.f, 0.f};
        for (int e = 0; e < NE; ++e) {
            const int s = __builtin_amdgcn_readlane(sv, e);
            if (s >= 0) {
                const int yrow = e * 4096 + b * CAP + s;
                const unsigned char* yr = ye + (size_t)yrow * D + 4 * F.lane; const float wv = selval[yrow] * (1.f / 32);
#pragma unroll
                for (int j = 0; j < 4; ++j) { const int y = *(const int*)(yr + 256 * j); const f32x2 lo = __builtin_amdgcn_cvt_pk_f32_fp8(y, false), hi = __builtin_amdgcn_cvt_pk_f32_fp8(y, true);
                    acc[j].x += wv * lo.x; acc[j].y += wv * lo.y; acc[j].z += wv * hi.x; acc[j].w += wv * hi.y; }
            }
        }
        const float* g2 = mod + (l * 3 + b) * 6 * D + 5 * D;
        f32x4 v[4];
#pragma unroll
        for (int j = 0; j < 4; ++j) { const int c = 4 * F.lane + 256 * j; const u32x2 t = *(const u32x2*)(X + (size_t)row * D + c);
            v[j] = (f32x4){bflo(t.x), bfhi(t.x), bflo(t.y), bfhi(t.y)} + *(const f32x4*)(g2 + c) * acc[j]; }
        if (l == 0) {
#pragma unroll
            for (int j = 0; j < 4; ++j) { u32x2 w; w.x = pk2(v[j].x, v[j].y); w.y = pk2(v[j].z, v[j].w); *(u32x2*)(X + (size_t)row * D + 4 * F.lane + 256 * j) = w; }
            normmod_row(v, A.in[P_NORMG] + (1 * 2 + 0) * D, mod + (1 * 3 + b) * 6 * D + 0 * D, mod + (1 * 3 + b) * 6 * D + 1 * D, H + (size_t)row * D, F.lane);
        } else {
            float s = 0.f;
#pragma unroll
            for (int j = 0; j < 4; ++j) s += (v[j].x * v[j].x + v[j].y * v[j].y) + (v[j].z * v[j].z + v[j].w * v[j].w);
            const float rstd = rsqrtf(wave_sum(s) * (1.f / D) + EPS);
#pragma unroll
            for (int j = 0; j < 4; ++j) { const int c = 4 * F.lane + 256 * j; *(f32x4*)(A.out + (size_t)row * D + c) = v[j] * rstd * *(const f32x4*)(A.in[P_FINALG] + c); }
        }
    }
}

constexpr int N_PHASES = 20;
__global__ void __launch_bounds__(NTHR, 2) fwd_kernel(Args A) {
    extern __shared__ __attribute__((aligned(16))) unsigned char lds_raw[];
    Frame F;
    F.lds = (LAS unsigned char*)lds_raw;
    F.tid = threadIdx.x; F.lane = F.tid & 63; F.wave = __builtin_amdgcn_readfirstlane(F.tid >> 6);
    F.G = gridDim.x; F.gw = blockIdx.x * NWAVES + F.wave; F.ngw = F.G * NWAVES;
    const int lo = A.ph_lo, hi = A.ph_hi;
#ifdef ONLY_PH
#define IN(k) ((k) == ONLY_PH && lo <= (k) && (k) < hi)
#else
#define IN(k) (lo <= (k) && (k) < hi)
#endif
#if MK_MULTI
#define SEAM(k) do { } while (0)
#else
    cg::grid_group grid = cg::this_grid();
    volatile LAS unsigned* bst = (volatile LAS unsigned*)(F.lds + LDS_BYTES - 64);
    if (F.tid < 16) bst[F.tid] = 0u;
    __syncthreads();
    XcdBarrier xbar = xcd_barrier_post((unsigned*)(A.ws + WS_CTL) + 4096, bst);
    if (lo < 0) { __threadfence(); grid.sync(); }
#define SEAM(k) do { if (IN(k) && IN((k) + 1)) xcd_barrier(xbar); } while (0)
#endif
    const int c = blockIdx.x;
    #define H ((bf16_t*)(A.ws + WS_H))
#define X ((bf16_t*)(A.ws + WS_X))
#define mod ((const float*)(A.ws + WS_MOD))
#define MOE_GU(l) { eng::Gemm g{(const char*)(A.ws + WS_H), (const char*)(A.ws + WS_W8 + (size_t)(l) * W8_LAYER), (const int*)(A.ws + WS_ROWLIST), (size_t)4096 * D, D / 2, 16, 16, NE}; \
        eng::EpiSwiglu E{0x79797979, 0x7F7F7F7F, A.ws + WS_HID}; eng::gemm_phase(F.lds, g, E, F.G, c); }
#define MOE_DN(l) { eng::Gemm g{(const char*)(A.ws + WS_HID), (const char*)(A.ws + WS_W8 + (size_t)(l) * W8_LAYER + W8_WD), nullptr, (size_t)D * DEXP, DEXP / 2, 16, 4, NE}; \
        eng::EpiDown E{0x79797979, 0x7D7D7D7D, A.ws + WS_YE}; eng::gemm_phase(F.lds, g, E, F.G, c); }

    if (IN(0)) ph_prep(F, A);
    SEAM(0);
    if (IN(1)) ph_norm0(F, A);
    SEAM(1);
    if (IN(2)) { eng::Gemm g{(const char*)H, (const char*)(A.ws + WS_WIN0T), nullptr, 0, D, NROW / 256, NIN0P / 256, 1};
        eng::EpiProj0 E{(bf16_t*)(A.ws + WS_QK), A.ws + WS_VTP, (bf16_t*)(A.ws + WS_R), (float*)(A.ws + WS_AFB)}; eng::gemm_phase(F.lds, g, E, F.G, c);
        if (6 * F.G + c >= (NROW / 256) * (NIN0P / 256)) convert_expert_fixed<3>(A, F.lds, F.tid, F.wave, F.lane); }
    SEAM(2);
    if (IN(3)) ph_gla_prep(F, A);
    SEAM(3);
    if (IN(4)) ph_gla_main(F, A);
    SEAM(4);
    if (IN(5)) ph_gla_finish(F, A);
    SEAM(5);
    if (IN(6)) { eng::Gemm g{(const char*)H, (const char*)(A.ws + WS_WOUT0T), nullptr, 0, D, NLAT / 256, D / 256, 1};
        eng::EpiResidT<true> E{A.in[P_X], X, mod + (0 * 3) * 6 * D + 2 * D}; eng::gemm_phase(F.lds, g, E, F.G, c); }
    SEAM(6);
    if (IN(7)) ph_norm2_router(F, A, 0);
    SEAM(7);
    if (IN(8)) ph_topk(F, A);
    SEAM(8);
    if (IN(9)) MOE_GU(0)
    SEAM(9);
    if (IN(10)) MOE_DN(0)
    SEAM(10);
    if (IN(11)) ph_combine(F, A, 0);
    SEAM(11);
    if (IN(12)) { eng::Gemm g{(const char*)H, (const char*)(A.ws + WS_WCINT), nullptr, 0, D, NLAT / 256, NCIN / 256, 1};
        g.trip = 1;
        eng::EpiConvFused E{A.ws + WS_CDUMP + (size_t)c * 131072, (bf16_t*)(A.ws + WS_H2), A.in[P_CK]}; eng::gemm_phase(F.lds, g, E, F.G, c); }
    SEAM(12);
    if (IN(14)) { eng::Gemm g{(const char*)(A.ws + WS_H2), (const char*)(A.ws + WS_WCOUTT), nullptr, 0, D, NLAT / 256, D / 256, 1};
        eng::EpiResidT<false> E{X, X, mod + (1 * 3) * 6 * D + 2 * D}; eng::gemm_phase(F.lds, g, E, F.G, c); }
    SEAM(14);
    if (IN(15)) ph_norm2_router(F, A, 1);
    SEAM(15);
    if (IN(16)) ph_topk(F, A);
    SEAM(16);
    if (IN(17)) MOE_GU(1)
    SEAM(17);
    if (IN(18)) MOE_DN(1)
    SEAM(18);
    if (IN(19)) ph_combine(F, A, 1);
#undef IN
#undef SEAM
#undef H
#undef X
#undef mod
#undef MOE_GU
#undef MOE_DN
}

extern "C" void kernel_launch(void* const* d_in, const int* in_sizes, int n_in, void* d_out, int out_size, void* d_ws, size_t ws_size, hipStream_t stream) {
    static int grid = 0;
    if (grid == 0) {
        if (n_in != 20 || in_sizes[0] != NLAT * D || out_size != NLAT * D || ws_size < WS_END) {
            fprintf(stderr, "kernel_launch: unexpected problem: n_in %d in0 %d out %d ws %zu (need %zu)\n", n_in, n_in > 0 ? in_sizes[0] : -1, out_size, ws_size, (size_t)WS_END); grid = -1; return; }
        int dev = 0, cus = 0, per_cu = 0;
        if (hipGetDevice(&dev) != hipSuccess || hipDeviceGetAttribute(&cus, hipDeviceAttributeMultiprocessorCount, dev) != hipSuccess) { grid = -1; return; }
        if (hipFuncSetAttribute((const void*)fwd_kernel, hipFuncAttributeMaxDynamicSharedMemorySize, LDS_BYTES) != hipSuccess) { fprintf(stderr, "kernel_launch: hipFuncSetAttribute failed\n"); grid = -1; return; }
        if (hipOccupancyMaxActiveBlocksPerMultiprocessor(&per_cu, (const void*)fwd_kernel, NTHR, LDS_BYTES) != hipSuccess || per_cu < 1) { fprintf(stderr, "kernel_launch: occupancy query says %d\n", per_cu); per_cu = 1; }
        (void)hipGetLastError();
        if (cus != 256) { fprintf(stderr, "kernel_launch: built for a 256-CU device (one workgroup per CU); found %d CUs\n", cus); grid = -1; return; }
        grid = cus;
    }
    if (grid < 0) return;
    Args a{};
    for (int i = 0; i < 20; ++i) a.in[i] = (const float*)d_in[i];
    a.out = (float*)d_out; a.ws = (unsigned char*)d_ws;
#if MK_MULTI
    for (int p = 0; p < N_PHASES; ++p) {
        a.ph_lo = p; a.ph_hi = p + 1;
        hipLaunchKernelGGL(fwd_kernel, dim3(grid), dim3(NTHR), LDS_BYTES, stream, a);
    }
#else
    if (hipMemsetAsync((char*)d_ws + WS_CTL, 0, 64 * 1024, stream) != hipSuccess) { fprintf(stderr, "kernel_launch: memset failed\n"); return; }
    a.ph_lo = 0; a.ph_hi = N_PHASES;
    void* kargs[] = {&a};
    hipError_t e = hipLaunchCooperativeKernel((const void*)fwd_kernel, dim3(grid), dim3(NTHR), kargs, LDS_BYTES, stream);
    if (e != hipSuccess) fprintf(stderr, "kernel_launch: cooperative launch failed: %s (grid %d)\n", hipGetErrorString(e), grid);
#endif
}
```

```cpp
#include <hip/hip_runtime.h>
#include <hip/hip_cooperative_groups.h>
#include <cstdio>
#include <cstdint>
namespace cg = cooperative_groups;

#ifndef MK_MULTI
#define MK_MULTI 0
#endif

#define LAS __attribute__((address_space(3)))
#define GAS __attribute__((address_space(1)))
typedef unsigned short bf16_t;
typedef short bf16x8 __attribute__((ext_vector_type(8)));
typedef float f32x4 __attribute__((ext_vector_type(4)));
typedef float f32x2 __attribute__((ext_vector_type(2)));
typedef unsigned u32x4 __attribute__((ext_vector_type(4)));
typedef unsigned u32x2 __attribute__((ext_vector_type(2)));
typedef int i32x4 __attribute__((ext_vector_type(4)));
typedef int i32x8 __attribute__((ext_vector_type(8)));

constexpr int D = 1024, NB = 2, T = 16384, NLAT = NB * T, CTXL = 256, NCTX = NB * CTXL, NROW = NLAT + NCTX;
constexpr int NE = 16, CAP = 2048, DEXP = 2048;
constexpr int HEADS = 4, HK = 128, HV = 256, DK = 512, DV = 1024, RANK = 16;
constexpr int NIN0 = 3104, NIN0P = 3328;
constexpr int NCIN = 3072;
constexpr float EPS = 1e-6f;
constexpr int NWAVES = 8, NTHR = 512;

constexpr size_t MiB = 1u << 20;
constexpr size_t WS_CTL = 0;
constexpr size_t WS_MOD = 1 * MiB;
constexpr size_t WS_WIN0T = 2 * MiB;
constexpr size_t WS_WOUT0T = 9 * MiB;
constexpr size_t WS_WCINT = 11 * MiB;
constexpr size_t WS_WCOUTT = 17 * MiB;
constexpr size_t WS_AFF = 19 * MiB;
constexpr size_t WS_SLOT = 21 * MiB;
constexpr size_t WS_ROWLIST = 23 * MiB;
constexpr size_t WS_SELVAL = 23 * MiB + 512 * 1024;
constexpr size_t WS_AFB = 24 * MiB;
constexpr size_t WS_W8 = 32 * MiB;
constexpr size_t W8_LAYER = 96 * MiB, W8_WD = 64 * MiB;
constexpr size_t WS_X = 224 * MiB;
constexpr size_t WS_H = 354 * MiB;
constexpr size_t WS_ARENA = 420 * MiB;
constexpr size_t WS_QK = WS_ARENA;
constexpr size_t WS_V = WS_ARENA + 65 * MiB;
constexpr size_t WS_R = WS_ARENA + 130 * MiB;
constexpr size_t WS_QP = WS_ARENA + 195 * MiB;
constexpr size_t WS_KP = WS_ARENA + 260 * MiB;
constexpr size_t WS_KTP = WS_ARENA + 325 * MiB;
constexpr size_t WS_VTP = WS_ARENA + 390 * MiB;
constexpr size_t WS_OI = WS_ARENA + 455 * MiB;
constexpr size_t WS_GAM = WS_ARENA + 519 * MiB;
constexpr size_t WS_OF = WS_QK;
constexpr size_t WS_OB = WS_V;
constexpr size_t WS_HID = WS_ARENA;
constexpr size_t WS_YE = WS_ARENA + 128 * MiB;
constexpr size_t WS_H2 = WS_ARENA;
constexpr size_t WS_CDUMP = WS_ARENA + 64 * MiB;
constexpr size_t WS_END = WS_ARENA + 522 * MiB;
static_assert(WS_R - WS_QK == 130 * MiB, "EpiProj0 strides");
constexpr size_t BLOB = 16384;
constexpr int NCHUNK = NROW / 64;

__device__ __forceinline__ float wave_sum(float v) {
#pragma unroll
    for (int o = 1; o < 64; o <<= 1) v += __shfl_xor(v, o);
    return v;
}
__device__ __forceinline__ int wave_sum_i(int v) {
#pragma unroll
    for (int o = 1; o < 64; o <<= 1) v += __shfl_xor(v, o);
    return v;
}
__device__ __forceinline__ unsigned f2bf(float f) { unsigned u = __builtin_bit_cast(unsigned, f); return (u + 0x7fffu + ((u >> 16) & 1u)) >> 16; }
typedef __bf16 bf16x2_t __attribute__((ext_vector_type(2)));
__device__ __forceinline__ unsigned pk2(float lo, float hi) { const f32x2 v = {lo, hi}; return __builtin_bit_cast(unsigned, __builtin_convertvector(v, bf16x2_t)); }
__device__ __forceinline__ float bflo(unsigned u) { return __builtin_bit_cast(float, u << 16); }
__device__ __forceinline__ float bfhi(unsigned u) { return __builtin_bit_cast(float, u & 0xffff0000u); }
__device__ __forceinline__ float silu_f(float x) { return x / (1.f + __expf(-x)); }
#define LDS_WAIT() asm volatile("s_waitcnt lgkmcnt(0)" ::: "memory")


#define XB_TMO      128
#define XB_XCNT(j)  (256  + 64 * (j))
#define XB_XSUB(j)  (1280 + 64 * (j))
#define XB_XGEN(j)  (2304 + 64 * (j))
#define XB_TOP      3328
#define XB_TOPGEN   3392
#define XCD_BAR_WORDS 3456
#define XB_SPIN_CAP (1u << 22)
__device__ __forceinline__ unsigned xb_ld(unsigned* p)              { return __hip_atomic_load(p, __ATOMIC_RELAXED, __HIP_MEMORY_SCOPE_AGENT); }
__device__ __forceinline__ unsigned xb_add(unsigned* p, unsigned v) { return __hip_atomic_fetch_add(p, v, __ATOMIC_RELAXED, __HIP_MEMORY_SCOPE_AGENT); }
__device__ __forceinline__ unsigned xb_xcc_id() { return (unsigned)__builtin_amdgcn_s_getreg((3 << 11) | 20) & 0xFu; }
#define XB_SPIN(cond, bar) do { unsigned _sp = 0; while (cond) { \
    if ((++_sp & 255u) == 0u) { if (xb_ld(&(bar)[XB_TMO])) break; if (_sp > XB_SPIN_CAP) { atomicAdd(&(bar)[XB_TMO], 1u); break; } } } } while (0)
struct XcdBarrier { unsigned* bar; unsigned x; volatile LAS unsigned* st; };
__device__ __forceinline__ XcdBarrier xcd_barrier_post(unsigned* bar, volatile LAS unsigned* st) {
    XcdBarrier b; b.bar = bar; b.x = xb_xcc_id(); b.st = st;
    if (threadIdx.x == 0) (void)xb_add(&bar[XB_XCNT(b.x)], 1u);
    return b;
}
__device__ __forceinline__ void xcd_barrier_complete(unsigned* bar, unsigned x, unsigned& nloc, unsigned& nx) {
    const unsigned G = gridDim.x * gridDim.y * gridDim.z;
    unsigned sum, cnt, mine, sp = 0u;
    for (;;) {
        sum = 0u; cnt = 0u; mine = 0u;
#pragma unroll
        for (unsigned j = 0; j < 16; ++j) { const unsigned c = xb_ld(&bar[XB_XCNT(j)]); sum += c; cnt += (c > 0u) ? 1u : 0u; mine = (j == x) ? c : mine; }
        if (sum == G) break;
        __builtin_amdgcn_s_sleep(1);
        if ((++sp & 255u) == 0u) { if (xb_ld(&bar[XB_TMO])) break; if (sp > XB_SPIN_CAP) { atomicAdd(&bar[XB_TMO], 1u); break; } }
    }
    nloc = mine > 0u ? mine : 1u; nx = cnt > 0u ? cnt : 1u;
}
__device__ __forceinline__ void xcd_barrier(const XcdBarrier& b) {
    asm volatile("s_waitcnt vmcnt(0)" ::: "memory");
    __syncthreads();
    if (threadIdx.x == 0) {
        unsigned* bar = b.bar;
        __builtin_amdgcn_s_waitcnt(0);
        unsigned nloc = b.st[0], nx = b.st[1];
        if (nloc == 0u) { xcd_barrier_complete(bar, b.x, nloc, nx); b.st[0] = nloc; b.st[1] = nx; }
        const unsigned old = xb_add(&bar[XB_XSUB(b.x)], 1u);
        const unsigned gen = old / nloc;
        if (old + 1u == (gen + 1u) * nloc) {
            __builtin_amdgcn_fence(__ATOMIC_RELEASE, "agent");
            asm volatile("s_waitcnt vmcnt(0)" ::: "memory");
            const unsigned og = xb_add(&bar[XB_TOP], 1u);
            const unsigned tg = og / nx;
            __builtin_amdgcn_fence(__ATOMIC_ACQUIRE, "agent");
            if (og + 1u == (tg + 1u) * nx) xb_add(&bar[XB_TOPGEN], 1u);
            else XB_SPIN(xb_ld(&bar[XB_TOPGEN]) == tg, bar);
            xb_add(&bar[XB_XGEN(b.x)], 1u);
            asm volatile("s_waitcnt vmcnt(0)" ::: "memory");
        } else {
            __builtin_amdgcn_fence(__ATOMIC_ACQUIRE, "agent");
            XB_SPIN(xb_ld(&bar[XB_XGEN(b.x)]) == gen, bar);
            asm volatile("s_waitcnt vmcnt(0)" ::: "memory");
        }
    }
    __syncthreads();
}

namespace eng {
constexpr int BM = 256, BK = 64, HALF = 128, HTB = HALF * BK * 2, STAGE_BYTES = 8 * HTB, NXCD = 8, WGM = 8;
__host__ __device__ __forceinline__ int lds_byte(int r, int c) { const int st = (r >> 4) * 2 + (c >> 5), rr = r & 15, cc = c & 31, ob = rr * 64 + cc * 2; return st * 1024 + (ob ^ (((ob >> 9) & 1) << 5)); }
__host__ __device__ __forceinline__ void stage_rc(int b, int& R, int& C) { const int st = b / 1024, sb = b % 1024, swz = sb ^ (((sb >> 9) & 1) << 5); R = (st >> 1) * 16 + swz / 64; C = (st & 1) * 32 + (swz % 64) / 2; }
__host__ __device__ __forceinline__ int perm32(int rho) { const int n = rho >> 4, i = rho & 15; return 8 * (i >> 2) + 4 * n + (i & 3); }

struct Unit { int e, pm, pn; };
struct Gemm {
    const char* A;
    const char* Bt;
    const int* rows;
    size_t bstride;
    int K, nM, nN, ngroups;
    int trip = 0;
};
__device__ __forceinline__ bool next_unit(const Gemm& g, int i, int G, int c, Unit& u) {
    if (g.trip) {
        const int per3 = g.nM * (g.nN / 3), j = i / 3, sec = i - 3 * j; int s = j * G + c; if (s >= per3) return false;
        { const int q = per3 / NXCD, r = per3 % NXCD, xcd = s % NXCD, off = s / NXCD; s = (xcd < r ? xcd * (q + 1) : r * (q + 1) + (xcd - r) * q) + off; }
        const int ncb = g.nN / 3; u.e = 0; u.pm = s / ncb; u.pn = 3 * (s % ncb) + sec; return true;
    }
    const int per = g.nM * g.nN;
    const long L = (long)i * G + c; if (L >= (long)per * g.ngroups) return false;
    u.e = (int)(L / per); int wgid = (int)(L % per);
    { const int nwg = per, q = nwg / NXCD, r = nwg % NXCD, xcd = wgid % NXCD, off = wgid / NXCD; wgid = (xcd < r ? xcd * (q + 1) : r * (q + 1) + (xcd - r) * q) + off; }
    const int nig = WGM * g.nN, gid = wgid / nig, fm = gid * WGM, gsz = (g.nM - fm) < WGM ? (g.nM - fm) : WGM;
    u.pm = fm + ((wgid % nig) % gsz); u.pn = (wgid % nig) / gsz; return true;
}
__device__ __forceinline__ bf16x8 lo8(const i32x8& f) { return __builtin_bit_cast(bf16x8, (i32x4)__builtin_shufflevector(f, f, 0, 1, 2, 3)); }
__device__ __forceinline__ bf16x8 hi8(const i32x8& f) { return __builtin_bit_cast(bf16x8, (i32x4)__builtin_shufflevector(f, f, 4, 5, 6, 7)); }
__device__ __forceinline__ i32x8 cat8(bf16x8 lo, bf16x8 hi) { const i32x4 a = __builtin_bit_cast(i32x4, lo), b = __builtin_bit_cast(i32x4, hi); return __builtin_shufflevector(a, b, 0, 1, 2, 3, 4, 5, 6, 7); }
__device__ __forceinline__ unsigned cvt_pk_bf16(float lo, float hi) { unsigned r; asm volatile("v_cvt_pk_bf16_f32 %0, %1, %2" : "=v"(r) : "v"(lo), "v"(hi)); return r; }

#ifndef ENG_SP2
#define ENG_SP2 true
#endif
#ifndef ENG_ALIGN
#define ENG_ALIGN true
#endif
template <class Epi, bool SP2 = ENG_SP2, bool ALIGN_EPI = ENG_ALIGN>
__device__ __forceinline__ void gemm_phase(LAS unsigned char* lds, const Gemm g, const Epi& E, int G, int c) {
    int tid = threadIdx.x; asm volatile("" : "+v"(tid));
    const int wid = __builtin_amdgcn_readfirstlane(tid >> 6), lane = tid & 63, wr = wid >> 2, wc = wid & 3, fr = lane & 15, fq = lane >> 4;
    const int K = g.K, nt = K / BK;
    int R0, C0; stage_rc(tid * 16, R0, C0);
    const int Rb0 = Epi::PERM ? ((R0 & ~31) + perm32(R0 & 31)) : R0;
    unsigned voffB[2]; voffB[0] = (unsigned)(Rb0 * K + C0) * 2u; voffB[1] = (unsigned)((Rb0 + 64) * K + C0) * 2u;
    constexpr bool SW = Epi::SWAPV;
    const char* const abase = SW ? g.Bt : g.A;
    const unsigned adelta = SW ? (unsigned)(size_t)(g.A - g.Bt) : 0u;
    const unsigned dltB = SW ? (unsigned)((R0 - Rb0) * K) * 2u : 0u;
    const size_t hstepB = (size_t)HALF * K * 2;
    const unsigned ldsw = (unsigned)wid * 1024u;
    const int aoff = lds_byte(wr * 64 + fr, fq * 8), boff = lds_byte(wc * 32 + fr, fq * 8);
#define PG8_SA(b, h) (((b) * 2 + (h)) * HTB)
#define PG8_SB(b, h) ((4 + (b) * 2 + (h)) * HTB)
#define PG8_GLDS(gp, bufoff, i) __builtin_amdgcn_global_load_lds((const unsigned*)(gp), (LAS unsigned*)(lds + (bufoff) + ldsw + (i) * 8192), 16, 0, 0)
#define PG8_STAGE_B(bufoff, bp, h, kt) do { const char* _p = (bp) + (size_t)(h) * hstepB + (size_t)(kt) * 128; asm volatile("" : "+s"(_p)); PG8_GLDS(_p + (voffB[0] + (SW ? dselB : 0u)), bufoff, 0); PG8_GLDS(_p + (voffB[1] + (SW ? dselB : 0u)), bufoff, 1); } while (0)
#define PG8_STAGE_A(bufoff, v0, v1, kt) do { const char* _p = abase + (size_t)(kt) * 128; asm volatile("" : "+s"(_p)); PG8_GLDS(_p + (v0), bufoff, 0); PG8_GLDS(_p + (v1), bufoff, 1); } while (0)
#define PG8_LDA(dst, b, h) do { _Pragma("unroll") for (int m = 0; m < 4; ++m) dst[m] = cat8(*(const LAS bf16x8*)(lds + PG8_SA(b, h) + aoff + m * 2048), *(const LAS bf16x8*)(lds + PG8_SA(b, h) + aoff + m * 2048 + 1024)); } while (0)
#define PG8_LDB(dst, b, h) do { _Pragma("unroll") for (int n = 0; n < 2; ++n) dst[n] = cat8(*(const LAS bf16x8*)(lds + PG8_SB(b, h) + boff + n * 2048), *(const LAS bf16x8*)(lds + PG8_SB(b, h) + boff + n * 2048 + 1024)); } while (0)
#define PG8_MMA(ai, bj, At, Bt) do { __builtin_amdgcn_s_setprio(1); \
        if constexpr (Epi::FP8) { _Pragma("unroll") for (int m = 0; m < 4; ++m) _Pragma("unroll") for (int n = 0; n < 2; ++n) \
            asm volatile("v_mfma_scale_f32_16x16x128_f8f6f4 %0, %1, %2, %0, %3, %4 op_sel_hi:[0,0,0]" : "+v"(acc[ai][bj][m][n]) : "v"(Bt[n]), "v"(At[m]), "v"(sc_w), "v"(sc_a)); } \
        else { _Pragma("unroll") for (int m = 0; m < 4; ++m) _Pragma("unroll") for (int n = 0; n < 2; ++n) { \
            acc[ai][bj][m][n] = __builtin_amdgcn_mfma_f32_16x16x32_bf16(lo8(Bt[n]), lo8(At[m]), acc[ai][bj][m][n], 0, 0, 0); \
            acc[ai][bj][m][n] = __builtin_amdgcn_mfma_f32_16x16x32_bf16(hi8(Bt[n]), hi8(At[m]), acc[ai][bj][m][n], 0, 0, 0); } } \
        __builtin_amdgcn_s_setprio(0); } while (0)
#define PG8_WAIT_V(n) asm volatile("s_waitcnt vmcnt(" #n ")" ::: "memory")
#define PG8_WAIT_L(n) asm volatile("s_waitcnt lgkmcnt(" #n ")" ::: "memory")
#define PG8_BAR __builtin_amdgcn_s_barrier()
#define PG8_SCHED __builtin_amdgcn_sched_barrier(0)
#define PG8_ROWOFF(u, h, i) ((SW && E.swapv(u)) ? (unsigned)(((u).pn * 256 + (h) * 128 + R0 + 64 * (i)) * K + C0) * 2u : adelta + ((unsigned)(((g.rows ? g.rows[((u).e * g.nM + (u).pm) * 256 + (h) * 128 + R0 + 64 * (i)] : (((u).e * g.nM + (u).pm) * 256 + (h) * 128 + R0 + 64 * (i))) * K + C0)) * 2u))
#define PG8_BPTR(u) ((SW && E.swapv(u)) ? g.A + (size_t)(u).pm * 2 * hstepB : g.Bt + (size_t)(u).e * g.bstride + (size_t)(u).pn * 2 * hstepB)
    Unit cur, nxt; int ui = 0;
    if (!next_unit(g, 0, G, c, cur)) return;
    f32x4 acc[2][2][4][2];
#pragma unroll
    for (int a = 0; a < 2; ++a)
#pragma unroll
        for (int b = 0; b < 2; ++b)
#pragma unroll
            for (int m = 0; m < 4; ++m)
#pragma unroll
                for (int n = 0; n < 2; ++n) acc[a][b][m][n] = (f32x4){0.f, 0.f, 0.f, 0.f};
    int sc_w = E.scale_w, sc_a = E.scale_a;
    asm volatile("" : "+v"(sc_w), "+v"(sc_a));
    i32x8 At[4], B0[2], B1[2];
    unsigned c00 = PG8_ROWOFF(cur, 0, 0), c01 = PG8_ROWOFF(cur, 0, 1), c10 = PG8_ROWOFF(cur, 1, 0), c11 = PG8_ROWOFF(cur, 1, 1);
    const char* cB = PG8_BPTR(cur);
    unsigned cD = (SW && E.swapv(cur)) ? dltB : 0u, dselB = cD;
    if constexpr (SP2) {
        PG8_STAGE_B(PG8_SB(0, 0), cB, 0, 0); PG8_STAGE_B(PG8_SB(0, 1), cB, 1, 0); PG8_STAGE_A(PG8_SA(0, 0), c00, c01, 0); PG8_STAGE_A(PG8_SA(0, 1), c10, c11, 0);
        if (wr == 1) PG8_BAR;
        PG8_WAIT_V(2); PG8_BAR;
        PG8_STAGE_B(PG8_SB(1, 0), cB, 0, 1); PG8_STAGE_A(PG8_SA(1, 0), c00, c01, 1); PG8_STAGE_B(PG8_SB(1, 1), cB, 1, 1);
        PG8_WAIT_V(6); PG8_BAR;
    } else {
        PG8_STAGE_B(PG8_SB(0, 0), cB, 0, 0); PG8_STAGE_A(PG8_SA(0, 0), c00, c01, 0); PG8_STAGE_B(PG8_SB(0, 1), cB, 1, 0); PG8_STAGE_A(PG8_SA(0, 1), c10, c11, 0);
        if (wr == 1) PG8_BAR;
        PG8_WAIT_V(4); PG8_BAR;
        PG8_STAGE_B(PG8_SB(1, 0), cB, 0, 1); PG8_STAGE_A(PG8_SA(1, 0), c00, c01, 1); PG8_STAGE_B(PG8_SB(1, 1), cB, 1, 1);
        PG8_WAIT_V(6); PG8_BAR;
    }
    for (;;) {
        const bool has_next = next_unit(g, ui + 1, G, c, nxt);
        unsigned n00 = c00, n01 = c01, n10 = c10, n11 = c11; const char* nB = cB; unsigned nD = cD;
        if (has_next) { n00 = PG8_ROWOFF(nxt, 0, 0); n01 = PG8_ROWOFF(nxt, 0, 1); n10 = PG8_ROWOFF(nxt, 1, 0); n11 = PG8_ROWOFF(nxt, 1, 1);
                        nB = PG8_BPTR(nxt); nD = (SW && E.swapv(nxt)) ? dltB : 0u; }
#pragma unroll 1
        for (int t = 0; t < nt; t += 2) {
            const bool last = (t == nt - 2);
            const int kt2 = last ? 0 : t + 2, kt3 = kt2 + 1;
            const char* b2 = last ? nB : cB; dselB = last ? nD : cD;
            const unsigned s00 = last ? n00 : c00, s01 = last ? n01 : c01, s10 = last ? n10 : c10, s11 = last ? n11 : c11;
            if constexpr (SP2) {
            PG8_LDB(B0, 0, 0); PG8_LDB(B1, 0, 1); PG8_SCHED; PG8_LDA(At, 0, 0); PG8_STAGE_A(PG8_SA(1, 1), c10, c11, t + 1);
            PG8_WAIT_V(8); PG8_WAIT_L(0); PG8_BAR; PG8_MMA(0, 0, At, B0); PG8_MMA(0, 1, At, B1); PG8_BAR; PG8_SCHED;
            PG8_LDA(At, 0, 1); PG8_STAGE_B(PG8_SB(0, 0), b2, 0, kt2); PG8_STAGE_B(PG8_SB(0, 1), b2, 1, kt2); PG8_STAGE_A(PG8_SA(0, 0), s00, s01, kt2);
            PG8_WAIT_V(8); PG8_WAIT_L(0); PG8_BAR; PG8_MMA(1, 0, At, B0); PG8_MMA(1, 1, At, B1); PG8_BAR; PG8_SCHED;
            PG8_LDB(B0, 1, 0); PG8_LDB(B1, 1, 1); PG8_SCHED; PG8_LDA(At, 1, 0); PG8_STAGE_A(PG8_SA(0, 1), s10, s11, kt2);
            PG8_WAIT_V(8); PG8_WAIT_L(0); PG8_BAR; PG8_MMA(0, 0, At, B0); PG8_MMA(0, 1, At, B1); PG8_BAR; PG8_SCHED;
            PG8_LDA(At, 1, 1); PG8_STAGE_B(PG8_SB(1, 0), b2, 0, kt3); PG8_STAGE_B(PG8_SB(1, 1), b2, 1, kt3); PG8_STAGE_A(PG8_SA(1, 0), s00, s01, kt3);
            PG8_WAIT_V(8); PG8_WAIT_L(0); PG8_BAR; PG8_MMA(1, 0, At, B0); PG8_MMA(1, 1, At, B1); PG8_BAR; PG8_SCHED;
            } else {
            PG8_LDB(B0, 0, 0); PG8_SCHED; PG8_LDA(At, 0, 0); PG8_STAGE_A(PG8_SA(1, 1), c10, c11, t + 1);
            PG8_WAIT_L(8); PG8_BAR; PG8_WAIT_L(0); PG8_MMA(0, 0, At, B0); PG8_BAR; PG8_SCHED;
            PG8_LDB(B1, 0, 1); PG8_STAGE_B(PG8_SB(0, 0), b2, 0, kt2);
            PG8_BAR; PG8_WAIT_L(0); PG8_MMA(0, 1, At, B1); PG8_BAR;
            PG8_LDA(At, 0, 1); PG8_STAGE_A(PG8_SA(0, 0), s00, s01, kt2);
            PG8_BAR; PG8_WAIT_L(0); PG8_MMA(1, 0, At, B0); PG8_BAR; PG8_SCHED;
            PG8_STAGE_B(PG8_SB(0, 1), b2, 1, kt2);
            PG8_WAIT_V(6); PG8_BAR; PG8_MMA(1, 1, At, B1); PG8_BAR;
            PG8_LDB(B0, 1, 0); PG8_SCHED; PG8_LDA(At, 1, 0); PG8_STAGE_A(PG8_SA(0, 1), s10, s11, kt2);
            PG8_WAIT_L(8); PG8_BAR; PG8_WAIT_L(0); PG8_MMA(0, 0, At, B0); PG8_BAR; PG8_SCHED;
            PG8_LDB(B1, 1, 1); PG8_STAGE_B(PG8_SB(1, 0), b2, 0, kt3);
            PG8_BAR; PG8_WAIT_L(0); PG8_MMA(0, 1, At, B1); PG8_BAR;
            PG8_LDA(At, 1, 1); PG8_STAGE_A(PG8_SA(1, 0), s00, s01, kt3);
            PG8_BAR; PG8_WAIT_L(0); PG8_MMA(1, 0, At, B0); PG8_BAR; PG8_SCHED;
            PG8_STAGE_B(PG8_SB(1, 1), b2, 1, kt3);
            PG8_WAIT_V(6); PG8_BAR; PG8_MMA(1, 1, At, B1); PG8_BAR;
            }
        }
        if constexpr (Epi::FP8) {
            _Pragma("unroll") for (int a = 0; a < 2; ++a)
                asm volatile("s_nop 15\n\ts_nop 15" : "+v"(acc[a][0][0][0]), "+v"(acc[a][0][0][1]), "+v"(acc[a][0][1][0]), "+v"(acc[a][0][1][1]), "+v"(acc[a][0][2][0]), "+v"(acc[a][0][2][1]), "+v"(acc[a][0][3][0]), "+v"(acc[a][0][3][1]),
                             "+v"(acc[a][1][0][0]), "+v"(acc[a][1][0][1]), "+v"(acc[a][1][1][0]), "+v"(acc[a][1][1][1]), "+v"(acc[a][1][2][0]), "+v"(acc[a][1][2][1]), "+v"(acc[a][1][3][0]), "+v"(acc[a][1][3][1]));
        }
        if constexpr (ALIGN_EPI) { if (wr == 0) PG8_BAR; }
        E(acc, cur, wr, wc, fr, fq);
        if (!has_next) break;
#pragma unroll
        for (int a = 0; a < 2; ++a)
#pragma unroll
            for (int b = 0; b < 2; ++b)
#pragma unroll
                for (int m = 0; m < 4; ++m)
#pragma unroll
                    for (int n = 0; n < 2; ++n) acc[a][b][m][n] = (f32x4){0.f, 0.f, 0.f, 0.f};
        cur = nxt; cB = nB; cD = nD; c00 = n00; c01 = n01; c10 = n10; c11 = n11; ++ui;
        if constexpr (ALIGN_EPI) { if (wr == 1) PG8_BAR; }
    }
    PG8_WAIT_V(0);
    if constexpr (!ALIGN_EPI) { if (wr == 0) PG8_BAR; }
    PG8_BAR;
#undef PG8_SA
#undef PG8_SB
#undef PG8_GLDS
#undef PG8_STAGE_A
#undef PG8_STAGE_B
#undef PG8_LDA
#undef PG8_LDB
#undef PG8_MMA
#undef PG8_WAIT_V
#undef PG8_WAIT_L
#undef PG8_BAR
#undef PG8_SCHED
#undef PG8_ROWOFF
#undef PG8_BPTR
}

struct EpiProj0 {
    static constexpr bool FP8 = false; static constexpr int scale_w = 0, scale_a = 0;
    static constexpr bool PERM = true; static constexpr bool SWAPV = true;
    __device__ __forceinline__ bool swapv(const Unit& u) const { return u.pn >= 4 && u.pn < 8; }
    bf16_t* qk; unsigned char* vtp; bf16_t* r; float* afb;
    __device__ __forceinline__ void operator()(const f32x4 (&acc)[2][2][4][2], const Unit& u, int wr, int wc, int fr, int fq) const {
        const int row0 = u.pm * BM + wr * 64 + fr;
        if (swapv(u)) {
            unsigned char* p0 = vtp + (size_t)(4 * u.pm + (wc >> 1)) * 131072 + (size_t)((((16 * (u.pn - 4) + 4 * wr) * 2 + (wc & 1)) * 64 + fr + 16 * fq) * 16);
#pragma unroll
            for (int ai = 0; ai < 2; ++ai)
#pragma unroll
                for (int m = 0; m < 4; ++m)
#pragma unroll
                    for (int bj = 0; bj < 2; ++bj) { const f32x4 v0 = acc[ai][bj][m][0], v1 = acc[ai][bj][m][1];
                        u32x4 w; w.x = cvt_pk_bf16(v0[0], v0[1]); w.y = cvt_pk_bf16(v0[2], v0[3]); w.z = cvt_pk_bf16(v1[0], v1[1]); w.w = cvt_pk_bf16(v1[2], v1[3]);
                        *(u32x4*)(p0 + (size_t)bj * 2 * 131072 + (size_t)(8 * ai + m) * 2048) = w; }
        } else if (u.pn < 12) {
            const float sc = (u.pn < 2) ? 0.08838834764831845f : 1.f;
            bf16_t* base = qk + (size_t)(u.pn >> 3) * (size_t)(130 * MiB / 2);
            const int col0 = (u.pn & 3) * BM + wc * 32 + 8 * fq;
#pragma unroll
            for (int ai = 0; ai < 2; ++ai)
#pragma unroll
                for (int m = 0; m < 4; ++m) { bf16_t* rowp = base + (size_t)(row0 + ai * HALF + m * 16) * D + col0;
#pragma unroll
                    for (int bj = 0; bj < 2; ++bj) { const f32x4 v0 = acc[ai][bj][m][0] * sc, v1 = acc[ai][bj][m][1] * sc;
                        u32x4 w; w.x = cvt_pk_bf16(v0[0], v0[1]); w.y = cvt_pk_bf16(v0[2], v0[3]); w.z = cvt_pk_bf16(v1[0], v1[1]); w.w = cvt_pk_bf16(v1[2], v1[3]);
                        *(u32x4*)(rowp + bj * HALF) = w; } }
        } else if (wc == 0) {
#pragma unroll
            for (int ai = 0; ai < 2; ++ai)
#pragma unroll
                for (int m = 0; m < 4; ++m) { float* rowp = afb + (size_t)(row0 + ai * HALF + m * 16) * 32 + 8 * fq;
                    *(f32x4*)(rowp) = acc[ai][0][m][0]; *(f32x4*)(rowp + 4) = acc[ai][0][m][1]; }
        }
    }
};
template <bool SRC_F32>
struct EpiResidT {
    static constexpr bool FP8 = false; static constexpr int scale_w = 0, scale_a = 0;
    static constexpr bool PERM = true; static constexpr bool SWAPV = false; __device__ __forceinline__ bool swapv(const Unit&) const { return false; }
    const void* src; bf16_t* dst; const float* gate;
    __device__ __forceinline__ void operator()(const f32x4 (&acc)[2][2][4][2], const Unit& u, int wr, int wc, int fr, int fq) const {
        const int row0 = u.pm * BM + wr * 64 + fr, col0 = u.pn * BM + wc * 32 + 8 * fq;
        const int b = (u.pm * BM) >> 14;
        f32x4 gv[2][2];
#pragma unroll
        for (int bj = 0; bj < 2; ++bj)
#pragma unroll
            for (int n = 0; n < 2; ++n) gv[bj][n] = *(const f32x4*)(gate + (size_t)b * 6 * D + col0 + bj * HALF + n * 4);
#pragma unroll
        for (int ai = 0; ai < 2; ++ai) {
            f32x4 sv[4][2][2];
#pragma unroll
            for (int m = 0; m < 4; ++m)
#pragma unroll
                for (int bj = 0; bj < 2; ++bj) { const size_t off = (size_t)(row0 + ai * HALF + m * 16) * D + col0 + bj * HALF;
                    if constexpr (SRC_F32) { sv[m][bj][0] = *(const f32x4*)((const float*)src + off); sv[m][bj][1] = *(const f32x4*)((const float*)src + off + 4); }
                    else { const u32x4 t = *(const u32x4*)((const bf16_t*)src + off);
                        sv[m][bj][0] = (f32x4){bflo(t.x), bfhi(t.x), bflo(t.y), bfhi(t.y)}; sv[m][bj][1] = (f32x4){bflo(t.z), bfhi(t.z), bflo(t.w), bfhi(t.w)}; } }
            asm volatile("" ::: "memory");
#pragma unroll
            for (int m = 0; m < 4; ++m)
#pragma unroll
                for (int bj = 0; bj < 2; ++bj) { const f32x4 y0 = sv[m][bj][0] + gv[bj][0] * acc[ai][bj][m][0], y1 = sv[m][bj][1] + gv[bj][1] * acc[ai][bj][m][1];
                    u32x4 w; w.x = cvt_pk_bf16(y0[0], y0[1]); w.y = cvt_pk_bf16(y0[2], y0[3]); w.z = cvt_pk_bf16(y1[0], y1[1]); w.w = cvt_pk_bf16(y1[2], y1[3]);
                    *(u32x4*)(dst + (size_t)(row0 + ai * HALF + m * 16) * D + col0 + bj * HALF) = w; }
        }
    }
};
struct EpiBf16Plain {
    static constexpr bool FP8 = false; static constexpr int scale_w = 0, scale_a = 0;
    static constexpr bool PERM = true; static constexpr bool SWAPV = false; __device__ __forceinline__ bool swapv(const Unit&) const { return false; }
    bf16_t* O; int ldc;
    __device__ __forceinline__ void operator()(const f32x4 (&acc)[2][2][4][2], const Unit& u, int wr, int wc, int fr, int fq) const {
        const int row0 = u.pm * BM + wr * 64 + fr, col0 = u.pn * BM + wc * 32 + 8 * fq;
#pragma unroll
        for (int ai = 0; ai < 2; ++ai)
#pragma unroll
            for (int m = 0; m < 4; ++m) { bf16_t* rowp = O + (size_t)(row0 + ai * HALF + m * 16) * ldc + col0;
#pragma unroll
                for (int bj = 0; bj < 2; ++bj) { const f32x4 v0 = acc[ai][bj][m][0], v1 = acc[ai][bj][m][1];
                    u32x4 w; w.x = cvt_pk_bf16(v0[0], v0[1]); w.y = cvt_pk_bf16(v0[2], v0[3]); w.z = cvt_pk_bf16(v1[0], v1[1]); w.w = cvt_pk_bf16(v1[2], v1[3]);
                    *(u32x4*)(rowp + bj * HALF) = w; } }
    }
};
__device__ __forceinline__ float dpp_shr1(float oldv, float x) { return __builtin_bit_cast(float, __builtin_amdgcn_update_dpp(__builtin_bit_cast(int, oldv), __builtin_bit_cast(int, x), 0x111, 0xF, 0xF, false)); }
__device__ __forceinline__ float dpp_shl1(float oldv, float x) { return __builtin_bit_cast(float, __builtin_amdgcn_update_dpp(__builtin_bit_cast(int, oldv), __builtin_bit_cast(int, x), 0x101, 0xF, 0xF, false)); }
__device__ __forceinline__ float dpp_ror1(float x) { return __builtin_bit_cast(float, __builtin_amdgcn_update_dpp(0, __builtin_bit_cast(int, x), 0x121, 0xF, 0xF, false)); }
__device__ __forceinline__ float dpp_rol1(float x) { return __builtin_bit_cast(float, __builtin_amdgcn_update_dpp(0, __builtin_bit_cast(int, x), 0x12F, 0xF, 0xF, false)); }
struct EpiConvFused {
    static constexpr bool FP8 = false; static constexpr int scale_w = 0, scale_a = 0;
    static constexpr bool PERM = true; static constexpr bool SWAPV = false; __device__ __forceinline__ bool swapv(const Unit&) const { return false; }
    unsigned char* dump;
    bf16_t* O; const float* ck;
    __device__ __forceinline__ void operator()(const f32x4 (&acc)[2][2][4][2], const Unit& u, int wr, int wc, int fr, int fq) const {
        const int cb = u.pn / 3, sec = u.pn - 3 * cb, tid = threadIdx.x;
        if (sec < 2) {
            const int cc = 256 * cb + 128 * sec + wc * 32 + 8 * fq;
            unsigned char* dp = dump + (size_t)sec * 65536 + tid * 16;
#pragma unroll
            for (int n = 0; n < 2; ++n) {
                const f32x4 k0 = *(const f32x4*)(ck + cc + 4 * n), k1 = *(const f32x4*)(ck + D + cc + 4 * n), k2 = *(const f32x4*)(ck + 2 * D + cc + 4 * n);
#pragma unroll
                for (int ai = 0; ai < 2; ++ai) {
                    f32x4 y[4];
#pragma unroll
                    for (int j = 0; j < 4; ++j) {
                        float x[4];
#pragma unroll
                        for (int m = 0; m < 4; ++m) x[m] = acc[ai][0][m][n][j] * acc[ai][1][m][n][j];
#pragma unroll
                        for (int m = 0; m < 4; ++m) {
                            const float up = dpp_shr1(m > 0 ? dpp_ror1(x[m - 1]) : 0.f, x[m]);
                            const float dn = dpp_shl1(m < 3 ? dpp_rol1(x[m + 1]) : 0.f, x[m]);
                            y[m][j] = k0[j] * up + k1[j] * x[m] + k2[j] * dn; }
                    }
#pragma unroll
                    for (int m = 0; m < 4; ++m) { u32x2 w; w.x = cvt_pk_bf16(y[m][0], y[m][1]); w.y = cvt_pk_bf16(y[m][2], y[m][3]);
                        *(u32x2*)(dp + (ai * 4 + m) * 8192 + n * 8) = w; }
                }
            }
        } else {
            const int row0 = u.pm * BM + wr * 64 + fr, col0 = 256 * cb + wc * 32 + 8 * fq;
            const unsigned loff = (unsigned)tid * 16u;
#pragma unroll
            for (int ai = 0; ai < 2; ++ai)
#pragma unroll
                for (int m = 0; m < 4; ++m) {
                    bf16_t* rowp = O + (size_t)(row0 + ai * HALF + m * 16) * D + col0;
                    const unsigned char* sb = dump + (ai * 4 + m) * 8192; asm volatile("" : "+s"(sb));
                    const u32x4 q0 = *(const u32x4*)(sb + loff), q1 = *(const u32x4*)(sb + 65536 + loff);
#pragma unroll
                    for (int bj = 0; bj < 2; ++bj) { const f32x4 v0 = acc[ai][bj][m][0], v1 = acc[ai][bj][m][1]; const u32x4 q = bj ? q1 : q0;
                        u32x4 w; w.x = cvt_pk_bf16(v0[0] * bflo(q.x), v0[1] * bfhi(q.x)); w.y = cvt_pk_bf16(v0[2] * bflo(q.y), v0[3] * bfhi(q.y));
                        w.z = cvt_pk_bf16(v1[0] * bflo(q.z), v1[1] * bfhi(q.z)); w.w = cvt_pk_bf16(v1[2] * bflo(q.w), v1[3] * bfhi(q.w));
                        *(u32x4*)(rowp + bj * HALF) = w; }
                    asm volatile("" ::: "memory");
                }
        }
    }
};
struct EpiSwiglu {
    static constexpr bool FP8 = true; int scale_w, scale_a;
    static constexpr bool PERM = true; static constexpr bool SWAPV = false; __device__ __forceinline__ bool swapv(const Unit&) const { return false; }
    unsigned char* hid;
    __device__ __forceinline__ void operator()(const f32x4 (&acc)[2][2][4][2], const Unit& u, int wr, int wc, int fr, int fq) const {
        const int row0 = u.e * 4096 + u.pm * BM + wr * 64 + fr, col0 = u.pn * HALF + wc * 32 + 8 * fq;
#pragma unroll
        for (int ai = 0; ai < 2; ++ai)
#pragma unroll
            for (int m = 0; m < 4; ++m) { unsigned char* rowp = hid + (size_t)(row0 + ai * HALF + m * 16) * DEXP + col0;
                float h[8];
#pragma unroll
                for (int n = 0; n < 2; ++n)
#pragma unroll
                    for (int j2 = 0; j2 < 2; ++j2) {
                        const f32x2 gt = {acc[ai][0][m][n][2 * j2], acc[ai][0][m][n][2 * j2 + 1]}, up = {acc[ai][1][m][n][2 * j2], acc[ai][1][m][n][2 * j2 + 1]};
                        const f32x2 a = gt * (f32x2){-1.4426950408889634f, -1.4426950408889634f};
                        f32x2 t; t.x = __builtin_amdgcn_exp2f(a.x); t.y = __builtin_amdgcn_exp2f(a.y);
                        const f32x2 d4 = t * (f32x2){0.25f, 0.25f} + (f32x2){0.25f, 0.25f};
                        f32x2 r4; r4.x = __builtin_amdgcn_rcpf(d4.x); r4.y = __builtin_amdgcn_rcpf(d4.y);
                        const f32x2 hv = (gt * up) * r4;
                        h[n * 4 + 2 * j2] = __builtin_amdgcn_fmed3f(hv.x, -448.f, 448.f); h[n * 4 + 2 * j2 + 1] = __builtin_amdgcn_fmed3f(hv.y, -448.f, 448.f); }
                int w0 = __builtin_amdgcn_cvt_pk_fp8_f32(h[0], h[1], 0, false); w0 = __builtin_amdgcn_cvt_pk_fp8_f32(h[2], h[3], w0, true);
                int w1 = __builtin_amdgcn_cvt_pk_fp8_f32(h[4], h[5], 0, false); w1 = __builtin_amdgcn_cvt_pk_fp8_f32(h[6], h[7], w1, true);
                u32x2 w; w.x = (unsigned)w0; w.y = (unsigned)w1;
                *(u32x2*)(rowp) = w; }
    }
};
struct EpiDown {
    static constexpr bool FP8 = true; int scale_w, scale_a;
    static constexpr bool PERM = true; static constexpr bool SWAPV = false; __device__ __forceinline__ bool swapv(const Unit&) const { return false; }
    unsigned char* ye;
    __device__ __forceinline__ void operator()(const f32x4 (&acc)[2][2][4][2], const Unit& u, int wr, int wc, int fr, int fq) const {
        const int row0 = u.e * 4096 + u.pm * BM + wr * 64 + fr, col0 = u.pn * BM + wc * 32 + 8 * fq;
#pragma unroll
        for (int ai = 0; ai < 2; ++ai)
#pragma unroll
            for (int m = 0; m < 4; ++m) { const int row = row0 + ai * HALF + m * 16; unsigned char* rowp = ye + (size_t)row * D + col0;
#pragma unroll
                for (int bj = 0; bj < 2; ++bj) { f32x4 v0 = acc[ai][bj][m][0] * 32.f, v1 = acc[ai][bj][m][1] * 32.f;
#pragma unroll
                    for (int i = 0; i < 4; ++i) { v0[i] = __builtin_amdgcn_fmed3f(v0[i], -448.f, 448.f); v1[i] = __builtin_amdgcn_fmed3f(v1[i], -448.f, 448.f); }
                    int w0 = __builtin_amdgcn_cvt_pk_fp8_f32(v0[0], v0[1], 0, false); w0 = __builtin_amdgcn_cvt_pk_fp8_f32(v0[2], v0[3], w0, true);
                    int w1 = __builtin_amdgcn_cvt_pk_fp8_f32(v1[0], v1[1], 0, false); w1 = __builtin_amdgcn_cvt_pk_fp8_f32(v1[2], v1[3], w1, true);
                    u32x2 w; w.x = (unsigned)w0; w.y = (unsigned)w1;
                    *(u32x2*)(rowp + bj * HALF) = w; } }
    }
};
}

constexpr int RING_BYTES = 131072, LDS_BYTES = 147456;
struct Args { const float* in[20]; float* out; unsigned char* ws; int ph_lo, ph_hi; };
struct Frame {
    LAS unsigned char* lds;
    int tid, lane, wave, gw, ngw, G;
};
#define P_X 0
#define P_C 1
#define P_CTX 2
#define P_CCTX 3
#define P_ADAW 4
#define P_ADAB 5
#define P_NORMG 6
#define P_GWIN 7
#define P_GWA2 8
#define P_GBA2 9
#define P_GNORMG 10
#define P_GWOUT 11
#define P_CWIN 12
#define P_CK 13
#define P_CWOUT 14
#define P_ROUTER 15
#define P_EGATE 16
#define P_EUP 17
#define P_EDOWN 18
#define P_FINALG 19

constexpr int TR_SCR = 64 * 65 * 4;
__device__ __forceinline__ void tr_item(const float* W, int ldw, int k0, int n0, bf16_t* WT, int ldo, int drow0, LAS float* scr, int lane) {
    f32x4 v[16];
#pragma unroll
    for (int i = 0; i < 16; ++i) v[i] = *(const f32x4*)(W + (size_t)(k0 + 4 * i + (lane >> 4)) * ldw + n0 + 4 * (lane & 15));
#pragma unroll
    for (int i = 0; i < 16; ++i) { LAS float* p = scr + (4 * i + (lane >> 4)) * 65 + 4 * (lane & 15); p[0] = v[i].x; p[1] = v[i].y; p[2] = v[i].z; p[3] = v[i].w; }
    LDS_WAIT(); asm volatile("" ::: "memory");
    const int c = lane & 7;
#pragma unroll
    for (int j = 0; j < 8; ++j) { const int n = (lane >> 3) + 8 * j; const LAS float* sp = scr + (8 * c) * 65 + n;
        u32x4 o; o.x = pk2(sp[0 * 65], sp[1 * 65]); o.y = pk2(sp[2 * 65], sp[3 * 65]); o.z = pk2(sp[4 * 65], sp[5 * 65]); o.w = pk2(sp[6 * 65], sp[7 * 65]);
        *(u32x4*)(WT + (size_t)(drow0 + n) * ldo + k0 + 8 * c) = o; }
    LDS_WAIT(); asm volatile("" ::: "memory");
}
__device__ __forceinline__ void tr_plain(Frame& F, const Args& A, const float* W, int K, int N, bf16_t* WT, int item, LAS float* scr) {
    const int nblk = (N + 63) / 64, kb = item / nblk, nb = item % nblk; int n0 = 64 * nb; if (n0 + 64 > N) n0 = N - 64;
    tr_item(W, N, 64 * kb, n0, WT, K, n0, scr, F.lane);
}
constexpr int TR_SCR8 = 128 * 33 * 4;
static_assert(TR_SCR8 >= TR_SCR, "per-wave scratch stride");
struct Tr8Item { const float* W; unsigned char* WT; int ldw, ldo, rowmap; };
constexpr int I8_G = (D / 128) * (DEXP / 256);
constexpr int I8_D = (DEXP / 128) * (D / 256);
constexpr int N_EXPERT_ITEMS = NE * (2 * I8_G + I8_D);
__device__ __forceinline__ Tr8Item expert_item(const Args& A, int gi) {
    const int l = gi / N_EXPERT_ITEMS, it = gi % N_EXPERT_ITEMS;
    unsigned char* wgu = A.ws + WS_W8 + (size_t)l * W8_LAYER; unsigned char* wd = wgu + W8_WD;
    constexpr int PER_E = 2 * I8_G + I8_D;
    const int e = it / PER_E; int r = it % PER_E;
    Tr8Item t;
    if (r < 2 * I8_G) {
        const int up = r / I8_G; r %= I8_G;
        const float* W = A.in[up ? P_EUP : P_EGATE] + ((size_t)l * NE + e) * D * DEXP;
        const int nblk = DEXP / 256, kb = r / nblk, nb = r % nblk, h0 = 256 * nb;
        t.W = W + (size_t)(128 * kb) * DEXP + h0; t.ldw = DEXP; t.WT = wgu + (size_t)e * 4096 * D + (size_t)(2 * h0 + 128 * up) * D + 128 * kb; t.ldo = D; t.rowmap = 1;
    } else {
        r -= 2 * I8_G;
        const float* W = A.in[P_EDOWN] + ((size_t)l * NE + e) * DEXP * D;
        const int nblk = D / 256, kb = r / nblk, nb = r % nblk;
        t.W = W + (size_t)(128 * kb) * D + 256 * nb; t.ldw = D; t.WT = wd + (size_t)e * D * DEXP + (size_t)(256 * nb) * DEXP + 128 * kb; t.ldo = DEXP; t.rowmap = 0;
    }
    return t;
}
__device__ __forceinline__ void tr8_load(const Tr8Item& t, f32x4 (&v)[16], int wave, int lane) {
#pragma unroll
    for (int i = 0; i < 16; ++i) v[i] = __builtin_nontemporal_load((const f32x4*)(t.W + (size_t)(16 * wave + i) * t.ldw + 4 * lane));
}
__device__ __forceinline__ void tr8_finish(const Tr8Item& t, const f32x4 (&v)[16], LAS unsigned char* tile, int tid, int wave, int lane) {
#pragma unroll
    for (int q = 0; q < 4; ++q) {
        int o[4];
#pragma unroll
        for (int g = 0; g < 4; ++g) { int w = __builtin_amdgcn_cvt_pk_fp8_f32(64.f * v[4 * g][q], 64.f * v[4 * g + 1][q], 0, false);
            o[g] = __builtin_amdgcn_cvt_pk_fp8_f32(64.f * v[4 * g + 2][q], 64.f * v[4 * g + 3][q], w, true); }
        u32x4 ov; ov.x = (unsigned)o[0]; ov.y = (unsigned)o[1]; ov.z = (unsigned)o[2]; ov.w = (unsigned)o[3];
        const int n = 4 * lane + q;
        *(LAS u32x4*)(tile + n * 128 + ((wave ^ (n & 7)) << 4)) = ov; }
    __syncthreads();
#pragma unroll
    for (int j = 0; j < 4; ++j) { const int p = tid + 512 * j, n = p >> 3, c = p & 7;
        const u32x4 ov = *(const LAS u32x4*)(tile + n * 128 + ((c ^ (n & 7)) << 4));
        const int drow = t.rowmap ? (256 * (n >> 7) + (n & 127)) : n;
        *(u32x4*)(t.WT + (size_t)drow * t.ldo + 16 * c) = ov; }
    __syncthreads();
}
__device__ __forceinline__ void convert_expert_dyn(const Args& A, unsigned* ctr, int end, LAS unsigned char* tile, volatile LAS int* slot, int tid, int wave, int lane) {
    if (tid == 0) { slot[0] = (int)__hip_atomic_fetch_add(ctr, 1u, __ATOMIC_RELAXED, __HIP_MEMORY_SCOPE_AGENT); slot[1] = (int)__hip_atomic_fetch_add(ctr, 1u, __ATOMIC_RELAXED, __HIP_MEMORY_SCOPE_AGENT); }
    __syncthreads();
    int ia = slot[0], ib = slot[1];
    if (ia >= end) return;
    f32x4 va[16], vb[16];
    Tr8Item ta = expert_item(A, ia), tb;
    tr8_load(ta, va, wave, lane);
    for (;;) {
        int rc = 0;
        tb = expert_item(A, min(ib, end - 1)); tr8_load(tb, vb, wave, lane);
        if (tid == 0) rc = (int)__hip_atomic_fetch_add(ctr, 1u, __ATOMIC_RELAXED, __HIP_MEMORY_SCOPE_AGENT);
        tr8_finish(ta, va, tile, tid, wave, lane);
        if (tid == 0) slot[0] = rc;
        __syncthreads();
        ia = ib; ib = slot[0];
        if (ia >= end) break;
        ta = expert_item(A, min(ib, end - 1)); tr8_load(ta, va, wave, lane);
        if (tid == 0) rc = (int)__hip_atomic_fetch_add(ctr, 1u, __ATOMIC_RELAXED, __HIP_MEMORY_SCOPE_AGENT);
        tr8_finish(tb, vb, tile, tid, wave, lane);
        if (tid == 0) slot[1] = rc;
        __syncthreads();
        ia = ib; ib = slot[1];
        if (ia >= end) break;
    }
}
template <int N>
__device__ __forceinline__ void convert_expert_fixed(const Args& A, LAS unsigned char* lds, int tid, int wave, int lane) {
    unsigned* ctr = (unsigned*)(A.ws + WS_CTL) + 2048; LAS unsigned char* tile = lds + 49152; volatile LAS int* slot = (volatile LAS int*)(lds + 40960);
    constexpr int end = 2 * N_EXPERT_ITEMS;
    __syncthreads();
    if (tid == 0) slot[0] = (int)__hip_atomic_fetch_add(ctr, (unsigned)N, __ATOMIC_RELAXED, __HIP_MEMORY_SCOPE_AGENT);
    __syncthreads();
    const int base = slot[0];
    if (base >= end) return;
    f32x4 va[16], vb[16];
    Tr8Item ta = expert_item(A, base), tb = ta;
    tr8_load(ta, va, wave, lane);
#pragma unroll
    for (int j = 0; j < N; ++j) {
        if ((j & 1) == 0) { if (j + 1 < N) { tb = expert_item(A, min(base + j + 1, end - 1)); tr8_load(tb, vb, wave, lane); } tr8_finish(ta, va, tile, tid, wave, lane); }
        else              { if (j + 1 < N) { ta = expert_item(A, min(base + j + 1, end - 1)); tr8_load(ta, va, wave, lane); } tr8_finish(tb, vb, tile, tid, wave, lane); }
    }
}

__device__ __forceinline__ void ph_prep(Frame& F, const Args& A) {
    LAS float* scr = (LAS float*)(F.lds + F.wave * TR_SCR8);
    bf16_t* win0 = (bf16_t*)(A.ws + WS_WIN0T); bf16_t* wout0 = (bf16_t*)(A.ws + WS_WOUT0T); bf16_t* wcin = (bf16_t*)(A.ws + WS_WCINT); bf16_t* wcout = (bf16_t*)(A.ws + WS_WCOUTT);
    {
        float* mod = (float*)(A.ws + WS_MOD);
        LAS float* red = (LAS float*)(F.lds + 8 * TR_SCR8);
        for (int it = blockIdx.x; it < 2 * 96; it += F.G) {
            const int l = it / 96, n = (it % 96) * 64 + F.lane;
            const float* w = A.in[P_ADAW] + (size_t)l * D * 6 * D + n;
            float a0 = 0.f, a1 = 0.f, a2 = 0.f;
#pragma unroll 16
            for (int kk = 0; kk < 128; ++kk) { const int k = F.wave * 128 + kk; const float wv = w[(size_t)k * 6 * D];
                a0 += silu_f(A.in[P_C][k]) * wv; a1 += silu_f(A.in[P_C][D + k]) * wv; a2 += silu_f(A.in[P_CCTX][k]) * wv; }
            red[(F.wave * 3 + 0) * 64 + F.lane] = a0; red[(F.wave * 3 + 1) * 64 + F.lane] = a1; red[(F.wave * 3 + 2) * 64 + F.lane] = a2;
            __syncthreads();
            if (F.wave < 3) { float sacc = A.in[P_ADAB][l * 6 * D + n];
#pragma unroll
                for (int w8 = 0; w8 < 8; ++w8) sacc += red[(w8 * 3 + F.wave) * 64 + F.lane];
                mod[(l * 3 + F.wave) * 6 * D + n] = sacc; }
            __syncthreads();
        }
    }
    constexpr int I0 = (D / 64) * ((NIN0 + 63) / 64), I1 = (D / 64) * (D / 64), I2 = (D / 64) * (NCIN / 64), I3 = I1;
    for (int it = F.gw; it < I0 + I1 + I2 + I3; it += F.ngw) {
        int r = it;
        if (r < I0) { tr_plain(F, A, A.in[P_GWIN], D, NIN0, win0, r, scr); continue; } r -= I0;
        if (r < I1) { tr_plain(F, A, A.in[P_GWOUT], D, D, wout0, r, scr); continue; } r -= I1;
        if (r < I2) {
            constexpr int nblk = NCIN / 64; const int kb = r / nblk, n0 = 64 * (r % nblk), sct = n0 >> 10, ch = n0 & 1023, cb = ch >> 8, hf = (ch >> 7) & 1;
            const int drow0 = sct == 0 ? (3 * cb + 2) * 256 + (ch & 255) : (3 * cb + hf) * 256 + 128 * (sct - 1) + (ch & 127);
            tr_item(A.in[P_CWIN], NCIN, 64 * kb, n0, wcin, D, drow0, scr, F.lane); continue; } r -= I2;
        tr_plain(F, A, A.in[P_CWOUT], D, D, wcout, r, scr);
    }
    { u32x4* z = (u32x4*)(win0 + (size_t)NIN0 * D); const int n16 = (NIN0P - NIN0) * D * 2 / 16;
      for (int i = F.gw * 64 + F.lane; i < n16; i += F.ngw * 64) z[i] = (u32x4){0u, 0u, 0u, 0u}; }
}

__device__ __forceinline__ void normmod_row(const f32x4 (&v)[4], const float* g, const float* sh, const float* sc, bf16_t* orow, int lane) {
    float s = 0.f;
#pragma unroll
    for (int j = 0; j < 4; ++j) s += (v[j].x * v[j].x + v[j].y * v[j].y) + (v[j].z * v[j].z + v[j].w * v[j].w);
    const float rstd = rsqrtf(wave_sum(s) * (1.f / D) + EPS);
#pragma unroll
    for (int j = 0; j < 4; ++j) { const int c = 4 * lane + 256 * j;
        const f32x4 gg = *(const f32x4*)(g + c), s1 = *(const f32x4*)(sh + c), s2 = *(const f32x4*)(sc + c);
        const f32x4 y = v[j] * rstd * gg * (s2 + 1.f) + s1;
        u32x2 w; w.x = pk2(y.x, y.y); w.y = pk2(y.z, y.w);
        *(u32x2*)(orow + c) = w; }
}
__device__ __forceinline__ void ph_norm0(Frame& F, const Args& A) {
    const float* mod = (const float*)(A.ws + WS_MOD); bf16_t* H = (bf16_t*)(A.ws + WS_H);
    for (int row = F.gw; row < NROW; row += F.ngw) {
        const float* xr = row < NLAT ? A.in[P_X] + (size_t)row * D : A.in[P_CTX] + (size_t)(row - NLAT) * D;
        const int s = row < NLAT ? (row >> 14) : 2;
        f32x4 v[4];
#pragma unroll
        for (int j = 0; j < 4; ++j) v[j] = *(const f32x4*)(xr + 4 * F.lane + 256 * j);
        normmod_row(v, A.in[P_NORMG] + 0 * D, mod + (0 * 3 + s) * 6 * D + 0 * D, mod + (0 * 3 + s) * 6 * D + 1 * D, H + (size_t)row * D, F.lane);
    }
}

__device__ __forceinline__ int jperm(int ks, int fq, int jj) { return 32 * ks + 16 * (jj >> 2) + 4 * fq + (jj & 3); }
__device__ __forceinline__ bf16x8 ldfrag(const unsigned char* blob, int blk, int lane) { return *(const bf16x8*)(blob + blk * 1024 + lane * 16); }
__device__ __forceinline__ unsigned cvtpk(float lo, float hi) { return pk2(lo, hi); }
__device__ __forceinline__ bf16x8 pack8(const f32x4& a, const f32x4& b) {
    u32x4 w; w.x = cvtpk(a[0], a[1]); w.y = cvtpk(a[2], a[3]); w.z = cvtpk(b[0], b[1]); w.w = cvtpk(b[2], b[3]);
    return __builtin_bit_cast(bf16x8, w);
}
__device__ __forceinline__ void ph_gla_prep(Frame& F, const Args& A) {
    constexpr int LSTR = 1040;
    LAS unsigned char* QS = F.lds; LAS unsigned char* KS = F.lds + 64 * LSTR;
    const bf16_t* qk = (const bf16_t*)(A.ws + WS_QK); const float* afb = (const float*)(A.ws + WS_AFB);
    float* gam = (float*)(A.ws + WS_GAM);
    const bool has_conv = blockIdx.x + 4 * F.G >= 2 * NCHUNK;
    const int pre = has_conv ? (int)(blockIdx.x & 3) : 0;
    if (pre == 1) convert_expert_fixed<1>(A, F.lds, F.tid, F.wave, F.lane);
    else if (pre == 2) convert_expert_fixed<2>(A, F.lds, F.tid, F.wave, F.lane);
    else if (pre == 3) convert_expert_fixed<3>(A, F.lds, F.tid, F.wave, F.lane);
    __syncthreads();
    const int dir = blockIdx.x & 1, d = F.tid;
    f32x2 w2[8];
#pragma unroll
    for (int r = 0; r < 8; ++r) { w2[r].x = A.in[P_GWA2][(dir * 16 + 2 * r) * DK + d]; w2[r].y = A.in[P_GWA2][(dir * 16 + 2 * r + 1) * DK + d]; }
    const float bias = A.in[P_GBA2][dir * DK + d];
    u32x4 t16[16]; f32x4 av = (f32x4){0.f, 0.f, 0.f, 0.f};
#define PREP_LOAD(it_) do { const int row0_ = ((it_) >> 1) * 64; \
        _Pragma("unroll") for (int u = 0; u < 16; ++u) { const int q16 = F.tid + NTHR * u, j = q16 >> 7, cp = q16 & 127; t16[u] = *(const u32x4*)((const unsigned char*)qk + ((size_t)(row0_ + j) * D) * 2 + cp * 16); } \
        if (F.tid < 256) av = *(const f32x4*)(afb + (size_t)(row0_ + (F.tid >> 2)) * 32 + dir * 16 + 4 * (F.tid & 3)); } while (0)
    if ((int)blockIdx.x < 2 * NCHUNK) PREP_LOAD((int)blockIdx.x);
    for (int item = blockIdx.x; item < 2 * NCHUNK; item += F.G) {
        {
            const int ch = item >> 1, row0 = ch * 64; (void)row0;
            LAS float* AFL = (LAS float*)(F.lds + 2 * 64 * LSTR);
            {
#pragma unroll
                for (int u = 0; u < 16; ++u) { const int q16 = F.tid + NTHR * u, j = q16 >> 7, cp = q16 & 127; *(LAS u32x4*)(((cp < 64) ? QS : KS) + j * LSTR + (cp & 63) * 16) = t16[u]; }
                if (F.tid < 256) *(LAS f32x4*)(AFL + (F.tid >> 2) * 16 + 4 * (F.tid & 3)) = av;
            }
            if (item + F.G < 2 * NCHUNK) PREP_LOAD(item + F.G);
            __syncthreads();
            float cum2 = 0.f;
#pragma unroll 1
            for (int jq = 0; jq < 64; jq += 4) {
                f32x4 ar[4][4]; unsigned qv[4], kv[4];
#pragma unroll
                for (int u = 0; u < 4; ++u) { const int j = dir ? 63 - (jq + u) : jq + u;
#pragma unroll
                    for (int r4 = 0; r4 < 4; ++r4) ar[u][r4] = *(const LAS f32x4*)(AFL + j * 16 + 4 * r4); }
#pragma unroll
                for (int u = 0; u < 4; ++u) { const int j = dir ? 63 - (jq + u) : jq + u;
                    qv[u] = *(const LAS bf16_t*)(QS + j * LSTR + d * 2); kv[u] = *(const LAS bf16_t*)(KS + j * LSTR + d * 2); }
                asm volatile("" ::: "memory");
                float ls2[4];
#pragma unroll
                for (int u = 0; u < 4; ++u) {
                    f32x2 za = (f32x2){bias, 0.f}, zb = (f32x2){0.f, 0.f};
#pragma unroll
                    for (int r4 = 0; r4 < 4; ++r4) { za = __builtin_elementwise_fma((f32x2){ar[u][r4].x, ar[u][r4].y}, w2[2 * r4], za); zb = __builtin_elementwise_fma((f32x2){ar[u][r4].z, ar[u][r4].w}, w2[2 * r4 + 1], zb); }
                    const float z = (za.x + za.y) + (zb.x + zb.y);
                    const float zl = z * 1.4426950408889634f;
                    ls2[u] = fminf(zl, 0.f) - __builtin_amdgcn_logf(1.f + __builtin_amdgcn_exp2f(-fabsf(zl)));
                }
                unsigned qk2[4];
#pragma unroll
                for (int u = 0; u < 4; ++u) {
                    cum2 += ls2[u] * (1.f / 16.f);
                    const float e = __builtin_amdgcn_exp2f(cum2), ei = __builtin_amdgcn_exp2f(-cum2);
                    qk2[u] = pk2(bflo(qv[u]) * e, bflo(kv[u]) * ei);
                }
#pragma unroll
                for (int u = 0; u < 4; ++u) { const int j = dir ? 63 - (jq + u) : jq + u;
                    *(LAS bf16_t*)(QS + j * LSTR + d * 2) = (bf16_t)(qk2[u] & 0xffffu); *(LAS bf16_t*)(KS + j * LSTR + d * 2) = (bf16_t)(qk2[u] >> 16); }
            }
            const float cum = cum2 * 0.6931471805599453f;
            gam[((size_t)dir * NCHUNK + ch) * DK + d] = __expf(cum);
            __syncthreads();
            {
                const int fr = F.lane & 15, fq = F.lane >> 4;
                unsigned char* blob0 = A.ws + (((size_t)dir * NCHUNK + ch) * 4) * BLOB + (size_t)F.tid * 16;
#pragma unroll
                for (int typ = 0; typ < 2; ++typ) {
                    const LAS unsigned char* src = (typ == 0) ? QS : KS;
                    u32x4 o[8];
#pragma unroll
                    for (int i8 = 0; i8 < 8; ++i8) { const int h = i8 >> 1, blk = F.wave + 8 * (i8 & 1), it = blk >> 2, sd = blk & 3, i = 16 * it + fr, d0 = h * HK + 32 * sd + 4 * fq;
                        const u32x2 lo = *(const LAS u32x2*)(src + i * LSTR + d0 * 2), hi = *(const LAS u32x2*)(src + i * LSTR + (d0 + 16) * 2);
                        o[i8].x = lo.x; o[i8].y = lo.y; o[i8].z = hi.x; o[i8].w = hi.y; }
                    unsigned char* dst = blob0 + (typ == 0 ? WS_QP : WS_KP);
#pragma unroll
                    for (int i8 = 0; i8 < 8; ++i8) *(u32x4*)(dst + (size_t)(i8 >> 1) * BLOB + (size_t)(i8 & 1) * 8192) = o[i8];
                }
                {
                    u32x4 o[8];
#pragma unroll
                    for (int i8 = 0; i8 < 8; ++i8) { const int h = i8 >> 1, blk = F.wave + 8 * (i8 & 1), mt = blk >> 1, ks = blk & 1, dd = h * HK + 16 * mt + fr; unsigned e[8];
#pragma unroll
                        for (int jj = 0; jj < 8; ++jj) e[jj] = *(const LAS bf16_t*)(KS + jperm(ks, fq, jj) * LSTR + dd * 2);
                        o[i8].x = e[0] | (e[1] << 16); o[i8].y = e[2] | (e[3] << 16); o[i8].z = e[4] | (e[5] << 16); o[i8].w = e[6] | (e[7] << 16); }
                    unsigned char* dst = blob0 + WS_KTP;
#pragma unroll
                    for (int i8 = 0; i8 < 8; ++i8) *(u32x4*)(dst + (size_t)(i8 >> 1) * BLOB + (size_t)(i8 & 1) * 8192) = o[i8];
                }
            }
            __syncthreads();
        }
    }
#undef PREP_LOAD
    if (has_conv) {
        if (pre == 0) convert_expert_fixed<4>(A, F.lds, F.tid, F.wave, F.lane);
        else if (pre == 1) convert_expert_fixed<3>(A, F.lds, F.tid, F.wave, F.lane);
        else if (pre == 2) convert_expert_fixed<2>(A, F.lds, F.tid, F.wave, F.lane);
        else convert_expert_fixed<1>(A, F.lds, F.tid, F.wave, F.lane);
    }
}

#define MFMA16(a, b, c) __builtin_amdgcn_mfma_f32_16x16x32_bf16((a), (b), (c), 0, 0, 0)
__device__ __forceinline__ void gla_intra_item(Frame& F, const Args& A, int item) {
    const int ch = item >> 2, h = item & 3, fr = F.lane & 15, fq = F.lane >> 4;
    const unsigned char* qpf = A.ws + WS_QP + (((size_t)0 * NCHUNK + ch) * 4 + h) * BLOB; const unsigned char* kpf = A.ws + WS_KP + (((size_t)0 * NCHUNK + ch) * 4 + h) * BLOB;
    const unsigned char* qpb = A.ws + WS_QP + (((size_t)1 * NCHUNK + ch) * 4 + h) * BLOB; const unsigned char* kpb = A.ws + WS_KP + (((size_t)1 * NCHUNK + ch) * 4 + h) * BLOB;
    bf16x8 Pf[4][2];
#pragma unroll
    for (int it = 0; it < 4; ++it) {
        f32x4 P[4];
#pragma unroll
        for (int jt = 0; jt < 4; ++jt) P[jt] = (f32x4){0.f, 0.f, 0.f, 0.f};
#pragma unroll
        for (int dirp = 0; dirp < 2; ++dirp) {
            const unsigned char* qp = dirp ? qpb : qpf; const unsigned char* kp = dirp ? kpb : kpf;
            bf16x8 kk[16], qq[4];
#pragma unroll
            for (int sd = 0; sd < 4; ++sd) qq[sd] = ldfrag(qp, it * 4 + sd, F.lane);
#pragma unroll
            for (int jt = 0; jt < 4; ++jt) if (dirp ? (jt >= it) : (jt <= it)) {
#pragma unroll
                for (int sd = 0; sd < 4; ++sd) kk[jt * 4 + sd] = ldfrag(kp, jt * 4 + sd, F.lane); }
#pragma unroll
            for (int jt = 0; jt < 4; ++jt) if (dirp ? (jt >= it) : (jt <= it)) {
                f32x4 a = (f32x4){0.f, 0.f, 0.f, 0.f};
#pragma unroll
                for (int sd = 0; sd < 4; ++sd) a = MFMA16(kk[jt * 4 + sd], qq[sd], a);
                if (jt == it) {
#pragma unroll
                    for (int r = 0; r < 4; ++r) { const int j = 4 * fq + r; const bool keep = dirp ? (j >= fr) : (j <= fr); a[r] = keep ? a[r] : 0.f; }
                }
                P[jt] += a;
            }
        }
        Pf[it][0] = pack8(P[0], P[1]); Pf[it][1] = pack8(P[2], P[3]);
    }
    const unsigned char* vt = A.ws + WS_VTP + (size_t)ch * 131072 + (size_t)(h * 16) * 2048;
    bf16_t* oi = (bf16_t*)(A.ws + WS_OI) + (size_t)(ch * 64 + fr) * DV + h * HV + 4 * fq;
#pragma unroll 1
    for (int ng = 0; ng < 4; ++ng) {
        bf16x8 va[8];
#pragma unroll
        for (int i = 0; i < 8; ++i) va[i] = ldfrag(vt, ng * 8 + i, F.lane);
#pragma unroll
        for (int n4 = 0; n4 < 4; ++n4)
#pragma unroll
            for (int it = 0; it < 4; ++it) {
                f32x4 acc = (f32x4){0.f, 0.f, 0.f, 0.f};
                acc = MFMA16(va[n4 * 2], Pf[it][0], acc); acc = MFMA16(va[n4 * 2 + 1], Pf[it][1], acc);
                u32x2 w; w.x = pk2(acc[0], acc[1]); w.y = pk2(acc[2], acc[3]);
                *(u32x2*)(oi + (size_t)(16 * it) * DV + 16 * (ng * 4 + n4)) = w;
            }
    }
}
struct ScanRegs { bf16x8 q[4], k[4], v[2][2]; f32x4 g[2]; };
__device__ __forceinline__ int scan_chunk(int b, int dir, int step) { return step >= 4 ? (256 * b + (dir ? 255 - (step - 4) : step - 4)) : (512 + 4 * b + (dir ? 3 - step : step)); }
__device__ __forceinline__ void scan_load(const Args& A, ScanRegs& R, int b, int h, int dir, int sp, int w, int step, int lane) {
    const int ch = scan_chunk(b, dir, step), fq = lane >> 4;
    const size_t bo = (((size_t)dir * NCHUNK + ch) * 4 + h) * BLOB;
    const unsigned char* qp = A.ws + WS_QP + bo; const unsigned char* ktp = A.ws + WS_KTP + bo;
    const unsigned char* vt = A.ws + WS_VTP + (size_t)ch * 131072 + (size_t)(h * 16 + 2 * sp) * 2048;
    const float* gp = (const float*)(A.ws + WS_GAM) + ((size_t)dir * NCHUNK + ch) * DK + h * HK + 32 * w + 4 * fq;
#pragma unroll
    for (int sd = 0; sd < 4; ++sd) R.q[sd] = ldfrag(qp, w * 4 + sd, lane);
#pragma unroll
    for (int m = 0; m < 2; ++m)
#pragma unroll
        for (int ks = 0; ks < 2; ++ks) R.k[m * 2 + ks] = ldfrag(ktp, (2 * w + m) * 2 + ks, lane);
#pragma unroll
    for (int s2 = 0; s2 < 2; ++s2) {
        const int o = 8 * ((lane & 15) >> 2) + 4 * s2 + (lane & 3);
        const unsigned char* vp = vt + (o >> 4) * 2048 + ((o & 15) + (lane & 48)) * 16;
        R.v[s2][0] = *(const bf16x8*)(vp); R.v[s2][1] = *(const bf16x8*)(vp + 1024); }
    R.g[0] = *(const f32x4*)(gp); R.g[1] = *(const f32x4*)(gp + 16);
}
#define LDS_ORDER() asm volatile("" ::: "memory")
__device__ __forceinline__ void scan_ds(const ScanRegs& R, f32x4 (&dS)[2][2]) {
#pragma unroll
    for (int s2 = 0; s2 < 2; ++s2)
#pragma unroll
        for (int m = 0; m < 2; ++m) { f32x4 d = (f32x4){0.f, 0.f, 0.f, 0.f}; d = MFMA16(R.k[m * 2], R.v[s2][0], d); d = MFMA16(R.k[m * 2 + 1], R.v[s2][1], d); dS[s2][m] = d; }
}
__device__ __forceinline__ void scan_step(const Args& A, const ScanRegs& R, const ScanRegs& Rn, f32x4 (&S)[2][2], f32x4 (&dS)[2][2], LAS unsigned char* xs, LAS unsigned* flags, bf16_t* O, int b, int h, int dir, int sp, int w, int step, int lane) {
    const int fr = lane & 15, fq = lane >> 4;
#pragma unroll
    for (int s2 = 0; s2 < 2; ++s2) {
        S[s2][0] = R.g[0] * (S[s2][0] + dS[s2][0]); S[s2][1] = R.g[1] * (S[s2][1] + dS[s2][1]);
        *(volatile LAS bf16x8*)(xs + ((step + 1) & 3) * 8192 + (s2 * 4 + w) * 1024 + lane * 16) = pack8(S[s2][0], S[s2][1]);
    }
    LDS_ORDER();
    if (lane == 0) *(volatile LAS unsigned*)(flags + w) = (unsigned)step + 2u;
    LDS_ORDER();
    scan_ds(Rn, dS);
    if (step >= 4) {
        { const unsigned need = (unsigned)step + 1u; unsigned spn = 0;
          for (;;) { const unsigned f = (lane < 4) ? *(volatile LAS unsigned*)(flags + lane) : need;
              if (__all((int)(f >= need))) break; if (++spn > (1u << 26)) break; }
          LDS_ORDER(); }
        const LAS unsigned char* slot = xs + (step & 3) * 8192 + lane * 16;
        bf16x8 sf[2][4];
#pragma unroll
        for (int s2 = 0; s2 < 2; ++s2)
#pragma unroll
            for (int sd = 0; sd < 4; ++sd) sf[s2][sd] = *(const LAS bf16x8*)(slot + (s2 * 4 + sd) * 1024);
        LDS_ORDER();
        const int ch = scan_chunk(b, dir, step);
        f32x4 acc0 = (f32x4){0.f, 0.f, 0.f, 0.f}, acc1 = acc0;
#pragma unroll
        for (int sd = 0; sd < 4; ++sd) { acc0 = MFMA16(sf[0][sd], R.q[sd], acc0); acc1 = MFMA16(sf[1][sd], R.q[sd], acc1); }
        u32x4 wv; wv.x = pk2(acc0[0], acc0[1]); wv.y = pk2(acc0[2], acc0[3]); wv.z = pk2(acc1[0], acc1[1]); wv.w = pk2(acc1[2], acc1[3]);
        *(u32x4*)(O + (size_t)(ch * 64 + 16 * w + fr) * DV + h * HV + 32 * sp + 8 * fq) = wv;
    }
}
__device__ __forceinline__ void gla_scan_item(Frame& F, const Args& A, int item, LAS unsigned char* xs, LAS unsigned* flags) {
    const int chain = item >> 3, sp = item & 7, b = chain >> 3, h = (chain >> 1) & 3, dir = chain & 1, w = F.wave;
    bf16_t* O = (bf16_t*)(A.ws + (dir ? WS_OB : WS_OF));
    f32x4 S[2][2], dS[2][2];
#pragma unroll
    for (int s2 = 0; s2 < 2; ++s2) { S[s2][0] = (f32x4){0.f, 0.f, 0.f, 0.f}; S[s2][1] = S[s2][0];
        *(volatile LAS bf16x8*)(xs + (s2 * 4 + w) * 1024 + F.lane * 16) = pack8(S[s2][0], S[s2][1]); }
    LDS_ORDER();
    if (F.lane == 0) *(volatile LAS unsigned*)(flags + w) = 1u;
    LDS_ORDER();
    ScanRegs Ra, Rb, Rc;
    scan_load(A, Ra, b, h, dir, sp, w, 0, F.lane);
    scan_load(A, Rb, b, h, dir, sp, w, 1, F.lane);
    scan_ds(Ra, dS);
    for (int step = 0; step < 261; step += 3) {
        scan_load(A, Rc, b, h, dir, sp, w, min(step + 2, 259), F.lane);
        scan_step(A, Ra, Rb, S, dS, xs, flags, O, b, h, dir, sp, w, step, F.lane);
        scan_load(A, Ra, b, h, dir, sp, w, min(step + 3, 259), F.lane);
        scan_step(A, Rb, Rc, S, dS, xs, flags, O, b, h, dir, sp, w, step + 1, F.lane);
        scan_load(A, Rb, b, h, dir, sp, w, min(step + 4, 259), F.lane);
        if (step + 2 < 260) scan_step(A, Rc, Ra, S, dS, xs, flags, O, b, h, dir, sp, w, step + 2, F.lane);
    }
}
__device__ __forceinline__ void ph_gla_main(Frame& F, const Args& A) {
    LAS unsigned char* xs = F.lds; LAS unsigned* flags = (LAS unsigned*)(F.lds + 32768);
    if (F.tid < 16) flags[F.tid] = 0u;
    __syncthreads();
    const int bi = blockIdx.x;
    unsigned* ctr = (unsigned*)(A.ws + WS_CTL) + 2048;
    volatile LAS int* slot = (volatile LAS int*)(F.lds + 40960);
    if (bi < 128) {
        if (F.wave < 4) gla_scan_item(F, A, ((2 * (bi & 7) + ((bi >> 3) & 1)) << 3) | ((bi >> 4) & 7), xs, flags);
        __syncthreads();
    } else {
        const int sw = (bi - 128) * NWAVES + F.wave, nsw = (F.G - 128) * NWAVES;
        for (int it = sw; it < 512 * 4; it += nsw) gla_intra_item(F, A, it);
        __syncthreads();
    }
    convert_expert_dyn(A, ctr, 2 * N_EXPERT_ITEMS, F.lds + 49152, slot, F.tid, F.wave, F.lane);
    __syncthreads();
}

__device__ __forceinline__ void ph_gla_finish(Frame& F, const Args& A) {
    const bf16_t* rp = (const bf16_t*)(A.ws + WS_R); const bf16_t* OFp = (const bf16_t*)(A.ws + WS_OF); const bf16_t* OBp = (const bf16_t*)(A.ws + WS_OB); const bf16_t* OIp = (const bf16_t*)(A.ws + WS_OI);
    bf16_t* Hh = (bf16_t*)(A.ws + WS_H);
    const f32x4 gn = *(const f32x4*)(A.in[P_GNORMG] + 4 * F.lane);
    for (int row = F.gw; row < NLAT; row += F.ngw) {
#pragma unroll
        for (int j = 0; j < 4; ++j) {
            const int cc = 4 * F.lane + 256 * j;
            const u32x2 a = *(const u32x2*)(OFp + (size_t)row * DV + cc), bq = *(const u32x2*)(OBp + (size_t)row * DV + cc), ci = *(const u32x2*)(OIp + (size_t)row * DV + cc);
            const u32x2 rr = *(const u32x2*)(rp + (size_t)row * D + cc);
            f32x4 o; o.x = bflo(a.x) + bflo(bq.x) + bflo(ci.x); o.y = bfhi(a.x) + bfhi(bq.x) + bfhi(ci.x); o.z = bflo(a.y) + bflo(bq.y) + bflo(ci.y); o.w = bfhi(a.y) + bfhi(bq.y) + bfhi(ci.y);
            const float ss = wave_sum((o.x * o.x + o.y * o.y) + (o.z * o.z + o.w * o.w));
            const float rstd = rsqrtf(ss * (1.f / HV) + EPS);
            f32x4 r; r.x = bflo(rr.x); r.y = bfhi(rr.x); r.z = bflo(rr.y); r.w = bfhi(rr.y);
            f32x4 y;
#pragma unroll
            for (int i = 0; i < 4; ++i) y[i] = o[i] * rstd * gn[i] * silu_f(r[i]);
            u32x2 w; w.x = pk2(y.x, y.y); w.y = pk2(y.z, y.w);
            *(u32x2*)(Hh + (size_t)row * D + cc) = w;
        }
    }
}

__device__ __forceinline__ void stage_router(Frame& F, const Args& A, int l) {
    LAS float* wl = (LAS float*)F.lds;
    const float* rw = A.in[P_ROUTER] + (size_t)l * D * NE;
    for (int idx = F.tid; idx < D * NE; idx += NTHR) { const int k = idx >> 4, e = idx & 15, j = k >> 8, ln = (k & 255) >> 2, i = k & 3; wl[((((j * 4 + i) * 4 + (e >> 2)) * 64) + ln) * 4 + (e & 3)] = rw[idx]; }
    __syncthreads();
}
template <int N, int M>
__device__ __forceinline__ void rs_step(const float (&v)[N], float (&w)[N / 2], int lane) {
    const bool hi = (lane & M) != 0;
#pragma unroll
    for (int e = 0; e < N / 2; ++e) { const float mine = hi ? v[N / 2 + e] : v[e], other = hi ? v[e] : v[N / 2 + e]; w[e] = mine + __shfl_xor(other, M); }
}
__device__ __forceinline__ void ph_norm2_router(Frame& F, const Args& A, int l) {
    const float* mod = (const float*)(A.ws + WS_MOD); unsigned char* H8 = A.ws + WS_H; const bf16_t* X = (const bf16_t*)(A.ws + WS_X); float* aff = (float*)(A.ws + WS_AFF);
    const float* g = A.in[P_NORMG] + (l * 2 + 1) * D; const float* rw = A.in[P_ROUTER] + (size_t)l * D * NE;
    LAS unsigned char* WF = F.lds;
    LAS float* GS = (LAS float*)(F.lds + 65536); LAS float* SH = GS + D; LAS float* CB = SH + D; LAS float* RED = CB + 16;
    const int fr = F.lane & 15, fq = F.lane >> 4;
    const int b = (int)((blockIdx.x * NWAVES * 16) >> 14);
    const float* sh = mod + (l * 3 + b) * 6 * D + 3 * D; const float* sc = mod + (l * 3 + b) * 6 * D + 4 * D;
    for (int k = F.tid; k < D; k += NTHR) { GS[k] = g[k] * (1.f + sc[k]); SH[k] = sh[k]; }
    __syncthreads();
    for (int p = F.tid; p < 32 * 64; p += NTHR) {
        const int s = p >> 6, ln = p & 63, e = ln & 15, k0 = 32 * s + 8 * (ln >> 4);
        float w[8];
#pragma unroll
        for (int i = 0; i < 8; ++i) w[i] = rw[(k0 + i) * NE + e] * GS[k0 + i];
        u32x4 hi, lo;
        hi.x = pk2(w[0], w[1]); hi.y = pk2(w[2], w[3]); hi.z = pk2(w[4], w[5]); hi.w = pk2(w[6], w[7]);
        lo.x = pk2(w[0] - bflo(hi.x), w[1] - bfhi(hi.x)); lo.y = pk2(w[2] - bflo(hi.y), w[3] - bfhi(hi.y)); lo.z = pk2(w[4] - bflo(hi.z), w[5] - bfhi(hi.z)); lo.w = pk2(w[6] - bflo(hi.w), w[7] - bfhi(hi.w));
        *(LAS u32x4*)(WF + ((s * 2 + 0) * 64 + ln) * 16) = hi; *(LAS u32x4*)(WF + ((s * 2 + 1) * 64 + ln) * 16) = lo;
    }
    { const int e = F.tid & 15, part = F.tid >> 4; float acc = 0.f;
#pragma unroll 8
      for (int i = 0; i < 32; ++i) { const int k = part * 32 + i; acc += SH[k] * rw[k * NE + e]; }
      RED[part * 16 + e] = acc; }
    __syncthreads();
    if (F.tid < 16) { float acc = 0.f;
#pragma unroll
        for (int q = 0; q < 32; ++q) acc += RED[q * 16 + F.tid];
        CB[F.tid] = acc; }
    __syncthreads();
    for (int grp = F.gw; grp < NLAT / 16; grp += F.ngw) {
        const int row0 = grp * 16, row = row0 + fr;
        const bf16_t* xr = X + (size_t)row * D + 8 * fq;
        u32x4 xv[32];
#pragma unroll
        for (int s = 0; s < 32; ++s) xv[s] = *(const u32x4*)(xr + 32 * s);
        f32x2 ss2 = (f32x2){0.f, 0.f};
        f32x4 acc = (f32x4){0.f, 0.f, 0.f, 0.f};
#pragma unroll
        for (int s = 0; s < 32; ++s) {
            const u32x4 t = xv[s];
            const f32x2 a0 = {bflo(t.x), bfhi(t.x)}, a1 = {bflo(t.y), bfhi(t.y)}, a2 = {bflo(t.z), bfhi(t.z)}, a3 = {bflo(t.w), bfhi(t.w)};
            ss2 = __builtin_elementwise_fma(a0, a0, ss2); ss2 = __builtin_elementwise_fma(a1, a1, ss2); ss2 = __builtin_elementwise_fma(a2, a2, ss2); ss2 = __builtin_elementwise_fma(a3, a3, ss2);
            const bf16x8 xb = __builtin_bit_cast(bf16x8, t);
            acc = MFMA16(*(const LAS bf16x8*)(WF + ((s * 2 + 0) * 64 + F.lane) * 16), xb, acc);
            acc = MFMA16(*(const LAS bf16x8*)(WF + ((s * 2 + 1) * 64 + F.lane) * 16), xb, acc);
            if ((s & 1) == 1) asm volatile("" ::: "memory");
        }
#pragma unroll
        for (int s = 0; s < 32; ++s) asm volatile("" : "+v"(xv[s]));
        float ss = ss2.x + ss2.y; ss += __shfl_xor(ss, 16); ss += __shfl_xor(ss, 32);
        const float rstd = rsqrtf(ss * (1.f / D) + EPS);
        float lg[4]; float mx = -3.0e38f;
#pragma unroll
        for (int r = 0; r < 4; ++r) { lg[r] = rstd * acc[r] + CB[4 * fq + r]; mx = fmaxf(mx, lg[r]); }
        mx = fmaxf(mx, __shfl_xor(mx, 16)); mx = fmaxf(mx, __shfl_xor(mx, 32));
        float ex[4], den = 0.f;
#pragma unroll
        for (int r = 0; r < 4; ++r) { ex[r] = __expf(lg[r] - mx); den += ex[r]; }
        den += __shfl_xor(den, 16); den += __shfl_xor(den, 32);
        const float inv = 1.f / den; const int t = row & (T - 1);
#pragma unroll
        for (int r = 0; r < 4; ++r) aff[((size_t)b * NE + 4 * fq + r) * T + t] = ex[r] * inv;
        unsigned char* hr = H8 + (size_t)row * D + 8 * fq;
#pragma unroll
        for (int s = 0; s < 32; ++s) {
            const u32x4 t4 = xv[s]; const int k0 = 32 * s + 8 * fq;
            const f32x4 g0 = *(const LAS f32x4*)(GS + k0), g1 = *(const LAS f32x4*)(GS + k0 + 4), h0 = *(const LAS f32x4*)(SH + k0), h1 = *(const LAS f32x4*)(SH + k0 + 4);
            f32x4 y0 = (f32x4){bflo(t4.x), bfhi(t4.x), bflo(t4.y), bfhi(t4.y)} * rstd * g0 + h0, y1 = (f32x4){bflo(t4.z), bfhi(t4.z), bflo(t4.w), bfhi(t4.w)} * rstd * g1 + h1;
            const f32x4 lim = (f32x4){448.f, 448.f, 448.f, 448.f};
            y0 = __builtin_elementwise_min(__builtin_elementwise_max(y0, -lim), lim); y1 = __builtin_elementwise_min(__builtin_elementwise_max(y1, -lim), lim);
            int w0 = __builtin_amdgcn_cvt_pk_fp8_f32(y0.x, y0.y, 0, false); w0 = __builtin_amdgcn_cvt_pk_fp8_f32(y0.z, y0.w, w0, true);
            int w1 = __builtin_amdgcn_cvt_pk_fp8_f32(y1.x, y1.y, 0, false); w1 = __builtin_amdgcn_cvt_pk_fp8_f32(y1.z, y1.w, w1, true);
            u32x2 wv; wv.x = (unsigned)w0; wv.y = (unsigned)w1;
            *(u32x2*)(hr + 32 * s) = wv;
            if ((s & 1) == 1) asm volatile("" ::: "memory");
        }
    }
    __syncthreads();
}

__device__ __forceinline__ void ph_topk(Frame& F, const Args& A) {
    LAS int* red = (LAS int*)F.lds;
    const float* aff = (const float*)(A.ws + WS_AFF); int* slot = (int*)(A.ws + WS_SLOT); int* rowlist = (int*)(A.ws + WS_ROWLIST); float* selval = (float*)(A.ws + WS_SELVAL);
    for (int item = blockIdx.x; item < NB * NE; item += F.G) {
        const int b = item / NE, e = item % NE;
        const float* a = aff + ((size_t)b * NE + e) * T + F.tid * 32;
        unsigned v[32];
#pragma unroll
        for (int q = 0; q < 8; ++q) { const u32x4 x = *(const u32x4*)(a + 4 * q); v[4 * q] = x.x; v[4 * q + 1] = x.y; v[4 * q + 2] = x.z; v[4 * q + 3] = x.w; }
        unsigned prefix = 0u; int par = 0;
        for (int bit = 30; bit >= 0; --bit) {
            const unsigned cand = prefix | (1u << bit); int cnt = 0;
#pragma unroll
            for (int i = 0; i < 32; ++i) cnt += (v[i] >= cand) ? 1 : 0;
            cnt = wave_sum_i(cnt);
            if (F.lane == 0) red[par * 16 + F.wave] = cnt;
            __syncthreads();
            int tot = 0;
#pragma unroll
            for (int w8 = 0; w8 < 8; ++w8) tot += red[par * 16 + w8];
            if (tot >= CAP) prefix = cand;
            par ^= 1;
        }
        __syncthreads();
        int mgt = 0, meq = 0;
#pragma unroll
        for (int i = 0; i < 32; ++i) { mgt += (v[i] > prefix) ? 1 : 0; meq += (v[i] == prefix) ? 1 : 0; }
        int igt = mgt, ieq = meq;
#pragma unroll
        for (int o = 1; o < 64; o <<= 1) { const int ug = __shfl_up(igt, o), ue = __shfl_up(ieq, o); if (F.lane >= o) { igt += ug; ieq += ue; } }
        if (F.lane == 63) { red[F.wave] = igt; red[16 + F.wave] = ieq; }
        __syncthreads();
        int bgt = 0, beq = 0, totgt = 0;
#pragma unroll
        for (int w8 = 0; w8 < 8; ++w8) { const int xg = red[w8], xe = red[16 + w8]; if (w8 < F.wave) { bgt += xg; beq += xe; } totgt += xg; }
        const int need_eq = CAP - totgt;
        int gtb = bgt + igt - mgt, eqb = beq + ieq - meq;
        const int t0 = F.tid * 32;
#pragma unroll
        for (int q = 0; q < 2; ++q) {
            int sl[16];
#pragma unroll
            for (int i = 0; i < 16; ++i) {
                const unsigned x = v[q * 16 + i]; const bool gt = x > prefix, eq = x == prefix; const bool sel = gt || (eq && eqb < need_eq);
                const int pos = gtb + (eqb < need_eq ? eqb : need_eq);
                sl[i] = sel ? pos : -1;
                if (sel) { rowlist[e * 4096 + b * CAP + pos] = b * T + t0 + q * 16 + i; selval[e * 4096 + b * CAP + pos] = __builtin_bit_cast(float, x); }
                gtb += gt ? 1 : 0; eqb += eq ? 1 : 0;
            }
#pragma unroll
            for (int i4 = 0; i4 < 4; ++i4) *(i32x4*)(slot + ((size_t)b * NE + e) * T + t0 + q * 16 + 4 * i4) = (i32x4){sl[4 * i4], sl[4 * i4 + 1], sl[4 * i4 + 2], sl[4 * i4 + 3]};
        }
        __syncthreads();
    }
}

__device__ __forceinline__ void ph_combine(Frame& F, const Args& A, int l) {
    const float* mod = (const float*)(A.ws + WS_MOD); bf16_t* X = (bf16_t*)(A.ws + WS_X); bf16_t* H = (bf16_t*)(A.ws + WS_H);
    const int* slot = (const int*)(A.ws + WS_SLOT); const unsigned char* ye = A.ws + WS_YE; const float* selval = (const float*)(A.ws + WS_SELVAL);
    for (int row = F.gw; row < NLAT; row += F.ngw) {
        const int b = row >> 14;
        const int sv = (F.lane < 16) ? slot[((size_t)b * NE + F.lane) * T + (row & (T - 1))] : -1;
        f32x4 acc[4];
#pragma unroll
        for (int j = 0; j < 4; ++j) acc[j] = (f32x4){0.f, 0.f, 0.f, 0.f};
        for (int e = 0; e < NE; ++e) {
            const int s = __builtin_amdgcn_readlane(sv, e);
            if (s >= 0) {
                const int yrow = e * 4096 + b * CAP + s;
                const unsigned char* yr = ye + (size_t)yrow * D + 4 * F.lane; const float wv = selval[yrow] * (1.f / 32);
#pragma unroll
                for (int j = 0; j < 4; ++j) { const int y = *(const int*)(yr + 256 * j); const f32x2 lo = __builtin_amdgcn_cvt_pk_f32_fp8(y, false), hi = __builtin_amdgcn_cvt_pk_f32_fp8(y, true);
                    acc[j].x += wv * lo.x; acc[j].y += wv * lo.y; acc[j].z += wv * hi.x; acc[j].w += wv * hi.y; }
            }
        }
        const float* g2 = mod + (l * 3 + b) * 6 * D + 5 * D;
        f32x4 v[4];
#pragma unroll
        for (int j = 0; j < 4; ++j) { const int c = 4 * F.lane + 256 * j; const u32x2 t = *(const u32x2*)(X + (size_t)row * D + c);
            v[j] = (f32x4){bflo(t.x), bfhi(t.x), bflo(t.y), bfhi(t.y)} + *(const f32x4*)(g2 + c) * acc[j]; }
        if (l == 0) {
#pragma unroll
            for (int j = 0; j < 4; ++j) { u32x2 w; w.x = pk2(v[j].x, v[j].y); w.y = pk2(v[j].z, v[j].w); *(u32x2*)(X + (size_t)row * D + 4 * F.lane + 256 * j) = w; }
            normmod_row(v, A.in[P_NORMG] + (1 * 2 + 0) * D, mod + (1 * 3 + b) * 6 * D + 0 * D, mod + (1 * 3 + b) * 6 * D + 1 * D, H + (size_t)row * D, F.lane);
        } else {
            float s = 0.f;
#pragma unroll
            for (int j = 0; j < 4; ++j) s += (v[j].x * v[j].x + v[j].y * v[j].y) + (v[j].z * v[j].z + v[j].w * v[j].w);
            const float rstd = rsqrtf(wave_sum(s) * (1.f / D) + EPS);
#pragma unroll
            for (int j = 0; j < 4; ++j) { const int c = 4 * F.lane + 256 * j; *(f32x4*)(A.out + (size_t)row * D + c) = v[j] * rstd * *(const f32x4*)(A.in[P_FINALG] + c); }
        }
    }
}

constexpr int N_PHASES = 20;
__global__ void __launch_bounds__(NTHR, 2) fwd_kernel(Args A) {
    extern __shared__ __attribute__((aligned(16))) unsigned char lds_raw[];
    Frame F;
    F.lds = (LAS unsigned char*)lds_raw;
    F.tid = threadIdx.x; F.lane = F.tid & 63; F.wave = __builtin_amdgcn_readfirstlane(F.tid >> 6);
    F.G = gridDim.x; F.gw = blockIdx.x * NWAVES + F.wave; F.ngw = F.G * NWAVES;
    const int lo = A.ph_lo, hi = A.ph_hi;
#ifdef ONLY_PH
#define IN(k) ((k) == ONLY_PH && lo <= (k) && (k) < hi)
#else
#define IN(k) (lo <= (k) && (k) < hi)
#endif
#if MK_MULTI
#define SEAM(k) do { } while (0)
#else
    cg::grid_group grid = cg::this_grid();
    volatile LAS unsigned* bst = (volatile LAS unsigned*)(F.lds + LDS_BYTES - 64);
    if (F.tid < 16) bst[F.tid] = 0u;
    __syncthreads();
    XcdBarrier xbar = xcd_barrier_post((unsigned*)(A.ws + WS_CTL) + 4096, bst);
    if (lo < 0) { __threadfence(); grid.sync(); }
#define SEAM(k) do { if (IN(k) && IN((k) + 1)) xcd_barrier(xbar); } while (0)
#endif
    const int c = blockIdx.x;
    #define H ((bf16_t*)(A.ws + WS_H))
#define X ((bf16_t*)(A.ws + WS_X))
#define mod ((const float*)(A.ws + WS_MOD))
#define MOE_GU(l) { eng::Gemm g{(const char*)(A.ws + WS_H), (const char*)(A.ws + WS_W8 + (size_t)(l) * W8_LAYER), (const int*)(A.ws + WS_ROWLIST), (size_t)4096 * D, D / 2, 16, 16, NE}; \
        eng::EpiSwiglu E{0x79797979, 0x7F7F7F7F, A.ws + WS_HID}; eng::gemm_phase(F.lds, g, E, F.G, c); }
#define MOE_DN(l) { eng::Gemm g{(const char*)(A.ws + WS_HID), (const char*)(A.ws + WS_W8 + (size_t)(l) * W8_LAYER + W8_WD), nullptr, (size_t)D * DEXP, DEXP / 2, 16, 4, NE}; \
        eng::EpiDown E{0x79797979, 0x7D7D7D7D, A.ws + WS_YE}; eng::gemm_phase(F.lds, g, E, F.G, c); }

    if (IN(0)) ph_prep(F, A);
    SEAM(0);
    if (IN(1)) ph_norm0(F, A);
    SEAM(1);
    if (IN(2)) { eng::Gemm g{(const char*)H, (const char*)(A.ws + WS_WIN0T), nullptr, 0, D, NROW / 256, NIN0P / 256, 1};
        eng::EpiProj0 E{(bf16_t*)(A.ws + WS_QK), A.ws + WS_VTP, (bf16_t*)(A.ws + WS_R), (float*)(A.ws + WS_AFB)}; eng::gemm_phase(F.lds, g, E, F.G, c);
        if (6 * F.G + c >= (NROW / 256) * (NIN0P / 256)) convert_expert_fixed<3>(A, F.lds, F.tid, F.wave, F.lane); }
    SEAM(2);
    if (IN(3)) ph_gla_prep(F, A);
    SEAM(3);
    if (IN(4)) ph_gla_main(F, A);
    SEAM(4);
    if (IN(5)) ph_gla_finish(F, A);
    SEAM(5);
    if (IN(6)) { eng::Gemm g{(const char*)H, (const char*)(A.ws + WS_WOUT0T), nullptr, 0, D, NLAT / 256, D / 256, 1};
        eng::EpiResidT<true> E{A.in[P_X], X, mod + (0 * 3) * 6 * D + 2 * D}; eng::gemm_phase(F.lds, g, E, F.G, c); }
    SEAM(6);
    if (IN(7)) ph_norm2_router(F, A, 0);
    SEAM(7);
    if (IN(8)) ph_topk(F, A);
    SEAM(8);
    if (IN(9)) MOE_GU(0)
    SEAM(9);
    if (IN(10)) MOE_DN(0)
    SEAM(10);
    if (IN(11)) ph_combine(F, A, 0);
    SEAM(11);
    if (IN(12)) { eng::Gemm g{(const char*)H, (const char*)(A.ws + WS_WCINT), nullptr, 0, D, NLAT / 256, NCIN / 256, 1};
        g.trip = 1;
        eng::EpiConvFused E{A.ws + WS_CDUMP + (size_t)c * 131072, (bf16_t*)(A.ws + WS_H2), A.in[P_CK]}; eng::gemm_phase(F.lds, g, E, F.G, c); }
    SEAM(12);
    if (IN(14)) { eng::Gemm g{(const char*)(A.ws + WS_H2), (const char*)(A.ws + WS_WCOUTT), nullptr, 0, D, NLAT / 256, D / 256, 1};
        eng::EpiResidT<false> E{X, X, mod + (1 * 3) * 6 * D + 2 * D}; eng::gemm_phase(F.lds, g, E, F.G, c); }
    SEAM(14);
    if (IN(15)) ph_norm2_router(F, A, 1);
    SEAM(15);
    if (IN(16)) ph_topk(F, A);
    SEAM(16);
    if (IN(17)) MOE_GU(1)
    SEAM(17);
    if (IN(18)) MOE_DN(1)
    SEAM(18);
    if (IN(19)) ph_combine(F, A, 1);
#undef IN
#undef SEAM
#undef H
#undef X
#undef mod
#undef MOE_GU
#undef MOE_DN
}

extern "C" void kernel_launch(void* const* d_in, const int* in_sizes, int n_in, void* d_out, int out_size, void* d_ws, size_t ws_size, hipStream_t stream) {
    static int grid = 0;
    if (grid == 0) {
        if (n_in != 20 || in_sizes[0] != NLAT * D || out_size != NLAT * D || ws_size < WS_END) {
            fprintf(stderr, "kernel_launch: unexpected problem: n_in %d in0 %d out %d ws %zu (need %zu)\n", n_in, n_in > 0 ? in_sizes[0] : -1, out_size, ws_size, (size_t)WS_END); grid = -1; return; }
        int dev = 0, cus = 0, per_cu = 0;
        if (hipGetDevice(&dev) != hipSuccess || hipDeviceGetAttribute(&cus, hipDeviceAttributeMultiprocessorCount, dev) != hipSuccess) { grid = -1; return; }
        if (hipFuncSetAttribute((const void*)fwd_kernel, hipFuncAttributeMaxDynamicSharedMemorySize, LDS_BYTES) != hipSuccess) { fprintf(stderr, "kernel_launch: hipFuncSetAttribute failed\n"); grid = -1; return; }
        if (hipOccupancyMaxActiveBlocksPerMultiprocessor(&per_cu, (const void*)fwd_kernel, NTHR, LDS_BYTES) != hipSuccess || per_cu < 1) { fprintf(stderr, "kernel_launch: occupancy query says %d\n", per_cu); per_cu = 1; }
        (void)hipGetLastError();
        if (cus != 256) { fprintf(stderr, "kernel_launch: built for a 256-CU device (one workgroup per CU); found %d CUs\n", cus); grid = -1; return; }
        grid = cus;
    }
    if (grid < 0) return;
    Args a{};
    for (int i = 0; i < 20; ++i) a.in[i] = (const float*)d_in[i];
    a.out = (float*)d_out; a.ws = (unsigned char*)d_ws;
#if MK_MULTI
    for (int p = 0; p < N_PHASES; ++p) {
        a.ph_lo = p; a.ph_hi = p + 1;
        hipLaunchKernelGGL(fwd_kernel, dim3(grid), dim3(NTHR), LDS_BYTES, stream, a);
    }
#else
    if (hipMemsetAsync((char*)d_ws + WS_CTL, 0, 64 * 1024, stream) != hipSuccess) { fprintf(stderr, "kernel_launch: memset failed\n"); return; }
    a.ph_lo = 0; a.ph_hi = N_PHASES;
    void* kargs[] = {&a};
    hipError_t e = hipLaunchCooperativeKernel((const void*)fwd_kernel, dim3(grid), dim3(NTHR), kargs, LDS_BYTES, stream);
    if (e != hipSuccess) fprintf(stderr, "kernel_launch: cooperative launch failed: %s (grid %d)\n", hipGetErrorString(e), grid);
#endif
}
```

```cpp
#include <hip/hip_runtime.h>
#include <hip/hip_cooperative_groups.h>
#include <cstdio>
#include <cstdint>
namespace cg = cooperative_groups;

#ifndef MK_MULTI
#define MK_MULTI 0
#endif

#define LAS __attribute__((address_space(3)))
#define GAS __attribute__((address_space(1)))
typedef unsigned short bf16_t;
typedef short bf16x8 __attribute__((ext_vector_type(8)));
typedef float f32x4 __attribute__((ext_vector_type(4)));
typedef float f32x2 __attribute__((ext_vector_type(2)));
typedef unsigned u32x4 __attribute__((ext_vector_type(4)));
typedef unsigned u32x2 __attribute__((ext_vector_type(2)));
typedef int i32x4 __attribute__((ext_vector_type(4)));
typedef int i32x8 __attribute__((ext_vector_type(8)));

constexpr int D = 1024, NB = 2, T = 16384, NLAT = NB * T, CTXL = 256, NCTX = NB * CTXL, NROW = NLAT + NCTX;
constexpr int NE = 16, CAP = 2048, DEXP = 2048;
constexpr int HEADS = 4, HK = 128, HV = 256, DK = 512, DV = 1024, RANK = 16;
constexpr int NIN0 = 3104, NIN0P = 3328;
constexpr int NCIN = 3072;
constexpr float EPS = 1e-6f;
constexpr int NWAVES = 8, NTHR = 512;

constexpr size_t MiB = 1u << 20;
constexpr size_t WS_CTL = 0;
constexpr size_t WS_MOD = 1 * MiB;
constexpr size_t WS_WIN0T = 2 * MiB;
constexpr size_t WS_WOUT0T = 9 * MiB;
constexpr size_t WS_WCINT = 11 * MiB;
constexpr size_t WS_WCOUTT = 17 * MiB;
constexpr size_t WS_AFF = 19 * MiB;
constexpr size_t WS_SLOT = 21 * MiB;
constexpr size_t WS_ROWLIST = 23 * MiB;
constexpr size_t WS_SELVAL = 23 * MiB + 512 * 1024;
constexpr size_t WS_AFB = 24 * MiB;
constexpr size_t WS_W8 = 32 * MiB;
constexpr size_t W8_LAYER = 96 * MiB, W8_WD = 64 * MiB;
constexpr size_t WS_X = 224 * MiB;
constexpr size_t WS_H = 354 * MiB;
constexpr size_t WS_ARENA = 420 * MiB;
constexpr size_t WS_QK = WS_ARENA;
constexpr size_t WS_V = WS_ARENA + 65 * MiB;
constexpr size_t WS_R = WS_ARENA + 130 * MiB;
constexpr size_t WS_QP = WS_ARENA + 195 * MiB;
constexpr size_t WS_KP = WS_ARENA + 260 * MiB;
constexpr size_t WS_KTP = WS_ARENA + 325 * MiB;
constexpr size_t WS_VTP = WS_ARENA + 390 * MiB;
constexpr size_t WS_OI = WS_ARENA + 455 * MiB;
constexpr size_t WS_GAM = WS_ARENA + 519 * MiB;
constexpr size_t WS_OF = WS_QK;
constexpr size_t WS_OB = WS_V;
constexpr size_t WS_HID = WS_ARENA;
constexpr size_t WS_YE = WS_ARENA + 128 * MiB;
constexpr size_t WS_H2 = WS_ARENA;
constexpr size_t WS_CDUMP = WS_ARENA + 64 * MiB;
constexpr size_t WS_END = WS_ARENA + 522 * MiB;
static_assert(WS_R - WS_QK == 130 * MiB, "EpiProj0 strides");
constexpr size_t BLOB = 16384;
constexpr int NCHUNK = NROW / 64;

__device__ __forceinline__ float wave_sum(float v) {
#pragma unroll
    for (int o = 1; o < 64; o <<= 1) v += __shfl_xor(v, o);
    return v;
}
__device__ __forceinline__ int wave_sum_i(int v) {
#pragma unroll
    for (int o = 1; o < 64; o <<= 1) v += __shfl_xor(v, o);
    return v;
}
__device__ __forceinline__ unsigned f2bf(float f) { unsigned u = __builtin_bit_cast(unsigned, f); return (u + 0x7fffu + ((u >> 16) & 1u)) >> 16; }
typedef __bf16 bf16x2_t __attribute__((ext_vector_type(2)));
__device__ __forceinline__ unsigned pk2(float lo, float hi) { const f32x2 v = {lo, hi}; return __builtin_bit_cast(unsigned, __builtin_convertvector(v, bf16x2_t)); }
__device__ __forceinline__ float bflo(unsigned u) { return __builtin_bit_cast(float, u << 16); }
__device__ __forceinline__ float bfhi(unsigned u) { return __builtin_bit_cast(float, u & 0xffff0000u); }
__device__ __forceinline__ float silu_f(float x) { return x / (1.f + __expf(-x)); }
#define LDS_WAIT() asm volatile("s_waitcnt lgkmcnt(0)" ::: "memory")


#define XB_TMO      128
#define XB_XCNT(j)  (256  + 64 * (j))
#define XB_XSUB(j)  (1280 + 64 * (j))
#define XB_XGEN(j)  (2304 + 64 * (j))
#define XB_TOP      3328
#define XB_TOPGEN   3392
#define XCD_BAR_WORDS 3456
#define XB_SPIN_CAP (1u << 22)
__device__ __forceinline__ unsigned xb_ld(unsigned* p)              { return __hip_atomic_load(p, __ATOMIC_RELAXED, __HIP_MEMORY_SCOPE_AGENT); }
__device__ __forceinline__ unsigned xb_add(unsigned* p, unsigned v) { return __hip_atomic_fetch_add(p, v, __ATOMIC_RELAXED, __HIP_MEMORY_SCOPE_AGENT); }
__device__ __forceinline__ unsigned xb_xcc_id() { return (unsigned)__builtin_amdgcn_s_getreg((3 << 11) | 20) & 0xFu; }
#define XB_SPIN(cond, bar) do { unsigned _sp = 0; while (cond) { \
    if ((++_sp & 255u) == 0u) { if (xb_ld(&(bar)[XB_TMO])) break; if (_sp > XB_SPIN_CAP) { atomicAdd(&(bar)[XB_TMO], 1u); break; } } } } while (0)
struct XcdBarrier { unsigned* bar; unsigned x; volatile LAS unsigned* st; };
__device__ __forceinline__ XcdBarrier xcd_barrier_post(unsigned* bar, volatile LAS unsigned* st) {
    XcdBarrier b; b.bar = bar; b.x = xb_xcc_id(); b.st = st;
    if (threadIdx.x == 0) (void)xb_add(&bar[XB_XCNT(b.x)], 1u);
    return b;
}
__device__ __forceinline__ void xcd_barrier_complete(unsigned* bar, unsigned x, unsigned& nloc, unsigned& nx) {
    const unsigned G = gridDim.x * gridDim.y * gridDim.z;
    unsigned sum, cnt, mine, sp = 0u;
    for (;;) {
        sum = 0u; cnt = 0u; mine = 0u;
#pragma unroll
        for (unsigned j = 0; j < 16; ++j) { const unsigned c = xb_ld(&bar[XB_XCNT(j)]); sum += c; cnt += (c > 0u) ? 1u : 0u; mine = (j == x) ? c : mine; }
        if (sum == G) break;
        __builtin_amdgcn_s_sleep(1);
        if ((++sp & 255u) == 0u) { if (xb_ld(&bar[XB_TMO])) break; if (sp > XB_SPIN_CAP) { atomicAdd(&bar[XB_TMO], 1u); break; } }
    }
    nloc = mine > 0u ? mine : 1u; nx = cnt > 0u ? cnt : 1u;
}
__device__ __forceinline__ void xcd_barrier(const XcdBarrier& b) {
    asm volatile("s_waitcnt vmcnt(0)" ::: "memory");
    __syncthreads();
    if (threadIdx.x == 0) {
        unsigned* bar = b.bar;
        __builtin_amdgcn_s_waitcnt(0);
        unsigned nloc = b.st[0], nx = b.st[1];
        if (nloc == 0u) { xcd_barrier_complete(bar, b.x, nloc, nx); b.st[0] = nloc; b.st[1] = nx; }
        const unsigned old = xb_add(&bar[XB_XSUB(b.x)], 1u);
        const unsigned gen = old / nloc;
        if (old + 1u == (gen + 1u) * nloc) {
            __builtin_amdgcn_fence(__ATOMIC_RELEASE, "agent");
            asm volatile("s_waitcnt vmcnt(0)" ::: "memory");
            const unsigned og = xb_add(&bar[XB_TOP], 1u);
            const unsigned tg = og / nx;
            __builtin_amdgcn_fence(__ATOMIC_ACQUIRE, "agent");
            if (og + 1u == (tg + 1u) * nx) xb_add(&bar[XB_TOPGEN], 1u);
            else XB_SPIN(xb_ld(&bar[XB_TOPGEN]) == tg, bar);
            xb_add(&bar[XB_XGEN(b.x)], 1u);
            asm volatile("s_waitcnt vmcnt(0)" ::: "memory");
        } else {
            __builtin_amdgcn_fence(__ATOMIC_ACQUIRE, "agent");
            XB_SPIN(xb_ld(&bar[XB_XGEN(b.x)]) == gen, bar);
            asm volatile("s_waitcnt vmcnt(0)" ::: "memory");
        }
    }
    __syncthreads();
}

namespace eng {
constexpr int BM = 256, BK = 64, HALF = 128, HTB = HALF * BK * 2, STAGE_BYTES = 8 * HTB, NXCD = 8, WGM = 8;
__host__ __device__ __forceinline__ int lds_byte(int r, int c) { const int st = (r >> 4) * 2 + (c >> 5), rr = r & 15, cc = c & 31, ob = rr * 64 + cc * 2; return st * 1024 + (ob ^ (((ob >> 9) & 1) << 5)); }
__host__ __device__ __forceinline__ void stage_rc(int b, int& R, int& C) { const int st = b / 1024, sb = b % 1024, swz = sb ^ (((sb >> 9) & 1) << 5); R = (st >> 1) * 16 + swz / 64; C = (st & 1) * 32 + (swz % 64) / 2; }
__host__ __device__ __forceinline__ int perm32(int rho) { const int n = rho >> 4, i = rho & 15; return 8 * (i >> 2) + 4 * n + (i & 3); }

struct Unit { int e, pm, pn; };
struct Gemm {
    const char* A;
    const char* Bt;
    const int* rows;
    size_t bstride;
    int K, nM, nN, ngroups;
    int rev = 0;
    int trip = 0;
};
__device__ __forceinline__ bool next_unit(const Gemm& g, int i, int G, int c, Unit& u) {
    if (g.trip) {
        const int per3 = g.nM * (g.nN / 3), j = i / 3, sec = i - 3 * j; int s = j * G + c; if (s >= per3) return false;
        { const int q = per3 / NXCD, r = per3 % NXCD, xcd = s % NXCD, off = s / NXCD; s = (xcd < r ? xcd * (q + 1) : r * (q + 1) + (xcd - r) * q) + off; }
        const int ncb = g.nN / 3; u.e = 0; u.pm = s / ncb; u.pn = 3 * (s % ncb) + sec; return true;
    }
    const int per = g.nM * g.nN;
    const long L = (long)i * G + c; if (L >= (long)per * g.ngroups) return false;
    u.e = (int)(L / per); int wgid = (int)(L % per);
    if (g.rev) u.e = g.ngroups - 1 - u.e;
    { const int nwg = per, q = nwg / NXCD, r = nwg % NXCD, xcd = wgid % NXCD, off = wgid / NXCD; wgid = (xcd < r ? xcd * (q + 1) : r * (q + 1) + (xcd - r) * q) + off; }
    const int nig = WGM * g.nN, gid = wgid / nig, fm = gid * WGM, gsz = (g.nM - fm) < WGM ? (g.nM - fm) : WGM;
    u.pm = fm + ((wgid % nig) % gsz); u.pn = (wgid % nig) / gsz; return true;
}
__device__ __forceinline__ bf16x8 lo8(const i32x8& f) { return __builtin_bit_cast(bf16x8, (i32x4)__builtin_shufflevector(f, f, 0, 1, 2, 3)); }
__device__ __forceinline__ bf16x8 hi8(const i32x8& f) { return __builtin_bit_cast(bf16x8, (i32x4)__builtin_shufflevector(f, f, 4, 5, 6, 7)); }
__device__ __forceinline__ i32x8 cat8(bf16x8 lo, bf16x8 hi) { const i32x4 a = __builtin_bit_cast(i32x4, lo), b = __builtin_bit_cast(i32x4, hi); return __builtin_shufflevector(a, b, 0, 1, 2, 3, 4, 5, 6, 7); }
__device__ __forceinline__ unsigned cvt_pk_bf16(float lo, float hi) { unsigned r; asm volatile("v_cvt_pk_bf16_f32 %0, %1, %2" : "=v"(r) : "v"(lo), "v"(hi)); return r; }

#ifndef ENG_SP2
#define ENG_SP2 true
#endif
#ifndef ENG_ALIGN
#define ENG_ALIGN true
#endif
template <class Epi, bool SP2 = ENG_SP2, bool ALIGN_EPI = ENG_ALIGN>
__device__ __forceinline__ void gemm_phase(LAS unsigned char* lds, const Gemm g, const Epi& E, int G, int c) {
    int tid = threadIdx.x; asm volatile("" : "+v"(tid));
    const int wid = __builtin_amdgcn_readfirstlane(tid >> 6), lane = tid & 63, wr = wid >> 2, wc = wid & 3, fr = lane & 15, fq = lane >> 4;
    const int K = g.K, nt = K / BK;
    int R0, C0; stage_rc(tid * 16, R0, C0);
    const int Rb0 = Epi::PERM ? ((R0 & ~31) + perm32(R0 & 31)) : R0;
    unsigned voffB[2]; voffB[0] = (unsigned)(Rb0 * K + C0) * 2u; voffB[1] = (unsigned)((Rb0 + 64) * K + C0) * 2u;
    constexpr bool SW = Epi::SWAPV;
    const char* const abase = SW ? g.Bt : g.A;
    const unsigned adelta = SW ? (unsigned)(size_t)(g.A - g.Bt) : 0u;
    const unsigned dltB = SW ? (unsigned)((R0 - Rb0) * K) * 2u : 0u;
    const size_t hstepB = (size_t)HALF * K * 2;
    const unsigned ldsw = (unsigned)wid * 1024u;
    const int aoff = lds_byte(wr * 64 + fr, fq * 8), boff = lds_byte(wc * 32 + fr, fq * 8);
#define PG8_SA(b, h) (((b) * 2 + (h)) * HTB)
#define PG8_SB(b, h) ((4 + (b) * 2 + (h)) * HTB)
#define PG8_GLDS(gp, bufoff, i) __builtin_amdgcn_global_load_lds((const unsigned*)(gp), (LAS unsigned*)(lds + (bufoff) + ldsw + (i) * 8192), 16, 0, 0)
#define PG8_STAGE_B(bufoff, bp, h, kt) do { const char* _p = (bp) + (size_t)(h) * hstepB + (size_t)(kt) * 128; asm volatile("" : "+s"(_p)); PG8_GLDS(_p + (voffB[0] + (SW ? dselB : 0u)), bufoff, 0); PG8_GLDS(_p + (voffB[1] + (SW ? dselB : 0u)), bufoff, 1); } while (0)
#define PG8_STAGE_A(bufoff, v0, v1, kt) do { const char* _p = abase + (size_t)(kt) * 128; asm volatile("" : "+s"(_p)); PG8_GLDS(_p + (v0), bufoff, 0); PG8_GLDS(_p + (v1), bufoff, 1); } while (0)
#define PG8_LDA(dst, b, h) do { _Pragma("unroll") for (int m = 0; m < 4; ++m) dst[m] = cat8(*(const LAS bf16x8*)(lds + PG8_SA(b, h) + aoff + m * 2048), *(const LAS bf16x8*)(lds + PG8_SA(b, h) + aoff + m * 2048 + 1024)); } while (0)
#define PG8_LDB(dst, b, h) do { _Pragma("unroll") for (int n = 0; n < 2; ++n) dst[n] = cat8(*(const LAS bf16x8*)(lds + PG8_SB(b, h) + boff + n * 2048), *(const LAS bf16x8*)(lds + PG8_SB(b, h) + boff + n * 2048 + 1024)); } while (0)
#define PG8_MMA(ai, bj, At, Bt) do { __builtin_amdgcn_s_setprio(1); \
        if constexpr (Epi::FP8) { _Pragma("unroll") for (int m = 0; m < 4; ++m) _Pragma("unroll") for (int n = 0; n < 2; ++n) \
            asm volatile("v_mfma_scale_f32_16x16x128_f8f6f4 %0, %1, %2, %0, %3, %4 op_sel_hi:[0,0,0]" : "+v"(acc[ai][bj][m][n]) : "v"(Bt[n]), "v"(At[m]), "v"(sc_w), "v"(sc_a)); } \
        else { _Pragma("unroll") for (int m = 0; m < 4; ++m) _Pragma("unroll") for (int n = 0; n < 2; ++n) { \
            acc[ai][bj][m][n] = __builtin_amdgcn_mfma_f32_16x16x32_bf16(lo8(Bt[n]), lo8(At[m]), acc[ai][bj][m][n], 0, 0, 0); \
            acc[ai][bj][m][n] = __builtin_amdgcn_mfma_f32_16x16x32_bf16(hi8(Bt[n]), hi8(At[m]), acc[ai][bj][m][n], 0, 0, 0); } } \
        __builtin_amdgcn_s_setprio(0); } while (0)
#define PG8_WAIT_V(n) asm volatile("s_waitcnt vmcnt(" #n ")" ::: "memory")
#define PG8_WAIT_L(n) asm volatile("s_waitcnt lgkmcnt(" #n ")" ::: "memory")
#define PG8_BAR __builtin_amdgcn_s_barrier()
#define PG8_SCHED __builtin_amdgcn_sched_barrier(0)
#define PG8_ROWOFF(u, h, i) ((SW && E.swapv(u)) ? (unsigned)(((u).pn * 256 + (h) * 128 + R0 + 64 * (i)) * K + C0) * 2u : adelta + ((unsigned)(((g.rows ? g.rows[((u).e * g.nM + (u).pm) * 256 + (h) * 128 + R0 + 64 * (i)] : (((u).e * g.nM + (u).pm) * 256 + (h) * 128 + R0 + 64 * (i))) * K + C0)) * 2u))
#define PG8_BPTR(u) ((SW && E.swapv(u)) ? g.A + (size_t)(u).pm * 2 * hstepB : g.Bt + (size_t)(u).e * g.bstride + (size_t)(u).pn * 2 * hstepB)
    Unit cur, nxt; int ui = 0;
    if (!next_unit(g, 0, G, c, cur)) return;
    f32x4 acc[2][2][4][2];
#pragma unroll
    for (int a = 0; a < 2; ++a)
#pragma unroll
        for (int b = 0; b < 2; ++b)
#pragma unroll
            for (int m = 0; m < 4; ++m)
#pragma unroll
                for (int n = 0; n < 2; ++n) acc[a][b][m][n] = (f32x4){0.f, 0.f, 0.f, 0.f};
    int sc_w = E.scale_w, sc_a = E.scale_a;
    asm volatile("" : "+v"(sc_w), "+v"(sc_a));
    i32x8 At[4], B0[2], B1[2];
    unsigned c00 = PG8_ROWOFF(cur, 0, 0), c01 = PG8_ROWOFF(cur, 0, 1), c10 = PG8_ROWOFF(cur, 1, 0), c11 = PG8_ROWOFF(cur, 1, 1);
    const char* cB = PG8_BPTR(cur);
    unsigned cD = (SW && E.swapv(cur)) ? dltB : 0u, dselB = cD;
    if constexpr (SP2) {
        PG8_STAGE_B(PG8_SB(0, 0), cB, 0, 0); PG8_STAGE_B(PG8_SB(0, 1), cB, 1, 0); PG8_STAGE_A(PG8_SA(0, 0), c00, c01, 0); PG8_STAGE_A(PG8_SA(0, 1), c10, c11, 0);
        if (wr == 1) PG8_BAR;
        PG8_WAIT_V(2); PG8_BAR;
        PG8_STAGE_B(PG8_SB(1, 0), cB, 0, 1); PG8_STAGE_A(PG8_SA(1, 0), c00, c01, 1); PG8_STAGE_B(PG8_SB(1, 1), cB, 1, 1);
        PG8_WAIT_V(6); PG8_BAR;
    } else {
        PG8_STAGE_B(PG8_SB(0, 0), cB, 0, 0); PG8_STAGE_A(PG8_SA(0, 0), c00, c01, 0); PG8_STAGE_B(PG8_SB(0, 1), cB, 1, 0); PG8_STAGE_A(PG8_SA(0, 1), c10, c11, 0);
        if (wr == 1) PG8_BAR;
        PG8_WAIT_V(4); PG8_BAR;
        PG8_STAGE_B(PG8_SB(1, 0), cB, 0, 1); PG8_STAGE_A(PG8_SA(1, 0), c00, c01, 1); PG8_STAGE_B(PG8_SB(1, 1), cB, 1, 1);
        PG8_WAIT_V(6); PG8_BAR;
    }
    for (;;) {
        const bool has_next = next_unit(g, ui + 1, G, c, nxt);
        unsigned n00 = c00, n01 = c01, n10 = c10, n11 = c11; const char* nB = cB; unsigned nD = cD;
        if (has_next) { n00 = PG8_ROWOFF(nxt, 0, 0); n01 = PG8_ROWOFF(nxt, 0, 1); n10 = PG8_ROWOFF(nxt, 1, 0); n11 = PG8_ROWOFF(nxt, 1, 1);
                        nB = PG8_BPTR(nxt); nD = (SW && E.swapv(nxt)) ? dltB : 0u; }
#pragma unroll 1
        for (int t = 0; t < nt; t += 2) {
            const bool last = (t == nt - 2);
            const int kt2 = last ? 0 : t + 2, kt3 = kt2 + 1;
            const char* b2 = last ? nB : cB; dselB = last ? nD : cD;
            const unsigned s00 = last ? n00 : c00, s01 = last ? n01 : c01, s10 = last ? n10 : c10, s11 = last ? n11 : c11;
            if constexpr (SP2) {
            PG8_LDB(B0, 0, 0); PG8_LDB(B1, 0, 1); PG8_SCHED; PG8_LDA(At, 0, 0); PG8_STAGE_A(PG8_SA(1, 1), c10, c11, t + 1);
            PG8_WAIT_V(8); PG8_WAIT_L(0); PG8_BAR; PG8_MMA(0, 0, At, B0); PG8_MMA(0, 1, At, B1); PG8_BAR; PG8_SCHED;
            PG8_LDA(At, 0, 1); PG8_STAGE_B(PG8_SB(0, 0), b2, 0, kt2); PG8_STAGE_B(PG8_SB(0, 1), b2, 1, kt2); PG8_STAGE_A(PG8_SA(0, 0), s00, s01, kt2);
            PG8_WAIT_V(8); PG8_WAIT_L(0); PG8_BAR; PG8_MMA(1, 0, At, B0); PG8_MMA(1, 1, At, B1); PG8_BAR; PG8_SCHED;
            PG8_LDB(B0, 1, 0); PG8_LDB(B1, 1, 1); PG8_SCHED; PG8_LDA(At, 1, 0); PG8_STAGE_A(PG8_SA(0, 1), s10, s11, kt2);
            PG8_WAIT_V(8); PG8_WAIT_L(0); PG8_BAR; PG8_MMA(0, 0, At, B0); PG8_MMA(0, 1, At, B1); PG8_BAR; PG8_SCHED;
            PG8_LDA(At, 1, 1); PG8_STAGE_B(PG8_SB(1, 0), b2, 0, kt3); PG8_STAGE_B(PG8_SB(1, 1), b2, 1, kt3); PG8_STAGE_A(PG8_SA(1, 0), s00, s01, kt3);
            PG8_WAIT_V(8); PG8_WAIT_L(0); PG8_BAR; PG8_MMA(1, 0, At, B0); PG8_MMA(1, 1, At, B1); PG8_BAR; PG8_SCHED;
            } else {
            PG8_LDB(B0, 0, 0); PG8_SCHED; PG8_LDA(At, 0, 0); PG8_STAGE_A(PG8_SA(1, 1), c10, c11, t + 1);
            PG8_WAIT_L(8); PG8_BAR; PG8_WAIT_L(0); PG8_MMA(0, 0, At, B0); PG8_BAR; PG8_SCHED;
            PG8_LDB(B1, 0, 1); PG8_STAGE_B(PG8_SB(0, 0), b2, 0, kt2);
            PG8_BAR; PG8_WAIT_L(0); PG8_MMA(0, 1, At, B1); PG8_BAR;
            PG8_LDA(At, 0, 1); PG8_STAGE_A(PG8_SA(0, 0), s00, s01, kt2);
            PG8_BAR; PG8_WAIT_L(0); PG8_MMA(1, 0, At, B0); PG8_BAR; PG8_SCHED;
            PG8_STAGE_B(PG8_SB(0, 1), b2, 1, kt2);
            PG8_WAIT_V(6); PG8_BAR; PG8_MMA(1, 1, At, B1); PG8_BAR;
            PG8_LDB(B0, 1, 0); PG8_SCHED; PG8_LDA(At, 1, 0); PG8_STAGE_A(PG8_SA(0, 1), s10, s11, kt2);
            PG8_WAIT_L(8); PG8_BAR; PG8_WAIT_L(0); PG8_MMA(0, 0, At, B0); PG8_BAR; PG8_SCHED;
            PG8_LDB(B1, 1, 1); PG8_STAGE_B(PG8_SB(1, 0), b2, 0, kt3);
            PG8_BAR; PG8_WAIT_L(0); PG8_MMA(0, 1, At, B1); PG8_BAR;
            PG8_LDA(At, 1, 1); PG8_STAGE_A(PG8_SA(1, 0), s00, s01, kt3);
            PG8_BAR; PG8_WAIT_L(0); PG8_MMA(1, 0, At, B0); PG8_BAR; PG8_SCHED;
            PG8_STAGE_B(PG8_SB(1, 1), b2, 1, kt3);
            PG8_WAIT_V(6); PG8_BAR; PG8_MMA(1, 1, At, B1); PG8_BAR;
            }
        }
        if constexpr (Epi::FP8) {
            _Pragma("unroll") for (int a = 0; a < 2; ++a)
                asm volatile("s_nop 15\n\ts_nop 15" : "+v"(acc[a][0][0][0]), "+v"(acc[a][0][0][1]), "+v"(acc[a][0][1][0]), "+v"(acc[a][0][1][1]), "+v"(acc[a][0][2][0]), "+v"(acc[a][0][2][1]), "+v"(acc[a][0][3][0]), "+v"(acc[a][0][3][1]),
                             "+v"(acc[a][1][0][0]), "+v"(acc[a][1][0][1]), "+v"(acc[a][1][1][0]), "+v"(acc[a][1][1][1]), "+v"(acc[a][1][2][0]), "+v"(acc[a][1][2][1]), "+v"(acc[a][1][3][0]), "+v"(acc[a][1][3][1]));
        }
        if constexpr (ALIGN_EPI) { if (wr == 0) PG8_BAR; }
        E(acc, cur, wr, wc, fr, fq);
        if (!has_next) break;
#pragma unroll
        for (int a = 0; a < 2; ++a)
#pragma unroll
            for (int b = 0; b < 2; ++b)
#pragma unroll
                for (int m = 0; m < 4; ++m)
#pragma unroll
                    for (int n = 0; n < 2; ++n) acc[a][b][m][n] = (f32x4){0.f, 0.f, 0.f, 0.f};
        cur = nxt; cB = nB; cD = nD; c00 = n00; c01 = n01; c10 = n10; c11 = n11; ++ui;
        if constexpr (ALIGN_EPI) { if (wr == 1) PG8_BAR; }
    }
    PG8_WAIT_V(0);
    if constexpr (!ALIGN_EPI) { if (wr == 0) PG8_BAR; }
    PG8_BAR;
#undef PG8_SA
#undef PG8_SB
#undef PG8_GLDS
#undef PG8_STAGE_A
#undef PG8_STAGE_B
#undef PG8_LDA
#undef PG8_LDB
#undef PG8_MMA
#undef PG8_WAIT_V
#undef PG8_WAIT_L
#undef PG8_BAR
#undef PG8_SCHED
#undef PG8_ROWOFF
#undef PG8_BPTR
}

struct EpiProj0 {
    static constexpr bool FP8 = false; static constexpr int scale_w = 0, scale_a = 0;
    static constexpr bool PERM = true; static constexpr bool SWAPV = true;
    __device__ __forceinline__ bool swapv(const Unit& u) const { return u.pn >= 4 && u.pn < 8; }
    bf16_t* qk; unsigned char* vtp; bf16_t* r; float* afb;
    __device__ __forceinline__ void operator()(const f32x4 (&acc)[2][2][4][2], const Unit& u, int wr, int wc, int fr, int fq) const {
        const int row0 = u.pm * BM + wr * 64 + fr;
        if (swapv(u)) {
            unsigned char* p0 = vtp + (size_t)(4 * u.pm + (wc >> 1)) * 131072 + (size_t)((((16 * (u.pn - 4) + 4 * wr) * 2 + (wc & 1)) * 64 + fr + 16 * fq) * 16);
#pragma unroll
            for (int ai = 0; ai < 2; ++ai)
#pragma unroll
                for (int m = 0; m < 4; ++m)
#pragma unroll
                    for (int bj = 0; bj < 2; ++bj) { const f32x4 v0 = acc[ai][bj][m][0], v1 = acc[ai][bj][m][1];
                        u32x4 w; w.x = cvt_pk_bf16(v0[0], v0[1]); w.y = cvt_pk_bf16(v0[2], v0[3]); w.z = cvt_pk_bf16(v1[0], v1[1]); w.w = cvt_pk_bf16(v1[2], v1[3]);
                        *(u32x4*)(p0 + (size_t)bj * 2 * 131072 + (size_t)(8 * ai + m) * 2048) = w; }
        } else if (u.pn < 12) {
            const float sc = (u.pn < 2) ? 0.08838834764831845f : 1.f;
            bf16_t* base = qk + (size_t)(u.pn >> 3) * (size_t)(130 * MiB / 2);
            const int col0 = (u.pn & 3) * BM + wc * 32 + 8 * fq;
#pragma unroll
            for (int ai = 0; ai < 2; ++ai)
#pragma unroll
                for (int m = 0; m < 4; ++m) { bf16_t* rowp = base + (size_t)(row0 + ai * HALF + m * 16) * D + col0;
#pragma unroll
                    for (int bj = 0; bj < 2; ++bj) { const f32x4 v0 = acc[ai][bj][m][0] * sc, v1 = acc[ai][bj][m][1] * sc;
                        u32x4 w; w.x = cvt_pk_bf16(v0[0], v0[1]); w.y = cvt_pk_bf16(v0[2], v0[3]); w.z = cvt_pk_bf16(v1[0], v1[1]); w.w = cvt_pk_bf16(v1[2], v1[3]);
                        *(u32x4*)(rowp + bj * HALF) = w; } }
        } else if (wc == 0) {
#pragma unroll
            for (int ai = 0; ai < 2; ++ai)
#pragma unroll
                for (int m = 0; m < 4; ++m) { float* rowp = afb + (size_t)(row0 + ai * HALF + m * 16) * 32 + 8 * fq;
                    *(f32x4*)(rowp) = acc[ai][0][m][0]; *(f32x4*)(rowp + 4) = acc[ai][0][m][1]; }
        }
    }
};
template <bool SRC_F32>
struct EpiResidT {
    static constexpr bool FP8 = false; static constexpr int scale_w = 0, scale_a = 0;
    static constexpr bool PERM = true; static constexpr bool SWAPV = false; __device__ __forceinline__ bool swapv(const Unit&) const { return false; }
    const void* src; bf16_t* dst; const float* gate;
    __device__ __forceinline__ void operator()(const f32x4 (&acc)[2][2][4][2], const Unit& u, int wr, int wc, int fr, int fq) const {
        const int row0 = u.pm * BM + wr * 64 + fr, col0 = u.pn * BM + wc * 32 + 8 * fq;
        const int b = (u.pm * BM) >> 14;
        f32x4 gv[2][2];
#pragma unroll
        for (int bj = 0; bj < 2; ++bj)
#pragma unroll
            for (int n = 0; n < 2; ++n) gv[bj][n] = *(const f32x4*)(gate + (size_t)b * 6 * D + col0 + bj * HALF + n * 4);
#pragma unroll
        for (int ai = 0; ai < 2; ++ai) {
            f32x4 sv[4][2][2];
#pragma unroll
            for (int m = 0; m < 4; ++m)
#pragma unroll
                for (int bj = 0; bj < 2; ++bj) { const size_t off = (size_t)(row0 + ai * HALF + m * 16) * D + col0 + bj * HALF;
                    if constexpr (SRC_F32) { sv[m][bj][0] = *(const f32x4*)((const float*)src + off); sv[m][bj][1] = *(const f32x4*)((const float*)src + off + 4); }
                    else { const u32x4 t = *(const u32x4*)((const bf16_t*)src + off);
                        sv[m][bj][0] = (f32x4){bflo(t.x), bfhi(t.x), bflo(t.y), bfhi(t.y)}; sv[m][bj][1] = (f32x4){bflo(t.z), bfhi(t.z), bflo(t.w), bfhi(t.w)}; } }
            asm volatile("" ::: "memory");
#pragma unroll
            for (int m = 0; m < 4; ++m)
#pragma unroll
                for (int bj = 0; bj < 2; ++bj) { const f32x4 y0 = sv[m][bj][0] + gv[bj][0] * acc[ai][bj][m][0], y1 = sv[m][bj][1] + gv[bj][1] * acc[ai][bj][m][1];
                    u32x4 w; w.x = cvt_pk_bf16(y0[0], y0[1]); w.y = cvt_pk_bf16(y0[2], y0[3]); w.z = cvt_pk_bf16(y1[0], y1[1]); w.w = cvt_pk_bf16(y1[2], y1[3]);
                    *(u32x4*)(dst + (size_t)(row0 + ai * HALF + m * 16) * D + col0 + bj * HALF) = w; }
        }
    }
};
struct EpiBf16Plain {
    static constexpr bool FP8 = false; static constexpr int scale_w = 0, scale_a = 0;
    static constexpr bool PERM = true; static constexpr bool SWAPV = false; __device__ __forceinline__ bool swapv(const Unit&) const { return false; }
    bf16_t* O; int ldc;
    __device__ __forceinline__ void operator()(const f32x4 (&acc)[2][2][4][2], const Unit& u, int wr, int wc, int fr, int fq) const {
        const int row0 = u.pm * BM + wr * 64 + fr, col0 = u.pn * BM + wc * 32 + 8 * fq;
#pragma unroll
        for (int ai = 0; ai < 2; ++ai)
#pragma unroll
            for (int m = 0; m < 4; ++m) { bf16_t* rowp = O + (size_t)(row0 + ai * HALF + m * 16) * ldc + col0;
#pragma unroll
                for (int bj = 0; bj < 2; ++bj) { const f32x4 v0 = acc[ai][bj][m][0], v1 = acc[ai][bj][m][1];
                    u32x4 w; w.x = cvt_pk_bf16(v0[0], v0[1]); w.y = cvt_pk_bf16(v0[2], v0[3]); w.z = cvt_pk_bf16(v1[0], v1[1]); w.w = cvt_pk_bf16(v1[2], v1[3]);
                    *(u32x4*)(rowp + bj * HALF) = w; } }
    }
};
__device__ __forceinline__ float dpp_shr1(float oldv, float x) { return __builtin_bit_cast(float, __builtin_amdgcn_update_dpp(__builtin_bit_cast(int, oldv), __builtin_bit_cast(int, x), 0x111, 0xF, 0xF, false)); }
__device__ __forceinline__ float dpp_shl1(float oldv, float x) { return __builtin_bit_cast(float, __builtin_amdgcn_update_dpp(__builtin_bit_cast(int, oldv), __builtin_bit_cast(int, x), 0x101, 0xF, 0xF, false)); }
__device__ __forceinline__ float dpp_ror1(float x) { return __builtin_bit_cast(float, __builtin_amdgcn_update_dpp(0, __builtin_bit_cast(int, x), 0x121, 0xF, 0xF, false)); }
__device__ __forceinline__ float dpp_rol1(float x) { return __builtin_bit_cast(float, __builtin_amdgcn_update_dpp(0, __builtin_bit_cast(int, x), 0x12F, 0xF, 0xF, false)); }
struct EpiConvFused {
    static constexpr bool FP8 = false; static constexpr int scale_w = 0, scale_a = 0;
    static constexpr bool PERM = true; static constexpr bool SWAPV = false; __device__ __forceinline__ bool swapv(const Unit&) const { return false; }
    unsigned char* dump;
    bf16_t* O; const float* ck;
    __device__ __forceinline__ void operator()(const f32x4 (&acc)[2][2][4][2], const Unit& u, int wr, int wc, int fr, int fq) const {
        const int cb = u.pn / 3, sec = u.pn - 3 * cb, tid = threadIdx.x;
        if (sec < 2) {
            const int cc = 256 * cb + 128 * sec + wc * 32 + 8 * fq;
            unsigned char* dp = dump + (size_t)sec * 65536 + tid * 16;
#pragma unroll
            for (int n = 0; n < 2; ++n) {
                const f32x4 k0 = *(const f32x4*)(ck + cc + 4 * n), k1 = *(const f32x4*)(ck + D + cc + 4 * n), k2 = *(const f32x4*)(ck + 2 * D + cc + 4 * n);
#pragma unroll
                for (int ai = 0; ai < 2; ++ai) {
                    f32x4 y[4];
#pragma unroll
                    for (int j = 0; j < 4; ++j) {
                        float x[4];
#pragma unroll
                        for (int m = 0; m < 4; ++m) x[m] = acc[ai][0][m][n][j] * acc[ai][1][m][n][j];
#pragma unroll
                        for (int m = 0; m < 4; ++m) {
                            const float up = dpp_shr1(m > 0 ? dpp_ror1(x[m - 1]) : 0.f, x[m]);
                            const float dn = dpp_shl1(m < 3 ? dpp_rol1(x[m + 1]) : 0.f, x[m]);
                            y[m][j] = k0[j] * up + k1[j] * x[m] + k2[j] * dn; }
                    }
#pragma unroll
                    for (int m = 0; m < 4; ++m) { u32x2 w; w.x = cvt_pk_bf16(y[m][0], y[m][1]); w.y = cvt_pk_bf16(y[m][2], y[m][3]);
                        *(u32x2*)(dp + (ai * 4 + m) * 8192 + n * 8) = w; }
                }
            }
        } else {
            const int row0 = u.pm * BM + wr * 64 + fr, col0 = 256 * cb + wc * 32 + 8 * fq;
            const unsigned loff = (unsigned)tid * 16u;
#pragma unroll
            for (int ai = 0; ai < 2; ++ai)
#pragma unroll
                for (int m = 0; m < 4; ++m) {
                    bf16_t* rowp = O + (size_t)(row0 + ai * HALF + m * 16) * D + col0;
                    const unsigned char* sb = dump + (ai * 4 + m) * 8192; asm volatile("" : "+s"(sb));
                    const u32x4 q0 = *(const u32x4*)(sb + loff), q1 = *(const u32x4*)(sb + 65536 + loff);
#pragma unroll
                    for (int bj = 0; bj < 2; ++bj) { const f32x4 v0 = acc[ai][bj][m][0], v1 = acc[ai][bj][m][1]; const u32x4 q = bj ? q1 : q0;
                        u32x4 w; w.x = cvt_pk_bf16(v0[0] * bflo(q.x), v0[1] * bfhi(q.x)); w.y = cvt_pk_bf16(v0[2] * bflo(q.y), v0[3] * bfhi(q.y));
                        w.z = cvt_pk_bf16(v1[0] * bflo(q.z), v1[1] * bfhi(q.z)); w.w = cvt_pk_bf16(v1[2] * bflo(q.w), v1[3] * bfhi(q.w));
                        *(u32x4*)(rowp + bj * HALF) = w; }
                    asm volatile("" ::: "memory");
                }
        }
    }
};
struct EpiSwiglu {
    static constexpr bool FP8 = true; int scale_w, scale_a;
    static constexpr bool PERM = true; static constexpr bool SWAPV = false; __device__ __forceinline__ bool swapv(const Unit&) const { return false; }
    unsigned char* hid;
    __device__ __forceinline__ void operator()(const f32x4 (&acc)[2][2][4][2], const Unit& u, int wr, int wc, int fr, int fq) const {
        const int row0 = u.e * 4096 + u.pm * BM + wr * 64 + fr, col0 = u.pn * HALF + wc * 32 + 8 * fq;
#pragma unroll
        for (int ai = 0; ai < 2; ++ai)
#pragma unroll
            for (int m = 0; m < 4; ++m) { unsigned char* rowp = hid + (size_t)(row0 + ai * HALF + m * 16) * DEXP + col0;
                float h[8];
#pragma unroll
                for (int n = 0; n < 2; ++n)
#pragma unroll
                    for (int j2 = 0; j2 < 2; ++j2) {
                        const f32x2 gt = {acc[ai][0][m][n][2 * j2], acc[ai][0][m][n][2 * j2 + 1]}, up = {acc[ai][1][m][n][2 * j2], acc[ai][1][m][n][2 * j2 + 1]};
                        const f32x2 a = gt * (f32x2){-1.4426950408889634f, -1.4426950408889634f};
                        f32x2 t; t.x = __builtin_amdgcn_exp2f(a.x); t.y = __builtin_amdgcn_exp2f(a.y);
                        const f32x2 d4 = t * (f32x2){0.25f, 0.25f} + (f32x2){0.25f, 0.25f};
                        f32x2 r4; r4.x = __builtin_amdgcn_rcpf(d4.x); r4.y = __builtin_amdgcn_rcpf(d4.y);
                        const f32x2 hv = (gt * up) * r4;
                        h[n * 4 + 2 * j2] = __builtin_amdgcn_fmed3f(hv.x, -448.f, 448.f); h[n * 4 + 2 * j2 + 1] = __builtin_amdgcn_fmed3f(hv.y, -448.f, 448.f); }
                int w0 = __builtin_amdgcn_cvt_pk_fp8_f32(h[0], h[1], 0, false); w0 = __builtin_amdgcn_cvt_pk_fp8_f32(h[2], h[3], w0, true);
                int w1 = __builtin_amdgcn_cvt_pk_fp8_f32(h[4], h[5], 0, false); w1 = __builtin_amdgcn_cvt_pk_fp8_f32(h[6], h[7], w1, true);
                u32x2 w; w.x = (unsigned)w0; w.y = (unsigned)w1;
                *(u32x2*)(rowp) = w; }
    }
};
struct EpiDown {
    static constexpr bool FP8 = true; int scale_w, scale_a;
    static constexpr bool PERM = true; static constexpr bool SWAPV = false; __device__ __forceinline__ bool swapv(const Unit&) const { return false; }
    unsigned char* ye;
    __device__ __forceinline__ void operator()(const f32x4 (&acc)[2][2][4][2], const Unit& u, int wr, int wc, int fr, int fq) const {
        const int row0 = u.e * 4096 + u.pm * BM + wr * 64 + fr, col0 = u.pn * BM + wc * 32 + 8 * fq;
#pragma unroll
        for (int ai = 0; ai < 2; ++ai)
#pragma unroll
            for (int m = 0; m < 4; ++m) { const int row = row0 + ai * HALF + m * 16; unsigned char* rowp = ye + (size_t)row * D + col0;
#pragma unroll
                for (int bj = 0; bj < 2; ++bj) { f32x4 v0 = acc[ai][bj][m][0] * 32.f, v1 = acc[ai][bj][m][1] * 32.f;
#pragma unroll
                    for (int i = 0; i < 4; ++i) { v0[i] = __builtin_amdgcn_fmed3f(v0[i], -448.f, 448.f); v1[i] = __builtin_amdgcn_fmed3f(v1[i], -448.f, 448.f); }
                    int w0 = __builtin_amdgcn_cvt_pk_fp8_f32(v0[0], v0[1], 0, false); w0 = __builtin_amdgcn_cvt_pk_fp8_f32(v0[2], v0[3], w0, true);
                    int w1 = __builtin_amdgcn_cvt_pk_fp8_f32(v1[0], v1[1], 0, false); w1 = __builtin_amdgcn_cvt_pk_fp8_f32(v1[2], v1[3], w1, true);
                    u32x2 w; w.x = (unsigned)w0; w.y = (unsigned)w1;
                    *(u32x2*)(rowp + bj * HALF) = w; } }
    }
};
}

constexpr int RING_BYTES = 131072, LDS_BYTES = 147456;
struct Args { const float* in[20]; float* out; unsigned char* ws; int ph_lo, ph_hi; };
struct Frame {
    LAS unsigned char* lds;
    int tid, lane, wave, gw, ngw, G;
};
#define P_X 0
#define P_C 1
#define P_CTX 2
#define P_CCTX 3
#define P_ADAW 4
#define P_ADAB 5
#define P_NORMG 6
#define P_GWIN 7
#define P_GWA2 8
#define P_GBA2 9
#define P_GNORMG 10
#define P_GWOUT 11
#define P_CWIN 12
#define P_CK 13
#define P_CWOUT 14
#define P_ROUTER 15
#define P_EGATE 16
#define P_EUP 17
#define P_EDOWN 18
#define P_FINALG 19

constexpr int TR_SCR = 64 * 65 * 4;
__device__ __forceinline__ void tr_item(const float* W, int ldw, int k0, int n0, bf16_t* WT, int ldo, int drow0, LAS float* scr, int lane) {
    f32x4 v[16];
#pragma unroll
    for (int i = 0; i < 16; ++i) v[i] = *(const f32x4*)(W + (size_t)(k0 + 4 * i + (lane >> 4)) * ldw + n0 + 4 * (lane & 15));
#pragma unroll
    for (int i = 0; i < 16; ++i) { LAS float* p = scr + (4 * i + (lane >> 4)) * 65 + 4 * (lane & 15); p[0] = v[i].x; p[1] = v[i].y; p[2] = v[i].z; p[3] = v[i].w; }
    LDS_WAIT(); asm volatile("" ::: "memory");
    const int c = lane & 7;
#pragma unroll
    for (int j = 0; j < 8; ++j) { const int n = (lane >> 3) + 8 * j; const LAS float* sp = scr + (8 * c) * 65 + n;
        u32x4 o; o.x = pk2(sp[0 * 65], sp[1 * 65]); o.y = pk2(sp[2 * 65], sp[3 * 65]); o.z = pk2(sp[4 * 65], sp[5 * 65]); o.w = pk2(sp[6 * 65], sp[7 * 65]);
        *(u32x4*)(WT + (size_t)(drow0 + n) * ldo + k0 + 8 * c) = o; }
    LDS_WAIT(); asm volatile("" ::: "memory");
}
__device__ __forceinline__ void tr_plain(Frame& F, const Args& A, const float* W, int K, int N, bf16_t* WT, int item, LAS float* scr) {
    const int nblk = (N + 63) / 64, kb = item / nblk, nb = item % nblk; int n0 = 64 * nb; if (n0 + 64 > N) n0 = N - 64;
    tr_item(W, N, 64 * kb, n0, WT, K, n0, scr, F.lane);
}
constexpr int TR_SCR8 = 128 * 33 * 4;
static_assert(TR_SCR8 >= TR_SCR, "per-wave scratch stride");
struct Tr8Item { const float* W; unsigned char* WT; int ldw, ldo, rowmap; };
constexpr int I8_G = (D / 128) * (DEXP / 256);
constexpr int I8_D = (DEXP / 128) * (D / 256);
constexpr int N_EXPERT_ITEMS = NE * (2 * I8_G + I8_D);
__device__ __forceinline__ Tr8Item expert_item(const Args& A, int gi) {
    const int l = gi / N_EXPERT_ITEMS, it = gi % N_EXPERT_ITEMS;
    unsigned char* wgu = A.ws + WS_W8 + (size_t)l * W8_LAYER; unsigned char* wd = wgu + W8_WD;
    constexpr int PER_E = 2 * I8_G + I8_D;
    const int e = it / PER_E; int r = it % PER_E;
    Tr8Item t;
    if (r < 2 * I8_G) {
        const int up = r / I8_G; r %= I8_G;
        const float* W = A.in[up ? P_EUP : P_EGATE] + ((size_t)l * NE + e) * D * DEXP;
        const int nblk = DEXP / 256, kb = r / nblk, nb = r % nblk, h0 = 256 * nb;
        t.W = W + (size_t)(128 * kb) * DEXP + h0; t.ldw = DEXP; t.WT = wgu + (size_t)e * 4096 * D + (size_t)(2 * h0 + 128 * up) * D + 128 * kb; t.ldo = D; t.rowmap = 1;
    } else {
        r -= 2 * I8_G;
        const float* W = A.in[P_EDOWN] + ((size_t)l * NE + e) * DEXP * D;
        const int nblk = D / 256, kb = r / nblk, nb = r % nblk;
        t.W = W + (size_t)(128 * kb) * D + 256 * nb; t.ldw = D; t.WT = wd + (size_t)e * D * DEXP + (size_t)(256 * nb) * DEXP + 128 * kb; t.ldo = DEXP; t.rowmap = 0;
    }
    return t;
}
__device__ __forceinline__ void tr8_load(const Tr8Item& t, f32x4 (&v)[16], int wave, int lane) {
#pragma unroll
    for (int i = 0; i < 16; ++i) v[i] = __builtin_nontemporal_load((const f32x4*)(t.W + (size_t)(16 * wave + i) * t.ldw + 4 * lane));
}
__device__ __forceinline__ void tr8_finish(const Tr8Item& t, const f32x4 (&v)[16], LAS unsigned char* tile, int tid, int wave, int lane) {
#pragma unroll
    for (int q = 0; q < 4; ++q) {
        int o[4];
#pragma unroll
        for (int g = 0; g < 4; ++g) { int w = __builtin_amdgcn_cvt_pk_fp8_f32(64.f * v[4 * g][q], 64.f * v[4 * g + 1][q], 0, false);
            o[g] = __builtin_amdgcn_cvt_pk_fp8_f32(64.f * v[4 * g + 2][q], 64.f * v[4 * g + 3][q], w, true); }
        u32x4 ov; ov.x = (unsigned)o[0]; ov.y = (unsigned)o[1]; ov.z = (unsigned)o[2]; ov.w = (unsigned)o[3];
        const int n = 4 * lane + q;
        *(LAS u32x4*)(tile + n * 128 + ((wave ^ (n & 7)) << 4)) = ov; }
    __syncthreads();
#pragma unroll
    for (int j = 0; j < 4; ++j) { const int p = tid + 512 * j, n = p >> 3, c = p & 7;
        const u32x4 ov = *(const LAS u32x4*)(tile + n * 128 + ((c ^ (n & 7)) << 4));
        const int drow = t.rowmap ? (256 * (n >> 7) + (n & 127)) : n;
        *(u32x4*)(t.WT + (size_t)drow * t.ldo + 16 * c) = ov; }
    __syncthreads();
}
__device__ __forceinline__ void convert_expert_dyn(const Args& A, unsigned* ctr, int end, LAS unsigned char* tile, volatile LAS int* slot, int tid, int wave, int lane) {
    if (tid == 0) { slot[0] = (int)__hip_atomic_fetch_add(ctr, 1u, __ATOMIC_RELAXED, __HIP_MEMORY_SCOPE_AGENT); slot[1] = (int)__hip_atomic_fetch_add(ctr, 1u, __ATOMIC_RELAXED, __HIP_MEMORY_SCOPE_AGENT); }
    __syncthreads();
    int ia = slot[0], ib = slot[1];
    if (ia >= end) return;
    f32x4 va[16], vb[16];
    Tr8Item ta = expert_item(A, ia), tb;
    tr8_load(ta, va, wave, lane);
    for (;;) {
        int rc = 0;
        tb = expert_item(A, min(ib, end - 1)); tr8_load(tb, vb, wave, lane);
        if (tid == 0) rc = (int)__hip_atomic_fetch_add(ctr, 1u, __ATOMIC_RELAXED, __HIP_MEMORY_SCOPE_AGENT);
        tr8_finish(ta, va, tile, tid, wave, lane);
        if (tid == 0) slot[0] = rc;
        __syncthreads();
        ia = ib; ib = slot[0];
        if (ia >= end) break;
        ta = expert_item(A, min(ib, end - 1)); tr8_load(ta, va, wave, lane);
        if (tid == 0) rc = (int)__hip_atomic_fetch_add(ctr, 1u, __ATOMIC_RELAXED, __HIP_MEMORY_SCOPE_AGENT);
        tr8_finish(tb, vb, tile, tid, wave, lane);
        if (tid == 0) slot[1] = rc;
        __syncthreads();
        ia = ib; ib = slot[1];
        if (ia >= end) break;
    }
}
template <int N>
__device__ __forceinline__ void convert_expert_fixed(const Args& A, LAS unsigned char* lds, int tid, int wave, int lane) {
    unsigned* ctr = (unsigned*)(A.ws + WS_CTL) + 2048; LAS unsigned char* tile = lds + 49152; volatile LAS int* slot = (volatile LAS int*)(lds + 40960);
    constexpr int end = 2 * N_EXPERT_ITEMS;
    __syncthreads();
    if (tid == 0) slot[0] = (int)__hip_atomic_fetch_add(ctr, (unsigned)N, __ATOMIC_RELAXED, __HIP_MEMORY_SCOPE_AGENT);
    __syncthreads();
    const int base = slot[0];
    if (base >= end) return;
    f32x4 va[16], vb[16];
    Tr8Item ta = expert_item(A, base), tb = ta;
    tr8_load(ta, va, wave, lane);
#pragma unroll
    for (int j = 0; j < N; ++j) {
        if ((j & 1) == 0) { if (j + 1 < N) { tb = expert_item(A, min(base + j + 1, end - 1)); tr8_load(tb, vb, wave, lane); } tr8_finish(ta, va, tile, tid, wave, lane); }
        else              { if (j + 1 < N) { ta = expert_item(A, min(base + j + 1, end - 1)); tr8_load(ta, va, wave, lane); } tr8_finish(tb, vb, tile, tid, wave, lane); }
    }
}

__device__ __forceinline__ void ph_prep(Frame& F, const Args& A) {
    LAS float* scr = (LAS float*)(F.lds + F.wave * TR_SCR8);
    bf16_t* win0 = (bf16_t*)(A.ws + WS_WIN0T); bf16_t* wout0 = (bf16_t*)(A.ws + WS_WOUT0T); bf16_t* wcin = (bf16_t*)(A.ws + WS_WCINT); bf16_t* wcout = (bf16_t*)(A.ws + WS_WCOUTT);
    {
        float* mod = (float*)(A.ws + WS_MOD);
        LAS float* red = (LAS float*)(F.lds + 8 * TR_SCR8);
        for (int it = blockIdx.x; it < 2 * 96; it += F.G) {
            const int l = it / 96, n = (it % 96) * 64 + F.lane;
            const float* w = A.in[P_ADAW] + (size_t)l * D * 6 * D + n;
            float a0 = 0.f, a1 = 0.f, a2 = 0.f;
#pragma unroll 16
            for (int kk = 0; kk < 128; ++kk) { const int k = F.wave * 128 + kk; const float wv = w[(size_t)k * 6 * D];
                a0 += silu_f(A.in[P_C][k]) * wv; a1 += silu_f(A.in[P_C][D + k]) * wv; a2 += silu_f(A.in[P_CCTX][k]) * wv; }
            red[(F.wave * 3 + 0) * 64 + F.lane] = a0; red[(F.wave * 3 + 1) * 64 + F.lane] = a1; red[(F.wave * 3 + 2) * 64 + F.lane] = a2;
            __syncthreads();
            if (F.wave < 3) { float sacc = A.in[P_ADAB][l * 6 * D + n];
#pragma unroll
                for (int w8 = 0; w8 < 8; ++w8) sacc += red[(w8 * 3 + F.wave) * 64 + F.lane];
                mod[(l * 3 + F.wave) * 6 * D + n] = sacc; }
            __syncthreads();
        }
    }
    constexpr int I0 = (D / 64) * ((NIN0 + 63) / 64), I1 = (D / 64) * (D / 64), I2 = (D / 64) * (NCIN / 64), I3 = I1;
    for (int it = F.gw; it < I0 + I1 + I2 + I3; it += F.ngw) {
        int r = it;
        if (r < I0) { tr_plain(F, A, A.in[P_GWIN], D, NIN0, win0, r, scr); continue; } r -= I0;
        if (r < I1) { tr_plain(F, A, A.in[P_GWOUT], D, D, wout0, r, scr); continue; } r -= I1;
        if (r < I2) {
            constexpr int nblk = NCIN / 64; const int kb = r / nblk, n0 = 64 * (r % nblk), sct = n0 >> 10, ch = n0 & 1023, cb = ch >> 8, hf = (ch >> 7) & 1;
            const int drow0 = sct == 0 ? (3 * cb + 2) * 256 + (ch & 255) : (3 * cb + hf) * 256 + 128 * (sct - 1) + (ch & 127);
            tr_item(A.in[P_CWIN], NCIN, 64 * kb, n0, wcin, D, drow0, scr, F.lane); continue; } r -= I2;
        tr_plain(F, A, A.in[P_CWOUT], D, D, wcout, r, scr);
    }
    { u32x4* z = (u32x4*)(win0 + (size_t)NIN0 * D); const int n16 = (NIN0P - NIN0) * D * 2 / 16;
      for (int i = F.gw * 64 + F.lane; i < n16; i += F.ngw * 64) z[i] = (u32x4){0u, 0u, 0u, 0u}; }
}

__device__ __forceinline__ void normmod_row(const f32x4 (&v)[4], const float* g, const float* sh, const float* sc, bf16_t* orow, int lane) {
    float s = 0.f;
#pragma unroll
    for (int j = 0; j < 4; ++j) s += (v[j].x * v[j].x + v[j].y * v[j].y) + (v[j].z * v[j].z + v[j].w * v[j].w);
    const float rstd = rsqrtf(wave_sum(s) * (1.f / D) + EPS);
#pragma unroll
    for (int j = 0; j < 4; ++j) { const int c = 4 * lane + 256 * j;
        const f32x4 gg = *(const f32x4*)(g + c), s1 = *(const f32x4*)(sh + c), s2 = *(const f32x4*)(sc + c);
        const f32x4 y = v[j] * rstd * gg * (s2 + 1.f) + s1;
        u32x2 w; w.x = pk2(y.x, y.y); w.y = pk2(y.z, y.w);
        *(u32x2*)(orow + c) = w; }
}
__device__ __forceinline__ void ph_norm0(Frame& F, const Args& A) {
    const float* mod = (const float*)(A.ws + WS_MOD); bf16_t* H = (bf16_t*)(A.ws + WS_H);
    for (int row = F.gw; row < NROW; row += F.ngw) {
        const float* xr = row < NLAT ? A.in[P_X] + (size_t)row * D : A.in[P_CTX] + (size_t)(row - NLAT) * D;
        const int s = row < NLAT ? (row >> 14) : 2;
        f32x4 v[4];
#pragma unroll
        for (int j = 0; j < 4; ++j) v[j] = *(const f32x4*)(xr + 4 * F.lane + 256 * j);
        normmod_row(v, A.in[P_NORMG] + 0 * D, mod + (0 * 3 + s) * 6 * D + 0 * D, mod + (0 * 3 + s) * 6 * D + 1 * D, H + (size_t)row * D, F.lane);
    }
}

__device__ __forceinline__ int jperm(int ks, int fq, int jj) { return 32 * ks + 16 * (jj >> 2) + 4 * fq + (jj & 3); }
__device__ __forceinline__ bf16x8 ldfrag(const unsigned char* blob, int blk, int lane) { return *(const bf16x8*)(blob + blk * 1024 + lane * 16); }
__device__ __forceinline__ unsigned cvtpk(float lo, float hi) { return pk2(lo, hi); }
__device__ __forceinline__ bf16x8 pack8(const f32x4& a, const f32x4& b) {
    u32x4 w; w.x = cvtpk(a[0], a[1]); w.y = cvtpk(a[2], a[3]); w.z = cvtpk(b[0], b[1]); w.w = cvtpk(b[2], b[3]);
    return __builtin_bit_cast(bf16x8, w);
}
__device__ __forceinline__ void ph_gla_prep(Frame& F, const Args& A) {
    constexpr int LSTR = 1040;
    LAS unsigned char* QS = F.lds; LAS unsigned char* KS = F.lds + 64 * LSTR;
    const bf16_t* qk = (const bf16_t*)(A.ws + WS_QK); const float* afb = (const float*)(A.ws + WS_AFB);
    float* gam = (float*)(A.ws + WS_GAM);
    const bool has_conv = blockIdx.x + 4 * F.G >= 2 * NCHUNK;
    const int pre = has_conv ? (int)(blockIdx.x & 3) : 0;
    if (pre == 1) convert_expert_fixed<1>(A, F.lds, F.tid, F.wave, F.lane);
    else if (pre == 2) convert_expert_fixed<2>(A, F.lds, F.tid, F.wave, F.lane);
    else if (pre == 3) convert_expert_fixed<3>(A, F.lds, F.tid, F.wave, F.lane);
    __syncthreads();
    const int dir = blockIdx.x & 1, d = F.tid;
    f32x2 w2[8];
#pragma unroll
    for (int r = 0; r < 8; ++r) { w2[r].x = A.in[P_GWA2][(dir * 16 + 2 * r) * DK + d]; w2[r].y = A.in[P_GWA2][(dir * 16 + 2 * r + 1) * DK + d]; }
    const float bias = A.in[P_GBA2][dir * DK + d];
    u32x4 t16[16]; f32x4 av = (f32x4){0.f, 0.f, 0.f, 0.f};
#define PREP_LOAD(it_) do { const int row0_ = ((it_) >> 1) * 64; \
        _Pragma("unroll") for (int u = 0; u < 16; ++u) { const int q16 = F.tid + NTHR * u, j = q16 >> 7, cp = q16 & 127; t16[u] = *(const u32x4*)((const unsigned char*)qk + ((size_t)(row0_ + j) * D) * 2 + cp * 16); } \
        if (F.tid < 256) av = *(const f32x4*)(afb + (size_t)(row0_ + (F.tid >> 2)) * 32 + dir * 16 + 4 * (F.tid & 3)); } while (0)
    if ((int)blockIdx.x < 2 * NCHUNK) PREP_LOAD((int)blockIdx.x);
    for (int item = blockIdx.x; item < 2 * NCHUNK; item += F.G) {
        {
            const int ch = item >> 1, row0 = ch * 64; (void)row0;
            LAS float* AFL = (LAS float*)(F.lds + 2 * 64 * LSTR);
            {
#pragma unroll
                for (int u = 0; u < 16; ++u) { const int q16 = F.tid + NTHR * u, j = q16 >> 7, cp = q16 & 127; *(LAS u32x4*)(((cp < 64) ? QS : KS) + j * LSTR + (cp & 63) * 16) = t16[u]; }
                if (F.tid < 256) *(LAS f32x4*)(AFL + (F.tid >> 2) * 16 + 4 * (F.tid & 3)) = av;
            }
            if (item + F.G < 2 * NCHUNK) PREP_LOAD(item + F.G);
            __syncthreads();
            float cum2 = 0.f;
#pragma unroll 1
            for (int jq = 0; jq < 64; jq += 4) {
                f32x4 ar[4][4]; unsigned qv[4], kv[4];
#pragma unroll
                for (int u = 0; u < 4; ++u) { const int j = dir ? 63 - (jq + u) : jq + u;
#pragma unroll
                    for (int r4 = 0; r4 < 4; ++r4) ar[u][r4] = *(const LAS f32x4*)(AFL + j * 16 + 4 * r4); }
#pragma unroll
                for (int u = 0; u < 4; ++u) { const int j = dir ? 63 - (jq + u) : jq + u;
                    qv[u] = *(const LAS bf16_t*)(QS + j * LSTR + d * 2); kv[u] = *(const LAS bf16_t*)(KS + j * LSTR + d * 2); }
                asm volatile("" ::: "memory");
                float ls2[4];
#pragma unroll
                for (int u = 0; u < 4; ++u) {
                    f32x2 za = (f32x2){bias, 0.f}, zb = (f32x2){0.f, 0.f};
#pragma unroll
                    for (int r4 = 0; r4 < 4; ++r4) { za = __builtin_elementwise_fma((f32x2){ar[u][r4].x, ar[u][r4].y}, w2[2 * r4], za); zb = __builtin_elementwise_fma((f32x2){ar[u][r4].z, ar[u][r4].w}, w2[2 * r4 + 1], zb); }
                    const float z = (za.x + za.y) + (zb.x + zb.y);
                    const float zl = z * 1.4426950408889634f;
                    ls2[u] = fminf(zl, 0.f) - __builtin_amdgcn_logf(1.f + __builtin_amdgcn_exp2f(-fabsf(zl)));
                }
                unsigned qk2[4];
#pragma unroll
                for (int u = 0; u < 4; ++u) {
                    cum2 += ls2[u] * (1.f / 16.f);
                    const float e = __builtin_amdgcn_exp2f(cum2), ei = __builtin_amdgcn_exp2f(-cum2);
                    qk2[u] = pk2(bflo(qv[u]) * e, bflo(kv[u]) * ei);
                }
#pragma unroll
                for (int u = 0; u < 4; ++u) { const int j = dir ? 63 - (jq + u) : jq + u;
                    *(LAS bf16_t*)(QS + j * LSTR + d * 2) = (bf16_t)(qk2[u] & 0xffffu); *(LAS bf16_t*)(KS + j * LSTR + d * 2) = (bf16_t)(qk2[u] >> 16); }
            }
            const float cum = cum2 * 0.6931471805599453f;
            gam[((size_t)dir * NCHUNK + ch) * DK + d] = __expf(cum);
            __syncthreads();
            {
                const int fr = F.lane & 15, fq = F.lane >> 4;
                unsigned char* blob0 = A.ws + (((size_t)dir * NCHUNK + ch) * 4) * BLOB + (size_t)F.tid * 16;
#pragma unroll
                for (int typ = 0; typ < 2; ++typ) {
                    const LAS unsigned char* src = (typ == 0) ? QS : KS;
                    u32x4 o[8];
#pragma unroll
                    for (int i8 = 0; i8 < 8; ++i8) { const int h = i8 >> 1, blk = F.wave + 8 * (i8 & 1), it = blk >> 2, sd = blk & 3, i = 16 * it + fr, d0 = h * HK + 32 * sd + 4 * fq;
                        const u32x2 lo = *(const LAS u32x2*)(src + i * LSTR + d0 * 2), hi = *(const LAS u32x2*)(src + i * LSTR + (d0 + 16) * 2);
                        o[i8].x = lo.x; o[i8].y = lo.y; o[i8].z = hi.x; o[i8].w = hi.y; }
                    unsigned char* dst = blob0 + (typ == 0 ? WS_QP : WS_KP);
#pragma unroll
                    for (int i8 = 0; i8 < 8; ++i8) *(u32x4*)(dst + (size_t)(i8 >> 1) * BLOB + (size_t)(i8 & 1) * 8192) = o[i8];
                }
                {
                    u32x4 o[8];
#pragma unroll
                    for (int i8 = 0; i8 < 8; ++i8) { const int h = i8 >> 1, blk = F.wave + 8 * (i8 & 1), mt = blk >> 1, ks = blk & 1, dd = h * HK + 16 * mt + fr; unsigned e[8];
#pragma unroll
                        for (int jj = 0; jj < 8; ++jj) e[jj] = *(const LAS bf16_t*)(KS + jperm(ks, fq, jj) * LSTR + dd * 2);
                        o[i8].x = e[0] | (e[1] << 16); o[i8].y = e[2] | (e[3] << 16); o[i8].z = e[4] | (e[5] << 16); o[i8].w = e[6] | (e[7] << 16); }
                    unsigned char* dst = blob0 + WS_KTP;
#pragma unroll
                    for (int i8 = 0; i8 < 8; ++i8) *(u32x4*)(dst + (size_t)(i8 >> 1) * BLOB + (size_t)(i8 & 1) * 8192) = o[i8];
                }
            }
            __syncthreads();
        }
    }
#undef PREP_LOAD
    if (has_conv) {
        if (pre == 0) convert_expert_fixed<4>(A, F.lds, F.tid, F.wave, F.lane);
        else if (pre == 1) convert_expert_fixed<3>(A, F.lds, F.tid, F.wave, F.lane);
        else if (pre == 2) convert_expert_fixed<2>(A, F.lds, F.tid, F.wave, F.lane);
        else convert_expert_fixed<1>(A, F.lds, F.tid, F.wave, F.lane);
    }
}

#define MFMA16(a, b, c) __builtin_amdgcn_mfma_f32_16x16x32_bf16((a), (b), (c), 0, 0, 0)
__device__ __forceinline__ void gla_intra_item(Frame& F, const Args& A, int item) {
    const int ch = item >> 2, h = item & 3, fr = F.lane & 15, fq = F.lane >> 4;
    const unsigned char* qpf = A.ws + WS_QP + (((size_t)0 * NCHUNK + ch) * 4 + h) * BLOB; const unsigned char* kpf = A.ws + WS_KP + (((size_t)0 * NCHUNK + ch) * 4 + h) * BLOB;
    const unsigned char* qpb = A.ws + WS_QP + (((size_t)1 * NCHUNK + ch) * 4 + h) * BLOB; const unsigned char* kpb = A.ws + WS_KP + (((size_t)1 * NCHUNK + ch) * 4 + h) * BLOB;
    bf16x8 Pf[4][2];
#pragma unroll
    for (int it = 0; it < 4; ++it) {
        f32x4 P[4];
#pragma unroll
        for (int jt = 0; jt < 4; ++jt) P[jt] = (f32x4){0.f, 0.f, 0.f, 0.f};
#pragma unroll
        for (int dirp = 0; dirp < 2; ++dirp) {
            const unsigned char* qp = dirp ? qpb : qpf; const unsigned char* kp = dirp ? kpb : kpf;
            bf16x8 kk[16], qq[4];
#pragma unroll
            for (int sd = 0; sd < 4; ++sd) qq[sd] = ldfrag(qp, it * 4 + sd, F.lane);
#pragma unroll
            for (int jt = 0; jt < 4; ++jt) if (dirp ? (jt >= it) : (jt <= it)) {
#pragma unroll
                for (int sd = 0; sd < 4; ++sd) kk[jt * 4 + sd] = ldfrag(kp, jt * 4 + sd, F.lane); }
#pragma unroll
            for (int jt = 0; jt < 4; ++jt) if (dirp ? (jt >= it) : (jt <= it)) {
                f32x4 a = (f32x4){0.f, 0.f, 0.f, 0.f};
#pragma unroll
                for (int sd = 0; sd < 4; ++sd) a = MFMA16(kk[jt * 4 + sd], qq[sd], a);
                if (jt == it) {
#pragma unroll
                    for (int r = 0; r < 4; ++r) { const int j = 4 * fq + r; const bool keep = dirp ? (j >= fr) : (j <= fr); a[r] = keep ? a[r] : 0.f; }
                }
                P[jt] += a;
            }
        }
        Pf[it][0] = pack8(P[0], P[1]); Pf[it][1] = pack8(P[2], P[3]);
    }
    const unsigned char* vt = A.ws + WS_VTP + (size_t)ch * 131072 + (size_t)(h * 16) * 2048;
    bf16_t* oi = (bf16_t*)(A.ws + WS_OI) + (size_t)(ch * 64 + fr) * DV + h * HV + 4 * fq;
#pragma unroll 1
    for (int ng = 0; ng < 4; ++ng) {
        bf16x8 va[8];
#pragma unroll
        for (int i = 0; i < 8; ++i) va[i] = ldfrag(vt, ng * 8 + i, F.lane);
#pragma unroll
        for (int n4 = 0; n4 < 4; ++n4)
#pragma unroll
            for (int it = 0; it < 4; ++it) {
                f32x4 acc = (f32x4){0.f, 0.f, 0.f, 0.f};
                acc = MFMA16(va[n4 * 2], Pf[it][0], acc); acc = MFMA16(va[n4 * 2 + 1], Pf[it][1], acc);
                u32x2 w; w.x = pk2(acc[0], acc[1]); w.y = pk2(acc[2], acc[3]);
                *(u32x2*)(oi + (size_t)(16 * it) * DV + 16 * (ng * 4 + n4)) = w;
            }
    }
}
struct ScanRegs { bf16x8 q[4], k[4], v[2][2]; f32x4 g[2]; };
__device__ __forceinline__ int scan_chunk(int b, int dir, int step) { return step >= 4 ? (256 * b + (dir ? 255 - (step - 4) : step - 4)) : (512 + 4 * b + (dir ? 3 - step : step)); }
__device__ __forceinline__ void scan_load(const Args& A, ScanRegs& R, int b, int h, int dir, int sp, int w, int step, int lane) {
    const int ch = scan_chunk(b, dir, step), fq = lane >> 4;
    const size_t bo = (((size_t)dir * NCHUNK + ch) * 4 + h) * BLOB;
    const unsigned char* qp = A.ws + WS_QP + bo; const unsigned char* ktp = A.ws + WS_KTP + bo;
    const unsigned char* vt = A.ws + WS_VTP + (size_t)ch * 131072 + (size_t)(h * 16 + 2 * sp) * 2048;
    const float* gp = (const float*)(A.ws + WS_GAM) + ((size_t)dir * NCHUNK + ch) * DK + h * HK + 32 * w + 4 * fq;
#pragma unroll
    for (int sd = 0; sd < 4; ++sd) R.q[sd] = ldfrag(qp, w * 4 + sd, lane);
#pragma unroll
    for (int m = 0; m < 2; ++m)
#pragma unroll
        for (int ks = 0; ks < 2; ++ks) R.k[m * 2 + ks] = ldfrag(ktp, (2 * w + m) * 2 + ks, lane);
#pragma unroll
    for (int s2 = 0; s2 < 2; ++s2) {
        const int o = 8 * ((lane & 15) >> 2) + 4 * s2 + (lane & 3);
        const unsigned char* vp = vt + (o >> 4) * 2048 + ((o & 15) + (lane & 48)) * 16;
        R.v[s2][0] = *(const bf16x8*)(vp); R.v[s2][1] = *(const bf16x8*)(vp + 1024); }
    R.g[0] = *(const f32x4*)(gp); R.g[1] = *(const f32x4*)(gp + 16);
}
#define LDS_ORDER() asm volatile("" ::: "memory")
__device__ __forceinline__ void scan_ds(const ScanRegs& R, f32x4 (&dS)[2][2]) {
#pragma unroll
    for (int s2 = 0; s2 < 2; ++s2)
#pragma unroll
        for (int m = 0; m < 2; ++m) { f32x4 d = (f32x4){0.f, 0.f, 0.f, 0.f}; d = MFMA16(R.k[m * 2], R.v[s2][0], d); d = MFMA16(R.k[m * 2 + 1], R.v[s2][1], d); dS[s2][m] = d; }
}
__device__ __forceinline__ void scan_step(const Args& A, const ScanRegs& R, const ScanRegs& Rn, f32x4 (&S)[2][2], f32x4 (&dS)[2][2], LAS unsigned char* xs, LAS unsigned* flags, bf16_t* O, int b, int h, int dir, int sp, int w, int step, int lane) {
    const int fr = lane & 15, fq = lane >> 4;
#pragma unroll
    for (int s2 = 0; s2 < 2; ++s2) {
        S[s2][0] = R.g[0] * (S[s2][0] + dS[s2][0]); S[s2][1] = R.g[1] * (S[s2][1] + dS[s2][1]);
        *(volatile LAS bf16x8*)(xs + ((step + 1) & 3) * 8192 + (s2 * 4 + w) * 1024 + lane * 16) = pack8(S[s2][0], S[s2][1]);
    }
    LDS_ORDER();
    if (lane == 0) *(volatile LAS unsigned*)(flags + w) = (unsigned)step + 2u;
    LDS_ORDER();
    scan_ds(Rn, dS);
    if (step >= 4) {
        { const unsigned need = (unsigned)step + 1u; unsigned spn = 0;
          for (;;) { const unsigned f = (lane < 4) ? *(volatile LAS unsigned*)(flags + lane) : need;
              if (__all((int)(f >= need))) break; if (++spn > (1u << 26)) break; }
          LDS_ORDER(); }
        const LAS unsigned char* slot = xs + (step & 3) * 8192 + lane * 16;
        bf16x8 sf[2][4];
#pragma unroll
        for (int s2 = 0; s2 < 2; ++s2)
#pragma unroll
            for (int sd = 0; sd < 4; ++sd) sf[s2][sd] = *(const LAS bf16x8*)(slot + (s2 * 4 + sd) * 1024);
        LDS_ORDER();
        const int ch = scan_chunk(b, dir, step);
        f32x4 acc0 = (f32x4){0.f, 0.f, 0.f, 0.f}, acc1 = acc0;
#pragma unroll
        for (int sd = 0; sd < 4; ++sd) { acc0 = MFMA16(sf[0][sd], R.q[sd], acc0); acc1 = MFMA16(sf[1][sd], R.q[sd], acc1); }
        u32x4 wv; wv.x = pk2(acc0[0], acc0[1]); wv.y = pk2(acc0[2], acc0[3]); wv.z = pk2(acc1[0], acc1[1]); wv.w = pk2(acc1[2], acc1[3]);
        *(u32x4*)(O + (size_t)(ch * 64 + 16 * w + fr) * DV + h * HV + 32 * sp + 8 * fq) = wv;
    }
}
__device__ __forceinline__ void gla_scan_item(Frame& F, const Args& A, int item, LAS unsigned char* xs, LAS unsigned* flags) {
    const int chain = item >> 3, sp = item & 7, b = chain >> 3, h = (chain >> 1) & 3, dir = chain & 1, w = F.wave;
    bf16_t* O = (bf16_t*)(A.ws + (dir ? WS_OB : WS_OF));
    f32x4 S[2][2], dS[2][2];
#pragma unroll
    for (int s2 = 0; s2 < 2; ++s2) { S[s2][0] = (f32x4){0.f, 0.f, 0.f, 0.f}; S[s2][1] = S[s2][0];
        *(volatile LAS bf16x8*)(xs + (s2 * 4 + w) * 1024 + F.lane * 16) = pack8(S[s2][0], S[s2][1]); }
    LDS_ORDER();
    if (F.lane == 0) *(volatile LAS unsigned*)(flags + w) = 1u;
    LDS_ORDER();
    ScanRegs Ra, Rb, Rc;
    scan_load(A, Ra, b, h, dir, sp, w, 0, F.lane);
    scan_load(A, Rb, b, h, dir, sp, w, 1, F.lane);
    scan_ds(Ra, dS);
    for (int step = 0; step < 261; step += 3) {
        scan_load(A, Rc, b, h, dir, sp, w, min(step + 2, 259), F.lane);
        scan_step(A, Ra, Rb, S, dS, xs, flags, O, b, h, dir, sp, w, step, F.lane);
        scan_load(A, Ra, b, h, dir, sp, w, min(step + 3, 259), F.lane);
        scan_step(A, Rb, Rc, S, dS, xs, flags, O, b, h, dir, sp, w, step + 1, F.lane);
        scan_load(A, Rb, b, h, dir, sp, w, min(step + 4, 259), F.lane);
        if (step + 2 < 260) scan_step(A, Rc, Ra, S, dS, xs, flags, O, b, h, dir, sp, w, step + 2, F.lane);
    }
}
__device__ __forceinline__ void ph_gla_main(Frame& F, const Args& A) {
    LAS unsigned char* xs = F.lds; LAS unsigned* flags = (LAS unsigned*)(F.lds + 32768);
    if (F.tid < 16) flags[F.tid] = 0u;
    __syncthreads();
    const int bi = blockIdx.x;
    unsigned* ctr = (unsigned*)(A.ws + WS_CTL) + 2048;
    volatile LAS int* slot = (volatile LAS int*)(F.lds + 40960);
    if (bi < 128) {
        if (F.wave < 4) gla_scan_item(F, A, ((2 * (bi & 7) + ((bi >> 3) & 1)) << 3) | ((bi >> 4) & 7), xs, flags);
        __syncthreads();
    } else {
        const int sw = (bi - 128) * NWAVES + F.wave, nsw = (F.G - 128) * NWAVES;
        for (int it = sw; it < 512 * 4; it += nsw) gla_intra_item(F, A, it);
        __syncthreads();
    }
    convert_expert_dyn(A, ctr, 2 * N_EXPERT_ITEMS, F.lds + 49152, slot, F.tid, F.wave, F.lane);
    __syncthreads();
}

__device__ __forceinline__ void ph_gla_finish(Frame& F, const Args& A) {
    const bf16_t* rp = (const bf16_t*)(A.ws + WS_R); const bf16_t* OFp = (const bf16_t*)(A.ws + WS_OF); const bf16_t* OBp = (const bf16_t*)(A.ws + WS_OB); const bf16_t* OIp = (const bf16_t*)(A.ws + WS_OI);
    bf16_t* Hh = (bf16_t*)(A.ws + WS_H);
    const f32x4 gn = *(const f32x4*)(A.in[P_GNORMG] + 4 * F.lane);
    for (int row = F.gw; row < NLAT; row += F.ngw) {
#pragma unroll
        for (int j = 0; j < 4; ++j) {
            const int cc = 4 * F.lane + 256 * j;
            const u32x2 a = *(const u32x2*)(OFp + (size_t)row * DV + cc), bq = *(const u32x2*)(OBp + (size_t)row * DV + cc), ci = *(const u32x2*)(OIp + (size_t)row * DV + cc);
            const u32x2 rr = *(const u32x2*)(rp + (size_t)row * D + cc);
            f32x4 o; o.x = bflo(a.x) + bflo(bq.x) + bflo(ci.x); o.y = bfhi(a.x) + bfhi(bq.x) + bfhi(ci.x); o.z = bflo(a.y) + bflo(bq.y) + bflo(ci.y); o.w = bfhi(a.y) + bfhi(bq.y) + bfhi(ci.y);
            const float ss = wave_sum((o.x * o.x + o.y * o.y) + (o.z * o.z + o.w * o.w));
            const float rstd = rsqrtf(ss * (1.f / HV) + EPS);
            f32x4 r; r.x = bflo(rr.x); r.y = bfhi(rr.x); r.z = bflo(rr.y); r.w = bfhi(rr.y);
            f32x4 y;
#pragma unroll
            for (int i = 0; i < 4; ++i) y[i] = o[i] * rstd * gn[i] * silu_f(r[i]);
            u32x2 w; w.x = pk2(y.x, y.y); w.y = pk2(y.z, y.w);
            *(u32x2*)(Hh + (size_t)row * D + cc) = w;
        }
    }
}

__device__ __forceinline__ void stage_router(Frame& F, const Args& A, int l) {
    LAS float* wl = (LAS float*)F.lds;
    const float* rw = A.in[P_ROUTER] + (size_t)l * D * NE;
    for (int idx = F.tid; idx < D * NE; idx += NTHR) { const int k = idx >> 4, e = idx & 15, j = k >> 8, ln = (k & 255) >> 2, i = k & 3; wl[((((j * 4 + i) * 4 + (e >> 2)) * 64) + ln) * 4 + (e & 3)] = rw[idx]; }
    __syncthreads();
}
template <int N, int M>
__device__ __forceinline__ void rs_step(const float (&v)[N], float (&w)[N / 2], int lane) {
    const bool hi = (lane & M) != 0;
#pragma unroll
    for (int e = 0; e < N / 2; ++e) { const float mine = hi ? v[N / 2 + e] : v[e], other = hi ? v[e] : v[N / 2 + e]; w[e] = mine + __shfl_xor(other, M); }
}
__device__ __forceinline__ void ph_norm2_router(Frame& F, const Args& A, int l) {
    const float* mod = (const float*)(A.ws + WS_MOD); unsigned char* H8 = A.ws + WS_H; const bf16_t* X = (const bf16_t*)(A.ws + WS_X); float* aff = (float*)(A.ws + WS_AFF);
    const float* g = A.in[P_NORMG] + (l * 2 + 1) * D; const float* rw = A.in[P_ROUTER] + (size_t)l * D * NE;
    LAS unsigned char* WF = F.lds;
    LAS float* GS = (LAS float*)(F.lds + 65536); LAS float* SH = GS + D; LAS float* CB = SH + D; LAS float* RED = CB + 16;
    const int fr = F.lane & 15, fq = F.lane >> 4;
    const int b = (int)((blockIdx.x * NWAVES * 16) >> 14);
    const float* sh = mod + (l * 3 + b) * 6 * D + 3 * D; const float* sc = mod + (l * 3 + b) * 6 * D + 4 * D;
    for (int k = F.tid; k < D; k += NTHR) { GS[k] = g[k] * (1.f + sc[k]); SH[k] = sh[k]; }
    __syncthreads();
    for (int p = F.tid; p < 32 * 64; p += NTHR) {
        const int s = p >> 6, ln = p & 63, e = ln & 15, k0 = 32 * s + 8 * (ln >> 4);
        float w[8];
#pragma unroll
        for (int i = 0; i < 8; ++i) w[i] = rw[(k0 + i) * NE + e] * GS[k0 + i];
        u32x4 hi, lo;
        hi.x = pk2(w[0], w[1]); hi.y = pk2(w[2], w[3]); hi.z = pk2(w[4], w[5]); hi.w = pk2(w[6], w[7]);
        lo.x = pk2(w[0] - bflo(hi.x), w[1] - bfhi(hi.x)); lo.y = pk2(w[2] - bflo(hi.y), w[3] - bfhi(hi.y)); lo.z = pk2(w[4] - bflo(hi.z), w[5] - bfhi(hi.z)); lo.w = pk2(w[6] - bflo(hi.w), w[7] - bfhi(hi.w));
        *(LAS u32x4*)(WF + ((s * 2 + 0) * 64 + ln) * 16) = hi; *(LAS u32x4*)(WF + ((s * 2 + 1) * 64 + ln) * 16) = lo;
    }
    { const int e = F.tid & 15, part = F.tid >> 4; float acc = 0.f;
#pragma unroll 8
      for (int i = 0; i < 32; ++i) { const int k = part * 32 + i; acc += SH[k] * rw[k * NE + e]; }
      RED[part * 16 + e] = acc; }
    __syncthreads();
    if (F.tid < 16) { float acc = 0.f;
#pragma unroll
        for (int q = 0; q < 32; ++q) acc += RED[q * 16 + F.tid];
        CB[F.tid] = acc; }
    __syncthreads();
    for (int grp = F.gw; grp < NLAT / 16; grp += F.ngw) {
        const int row0 = grp * 16, row = row0 + fr;
        const bf16_t* xr = X + (size_t)row * D + 8 * fq;
        u32x4 xv[32];
#pragma unroll
        for (int s = 0; s < 32; ++s) xv[s] = *(const u32x4*)(xr + 32 * s);
        f32x2 ss2 = (f32x2){0.f, 0.f};
        f32x4 acc = (f32x4){0.f, 0.f, 0.f, 0.f};
#pragma unroll
        for (int s = 0; s < 32; ++s) {
            const u32x4 t = xv[s];
            const f32x2 a0 = {bflo(t.x), bfhi(t.x)}, a1 = {bflo(t.y), bfhi(t.y)}, a2 = {bflo(t.z), bfhi(t.z)}, a3 = {bflo(t.w), bfhi(t.w)};
            ss2 = __builtin_elementwise_fma(a0, a0, ss2); ss2 = __builtin_elementwise_fma(a1, a1, ss2); ss2 = __builtin_elementwise_fma(a2, a2, ss2); ss2 = __builtin_elementwise_fma(a3, a3, ss2);
            const bf16x8 xb = __builtin_bit_cast(bf16x8, t);
            acc = MFMA16(*(const LAS bf16x8*)(WF + ((s * 2 + 0) * 64 + F.lane) * 16), xb, acc);
            acc = MFMA16(*(const LAS bf16x8*)(WF + ((s * 2 + 1) * 64 + F.lane) * 16), xb, acc);
            if ((s & 1) == 1) asm volatile("" ::: "memory");
        }
#pragma unroll
        for (int s = 0; s < 32; ++s) asm volatile("" : "+v"(xv[s]));
        float ss = ss2.x + ss2.y; ss += __shfl_xor(ss, 16); ss += __shfl_xor(ss, 32);
        const float rstd = rsqrtf(ss * (1.f / D) + EPS);
        float lg[4]; float mx = -3.0e38f;
#pragma unroll
        for (int r = 0; r < 4; ++r) { lg[r] = rstd * acc[r] + CB[4 * fq + r]; mx = fmaxf(mx, lg[r]); }
        mx = fmaxf(mx, __shfl_xor(mx, 16)); mx = fmaxf(mx, __shfl_xor(mx, 32));
        float ex[4], den = 0.f;
#pragma unroll
        for (int r = 0; r < 4; ++r) { ex[r] = __expf(lg[r] - mx); den += ex[r]; }
        den += __shfl_xor(den, 16); den += __shfl_xor(den, 32);
        const float inv = 1.f / den; const int t = row & (T - 1);
#pragma unroll
        for (int r = 0; r < 4; ++r) aff[((size_t)b * NE + 4 * fq + r) * T + t] = ex[r] * inv;
        unsigned char* hr = H8 + (size_t)row * D + 8 * fq;
#pragma unroll
        for (int s = 0; s < 32; ++s) {
            const u32x4 t4 = xv[s]; const int k0 = 32 * s + 8 * fq;
            const f32x4 g0 = *(const LAS f32x4*)(GS + k0), g1 = *(const LAS f32x4*)(GS + k0 + 4), h0 = *(const LAS f32x4*)(SH + k0), h1 = *(const LAS f32x4*)(SH + k0 + 4);
            f32x4 y0 = (f32x4){bflo(t4.x), bfhi(t4.x), bflo(t4.y), bfhi(t4.y)} * rstd * g0 + h0, y1 = (f32x4){bflo(t4.z), bfhi(t4.z), bflo(t4.w), bfhi(t4.w)} * rstd * g1 + h1;
            const f32x4 lim = (f32x4){448.f, 448.f, 448.f, 448.f};
            y0 = __builtin_elementwise_min(__builtin_elementwise_max(y0, -lim), lim); y1 = __builtin_elementwise_min(__builtin_elementwise_max(y1, -lim), lim);
            int w0 = __builtin_amdgcn_cvt_pk_fp8_f32(y0.x, y0.y, 0, false); w0 = __builtin_amdgcn_cvt_pk_fp8_f32(y0.z, y0.w, w0, true);
            int w1 = __builtin_amdgcn_cvt_pk_fp8_f32(y1.x, y1.y, 0, false); w1 = __builtin_amdgcn_cvt_pk_fp8_f32(y1.z, y1.w, w1, true);
            u32x2 wv; wv.x = (unsigned)w0; wv.y = (unsigned)w1;
            *(u32x2*)(hr + 32 * s) = wv;
            if ((s & 1) == 1) asm volatile("" ::: "memory");
        }
    }
    __syncthreads();
}

__device__ __forceinline__ void ph_topk(Frame& F, const Args& A) {
    LAS int* red = (LAS int*)F.lds;
    const float* aff = (const float*)(A.ws + WS_AFF); int* slot = (int*)(A.ws + WS_SLOT); int* rowlist = (int*)(A.ws + WS_ROWLIST); float* selval = (float*)(A.ws + WS_SELVAL);
    for (int item = blockIdx.x; item < NB * NE; item += F.G) {
        const int b = item / NE, e = item % NE;
        const float* a = aff + ((size_t)b * NE + e) * T + F.tid * 32;
        unsigned v[32];
#pragma unroll
        for (int q = 0; q < 8; ++q) { const u32x4 x = *(const u32x4*)(a + 4 * q); v[4 * q] = x.x; v[4 * q + 1] = x.y; v[4 * q + 2] = x.z; v[4 * q + 3] = x.w; }
        unsigned prefix = 0u; int par = 0;
        for (int bit = 30; bit >= 0; --bit) {
            const unsigned cand = prefix | (1u << bit); int cnt = 0;
#pragma unroll
            for (int i = 0; i < 32; ++i) cnt += (v[i] >= cand) ? 1 : 0;
            cnt = wave_sum_i(cnt);
            if (F.lane == 0) red[par * 16 + F.wave] = cnt;
            __syncthreads();
            int tot = 0;
#pragma unroll
            for (int w8 = 0; w8 < 8; ++w8) tot += red[par * 16 + w8];
            if (tot >= CAP) prefix = cand;
            par ^= 1;
        }
        __syncthreads();
        int mgt = 0, meq = 0;
#pragma unroll
        for (int i = 0; i < 32; ++i) { mgt += (v[i] > prefix) ? 1 : 0; meq += (v[i] == prefix) ? 1 : 0; }
        int igt = mgt, ieq = meq;
#pragma unroll
        for (int o = 1; o < 64; o <<= 1) { const int ug = __shfl_up(igt, o), ue = __shfl_up(ieq, o); if (F.lane >= o) { igt += ug; ieq += ue; } }
        if (F.lane == 63) { red[F.wave] = igt; red[16 + F.wave] = ieq; }
        __syncthreads();
        int bgt = 0, beq = 0, totgt = 0;
#pragma unroll
        for (int w8 = 0; w8 < 8; ++w8) { const int xg = red[w8], xe = red[16 + w8]; if (w8 < F.wave) { bgt += xg; beq += xe; } totgt += xg; }
        const int need_eq = CAP - totgt;
        int gtb = bgt + igt - mgt, eqb = beq + ieq - meq;
        const int t0 = F.tid * 32;
#pragma unroll
        for (int q = 0; q < 2; ++q) {
            int sl[16];
#pragma unroll
            for (int i = 0; i < 16; ++i) {
                const unsigned x = v[q * 16 + i]; const bool gt = x > prefix, eq = x == prefix; const bool sel = gt || (eq && eqb < need_eq);
                const int pos = gtb + (eqb < need_eq ? eqb : need_eq);
                sl[i] = sel ? pos : -1;
                if (sel) { rowlist[e * 4096 + b * CAP + pos] = b * T + t0 + q * 16 + i; selval[e * 4096 + b * CAP + pos] = __builtin_bit_cast(float, x); }
                gtb += gt ? 1 : 0; eqb += eq ? 1 : 0;
            }
#pragma unroll
            for (int i4 = 0; i4 < 4; ++i4) *(i32x4*)(slot + ((size_t)b * NE + e) * T + t0 + q * 16 + 4 * i4) = (i32x4){sl[4 * i4], sl[4 * i4 + 1], sl[4 * i4 + 2], sl[4 * i4 + 3]};
        }
        __syncthreads();
    }
}

__device__ __forceinline__ void ph_combine(Frame& F, const Args& A, int l) {
    const float* mod = (const float*)(A.ws + WS_MOD); bf16_t* X = (bf16_t*)(A.ws + WS_X); bf16_t* H = (bf16_t*)(A.ws + WS_H);
    const int* slot = (const int*)(A.ws + WS_SLOT); const unsigned char* ye = A.ws + WS_YE; const float* selval = (const float*)(A.ws + WS_SELVAL);
    for (int row = F.gw; row < NLAT; row += F.ngw) {
        const int b = row >> 14;
        const int sv = (F.lane < 16) ? slot[((size_t)b * NE + F.lane) * T + (row & (T - 1))] : -1;
        f32x4 acc[4];
#pragma unroll
        for (int j = 0; j < 4; ++j) acc[j] = (f32x4){0.f, 0.f, 0.f, 0.f};
        for (int e = 0; e < NE; ++e) {
            const int s = __builtin_amdgcn_readlane(sv, e);
            if (s >= 0) {
                const int yrow = e * 4096 + b * CAP + s;
                const unsigned char* yr = ye + (size_t)yrow * D + 4 * F.lane; const float wv = selval[yrow] * (1.f / 32);
#pragma unroll
                for (int j = 0; j < 4; ++j) { const int y = *(const int*)(yr + 256 * j); const f32x2 lo = __builtin_amdgcn_cvt_pk_f32_fp8(y, false), hi = __builtin_amdgcn_cvt_pk_f32_fp8(y, true);
                    acc[j].x += wv * lo.x; acc[j].y += wv * lo.y; acc[j].z += wv * hi.x; acc[j].w += wv * hi.y; }
            }
        }
        const float* g2 = mod + (l * 3 + b) * 6 * D + 5 * D;
        f32x4 v[4];
#pragma unroll
        for (int j = 0; j < 4; ++j) { const int c = 4 * F.lane + 256 * j; const u32x2 t = *(const u32x2*)(X + (size_t)row * D + c);
            v[j] = (f32x4){bflo(t.x), bfhi(t.x), bflo(t.y), bfhi(t.y)} + *(const f32x4*)(g2 + c) * acc[j]; }
        if (l == 0) {
#pragma unroll
            for (int j = 0; j < 4; ++j) { u32x2 w; w.x = pk2(v[j].x, v[j].y); w.y = pk2(v[j].z, v[j].w); *(u32x2*)(X + (size_t)row * D + 4 * F.lane + 256 * j) = w; }
            normmod_row(v, A.in[P_NORMG] + (1 * 2 + 0) * D, mod + (1 * 3 + b) * 6 * D + 0 * D, mod + (1 * 3 + b) * 6 * D + 1 * D, H + (size_t)row * D, F.lane);
        } else {
            float s = 0.f;
#pragma unroll
            for (int j = 0; j < 4; ++j) s += (v[j].x * v[j].x + v[j].y * v[j].y) + (v[j].z * v[j].z + v[j].w * v[j].w);
            const float rstd = rsqrtf(wave_sum(s) * (1.f / D) + EPS);
#pragma unroll
            for (int j = 0; j < 4; ++j) { const int c = 4 * F.lane + 256 * j; *(f32x4*)(A.out + (size_t)row * D + c) = v[j] * rstd * *(const f32x4*)(A.in[P_FINALG] + c); }
        }
    }
}

constexpr int N_PHASES = 20;
__global__ void __launch_bounds__(NTHR, 2) fwd_kernel(Args A) {
    extern __shared__ __attribute__((aligned(16))) unsigned char lds_raw[];
    Frame F;
    F.lds = (LAS unsigned char*)lds_raw;
    F.tid = threadIdx.x; F.lane = F.tid & 63; F.wave = __builtin_amdgcn_readfirstlane(F.tid >> 6);
    F.G = gridDim.x; F.gw = blockIdx.x * NWAVES + F.wave; F.ngw = F.G * NWAVES;
    const int lo = A.ph_lo, hi = A.ph_hi;
#ifdef ONLY_PH
#define IN(k) ((k) == ONLY_PH && lo <= (k) && (k) < hi)
#else
#define IN(k) (lo <= (k) && (k) < hi)
#endif
#if MK_MULTI
#define SEAM(k) do { } while (0)
#else
    cg::grid_group grid = cg::this_grid();
    volatile LAS unsigned* bst = (volatile LAS unsigned*)(F.lds + LDS_BYTES - 64);
    if (F.tid < 16) bst[F.tid] = 0u;
    __syncthreads();
    XcdBarrier xbar = xcd_barrier_post((unsigned*)(A.ws + WS_CTL) + 4096, bst);
    if (lo < 0) { __threadfence(); grid.sync(); }
#define SEAM(k) do { if (IN(k) && IN((k) + 1)) xcd_barrier(xbar); } while (0)
#endif
    const int c = blockIdx.x;
    #define H ((bf16_t*)(A.ws + WS_H))
#define X ((bf16_t*)(A.ws + WS_X))
#define mod ((const float*)(A.ws + WS_MOD))
#define MOE_GU(l) { eng::Gemm g{(const char*)(A.ws + WS_H), (const char*)(A.ws + WS_W8 + (size_t)(l) * W8_LAYER), (const int*)(A.ws + WS_ROWLIST), (size_t)4096 * D, D / 2, 16, 16, NE}; \
        eng::EpiSwiglu E{0x79797979, 0x7F7F7F7F, A.ws + WS_HID}; eng::gemm_phase(F.lds, g, E, F.G, c); }
#define MOE_DN(l) { eng::Gemm g{(const char*)(A.ws + WS_HID), (const char*)(A.ws + WS_W8 + (size_t)(l) * W8_LAYER + W8_WD), nullptr, (size_t)D * DEXP, DEXP / 2, 16, 4, NE}; g.rev = 1; \
        eng::EpiDown E{0x79797979, 0x7D7D7D7D, A.ws + WS_YE}; eng::gemm_phase(F.lds, g, E, F.G, c); }

    if (IN(0)) ph_prep(F, A);
    SEAM(0);
    if (IN(1)) ph_norm0(F, A);
    SEAM(1);
    if (IN(2)) { eng::Gemm g{(const char*)H, (const char*)(A.ws + WS_WIN0T), nullptr, 0, D, NROW / 256, NIN0P / 256, 1};
        eng::EpiProj0 E{(bf16_t*)(A.ws + WS_QK), A.ws + WS_VTP, (bf16_t*)(A.ws + WS_R), (float*)(A.ws + WS_AFB)}; eng::gemm_phase(F.lds, g, E, F.G, c);
        if (6 * F.G + c >= (NROW / 256) * (NIN0P / 256)) convert_expert_fixed<3>(A, F.lds, F.tid, F.wave, F.lane); }
    SEAM(2);
    if (IN(3)) ph_gla_prep(F, A);
    SEAM(3);
    if (IN(4)) ph_gla_main(F, A);
    SEAM(4);
    if (IN(5)) ph_gla_finish(F, A);
    SEAM(5);
    if (IN(6)) { eng::Gemm g{(const char*)H, (const char*)(A.ws + WS_WOUT0T), nullptr, 0, D, NLAT / 256, D / 256, 1};
        eng::EpiResidT<true> E{A.in[P_X], X, mod + (0 * 3) * 6 * D + 2 * D}; eng::gemm_phase(F.lds, g, E, F.G, c); }
    SEAM(6);
    if (IN(7)) ph_norm2_router(F, A, 0);
    SEAM(7);
    if (IN(8)) ph_topk(F, A);
    SEAM(8);
    if (IN(9)) MOE_GU(0)
    SEAM(9);
    if (IN(10)) MOE_DN(0)
    SEAM(10);
    if (IN(11)) ph_combine(F, A, 0);
    SEAM(11);
    if (IN(12)) { eng::Gemm g{(const char*)H, (const char*)(A.ws + WS_WCINT), nullptr, 0, D, NLAT / 256, NCIN / 256, 1};
        g.trip = 1;
        eng::EpiConvFused E{A.ws + WS_CDUMP + (size_t)c * 131072, (bf16_t*)(A.ws + WS_H2), A.in[P_CK]}; eng::gemm_phase(F.lds, g, E, F.G, c); }
    SEAM(12);
    if (IN(14)) { eng::Gemm g{(const char*)(A.ws + WS_H2), (const char*)(A.ws + WS_WCOUTT), nullptr, 0, D, NLAT / 256, D / 256, 1};
        eng::EpiResidT<false> E{X, X, mod + (1 * 3) * 6 * D + 2 * D}; eng::gemm_phase(F.lds, g, E, F.G, c); }
    SEAM(14);
    if (IN(15)) ph_norm2_router(F, A, 1);
    SEAM(15);
    if (IN(16)) ph_topk(F, A);
    SEAM(16);
    if (IN(17)) MOE_GU(1)
    SEAM(17);
    if (IN(18)) MOE_DN(1)
    SEAM(18);
    if (IN(19)) ph_combine(F, A, 1);
#undef IN
#undef SEAM
#undef H
#undef X
#undef mod
#undef MOE_GU
#undef MOE_DN
}

extern "C" void kernel_launch(void* const* d_in, const int* in_sizes, int n_in, void* d_out, int out_size, void* d_ws, size_t ws_size, hipStream_t stream) {
    static int grid = 0;
    if (grid == 0) {
        if (n_in != 20 || in_sizes[0] != NLAT * D || out_size != NLAT * D || ws_size < WS_END) {
            fprintf(stderr, "kernel_launch: unexpected problem: n_in %d in0 %d out %d ws %zu (need %zu)\n", n_in, n_in > 0 ? in_sizes[0] : -1, out_size, ws_size, (size_t)WS_END); grid = -1; return; }
        int dev = 0, cus = 0, per_cu = 0;
        if (hipGetDevice(&dev) != hipSuccess || hipDeviceGetAttribute(&cus, hipDeviceAttributeMultiprocessorCount, dev) != hipSuccess) { grid = -1; return; }
        if (hipFuncSetAttribute((const void*)fwd_kernel, hipFuncAttributeMaxDynamicSharedMemorySize, LDS_BYTES) != hipSuccess) { fprintf(stderr, "kernel_launch: hipFuncSetAttribute failed\n"); grid = -1; return; }
        if (hipOccupancyMaxActiveBlocksPerMultiprocessor(&per_cu, (const void*)fwd_kernel, NTHR, LDS_BYTES) != hipSuccess || per_cu < 1) { fprintf(stderr, "kernel_launch: occupancy query says %d\n", per_cu); per_cu = 1; }
        (void)hipGetLastError();
        if (cus != 256) { fprintf(stderr, "kernel_launch: built for a 256-CU device (one workgroup per CU); found %d CUs\n", cus); grid = -1; return; }
        grid = cus;
    }
    if (grid < 0) return;
    Args a{};
    for (int i = 0; i < 20; ++i) a.in[i] = (const float*)d_in[i];
    a.out = (float*)d_out; a.ws = (unsigned char*)d_ws;
#if MK_MULTI
    for (int p = 0; p < N_PHASES; ++p) {
        a.ph_lo = p; a.ph_hi = p + 1;
        hipLaunchKernelGGL(fwd_kernel, dim3(grid), dim3(NTHR), LDS_BYTES, stream, a);
    }
#else
    if (hipMemsetAsync((char*)d_ws + WS_CTL, 0, 64 * 1024, stream) != hipSuccess) { fprintf(stderr, "kernel_launch: memset failed\n"); return; }
    a.ph_lo = 0; a.ph_hi = N_PHASES;
    void* kargs[] = {&a};
    hipError_t e = hipLaunchCooperativeKernel((const void*)fwd_kernel, dim3(grid), dim3(NTHR), kargs, LDS_BYTES, stream);
    if (e != hipSuccess) fprintf(stderr, "kernel_launch: cooperative launch failed: %s (grid %d)\n", hipGetErrorString(e), grid);
#endif
}
```

```cpp
#include <hip/hip_runtime.h>
#include <hip/hip_cooperative_groups.h>
#include <cstdio>
#include <cstdint>
namespace cg = cooperative_groups;

#ifndef MK_MULTI
#define MK_MULTI 0
#endif

#define LAS __attribute__((address_space(3)))
#define GAS __attribute__((address_space(1)))
typedef unsigned short bf16_t;
typedef short bf16x8 __attribute__((ext_vector_type(8)));
typedef float f32x4 __attribute__((ext_vector_type(4)));
typedef float f32x2 __attribute__((ext_vector_type(2)));
typedef unsigned u32x4 __attribute__((ext_vector_type(4)));
typedef unsigned u32x2 __attribute__((ext_vector_type(2)));
typedef int i32x4 __attribute__((ext_vector_type(4)));
typedef int i32x8 __attribute__((ext_vector_type(8)));

constexpr int D = 1024, NB = 2, T = 16384, NLAT = NB * T, CTXL = 256, NCTX = NB * CTXL, NROW = NLAT + NCTX;
constexpr int NE = 16, CAP = 2048, DEXP = 2048;
constexpr int HEADS = 4, HK = 128, HV = 256, DK = 512, DV = 1024, RANK = 16;
constexpr int NIN0 = 3104, NIN0P = 3328;
constexpr int NCIN = 3072;
constexpr float EPS = 1e-6f;
constexpr int NWAVES = 8, NTHR = 512;

constexpr size_t MiB = 1u << 20;
constexpr size_t WS_CTL = 0;
constexpr size_t WS_MOD = 1 * MiB;
constexpr size_t WS_WIN0T = 2 * MiB;
constexpr size_t WS_WOUT0T = 9 * MiB;
constexpr size_t WS_WCINT = 11 * MiB;
constexpr size_t WS_WCOUTT = 17 * MiB;
constexpr size_t WS_AFF = 19 * MiB;
constexpr size_t WS_SLOT = 21 * MiB;
constexpr size_t WS_ROWLIST = 23 * MiB;
constexpr size_t WS_SELVAL = 23 * MiB + 512 * 1024;
constexpr size_t WS_AFB = 24 * MiB;
constexpr size_t WS_W8 = 32 * MiB;
constexpr size_t W8_LAYER = 96 * MiB, W8_WD = 64 * MiB;
constexpr size_t WS_X = 224 * MiB;
constexpr size_t WS_H = 354 * MiB;
constexpr size_t WS_ARENA = 420 * MiB;
constexpr size_t WS_QK = WS_ARENA;
constexpr size_t WS_V = WS_ARENA + 65 * MiB;
constexpr size_t WS_R = WS_ARENA + 130 * MiB;
constexpr size_t WS_QP = WS_ARENA + 195 * MiB;
constexpr size_t WS_KP = WS_ARENA + 260 * MiB;
constexpr size_t WS_KTP = WS_ARENA + 325 * MiB;
constexpr size_t WS_VTP = WS_ARENA + 390 * MiB;
constexpr size_t WS_OI = WS_ARENA + 455 * MiB;
constexpr size_t WS_GAM = WS_ARENA + 519 * MiB;
constexpr size_t WS_OF = WS_QK;
constexpr size_t WS_OB = WS_V;
constexpr size_t WS_HID = WS_ARENA;
constexpr size_t WS_YE = WS_ARENA + 128 * MiB;
constexpr size_t WS_H2 = WS_ARENA;
constexpr size_t WS_CDUMP = WS_ARENA + 64 * MiB;
constexpr size_t WS_END = WS_ARENA + 522 * MiB;
static_assert(WS_R - WS_QK == 130 * MiB, "EpiProj0 strides");
constexpr size_t BLOB = 16384;
constexpr int NCHUNK = NROW / 64;

__device__ __forceinline__ float wave_sum(float v) {
#pragma unroll
    for (int o = 1; o < 64; o <<= 1) v += __shfl_xor(v, o);
    return v;
}
__device__ __forceinline__ int wave_sum_i(int v) {
#pragma unroll
    for (int o = 1; o < 64; o <<= 1) v += __shfl_xor(v, o);
    return v;
}
__device__ __forceinline__ unsigned f2bf(float f) { unsigned u = __builtin_bit_cast(unsigned, f); return (u + 0x7fffu + ((u >> 16) & 1u)) >> 16; }
typedef __bf16 bf16x2_t __attribute__((ext_vector_type(2)));
__device__ __forceinline__ unsigned pk2(float lo, float hi) { const f32x2 v = {lo, hi}; return __builtin_bit_cast(unsigned, __builtin_convertvector(v, bf16x2_t)); }
__device__ __forceinline__ float bflo(unsigned u) { return __builtin_bit_cast(float, u << 16); }
__device__ __forceinline__ float bfhi(unsigned u) { return __builtin_bit_cast(float, u & 0xffff0000u); }
__device__ __forceinline__ float silu_f(float x) { return x / (1.f + __expf(-x)); }
#define LDS_WAIT() asm volatile("s_waitcnt lgkmcnt(0)" ::: "memory")


#define XB_TMO      128
#define XB_XCNT(j)  (256  + 64 * (j))
#define XB_XSUB(j)  (1280 + 64 * (j))
#define XB_XGEN(j)  (2304 + 64 * (j))
#define XB_TOP      3328
#define XB_TOPGEN   3392
#define XCD_BAR_WORDS 3456
#define XB_SPIN_CAP (1u << 22)
__device__ __forceinline__ unsigned xb_ld(unsigned* p)              { return __hip_atomic_load(p, __ATOMIC_RELAXED, __HIP_MEMORY_SCOPE_AGENT); }
__device__ __forceinline__ unsigned xb_add(unsigned* p, unsigned v) { return __hip_atomic_fetch_add(p, v, __ATOMIC_RELAXED, __HIP_MEMORY_SCOPE_AGENT); }
__device__ __forceinline__ unsigned xb_xcc_id() { return (unsigned)__builtin_amdgcn_s_getreg((3 << 11) | 20) & 0xFu; }
#define XB_SPIN(cond, bar) do { unsigned _sp = 0; while (cond) { \
    if ((++_sp & 255u) == 0u) { if (xb_ld(&(bar)[XB_TMO])) break; if (_sp > XB_SPIN_CAP) { atomicAdd(&(bar)[XB_TMO], 1u); break; } } } } while (0)
struct XcdBarrier { unsigned* bar; unsigned x; volatile LAS unsigned* st; };
__device__ __forceinline__ XcdBarrier xcd_barrier_post(unsigned* bar, volatile LAS unsigned* st) {
    XcdBarrier b; b.bar = bar; b.x = xb_xcc_id(); b.st = st;
    if (threadIdx.x == 0) (void)xb_add(&bar[XB_XCNT(b.x)], 1u);
    return b;
}
__device__ __forceinline__ void xcd_barrier_complete(unsigned* bar, unsigned x, unsigned& nloc, unsigned& nx) {
    const unsigned G = gridDim.x * gridDim.y * gridDim.z;
    unsigned sum, cnt, mine, sp = 0u;
    for (;;) {
        sum = 0u; cnt = 0u; mine = 0u;
#pragma unroll
        for (unsigned j = 0; j < 16; ++j) { const unsigned c = xb_ld(&bar[XB_XCNT(j)]); sum += c; cnt += (c > 0u) ? 1u : 0u; mine = (j == x) ? c : mine; }
        if (sum == G) break;
        __builtin_amdgcn_s_sleep(1);
        if ((++sp & 255u) == 0u) { if (xb_ld(&bar[XB_TMO])) break; if (sp > XB_SPIN_CAP) { atomicAdd(&bar[XB_TMO], 1u); break; } }
    }
    nloc = mine > 0u ? mine : 1u; nx = cnt > 0u ? cnt : 1u;
}
__device__ __forceinline__ void xcd_barrier(const XcdBarrier& b) {
    asm volatile("s_waitcnt vmcnt(0)" ::: "memory");
    __syncthreads();
    if (threadIdx.x == 0) {
        unsigned* bar = b.bar;
        __builtin_amdgcn_s_waitcnt(0);
        unsigned nloc = b.st[0], nx = b.st[1];
        if (nloc == 0u) { xcd_barrier_complete(bar, b.x, nloc, nx); b.st[0] = nloc; b.st[1] = nx; }
        const unsigned old = xb_add(&bar[XB_XSUB(b.x)], 1u);
        const unsigned gen = old / nloc;
        if (old + 1u == (gen + 1u) * nloc) {
            __builtin_amdgcn_fence(__ATOMIC_RELEASE, "agent");
            asm volatile("s_waitcnt vmcnt(0)" ::: "memory");
            const unsigned og = xb_add(&bar[XB_TOP], 1u);
            const unsigned tg = og / nx;
            __builtin_amdgcn_fence(__ATOMIC_ACQUIRE, "agent");
            if (og + 1u == (tg + 1u) * nx) xb_add(&bar[XB_TOPGEN], 1u);
            else XB_SPIN(xb_ld(&bar[XB_TOPGEN]) == tg, bar);
            xb_add(&bar[XB_XGEN(b.x)], 1u);
            asm volatile("s_waitcnt vmcnt(0)" ::: "memory");
        } else {
            __builtin_amdgcn_fence(__ATOMIC_ACQUIRE, "agent");
            XB_SPIN(xb_ld(&bar[XB_XGEN(b.x)]) == gen, bar);
            asm volatile("s_waitcnt vmcnt(0)" ::: "memory");
        }
    }
    __syncthreads();
}

namespace eng {
constexpr int BM = 256, BK = 64, HALF = 128, HTB = HALF * BK * 2, STAGE_BYTES = 8 * HTB, NXCD = 8, WGM = 8;
__host__ __device__ __forceinline__ int lds_byte(int r, int c) { const int st = (r >> 4) * 2 + (c >> 5), rr = r & 15, cc = c & 31, ob = rr * 64 + cc * 2; return st * 1024 + (ob ^ (((ob >> 9) & 1) << 5)); }
__host__ __device__ __forceinline__ void stage_rc(int b, int& R, int& C) { const int st = b / 1024, sb = b % 1024, swz = sb ^ (((sb >> 9) & 1) << 5); R = (st >> 1) * 16 + swz / 64; C = (st & 1) * 32 + (swz % 64) / 2; }
__host__ __device__ __forceinline__ int perm32(int rho) { const int n = rho >> 4, i = rho & 15; return 8 * (i >> 2) + 4 * n + (i & 3); }

struct Unit { int e, pm, pn; };
struct Gemm {
    const char* A;
    const char* Bt;
    const int* rows;
    size_t bstride;
    int K, nM, nN, ngroups;
    int rev = 0;
    int trip = 0;
};
__device__ __forceinline__ bool next_unit(const Gemm& g, int i, int G, int c, Unit& u) {
    if (g.trip) {
        const int per3 = g.nM * (g.nN / 3), j = i / 3, sec = i - 3 * j; int s = j * G + c; if (s >= per3) return false;
        { const int q = per3 / NXCD, r = per3 % NXCD, xcd = s % NXCD, off = s / NXCD; s = (xcd < r ? xcd * (q + 1) : r * (q + 1) + (xcd - r) * q) + off; }
        const int ncb = g.nN / 3; u.e = 0; u.pm = s / ncb; u.pn = 3 * (s % ncb) + sec; return true;
    }
    const int per = g.nM * g.nN;
    const long L = (long)i * G + c; if (L >= (long)per * g.ngroups) return false;
    u.e = (int)(L / per); int wgid = (int)(L % per);
    if (g.rev) u.e = g.ngroups - 1 - u.e;
    { const int nwg = per, q = nwg / NXCD, r = nwg % NXCD, xcd = wgid % NXCD, off = wgid / NXCD; wgid = (xcd < r ? xcd * (q + 1) : r * (q + 1) + (xcd - r) * q) + off; }
    const int nig = WGM * g.nN, gid = wgid / nig, fm = gid * WGM, gsz = (g.nM - fm) < WGM ? (g.nM - fm) : WGM;
    u.pm = fm + ((wgid % nig) % gsz); u.pn = (wgid % nig) / gsz; return true;
}
__device__ __forceinline__ bf16x8 lo8(const i32x8& f) { return __builtin_bit_cast(bf16x8, (i32x4)__builtin_shufflevector(f, f, 0, 1, 2, 3)); }
__device__ __forceinline__ bf16x8 hi8(const i32x8& f) { return __builtin_bit_cast(bf16x8, (i32x4)__builtin_shufflevector(f, f, 4, 5, 6, 7)); }
__device__ __forceinline__ i32x8 cat8(bf16x8 lo, bf16x8 hi) { const i32x4 a = __builtin_bit_cast(i32x4, lo), b = __builtin_bit_cast(i32x4, hi); return __builtin_shufflevector(a, b, 0, 1, 2, 3, 4, 5, 6, 7); }
__device__ __forceinline__ unsigned cvt_pk_bf16(float lo, float hi) { unsigned r; asm volatile("v_cvt_pk_bf16_f32 %0, %1, %2" : "=v"(r) : "v"(lo), "v"(hi)); return r; }

#ifndef ENG_SP2
#define ENG_SP2 true
#endif
#ifndef ENG_ALIGN
#define ENG_ALIGN true
#endif
template <class Epi, bool SP2 = ENG_SP2, bool ALIGN_EPI = ENG_ALIGN>
__device__ __forceinline__ void gemm_phase(LAS unsigned char* lds, const Gemm g, const Epi& E, int G, int c) {
    int tid = threadIdx.x; asm volatile("" : "+v"(tid));
    const int wid = __builtin_amdgcn_readfirstlane(tid >> 6), lane = tid & 63, wr = wid >> 2, wc = wid & 3, fr = lane & 15, fq = lane >> 4;
    const int K = g.K, nt = K / BK;
    int R0, C0; stage_rc(tid * 16, R0, C0);
    const int Rb0 = Epi::PERM ? ((R0 & ~31) + perm32(R0 & 31)) : R0;
    unsigned voffB[2]; voffB[0] = (unsigned)(Rb0 * K + C0) * 2u; voffB[1] = (unsigned)((Rb0 + 64) * K + C0) * 2u;
    constexpr bool SW = Epi::SWAPV;
    const char* const abase = SW ? g.Bt : g.A;
    const unsigned adelta = SW ? (unsigned)(size_t)(g.A - g.Bt) : 0u;
    const unsigned dltB = SW ? (unsigned)((R0 - Rb0) * K) * 2u : 0u;
    const size_t hstepB = (size_t)HALF * K * 2;
    const unsigned ldsw = (unsigned)wid * 1024u;
    const int aoff = lds_byte(wr * 64 + fr, fq * 8), boff = lds_byte(wc * 32 + fr, fq * 8);
#define PG8_SA(b, h) (((b) * 2 + (h)) * HTB)
#define PG8_SB(b, h) ((4 + (b) * 2 + (h)) * HTB)
#define PG8_GLDS(gp, bufoff, i) __builtin_amdgcn_global_load_lds((const unsigned*)(gp), (LAS unsigned*)(lds + (bufoff) + ldsw + (i) * 8192), 16, 0, 0)
#define PG8_STAGE_B(bufoff, bp, h, kt) do { const char* _p = (bp) + (size_t)(h) * hstepB + (size_t)(kt) * 128; asm volatile("" : "+s"(_p)); PG8_GLDS(_p + (voffB[0] + (SW ? dselB : 0u)), bufoff, 0); PG8_GLDS(_p + (voffB[1] + (SW ? dselB : 0u)), bufoff, 1); } while (0)
#define PG8_STAGE_A(bufoff, v0, v1, kt) do { const char* _p = abase + (size_t)(kt) * 128; asm volatile("" : "+s"(_p)); PG8_GLDS(_p + (v0), bufoff, 0); PG8_GLDS(_p + (v1), bufoff, 1); } while (0)
#define PG8_LDA(dst, b, h) do { _Pragma("unroll") for (int m = 0; m < 4; ++m) dst[m] = cat8(*(const LAS bf16x8*)(lds + PG8_SA(b, h) + aoff + m * 2048), *(const LAS bf16x8*)(lds + PG8_SA(b, h) + aoff + m * 2048 + 1024)); } while (0)
#define PG8_LDB(dst, b, h) do { _Pragma("unroll") for (int n = 0; n < 2; ++n) dst[n] = cat8(*(const LAS bf16x8*)(lds + PG8_SB(b, h) + boff + n * 2048), *(const LAS bf16x8*)(lds + PG8_SB(b, h) + boff + n * 2048 + 1024)); } while (0)
#define PG8_MMA(ai, bj, At, Bt) do { __builtin_amdgcn_s_setprio(1); \
        if constexpr (Epi::FP8) { _Pragma("unroll") for (int m = 0; m < 4; ++m) _Pragma("unroll") for (int n = 0; n < 2; ++n) \
            asm volatile("v_mfma_scale_f32_16x16x128_f8f6f4 %0, %1, %2, %0, %3, %4 op_sel_hi:[0,0,0]" : "+v"(acc[ai][bj][m][n]) : "v"(Bt[n]), "v"(At[m]), "v"(sc_w), "v"(sc_a)); } \
        else { _Pragma("unroll") for (int m = 0; m < 4; ++m) _Pragma("unroll") for (int n = 0; n < 2; ++n) { \
            acc[ai][bj][m][n] = __builtin_amdgcn_mfma_f32_16x16x32_bf16(lo8(Bt[n]), lo8(At[m]), acc[ai][bj][m][n], 0, 0, 0); \
            acc[ai][bj][m][n] = __builtin_amdgcn_mfma_f32_16x16x32_bf16(hi8(Bt[n]), hi8(At[m]), acc[ai][bj][m][n], 0, 0, 0); } } \
        __builtin_amdgcn_s_setprio(0); } while (0)
#define PG8_WAIT_V(n) asm volatile("s_waitcnt vmcnt(" #n ")" ::: "memory")
#define PG8_WAIT_L(n) asm volatile("s_waitcnt lgkmcnt(" #n ")" ::: "memory")
#define PG8_BAR __builtin_amdgcn_s_barrier()
#define PG8_SCHED __builtin_amdgcn_sched_barrier(0)
#define PG8_ROWOFF(u, h, i) ((SW && E.swapv(u)) ? (unsigned)(((u).pn * 256 + (h) * 128 + R0 + 64 * (i)) * K + C0) * 2u : adelta + ((unsigned)(((g.rows ? g.rows[((u).e * g.nM + (u).pm) * 256 + (h) * 128 + R0 + 64 * (i)] : (((u).e * g.nM + (u).pm) * 256 + (h) * 128 + R0 + 64 * (i))) * K + C0)) * 2u))
#define PG8_BPTR(u) ((SW && E.swapv(u)) ? g.A + (size_t)(u).pm * 2 * hstepB : g.Bt + (size_t)(u).e * g.bstride + (size_t)(u).pn * 2 * hstepB)
    Unit cur, nxt; int ui = 0;
    if (!next_unit(g, 0, G, c, cur)) return;
    f32x4 acc[2][2][4][2];
#pragma unroll
    for (int a = 0; a < 2; ++a)
#pragma unroll
        for (int b = 0; b < 2; ++b)
#pragma unroll
            for (int m = 0; m < 4; ++m)
#pragma unroll
                for (int n = 0; n < 2; ++n) acc[a][b][m][n] = (f32x4){0.f, 0.f, 0.f, 0.f};
    int sc_w = E.scale_w, sc_a = E.scale_a;
    asm volatile("" : "+v"(sc_w), "+v"(sc_a));
    i32x8 At[4], B0[2], B1[2];
    unsigned c00 = PG8_ROWOFF(cur, 0, 0), c01 = PG8_ROWOFF(cur, 0, 1), c10 = PG8_ROWOFF(cur, 1, 0), c11 = PG8_ROWOFF(cur, 1, 1);
    const char* cB = PG8_BPTR(cur);
    unsigned cD = (SW && E.swapv(cur)) ? dltB : 0u, dselB = cD;
    if constexpr (SP2) {
        PG8_STAGE_B(PG8_SB(0, 0), cB, 0, 0); PG8_STAGE_B(PG8_SB(0, 1), cB, 1, 0); PG8_STAGE_A(PG8_SA(0, 0), c00, c01, 0); PG8_STAGE_A(PG8_SA(0, 1), c10, c11, 0);
        if (wr == 1) PG8_BAR;
        PG8_WAIT_V(2); PG8_BAR;
        PG8_STAGE_B(PG8_SB(1, 0), cB, 0, 1); PG8_STAGE_A(PG8_SA(1, 0), c00, c01, 1); PG8_STAGE_B(PG8_SB(1, 1), cB, 1, 1);
        PG8_WAIT_V(6); PG8_BAR;
    } else {
        PG8_STAGE_B(PG8_SB(0, 0), cB, 0, 0); PG8_STAGE_A(PG8_SA(0, 0), c00, c01, 0); PG8_STAGE_B(PG8_SB(0, 1), cB, 1, 0); PG8_STAGE_A(PG8_SA(0, 1), c10, c11, 0);
        if (wr == 1) PG8_BAR;
        PG8_WAIT_V(4); PG8_BAR;
        PG8_STAGE_B(PG8_SB(1, 0), cB, 0, 1); PG8_STAGE_A(PG8_SA(1, 0), c00, c01, 1); PG8_STAGE_B(PG8_SB(1, 1), cB, 1, 1);
        PG8_WAIT_V(6); PG8_BAR;
    }
    for (;;) {
        const bool has_next = next_unit(g, ui + 1, G, c, nxt);
        unsigned n00 = c00, n01 = c01, n10 = c10, n11 = c11; const char* nB = cB; unsigned nD = cD;
        if (has_next) { n00 = PG8_ROWOFF(nxt, 0, 0); n01 = PG8_ROWOFF(nxt, 0, 1); n10 = PG8_ROWOFF(nxt, 1, 0); n11 = PG8_ROWOFF(nxt, 1, 1);
                        nB = PG8_BPTR(nxt); nD = (SW && E.swapv(nxt)) ? dltB : 0u; }
#pragma unroll 1
        for (int t = 0; t < nt; t += 2) {
            const bool last = (t == nt - 2);
            const int kt2 = last ? 0 : t + 2, kt3 = kt2 + 1;
            const char* b2 = last ? nB : cB; dselB = last ? nD : cD;
            const unsigned s00 = last ? n00 : c00, s01 = last ? n01 : c01, s10 = last ? n10 : c10, s11 = last ? n11 : c11;
            if constexpr (SP2) {
            PG8_LDB(B0, 0, 0); PG8_LDB(B1, 0, 1); PG8_SCHED; PG8_LDA(At, 0, 0); PG8_STAGE_A(PG8_SA(1, 1), c10, c11, t + 1);
            PG8_WAIT_V(8); PG8_WAIT_L(0); PG8_BAR; PG8_MMA(0, 0, At, B0); PG8_MMA(0, 1, At, B1); PG8_BAR; PG8_SCHED;
            PG8_LDA(At, 0, 1); PG8_STAGE_B(PG8_SB(0, 0), b2, 0, kt2); PG8_STAGE_B(PG8_SB(0, 1), b2, 1, kt2); PG8_STAGE_A(PG8_SA(0, 0), s00, s01, kt2);
            PG8_WAIT_V(8); PG8_WAIT_L(0); PG8_BAR; PG8_MMA(1, 0, At, B0); PG8_MMA(1, 1, At, B1); PG8_BAR; PG8_SCHED;
            PG8_LDB(B0, 1, 0); PG8_LDB(B1, 1, 1); PG8_SCHED; PG8_LDA(At, 1, 0); PG8_STAGE_A(PG8_SA(0, 1), s10, s11, kt2);
            PG8_WAIT_V(8); PG8_WAIT_L(0); PG8_BAR; PG8_MMA(0, 0, At, B0); PG8_MMA(0, 1, At, B1); PG8_BAR; PG8_SCHED;
            PG8_LDA(At, 1, 1); PG8_STAGE_B(PG8_SB(1, 0), b2, 0, kt3); PG8_STAGE_B(PG8_SB(1, 1), b2, 1, kt3); PG8_STAGE_A(PG8_SA(1, 0), s00, s01, kt3);
            PG8_WAIT_V(8); PG8_WAIT_L(0); PG8_BAR; PG8_MMA(1, 0, At, B0); PG8_MMA(1, 1, At, B1); PG8_BAR; PG8_SCHED;
            } else {
            PG8_LDB(B0, 0, 0); PG8_SCHED; PG8_LDA(At, 0, 0); PG8_STAGE_A(PG8_SA(1, 1), c10, c11, t + 1);
            PG8_WAIT_L(8); PG8_BAR; PG8_WAIT_L(0); PG8_MMA(0, 0, At, B0); PG8_BAR; PG8_SCHED;
            PG8_LDB(B1, 0, 1); PG8_STAGE_B(PG8_SB(0, 0), b2, 0, kt2);
            PG8_BAR; PG8_WAIT_L(0); PG8_MMA(0, 1, At, B1); PG8_BAR;
            PG8_LDA(At, 0, 1); PG8_STAGE_A(PG8_SA(0, 0), s00, s01, kt2);
            PG8_BAR; PG8_WAIT_L(0); PG8_MMA(1, 0, At, B0); PG8_BAR; PG8_SCHED;
            PG8_STAGE_B(PG8_SB(0, 1), b2, 1, kt2);
            PG8_WAIT_V(6); PG8_BAR; PG8_MMA(1, 1, At, B1); PG8_BAR;
            PG8_LDB(B0, 1, 0); PG8_SCHED; PG8_LDA(At, 1, 0); PG8_STAGE_A(PG8_SA(0, 1), s10, s11, kt2);
            PG8_WAIT_L(8); PG8_BAR; PG8_WAIT_L(0); PG8_MMA(0, 0, At, B0); PG8_BAR; PG8_SCHED;
            PG8_LDB(B1, 1, 1); PG8_STAGE_B(PG8_SB(1, 0), b2, 0, kt3);
            PG8_BAR; PG8_WAIT_L(0); PG8_MMA(0, 1, At, B1); PG8_BAR;
            PG8_LDA(At, 1, 1); PG8_STAGE_A(PG8_SA(1, 0), s00, s01, kt3);
            PG8_BAR; PG8_WAIT_L(0); PG8_MMA(1, 0, At, B0); PG8_BAR; PG8_SCHED;
            PG8_STAGE_B(PG8_SB(1, 1), b2, 1, kt3);
            PG8_WAIT_V(6); PG8_BAR; PG8_MMA(1, 1, At, B1); PG8_BAR;
            }
        }
        if constexpr (Epi::FP8) {
            _Pragma("unroll") for (int a = 0; a < 2; ++a)
                asm volatile("s_nop 15\n\ts_nop 15" : "+v"(acc[a][0][0][0]), "+v"(acc[a][0][0][1]), "+v"(acc[a][0][1][0]), "+v"(acc[a][0][1][1]), "+v"(acc[a][0][2][0]), "+v"(acc[a][0][2][1]), "+v"(acc[a][0][3][0]), "+v"(acc[a][0][3][1]),
                             "+v"(acc[a][1][0][0]), "+v"(acc[a][1][0][1]), "+v"(acc[a][1][1][0]), "+v"(acc[a][1][1][1]), "+v"(acc[a][1][2][0]), "+v"(acc[a][1][2][1]), "+v"(acc[a][1][3][0]), "+v"(acc[a][1][3][1]));
        }
        if constexpr (ALIGN_EPI) { if (wr == 0) PG8_BAR; }
        E(acc, cur, wr, wc, fr, fq);
        if (!has_next) break;
#pragma unroll
        for (int a = 0; a < 2; ++a)
#pragma unroll
            for (int b = 0; b < 2; ++b)
#pragma unroll
                for (int m = 0; m < 4; ++m)
#pragma unroll
                    for (int n = 0; n < 2; ++n) acc[a][b][m][n] = (f32x4){0.f, 0.f, 0.f, 0.f};
        cur = nxt; cB = nB; cD = nD; c00 = n00; c01 = n01; c10 = n10; c11 = n11; ++ui;
        if constexpr (ALIGN_EPI) { if (wr == 1) PG8_BAR; }
    }
    PG8_WAIT_V(0);
    if constexpr (!ALIGN_EPI) { if (wr == 0) PG8_BAR; }
    PG8_BAR;
#undef PG8_SA
#undef PG8_SB
#undef PG8_GLDS
#undef PG8_STAGE_A
#undef PG8_STAGE_B
#undef PG8_LDA
#undef PG8_LDB
#undef PG8_MMA
#undef PG8_WAIT_V
#undef PG8_WAIT_L
#undef PG8_BAR
#undef PG8_SCHED
#undef PG8_ROWOFF
#undef PG8_BPTR
}

struct EpiProj0 {
    static constexpr bool FP8 = false; static constexpr int scale_w = 0, scale_a = 0;
    static constexpr bool PERM = true; static constexpr bool SWAPV = true;
    __device__ __forceinline__ bool swapv(const Unit& u) const { return u.pn >= 4 && u.pn < 8; }
    bf16_t* qk; unsigned char* vtp; bf16_t* r; float* afb;
    __device__ __forceinline__ void operator()(const f32x4 (&acc)[2][2][4][2], const Unit& u, int wr, int wc, int fr, int fq) const {
        const int row0 = u.pm * BM + wr * 64 + fr;
        if (swapv(u)) {
            unsigned char* p0 = vtp + (size_t)(4 * u.pm + (wc >> 1)) * 131072 + (size_t)((((16 * (u.pn - 4) + 4 * wr) * 2 + (wc & 1)) * 64 + fr + 16 * fq) * 16);
#pragma unroll
            for (int ai = 0; ai < 2; ++ai)
#pragma unroll
                for (int m = 0; m < 4; ++m)
#pragma unroll
                    for (int bj = 0; bj < 2; ++bj) { const f32x4 v0 = acc[ai][bj][m][0], v1 = acc[ai][bj][m][1];
                        u32x4 w; w.x = cvt_pk_bf16(v0[0], v0[1]); w.y = cvt_pk_bf16(v0[2], v0[3]); w.z = cvt_pk_bf16(v1[0], v1[1]); w.w = cvt_pk_bf16(v1[2], v1[3]);
                        *(u32x4*)(p0 + (size_t)bj * 2 * 131072 + (size_t)(8 * ai + m) * 2048) = w; }
        } else if (u.pn < 12) {
            const float sc = (u.pn < 2) ? 0.08838834764831845f : 1.f;
            bf16_t* base = qk + (size_t)(u.pn >> 3) * (size_t)(130 * MiB / 2);
            const int col0 = (u.pn & 3) * BM + wc * 32 + 8 * fq;
#pragma unroll
            for (int ai = 0; ai < 2; ++ai)
#pragma unroll
                for (int m = 0; m < 4; ++m) { bf16_t* rowp = base + (size_t)(row0 + ai * HALF + m * 16) * D + col0;
#pragma unroll
                    for (int bj = 0; bj < 2; ++bj) { const f32x4 v0 = acc[ai][bj][m][0] * sc, v1 = acc[ai][bj][m][1] * sc;
                        u32x4 w; w.x = cvt_pk_bf16(v0[0], v0[1]); w.y = cvt_pk_bf16(v0[2], v0[3]); w.z = cvt_pk_bf16(v1[0], v1[1]); w.w = cvt_pk_bf16(v1[2], v1[3]);
                        *(u32x4*)(rowp + bj * HALF) = w; } }
        } else if (wc == 0) {
#pragma unroll
            for (int ai = 0; ai < 2; ++ai)
#pragma unroll
                for (int m = 0; m < 4; ++m) { float* rowp = afb + (size_t)(row0 + ai * HALF + m * 16) * 32 + 8 * fq;
                    *(f32x4*)(rowp) = acc[ai][0][m][0]; *(f32x4*)(rowp + 4) = acc[ai][0][m][1]; }
        }
    }
};
template <bool SRC_F32>
struct EpiResidT {
    static constexpr bool FP8 = false; static constexpr int scale_w = 0, scale_a = 0;
    static constexpr bool PERM = true; static constexpr bool SWAPV = false; __device__ __forceinline__ bool swapv(const Unit&) const { return false; }
    const void* src; bf16_t* dst; const float* gate;
    __device__ __forceinline__ void operator()(const f32x4 (&acc)[2][2][4][2], const Unit& u, int wr, int wc, int fr, int fq) const {
        const int row0 = u.pm * BM + wr * 64 + fr, col0 = u.pn * BM + wc * 32 + 8 * fq;
        const int b = (u.pm * BM) >> 14;
        f32x4 gv[2][2];
#pragma unroll
        for (int bj = 0; bj < 2; ++bj)
#pragma unroll
            for (int n = 0; n < 2; ++n) gv[bj][n] = *(const f32x4*)(gate + (size_t)b * 6 * D + col0 + bj * HALF + n * 4);
#pragma unroll
        for (int ai = 0; ai < 2; ++ai) {
            f32x4 sv[4][2][2];
#pragma unroll
            for (int m = 0; m < 4; ++m)
#pragma unroll
                for (int bj = 0; bj < 2; ++bj) { const size_t off = (size_t)(row0 + ai * HALF + m * 16) * D + col0 + bj * HALF;
                    if constexpr (SRC_F32) { sv[m][bj][0] = *(const f32x4*)((const float*)src + off); sv[m][bj][1] = *(const f32x4*)((const float*)src + off + 4); }
                    else { const u32x4 t = *(const u32x4*)((const bf16_t*)src + off);
                        sv[m][bj][0] = (f32x4){bflo(t.x), bfhi(t.x), bflo(t.y), bfhi(t.y)}; sv[m][bj][1] = (f32x4){bflo(t.z), bfhi(t.z), bflo(t.w), bfhi(t.w)}; } }
            asm volatile("" ::: "memory");
#pragma unroll
            for (int m = 0; m < 4; ++m)
#pragma unroll
                for (int bj = 0; bj < 2; ++bj) { const f32x4 y0 = sv[m][bj][0] + gv[bj][0] * acc[ai][bj][m][0], y1 = sv[m][bj][1] + gv[bj][1] * acc[ai][bj][m][1];
                    u32x4 w; w.x = cvt_pk_bf16(y0[0], y0[1]); w.y = cvt_pk_bf16(y0[2], y0[3]); w.z = cvt_pk_bf16(y1[0], y1[1]); w.w = cvt_pk_bf16(y1[2], y1[3]);
                    *(u32x4*)(dst + (size_t)(row0 + ai * HALF + m * 16) * D + col0 + bj * HALF) = w; }
        }
    }
};
struct EpiBf16Plain {
    static constexpr bool FP8 = false; static constexpr int scale_w = 0, scale_a = 0;
    static constexpr bool PERM = true; static constexpr bool SWAPV = false; __device__ __forceinline__ bool swapv(const Unit&) const { return false; }
    bf16_t* O; int ldc;
    __device__ __forceinline__ void operator()(const f32x4 (&acc)[2][2][4][2], const Unit& u, int wr, int wc, int fr, int fq) const {
        const int row0 = u.pm * BM + wr * 64 + fr, col0 = u.pn * BM + wc * 32 + 8 * fq;
#pragma unroll
        for (int ai = 0; ai < 2; ++ai)
#pragma unroll
            for (int m = 0; m < 4; ++m) { bf16_t* rowp = O + (size_t)(row0 + ai * HALF + m * 16) * ldc + col0;
#pragma unroll
                for (int bj = 0; bj < 2; ++bj) { const f32x4 v0 = acc[ai][bj][m][0], v1 = acc[ai][bj][m][1];
                    u32x4 w; w.x = cvt_pk_bf16(v0[0], v0[1]); w.y = cvt_pk_bf16(v0[2], v0[3]); w.z = cvt_pk_bf16(v1[0], v1[1]); w.w = cvt_pk_bf16(v1[2], v1[3]);
                    *(u32x4*)(rowp + bj * HALF) = w; } }
    }
};
__device__ __forceinline__ float dpp_shr1(float oldv, float x) { return __builtin_bit_cast(float, __builtin_amdgcn_update_dpp(__builtin_bit_cast(int, oldv), __builtin_bit_cast(int, x), 0x111, 0xF, 0xF, false)); }
__device__ __forceinline__ float dpp_shl1(float oldv, float x) { return __builtin_bit_cast(float, __builtin_amdgcn_update_dpp(__builtin_bit_cast(int, oldv), __builtin_bit_cast(int, x), 0x101, 0xF, 0xF, false)); }
__device__ __forceinline__ float dpp_ror1(float x) { return __builtin_bit_cast(float, __builtin_amdgcn_update_dpp(0, __builtin_bit_cast(int, x), 0x121, 0xF, 0xF, false)); }
__device__ __forceinline__ float dpp_rol1(float x) { return __builtin_bit_cast(float, __builtin_amdgcn_update_dpp(0, __builtin_bit_cast(int, x), 0x12F, 0xF, 0xF, false)); }
struct EpiConvFused {
    static constexpr bool FP8 = false; static constexpr int scale_w = 0, scale_a = 0;
    static constexpr bool PERM = true; static constexpr bool SWAPV = false; __device__ __forceinline__ bool swapv(const Unit&) const { return false; }
    unsigned char* dump;
    bf16_t* O; const float* ck;
    __device__ __forceinline__ void operator()(const f32x4 (&acc)[2][2][4][2], const Unit& u, int wr, int wc, int fr, int fq) const {
        const int cb = u.pn / 3, sec = u.pn - 3 * cb, tid = threadIdx.x;
        if (sec < 2) {
            const int cc = 256 * cb + 128 * sec + wc * 32 + 8 * fq;
            unsigned char* dp = dump + (size_t)sec * 65536 + tid * 16;
#pragma unroll
            for (int n = 0; n < 2; ++n) {
                const f32x4 k0 = *(const f32x4*)(ck + cc + 4 * n), k1 = *(const f32x4*)(ck + D + cc + 4 * n), k2 = *(const f32x4*)(ck + 2 * D + cc + 4 * n);
#pragma unroll
                for (int ai = 0; ai < 2; ++ai) {
                    f32x4 y[4];
#pragma unroll
                    for (int j = 0; j < 4; ++j) {
                        float x[4];
#pragma unroll
                        for (int m = 0; m < 4; ++m) x[m] = acc[ai][0][m][n][j] * acc[ai][1][m][n][j];
#pragma unroll
                        for (int m = 0; m < 4; ++m) {
                            const float up = dpp_shr1(m > 0 ? dpp_ror1(x[m - 1]) : 0.f, x[m]);
                            const float dn = dpp_shl1(m < 3 ? dpp_rol1(x[m + 1]) : 0.f, x[m]);
                            y[m][j] = k0[j] * up + k1[j] * x[m] + k2[j] * dn; }
                    }
#pragma unroll
                    for (int m = 0; m < 4; ++m) { u32x2 w; w.x = cvt_pk_bf16(y[m][0], y[m][1]); w.y = cvt_pk_bf16(y[m][2], y[m][3]);
                        *(u32x2*)(dp + (ai * 4 + m) * 8192 + n * 8) = w; }
                }
            }
        } else {
            const int row0 = u.pm * BM + wr * 64 + fr, col0 = 256 * cb + wc * 32 + 8 * fq;
            const unsigned loff = (unsigned)tid * 16u;
#pragma unroll
            for (int ai = 0; ai < 2; ++ai)
#pragma unroll
                for (int m = 0; m < 4; ++m) {
                    bf16_t* rowp = O + (size_t)(row0 + ai * HALF + m * 16) * D + col0;
                    const unsigned char* sb = dump + (ai * 4 + m) * 8192; asm volatile("" : "+s"(sb));
                    const u32x4 q0 = *(const u32x4*)(sb + loff), q1 = *(const u32x4*)(sb + 65536 + loff);
#pragma unroll
                    for (int bj = 0; bj < 2; ++bj) { const f32x4 v0 = acc[ai][bj][m][0], v1 = acc[ai][bj][m][1]; const u32x4 q = bj ? q1 : q0;
                        u32x4 w; w.x = cvt_pk_bf16(v0[0] * bflo(q.x), v0[1] * bfhi(q.x)); w.y = cvt_pk_bf16(v0[2] * bflo(q.y), v0[3] * bfhi(q.y));
                        w.z = cvt_pk_bf16(v1[0] * bflo(q.z), v1[1] * bfhi(q.z)); w.w = cvt_pk_bf16(v1[2] * bflo(q.w), v1[3] * bfhi(q.w));
                        *(u32x4*)(rowp + bj * HALF) = w; }
                    asm volatile("" ::: "memory");
                }
        }
    }
};
struct EpiSwiglu {
    static constexpr bool FP8 = true; int scale_w, scale_a;
    static constexpr bool PERM = true; static constexpr bool SWAPV = false; __device__ __forceinline__ bool swapv(const Unit&) const { return false; }
    unsigned char* hid;
    __device__ __forceinline__ void operator()(const f32x4 (&acc)[2][2][4][2], const Unit& u, int wr, int wc, int fr, int fq) const {
        const int row0 = u.e * 4096 + u.pm * BM + wr * 64 + fr, col0 = u.pn * HALF + wc * 32 + 8 * fq;
#pragma unroll
        for (int ai = 0; ai < 2; ++ai)
#pragma unroll
            for (int m = 0; m < 4; ++m) { unsigned char* rowp = hid + (size_t)(row0 + ai * HALF + m * 16) * DEXP + col0;
                float h[8];
#pragma unroll
                for (int n = 0; n < 2; ++n)
#pragma unroll
                    for (int j2 = 0; j2 < 2; ++j2) {
                        const f32x2 gt = {acc[ai][0][m][n][2 * j2], acc[ai][0][m][n][2 * j2 + 1]}, up = {acc[ai][1][m][n][2 * j2], acc[ai][1][m][n][2 * j2 + 1]};
                        const f32x2 a = gt * (f32x2){-1.4426950408889634f, -1.4426950408889634f};
                        f32x2 t; t.x = __builtin_amdgcn_exp2f(a.x); t.y = __builtin_amdgcn_exp2f(a.y);
                        const f32x2 d4 = t * (f32x2){0.25f, 0.25f} + (f32x2){0.25f, 0.25f};
                        f32x2 r4; r4.x = __builtin_amdgcn_rcpf(d4.x); r4.y = __builtin_amdgcn_rcpf(d4.y);
                        const f32x2 hv = (gt * up) * r4;
                        h[n * 4 + 2 * j2] = __builtin_amdgcn_fmed3f(hv.x, -448.f, 448.f); h[n * 4 + 2 * j2 + 1] = __builtin_amdgcn_fmed3f(hv.y, -448.f, 448.f); }
                int w0 = __builtin_amdgcn_cvt_pk_fp8_f32(h[0], h[1], 0, false); w0 = __builtin_amdgcn_cvt_pk_fp8_f32(h[2], h[3], w0, true);
                int w1 = __builtin_amdgcn_cvt_pk_fp8_f32(h[4], h[5], 0, false); w1 = __builtin_amdgcn_cvt_pk_fp8_f32(h[6], h[7], w1, true);
                u32x2 w; w.x = (unsigned)w0; w.y = (unsigned)w1;
                *(u32x2*)(rowp) = w; }
    }
};
struct EpiDown {
    static constexpr bool FP8 = true; int scale_w, scale_a;
    static constexpr bool PERM = true; static constexpr bool SWAPV = false; __device__ __forceinline__ bool swapv(const Unit&) const { return false; }
    unsigned char* ye;
    __device__ __forceinline__ void operator()(const f32x4 (&acc)[2][2][4][2], const Unit& u, int wr, int wc, int fr, int fq) const {
        const int row0 = u.e * 4096 + u.pm * BM + wr * 64 + fr, col0 = u.pn * BM + wc * 32 + 8 * fq;
#pragma unroll
        for (int ai = 0; ai < 2; ++ai)
#pragma unroll
            for (int m = 0; m < 4; ++m) { const int row = row0 + ai * HALF + m * 16; unsigned char* rowp = ye + (size_t)row * D + col0;
#pragma unroll
                for (int bj = 0; bj < 2; ++bj) { f32x4 v0 = acc[ai][bj][m][0] * 32.f, v1 = acc[ai][bj][m][1] * 32.f;
#pragma unroll
                    for (int i = 0; i < 4; ++i) { v0[i] = __builtin_amdgcn_fmed3f(v0[i], -448.f, 448.f); v1[i] = __builtin_amdgcn_fmed3f(v1[i], -448.f, 448.f); }
                    int w0 = __builtin_amdgcn_cvt_pk_fp8_f32(v0[0], v0[1], 0, false); w0 = __builtin_amdgcn_cvt_pk_fp8_f32(v0[2], v0[3], w0, true);
                    int w1 = __builtin_amdgcn_cvt_pk_fp8_f32(v1[0], v1[1], 0, false); w1 = __builtin_amdgcn_cvt_pk_fp8_f32(v1[2], v1[3], w1, true);
                    u32x2 w; w.x = (unsigned)w0; w.y = (unsigned)w1;
                    *(u32x2*)(rowp + bj * HALF) = w; } }
    }
};
}

constexpr int RING_BYTES = 131072, LDS_BYTES = 147456;
struct Args { const float* in[20]; float* out; unsigned char* ws; int ph_lo, ph_hi; };
struct Frame {
    LAS unsigned char* lds;
    int tid, lane, wave, gw, ngw, G;
};
#define P_X 0
#define P_C 1
#define P_CTX 2
#define P_CCTX 3
#define P_ADAW 4
#define P_ADAB 5
#define P_NORMG 6
#define P_GWIN 7
#define P_GWA2 8
#define P_GBA2 9
#define P_GNORMG 10
#define P_GWOUT 11
#define P_CWIN 12
#define P_CK 13
#define P_CWOUT 14
#define P_ROUTER 15
#define P_EGATE 16
#define P_EUP 17
#define P_EDOWN 18
#define P_FINALG 19

constexpr int TR_SCR = 64 * 65 * 4;
__device__ __forceinline__ void tr_item(const float* W, int ldw, int k0, int n0, bf16_t* WT, int ldo, int drow0, LAS float* scr, int lane) {
    f32x4 v[16];
#pragma unroll
    for (int i = 0; i < 16; ++i) v[i] = *(const f32x4*)(W + (size_t)(k0 + 4 * i + (lane >> 4)) * ldw + n0 + 4 * (lane & 15));
#pragma unroll
    for (int i = 0; i < 16; ++i) { LAS float* p = scr + (4 * i + (lane >> 4)) * 65 + 4 * (lane & 15); p[0] = v[i].x; p[1] = v[i].y; p[2] = v[i].z; p[3] = v[i].w; }
    LDS_WAIT(); asm volatile("" ::: "memory");
    const int c = lane & 7;
#pragma unroll
    for (int j = 0; j < 8; ++j) { const int n = (lane >> 3) + 8 * j; const LAS float* sp = scr + (8 * c) * 65 + n;
        u32x4 o; o.x = pk2(sp[0 * 65], sp[1 * 65]); o.y = pk2(sp[2 * 65], sp[3 * 65]); o.z = pk2(sp[4 * 65], sp[5 * 65]); o.w = pk2(sp[6 * 65], sp[7 * 65]);
        *(u32x4*)(WT + (size_t)(drow0 + n) * ldo + k0 + 8 * c) = o; }
    LDS_WAIT(); asm volatile("" ::: "memory");
}
__device__ __forceinline__ void tr_plain(Frame& F, const Args& A, const float* W, int K, int N, bf16_t* WT, int item, LAS float* scr) {
    const int nblk = (N + 63) / 64, kb = item / nblk, nb = item % nblk; int n0 = 64 * nb; if (n0 + 64 > N) n0 = N - 64;
    tr_item(W, N, 64 * kb, n0, WT, K, n0, scr, F.lane);
}
constexpr int TR_SCR8 = 128 * 33 * 4;
static_assert(TR_SCR8 >= TR_SCR, "per-wave scratch stride");
struct Tr8Item { const float* W; unsigned char* WT; int ldw, ldo, rowmap; };
constexpr int I8_G = (D / 128) * (DEXP / 256);
constexpr int I8_D = (DEXP / 128) * (D / 256);
constexpr int N_EXPERT_ITEMS = NE * (2 * I8_G + I8_D);
__device__ __forceinline__ Tr8Item expert_item(const Args& A, int gi) {
    const int l = gi / N_EXPERT_ITEMS, it = gi % N_EXPERT_ITEMS;
    unsigned char* wgu = A.ws + WS_W8 + (size_t)l * W8_LAYER; unsigned char* wd = wgu + W8_WD;
    constexpr int PER_E = 2 * I8_G + I8_D;
    const int e = it / PER_E; int r = it % PER_E;
    Tr8Item t;
    if (r < 2 * I8_G) {
        const int up = r / I8_G; r %= I8_G;
        const float* W = A.in[up ? P_EUP : P_EGATE] + ((size_t)l * NE + e) * D * DEXP;
        const int nblk = DEXP / 256, kb = r / nblk, nb = r % nblk, h0 = 256 * nb;
        t.W = W + (size_t)(128 * kb) * DEXP + h0; t.ldw = DEXP; t.WT = wgu + (size_t)e * 4096 * D + (size_t)(2 * h0 + 128 * up) * D + 128 * kb; t.ldo = D; t.rowmap = 1;
    } else {
        r -= 2 * I8_G;
        const float* W = A.in[P_EDOWN] + ((size_t)l * NE + e) * DEXP * D;
        const int nblk = D / 256, kb = r / nblk, nb = r % nblk;
        t.W = W + (size_t)(128 * kb) * D + 256 * nb; t.ldw = D; t.WT = wd + (size_t)e * D * DEXP + (size_t)(256 * nb) * DEXP + 128 * kb; t.ldo = DEXP; t.rowmap = 0;
    }
    return t;
}
__device__ __forceinline__ void tr8_load(const Tr8Item& t, f32x4 (&v)[16], int wave, int lane) {
#pragma unroll
    for (int i = 0; i < 16; ++i) v[i] = __builtin_nontemporal_load((const f32x4*)(t.W + (size_t)(16 * wave + i) * t.ldw + 4 * lane));
}
__device__ __forceinline__ void tr8_finish(const Tr8Item& t, const f32x4 (&v)[16], LAS unsigned char* tile, int tid, int wave, int lane) {
#pragma unroll
    for (int q = 0; q < 4; ++q) {
        int o[4];
#pragma unroll
        for (int g = 0; g < 4; ++g) { int w = __builtin_amdgcn_cvt_pk_fp8_f32(64.f * v[4 * g][q], 64.f * v[4 * g + 1][q], 0, false);
            o[g] = __builtin_amdgcn_cvt_pk_fp8_f32(64.f * v[4 * g + 2][q], 64.f * v[4 * g + 3][q], w, true); }
        u32x4 ov; ov.x = (unsigned)o[0]; ov.y = (unsigned)o[1]; ov.z = (unsigned)o[2]; ov.w = (unsigned)o[3];
        const int n = 4 * lane + q;
        *(LAS u32x4*)(tile + n * 128 + ((wave ^ (n & 7)) << 4)) = ov; }
    __syncthreads();
#pragma unroll
    for (int j = 0; j < 4; ++j) { const int p = tid + 512 * j, n = p >> 3, c = p & 7;
        const u32x4 ov = *(const LAS u32x4*)(tile + n * 128 + ((c ^ (n & 7)) << 4));
        const int drow = t.rowmap ? (256 * (n >> 7) + (n & 127)) : n;
        *(u32x4*)(t.WT + (size_t)drow * t.ldo + 16 * c) = ov; }
    __syncthreads();
}
__device__ __forceinline__ void convert_expert_dyn(const Args& A, unsigned* ctr, int end, LAS unsigned char* tile, volatile LAS int* slot, int tid, int wave, int lane) {
    if (tid == 0) { slot[0] = (int)__hip_atomic_fetch_add(ctr, 1u, __ATOMIC_RELAXED, __HIP_MEMORY_SCOPE_AGENT); slot[1] = (int)__hip_atomic_fetch_add(ctr, 1u, __ATOMIC_RELAXED, __HIP_MEMORY_SCOPE_AGENT); }
    __syncthreads();
    int ia = slot[0], ib = slot[1];
    if (ia >= end) return;
    f32x4 va[16], vb[16];
    Tr8Item ta = expert_item(A, ia), tb;
    tr8_load(ta, va, wave, lane);
    for (;;) {
        int rc = 0;
        tb = expert_item(A, min(ib, end - 1)); tr8_load(tb, vb, wave, lane);
        if (tid == 0) rc = (int)__hip_atomic_fetch_add(ctr, 1u, __ATOMIC_RELAXED, __HIP_MEMORY_SCOPE_AGENT);
        tr8_finish(ta, va, tile, tid, wave, lane);
        if (tid == 0) slot[0] = rc;
        __syncthreads();
        ia = ib; ib = slot[0];
        if (ia >= end) break;
        ta = expert_item(A, min(ib, end - 1)); tr8_load(ta, va, wave, lane);
        if (tid == 0) rc = (int)__hip_atomic_fetch_add(ctr, 1u, __ATOMIC_RELAXED, __HIP_MEMORY_SCOPE_AGENT);
        tr8_finish(tb, vb, tile, tid, wave, lane);
        if (tid == 0) slot[1] = rc;
        __syncthreads();
        ia = ib; ib = slot[1];
        if (ia >= end) break;
    }
}
template <int N>
__device__ __forceinline__ void convert_expert_fixed(const Args& A, LAS unsigned char* lds, int tid, int wave, int lane) {
    unsigned* ctr = (unsigned*)(A.ws + WS_CTL) + 2048; LAS unsigned char* tile = lds + 49152; volatile LAS int* slot = (volatile LAS int*)(lds + 40960);
    constexpr int end = 2 * N_EXPERT_ITEMS;
    __syncthreads();
    if (tid == 0) slot[0] = (int)__hip_atomic_fetch_add(ctr, (unsigned)N, __ATOMIC_RELAXED, __HIP_MEMORY_SCOPE_AGENT);
    __syncthreads();
    const int base = slot[0];
    if (base >= end) return;
    f32x4 va[16], vb[16];
    Tr8Item ta = expert_item(A, base), tb = ta;
    tr8_load(ta, va, wave, lane);
#pragma unroll
    for (int j = 0; j < N; ++j) {
        if ((j & 1) == 0) { if (j + 1 < N) { tb = expert_item(A, min(base + j + 1, end - 1)); tr8_load(tb, vb, wave, lane); } tr8_finish(ta, va, tile, tid, wave, lane); }
        else              { if (j + 1 < N) { ta = expert_item(A, min(base + j + 1, end - 1)); tr8_load(ta, va, wave, lane); } tr8_finish(tb, vb, tile, tid, wave, lane); }
    }
}

__device__ __forceinline__ void ph_prep(Frame& F, const Args& A) {
    LAS float* scr = (LAS float*)(F.lds + F.wave * TR_SCR8);
    bf16_t* win0 = (bf16_t*)(A.ws + WS_WIN0T); bf16_t* wout0 = (bf16_t*)(A.ws + WS_WOUT0T); bf16_t* wcin = (bf16_t*)(A.ws + WS_WCINT); bf16_t* wcout = (bf16_t*)(A.ws + WS_WCOUTT);
    {
        float* mod = (float*)(A.ws + WS_MOD);
        LAS float* red = (LAS float*)(F.lds + 8 * TR_SCR8);
        for (int it = blockIdx.x; it < 2 * 96; it += F.G) {
            const int l = it / 96, n = (it % 96) * 64 + F.lane;
            const float* w = A.in[P_ADAW] + (size_t)l * D * 6 * D + n;
            float a0 = 0.f, a1 = 0.f, a2 = 0.f;
#pragma unroll 16
            for (int kk = 0; kk < 128; ++kk) { const int k = F.wave * 128 + kk; const float wv = w[(size_t)k * 6 * D];
                a0 += silu_f(A.in[P_C][k]) * wv; a1 += silu_f(A.in[P_C][D + k]) * wv; a2 += silu_f(A.in[P_CCTX][k]) * wv; }
            red[(F.wave * 3 + 0) * 64 + F.lane] = a0; red[(F.wave * 3 + 1) * 64 + F.lane] = a1; red[(F.wave * 3 + 2) * 64 + F.lane] = a2;
            __syncthreads();
            if (F.wave < 3) { float sacc = A.in[P_ADAB][l * 6 * D + n];
#pragma unroll
                for (int w8 = 0; w8 < 8; ++w8) sacc += red[(w8 * 3 + F.wave) * 64 + F.lane];
                mod[(l * 3 + F.wave) * 6 * D + n] = sacc; }
            __syncthreads();
        }
    }
    constexpr int I0 = (D / 64) * ((NIN0 + 63) / 64), I1 = (D / 64) * (D / 64), I2 = (D / 64) * (NCIN / 64), I3 = I1;
    for (int it = F.gw; it < I0 + I1 + I2 + I3; it += F.ngw) {
        int r = it;
        if (r < I0) { tr_plain(F, A, A.in[P_GWIN], D, NIN0, win0, r, scr); continue; } r -= I0;
        if (r < I1) { tr_plain(F, A, A.in[P_GWOUT], D, D, wout0, r, scr); continue; } r -= I1;
        if (r < I2) {
            constexpr int nblk = NCIN / 64; const int kb = r / nblk, n0 = 64 * (r % nblk), sct = n0 >> 10, ch = n0 & 1023, cb = ch >> 8, hf = (ch >> 7) & 1;
            const int drow0 = sct == 0 ? (3 * cb + 2) * 256 + (ch & 255) : (3 * cb + hf) * 256 + 128 * (sct - 1) + (ch & 127);
            tr_item(A.in[P_CWIN], NCIN, 64 * kb, n0, wcin, D, drow0, scr, F.lane); continue; } r -= I2;
        tr_plain(F, A, A.in[P_CWOUT], D, D, wcout, r, scr);
    }
    { u32x4* z = (u32x4*)(win0 + (size_t)NIN0 * D); const int n16 = (NIN0P - NIN0) * D * 2 / 16;
      for (int i = F.gw * 64 + F.lane; i < n16; i += F.ngw * 64) z[i] = (u32x4){0u, 0u, 0u, 0u}; }
}

__device__ __forceinline__ void normmod_row(const f32x4 (&v)[4], const float* g, const float* sh, const float* sc, bf16_t* orow, int lane) {
    float s = 0.f;
#pragma unroll
    for (int j = 0; j < 4; ++j) s += (v[j].x * v[j].x + v[j].y * v[j].y) + (v[j].z * v[j].z + v[j].w * v[j].w);
    const float rstd = rsqrtf(wave_sum(s) * (1.f / D) + EPS);
#pragma unroll
    for (int j = 0; j < 4; ++j) { const int c = 4 * lane + 256 * j;
        const f32x4 gg = *(const f32x4*)(g + c), s1 = *(const f32x4*)(sh + c), s2 = *(const f32x4*)(sc + c);
        const f32x4 y = v[j] * rstd * gg * (s2 + 1.f) + s1;
        u32x2 w; w.x = pk2(y.x, y.y); w.y = pk2(y.z, y.w);
        *(u32x2*)(orow + c) = w; }
}
__device__ __forceinline__ void ph_norm0(Frame& F, const Args& A) {
    const float* mod = (const float*)(A.ws + WS_MOD); bf16_t* H = (bf16_t*)(A.ws + WS_H);
    for (int row = F.gw; row < NROW; row += F.ngw) {
        const float* xr = row < NLAT ? A.in[P_X] + (size_t)row * D : A.in[P_CTX] + (size_t)(row - NLAT) * D;
        const int s = row < NLAT ? (row >> 14) : 2;
        f32x4 v[4];
#pragma unroll
        for (int j = 0; j < 4; ++j) v[j] = *(const f32x4*)(xr + 4 * F.lane + 256 * j);
        normmod_row(v, A.in[P_NORMG] + 0 * D, mod + (0 * 3 + s) * 6 * D + 0 * D, mod + (0 * 3 + s) * 6 * D + 1 * D, H + (size_t)row * D, F.lane);
    }
}

__device__ __forceinline__ int jperm(int ks, int fq, int jj) { return 32 * ks + 16 * (jj >> 2) + 4 * fq + (jj & 3); }
__device__ __forceinline__ bf16x8 ldfrag(const unsigned char* blob, int blk, int lane) { return *(const bf16x8*)(blob + blk * 1024 + lane * 16); }
__device__ __forceinline__ unsigned cvtpk(float lo, float hi) { return pk2(lo, hi); }
__device__ __forceinline__ bf16x8 pack8(const f32x4& a, const f32x4& b) {
    u32x4 w; w.x = cvtpk(a[0], a[1]); w.y = cvtpk(a[2], a[3]); w.z = cvtpk(b[0], b[1]); w.w = cvtpk(b[2], b[3]);
    return __builtin_bit_cast(bf16x8, w);
}
__device__ __forceinline__ void ph_gla_prep(Frame& F, const Args& A) {
    constexpr int LSTR = 1040;
    LAS unsigned char* QS = F.lds; LAS unsigned char* KS = F.lds + 64 * LSTR;
    const bf16_t* qk = (const bf16_t*)(A.ws + WS_QK); const float* afb = (const float*)(A.ws + WS_AFB);
    float* gam = (float*)(A.ws + WS_GAM);
    const bool has_conv = blockIdx.x + 4 * F.G >= 2 * NCHUNK;
    const int pre = has_conv ? (int)(blockIdx.x & 3) : 0;
    if (pre == 1) convert_expert_fixed<1>(A, F.lds, F.tid, F.wave, F.lane);
    else if (pre == 2) convert_expert_fixed<2>(A, F.lds, F.tid, F.wave, F.lane);
    else if (pre == 3) convert_expert_fixed<3>(A, F.lds, F.tid, F.wave, F.lane);
    __syncthreads();
    const int dir = blockIdx.x & 1, d = F.tid;
    f32x2 w2[8];
#pragma unroll
    for (int r = 0; r < 8; ++r) { w2[r].x = A.in[P_GWA2][(dir * 16 + 2 * r) * DK + d]; w2[r].y = A.in[P_GWA2][(dir * 16 + 2 * r + 1) * DK + d]; }
    const float bias = A.in[P_GBA2][dir * DK + d];
    u32x4 t16[16]; f32x4 av = (f32x4){0.f, 0.f, 0.f, 0.f};
#define PREP_LOAD(it_) do { const int row0_ = ((it_) >> 1) * 64; \
        _Pragma("unroll") for (int u = 0; u < 16; ++u) { const int q16 = F.tid + NTHR * u, j = q16 >> 7, cp = q16 & 127; t16[u] = *(const u32x4*)((const unsigned char*)qk + ((size_t)(row0_ + j) * D) * 2 + cp * 16); } \
        if (F.tid < 256) av = *(const f32x4*)(afb + (size_t)(row0_ + (F.tid >> 2)) * 32 + dir * 16 + 4 * (F.tid & 3)); } while (0)
    if ((int)blockIdx.x < 2 * NCHUNK) PREP_LOAD((int)blockIdx.x);
    for (int item = blockIdx.x; item < 2 * NCHUNK; item += F.G) {
        {
            const int ch = item >> 1, row0 = ch * 64; (void)row0;
            LAS float* AFL = (LAS float*)(F.lds + 2 * 64 * LSTR);
            {
#pragma unroll
                for (int u = 0; u < 16; ++u) { const int q16 = F.tid + NTHR * u, j = q16 >> 7, cp = q16 & 127; *(LAS u32x4*)(((cp < 64) ? QS : KS) + j * LSTR + (cp & 63) * 16) = t16[u]; }
                if (F.tid < 256) *(LAS f32x4*)(AFL + (F.tid >> 2) * 16 + 4 * (F.tid & 3)) = av;
            }
            if (item + F.G < 2 * NCHUNK) PREP_LOAD(item + F.G);
            __syncthreads();
            float cum2 = 0.f;
#pragma unroll 1
            for (int jq = 0; jq < 64; jq += 4) {
                f32x4 ar[4][4]; unsigned qv[4], kv[4];
#pragma unroll
                for (int u = 0; u < 4; ++u) { const int j = dir ? 63 - (jq + u) : jq + u;
#pragma unroll
                    for (int r4 = 0; r4 < 4; ++r4) ar[u][r4] = *(const LAS f32x4*)(AFL + j * 16 + 4 * r4); }
#pragma unroll
                for (int u = 0; u < 4; ++u) { const int j = dir ? 63 - (jq + u) : jq + u;
                    qv[u] = *(const LAS bf16_t*)(QS + j * LSTR + d * 2); kv[u] = *(const LAS bf16_t*)(KS + j * LSTR + d * 2); }
                asm volatile("" ::: "memory");
                float ls2[4];
#pragma unroll
                for (int u = 0; u < 4; ++u) {
                    f32x2 za = (f32x2){bias, 0.f}, zb = (f32x2){0.f, 0.f};
#pragma unroll
                    for (int r4 = 0; r4 < 4; ++r4) { za = __builtin_elementwise_fma((f32x2){ar[u][r4].x, ar[u][r4].y}, w2[2 * r4], za); zb = __builtin_elementwise_fma((f32x2){ar[u][r4].z, ar[u][r4].w}, w2[2 * r4 + 1], zb); }
                    const float z = (za.x + za.y) + (zb.x + zb.y);
                    const float zl = z * 1.4426950408889634f;
                    ls2[u] = fminf(zl, 0.f) - __builtin_amdgcn_logf(1.f + __builtin_amdgcn_exp2f(-fabsf(zl)));
                }
                unsigned qk2[4];
#pragma unroll
                for (int u = 0; u < 4; ++u) {
                    cum2 += ls2[u] * (1.f / 16.f);
                    const float e = __builtin_amdgcn_exp2f(cum2), ei = __builtin_amdgcn_exp2f(-cum2);
                    qk2[u] = pk2(bflo(qv[u]) * e, bflo(kv[u]) * ei);
                }
#pragma unroll
                for (int u = 0; u < 4; ++u) { const int j = dir ? 63 - (jq + u) : jq + u;
                    *(LAS bf16_t*)(QS + j * LSTR + d * 2) = (bf16_t)(qk2[u] & 0xffffu); *(LAS bf16_t*)(KS + j * LSTR + d * 2) = (bf16_t)(qk2[u] >> 16); }
            }
            const float cum = cum2 * 0.6931471805599453f;
            gam[((size_t)dir * NCHUNK + ch) * DK + d] = __expf(cum);
            __syncthreads();
            {
                const int fr = F.lane & 15, fq = F.lane >> 4;
                unsigned char* blob0 = A.ws + (((size_t)dir * NCHUNK + ch) * 4) * BLOB + (size_t)F.tid * 16;
#pragma unroll
                for (int typ = 0; typ < 2; ++typ) {
                    const LAS unsigned char* src = (typ == 0) ? QS : KS;
                    u32x4 o[8];
#pragma unroll
                    for (int i8 = 0; i8 < 8; ++i8) { const int h = i8 >> 1, blk = F.wave + 8 * (i8 & 1), it = blk >> 2, sd = blk & 3, i = 16 * it + fr, d0 = h * HK + 32 * sd + 4 * fq;
                        const u32x2 lo = *(const LAS u32x2*)(src + i * LSTR + d0 * 2), hi = *(const LAS u32x2*)(src + i * LSTR + (d0 + 16) * 2);
                        o[i8].x = lo.x; o[i8].y = lo.y; o[i8].z = hi.x; o[i8].w = hi.y; }
                    unsigned char* dst = blob0 + (typ == 0 ? WS_QP : WS_KP);
#pragma unroll
                    for (int i8 = 0; i8 < 8; ++i8) *(u32x4*)(dst + (size_t)(i8 >> 1) * BLOB + (size_t)(i8 & 1) * 8192) = o[i8];
                }
                {
                    u32x4 o[8];
#pragma unroll
                    for (int i8 = 0; i8 < 8; ++i8) { const int h = i8 >> 1, blk = F.wave + 8 * (i8 & 1), mt = blk >> 1, ks = blk & 1, dd = h * HK + 16 * mt + fr; unsigned e[8];
#pragma unroll
                        for (int jj = 0; jj < 8; ++jj) e[jj] = *(const LAS bf16_t*)(KS + jperm(ks, fq, jj) * LSTR + dd * 2);
                        o[i8].x = e[0] | (e[1] << 16); o[i8].y = e[2] | (e[3] << 16); o[i8].z = e[4] | (e[5] << 16); o[i8].w = e[6] | (e[7] << 16); }
                    unsigned char* dst = blob0 + WS_KTP;
#pragma unroll
                    for (int i8 = 0; i8 < 8; ++i8) *(u32x4*)(dst + (size_t)(i8 >> 1) * BLOB + (size_t)(i8 & 1) * 8192) = o[i8];
                }
            }
            __syncthreads();
        }
    }
#undef PREP_LOAD
    if (has_conv) {
        if (pre == 0) convert_expert_fixed<4>(A, F.lds, F.tid, F.wave, F.lane);
        else if (pre == 1) convert_expert_fixed<3>(A, F.lds, F.tid, F.wave, F.lane);
        else if (pre == 2) convert_expert_fixed<2>(A, F.lds, F.tid, F.wave, F.lane);
        else convert_expert_fixed<1>(A, F.lds, F.tid, F.wave, F.lane);
    }
}

#define MFMA16(a, b, c) __builtin_amdgcn_mfma_f32_16x16x32_bf16((a), (b), (c), 0, 0, 0)
__device__ __forceinline__ void gla_intra_item(Frame& F, const Args& A, int item) {
    const int ch = item >> 2, h = item & 3, fr = F.lane & 15, fq = F.lane >> 4;
    const unsigned char* qpf = A.ws + WS_QP + (((size_t)0 * NCHUNK + ch) * 4 + h) * BLOB; const unsigned char* kpf = A.ws + WS_KP + (((size_t)0 * NCHUNK + ch) * 4 + h) * BLOB;
    const unsigned char* qpb = A.ws + WS_QP + (((size_t)1 * NCHUNK + ch) * 4 + h) * BLOB; const unsigned char* kpb = A.ws + WS_KP + (((size_t)1 * NCHUNK + ch) * 4 + h) * BLOB;
    bf16x8 Pf[4][2];
#pragma unroll
    for (int it = 0; it < 4; ++it) {
        f32x4 P[4];
#pragma unroll
        for (int jt = 0; jt < 4; ++jt) P[jt] = (f32x4){0.f, 0.f, 0.f, 0.f};
#pragma unroll
        for (int dirp = 0; dirp < 2; ++dirp) {
            const unsigned char* qp = dirp ? qpb : qpf; const unsigned char* kp = dirp ? kpb : kpf;
            bf16x8 kk[16], qq[4];
#pragma unroll
            for (int sd = 0; sd < 4; ++sd) qq[sd] = ldfrag(qp, it * 4 + sd, F.lane);
#pragma unroll
            for (int jt = 0; jt < 4; ++jt) if (dirp ? (jt >= it) : (jt <= it)) {
#pragma unroll
                for (int sd = 0; sd < 4; ++sd) kk[jt * 4 + sd] = ldfrag(kp, jt * 4 + sd, F.lane); }
#pragma unroll
            for (int jt = 0; jt < 4; ++jt) if (dirp ? (jt >= it) : (jt <= it)) {
                f32x4 a = (f32x4){0.f, 0.f, 0.f, 0.f};
#pragma unroll
                for (int sd = 0; sd < 4; ++sd) a = MFMA16(kk[jt * 4 + sd], qq[sd], a);
                if (jt == it) {
#pragma unroll
                    for (int r = 0; r < 4; ++r) { const int j = 4 * fq + r; const bool keep = dirp ? (j >= fr) : (j <= fr); a[r] = keep ? a[r] : 0.f; }
                }
                P[jt] += a;
            }
        }
        Pf[it][0] = pack8(P[0], P[1]); Pf[it][1] = pack8(P[2], P[3]);
    }
    const unsigned char* vt = A.ws + WS_VTP + (size_t)ch * 131072 + (size_t)(h * 16) * 2048;
    bf16_t* oi = (bf16_t*)(A.ws + WS_OI) + (size_t)(ch * 64 + fr) * DV + h * HV + 4 * fq;
#pragma unroll 1
    for (int ng = 0; ng < 4; ++ng) {
        bf16x8 va[8];
#pragma unroll
        for (int i = 0; i < 8; ++i) va[i] = ldfrag(vt, ng * 8 + i, F.lane);
#pragma unroll
        for (int n4 = 0; n4 < 4; ++n4)
#pragma unroll
            for (int it = 0; it < 4; ++it) {
                f32x4 acc = (f32x4){0.f, 0.f, 0.f, 0.f};
                acc = MFMA16(va[n4 * 2], Pf[it][0], acc); acc = MFMA16(va[n4 * 2 + 1], Pf[it][1], acc);
                u32x2 w; w.x = pk2(acc[0], acc[1]); w.y = pk2(acc[2], acc[3]);
                *(u32x2*)(oi + (size_t)(16 * it) * DV + 16 * (ng * 4 + n4)) = w;
            }
    }
}
struct ScanRegs { bf16x8 q[4], k[4], v[2][2]; f32x4 g[2]; };
__device__ __forceinline__ int scan_chunk(int b, int dir, int step) { return step >= 4 ? (256 * b + (dir ? 255 - (step - 4) : step - 4)) : (512 + 4 * b + (dir ? 3 - step : step)); }
__device__ __forceinline__ void scan_load(const Args& A, ScanRegs& R, int b, int h, int dir, int sp, int w, int step, int lane) {
    const int ch = scan_chunk(b, dir, step), fq = lane >> 4;
    const size_t bo = (((size_t)dir * NCHUNK + ch) * 4 + h) * BLOB;
    const unsigned char* qp = A.ws + WS_QP + bo; const unsigned char* ktp = A.ws + WS_KTP + bo;
    const unsigned char* vt = A.ws + WS_VTP + (size_t)ch * 131072 + (size_t)(h * 16 + 2 * sp) * 2048;
    const float* gp = (const float*)(A.ws + WS_GAM) + ((size_t)dir * NCHUNK + ch) * DK + h * HK + 32 * w + 4 * fq;
#pragma unroll
    for (int sd = 0; sd < 4; ++sd) R.q[sd] = ldfrag(qp, w * 4 + sd, lane);
#pragma unroll
    for (int m = 0; m < 2; ++m)
#pragma unroll
        for (int ks = 0; ks < 2; ++ks) R.k[m * 2 + ks] = ldfrag(ktp, (2 * w + m) * 2 + ks, lane);
#pragma unroll
    for (int s2 = 0; s2 < 2; ++s2) {
        const int o = 8 * ((lane & 15) >> 2) + 4 * s2 + (lane & 3);
        const unsigned char* vp = vt + (o >> 4) * 2048 + ((o & 15) + (lane & 48)) * 16;
        R.v[s2][0] = *(const bf16x8*)(vp); R.v[s2][1] = *(const bf16x8*)(vp + 1024); }
    R.g[0] = *(const f32x4*)(gp); R.g[1] = *(const f32x4*)(gp + 16);
}
#define LDS_ORDER() asm volatile("" ::: "memory")
__device__ __forceinline__ void scan_ds(const ScanRegs& R, f32x4 (&dS)[2][2]) {
#pragma unroll
    for (int s2 = 0; s2 < 2; ++s2)
#pragma unroll
        for (int m = 0; m < 2; ++m) { f32x4 d = (f32x4){0.f, 0.f, 0.f, 0.f}; d = MFMA16(R.k[m * 2], R.v[s2][0], d); d = MFMA16(R.k[m * 2 + 1], R.v[s2][1], d); dS[s2][m] = d; }
}
__device__ __forceinline__ void scan_step(const Args& A, const ScanRegs& R, const ScanRegs& Rn, f32x4 (&S)[2][2], f32x4 (&dS)[2][2], LAS unsigned char* xs, LAS unsigned* flags, bf16_t* O, int b, int h, int dir, int sp, int w, int step, int lane) {
    const int fr = lane & 15, fq = lane >> 4;
#pragma unroll
    for (int s2 = 0; s2 < 2; ++s2) {
        S[s2][0] = R.g[0] * (S[s2][0] + dS[s2][0]); S[s2][1] = R.g[1] * (S[s2][1] + dS[s2][1]);
        *(volatile LAS bf16x8*)(xs + ((step + 1) & 3) * 8192 + (s2 * 4 + w) * 1024 + lane * 16) = pack8(S[s2][0], S[s2][1]);
    }
    LDS_ORDER();
    if (lane == 0) *(volatile LAS unsigned*)(flags + w) = (unsigned)step + 2u;
    LDS_ORDER();
    scan_ds(Rn, dS);
    if (step >= 4) {
        { const unsigned need = (unsigned)step + 1u; unsigned spn = 0;
          for (;;) { const unsigned f = (lane < 4) ? *(volatile LAS unsigned*)(flags + lane) : need;
              if (__all((int)(f >= need))) break; if (++spn > (1u << 26)) break; }
          LDS_ORDER(); }
        const LAS unsigned char* slot = xs + (step & 3) * 8192 + lane * 16;
        bf16x8 sf[2][4];
#pragma unroll
        for (int s2 = 0; s2 < 2; ++s2)
#pragma unroll
            for (int sd = 0; sd < 4; ++sd) sf[s2][sd] = *(const LAS bf16x8*)(slot + (s2 * 4 + sd) * 1024);
        LDS_ORDER();
        const int ch = scan_chunk(b, dir, step);
        f32x4 acc0 = (f32x4){0.f, 0.f, 0.f, 0.f}, acc1 = acc0;
#pragma unroll
        for (int sd = 0; sd < 4; ++sd) { acc0 = MFMA16(sf[0][sd], R.q[sd], acc0); acc1 = MFMA16(sf[1][sd], R.q[sd], acc1); }
        u32x4 wv; wv.x = pk2(acc0[0], acc0[1]); wv.y = pk2(acc0[2], acc0[3]); wv.z = pk2(acc1[0], acc1[1]); wv.w = pk2(acc1[2], acc1[3]);
        *(u32x4*)(O + (size_t)(ch * 64 + 16 * w + fr) * DV + h * HV + 32 * sp + 8 * fq) = wv;
    }
}
__device__ __forceinline__ void gla_scan_item(Frame& F, const Args& A, int item, LAS unsigned char* xs, LAS unsigned* flags) {
    const int chain = item >> 3, sp = item & 7, b = chain >> 3, h = (chain >> 1) & 3, dir = chain & 1, w = F.wave;
    bf16_t* O = (bf16_t*)(A.ws + (dir ? WS_OB : WS_OF));
    f32x4 S[2][2], dS[2][2];
#pragma unroll
    for (int s2 = 0; s2 < 2; ++s2) { S[s2][0] = (f32x4){0.f, 0.f, 0.f, 0.f}; S[s2][1] = S[s2][0];
        *(volatile LAS bf16x8*)(xs + (s2 * 4 + w) * 1024 + F.lane * 16) = pack8(S[s2][0], S[s2][1]); }
    LDS_ORDER();
    if (F.lane == 0) *(volatile LAS unsigned*)(flags + w) = 1u;
    LDS_ORDER();
    ScanRegs Ra, Rb, Rc;
    scan_load(A, Ra, b, h, dir, sp, w, 0, F.lane);
    scan_load(A, Rb, b, h, dir, sp, w, 1, F.lane);
    scan_ds(Ra, dS);
    for (int step = 0; step < 261; step += 3) {
        scan_load(A, Rc, b, h, dir, sp, w, min(step + 2, 259), F.lane);
        scan_step(A, Ra, Rb, S, dS, xs, flags, O, b, h, dir, sp, w, step, F.lane);
        scan_load(A, Ra, b, h, dir, sp, w, min(step + 3, 259), F.lane);
        scan_step(A, Rb, Rc, S, dS, xs, flags, O, b, h, dir, sp, w, step + 1, F.lane);
        scan_load(A, Rb, b, h, dir, sp, w, min(step + 4, 259), F.lane);
        if (step + 2 < 260) scan_step(A, Rc, Ra, S, dS, xs, flags, O, b, h, dir, sp, w, step + 2, F.lane);
    }
}
__device__ __forceinline__ void ph_gla_main(Frame& F, const Args& A) {
    LAS unsigned char* xs = F.lds; LAS unsigned* flags = (LAS unsigned*)(F.lds + 32768);
    if (F.tid < 16) flags[F.tid] = 0u;
    __syncthreads();
    const int bi = blockIdx.x;
    unsigned* ctr = (unsigned*)(A.ws + WS_CTL) + 2048;
    volatile LAS int* slot = (volatile LAS int*)(F.lds + 40960);
    if (bi < 128) {
        if (F.wave < 4) gla_scan_item(F, A, ((2 * (bi & 7) + ((bi >> 3) & 1)) << 3) | ((bi >> 4) & 7), xs, flags);
        __syncthreads();
    } else {
        const int sw = (bi - 128) * NWAVES + F.wave, nsw = (F.G - 128) * NWAVES;
        for (int it = sw; it < 512 * 4; it += nsw) gla_intra_item(F, A, it);
        __syncthreads();
    }
    convert_expert_dyn(A, ctr, 2 * N_EXPERT_ITEMS, F.lds + 49152, slot, F.tid, F.wave, F.lane);
    __syncthreads();
}

__device__ __forceinline__ void ph_gla_finish(Frame& F, const Args& A) {
    const bf16_t* rp = (const bf16_t*)(A.ws + WS_R); const bf16_t* OFp = (const bf16_t*)(A.ws + WS_OF); const bf16_t* OBp = (const bf16_t*)(A.ws + WS_OB); const bf16_t* OIp = (const bf16_t*)(A.ws + WS_OI);
    bf16_t* Hh = (bf16_t*)(A.ws + WS_H);
    const f32x4 gn = *(const f32x4*)(A.in[P_GNORMG] + 4 * F.lane);
    for (int row = F.gw; row < NLAT; row += F.ngw) {
#pragma unroll
        for (int j = 0; j < 4; ++j) {
            const int cc = 4 * F.lane + 256 * j;
            const u32x2 a = *(const u32x2*)(OFp + (size_t)row * DV + cc), bq = *(const u32x2*)(OBp + (size_t)row * DV + cc), ci = *(const u32x2*)(OIp + (size_t)row * DV + cc);
            const u32x2 rr = *(const u32x2*)(rp + (size_t)row * D + cc);
            f32x4 o; o.x = bflo(a.x) + bflo(bq.x) + bflo(ci.x); o.y = bfhi(a.x) + bfhi(bq.x) + bfhi(ci.x); o.z = bflo(a.y) + bflo(bq.y) + bflo(ci.y); o.w = bfhi(a.y) + bfhi(bq.y) + bfhi(ci.y);
            const float ss = wave_sum((o.x * o.x + o.y * o.y) + (o.z * o.z + o.w * o.w));
            const float rstd = rsqrtf(ss * (1.f / HV) + EPS);
            f32x4 r; r.x = bflo(rr.x); r.y = bfhi(rr.x); r.z = bflo(rr.y); r.w = bfhi(rr.y);
            f32x4 y;
#pragma unroll
            for (int i = 0; i < 4; ++i) y[i] = o[i] * rstd * gn[i] * silu_f(r[i]);
            u32x2 w; w.x = pk2(y.x, y.y); w.y = pk2(y.z, y.w);
            *(u32x2*)(Hh + (size_t)row * D + cc) = w;
        }
    }
}

__device__ __forceinline__ void stage_router(Frame& F, const Args& A, int l) {
    LAS float* wl = (LAS float*)F.lds;
    const float* rw = A.in[P_ROUTER] + (size_t)l * D * NE;
    for (int idx = F.tid; idx < D * NE; idx += NTHR) { const int k = idx >> 4, e = idx & 15, j = k >> 8, ln = (k & 255) >> 2, i = k & 3; wl[((((j * 4 + i) * 4 + (e >> 2)) * 64) + ln) * 4 + (e & 3)] = rw[idx]; }
    __syncthreads();
}
template <int N, int M>
__device__ __forceinline__ void rs_step(const float (&v)[N], float (&w)[N / 2], int lane) {
    const bool hi = (lane & M) != 0;
#pragma unroll
    for (int e = 0; e < N / 2; ++e) { const float mine = hi ? v[N / 2 + e] : v[e], other = hi ? v[e] : v[N / 2 + e]; w[e] = mine + __shfl_xor(other, M); }
}
__device__ __forceinline__ void ph_norm2_router(Frame& F, const Args& A, int l) {
    const float* mod = (const float*)(A.ws + WS_MOD); unsigned char* H8 = A.ws + WS_H; const bf16_t* X = (const bf16_t*)(A.ws + WS_X); float* aff = (float*)(A.ws + WS_AFF);
    const float* g = A.in[P_NORMG] + (l * 2 + 1) * D; const float* rw = A.in[P_ROUTER] + (size_t)l * D * NE;
    LAS unsigned char* WF = F.lds;
    LAS float* GS = (LAS float*)(F.lds + 65536); LAS float* SH = GS + D; LAS float* CB = SH + D; LAS float* RED = CB + 16;
    const int fr = F.lane & 15, fq = F.lane >> 4;
    const int b = (int)((blockIdx.x * NWAVES * 16) >> 14);
    const float* sh = mod + (l * 3 + b) * 6 * D + 3 * D; const float* sc = mod + (l * 3 + b) * 6 * D + 4 * D;
    for (int k = F.tid; k < D; k += NTHR) { GS[k] = g[k] * (1.f + sc[k]); SH[k] = sh[k]; }
    __syncthreads();
    for (int p = F.tid; p < 32 * 64; p += NTHR) {
        const int s = p >> 6, ln = p & 63, e = ln & 15, k0 = 32 * s + 8 * (ln >> 4);
        float w[8];
#pragma unroll
        for (int i = 0; i < 8; ++i) w[i] = rw[(k0 + i) * NE + e] * GS[k0 + i];
        u32x4 hi, lo;
        hi.x = pk2(w[0], w[1]); hi.y = pk2(w[2], w[3]); hi.z = pk2(w[4], w[5]); hi.w = pk2(w[6], w[7]);
        lo.x = pk2(w[0] - bflo(hi.x), w[1] - bfhi(hi.x)); lo.y = pk2(w[2] - bflo(hi.y), w[3] - bfhi(hi.y)); lo.z = pk2(w[4] - bflo(hi.z), w[5] - bfhi(hi.z)); lo.w = pk2(w[6] - bflo(hi.w), w[7] - bfhi(hi.w));
        *(LAS u32x4*)(WF + ((s * 2 + 0) * 64 + ln) * 16) = hi; *(LAS u32x4*)(WF + ((s * 2 + 1) * 64 + ln) * 16) = lo;
    }
    { const int e = F.tid & 15, part = F.tid >> 4; float acc = 0.f;
#pragma unroll 8
      for (int i = 0; i < 32; ++i) { const int k = part * 32 + i; acc += SH[k] * rw[k * NE + e]; }
      RED[part * 16 + e] = acc; }
    __syncthreads();
    if (F.tid < 16) { float acc = 0.f;
#pragma unroll
        for (int q = 0; q < 32; ++q) acc += RED[q * 16 + F.tid];
        CB[F.tid] = acc; }
    __syncthreads();
    for (int grp = F.gw; grp < NLAT / 16; grp += F.ngw) {
        const int row0 = grp * 16, row = row0 + fr;
        const bf16_t* xr = X + (size_t)row * D + 8 * fq;
        u32x4 xv[32];
#pragma unroll
        for (int s = 0; s < 32; ++s) xv[s] = *(const u32x4*)(xr + 32 * s);
        f32x2 ss2 = (f32x2){0.f, 0.f};
        f32x4 acc = (f32x4){0.f, 0.f, 0.f, 0.f};
#pragma unroll
        for (int s = 0; s < 32; ++s) {
            const u32x4 t = xv[s];
            const f32x2 a0 = {bflo(t.x), bfhi(t.x)}, a1 = {bflo(t.y), bfhi(t.y)}, a2 = {bflo(t.z), bfhi(t.z)}, a3 = {bflo(t.w), bfhi(t.w)};
            ss2 = __builtin_elementwise_fma(a0, a0, ss2); ss2 = __builtin_elementwise_fma(a1, a1, ss2); ss2 = __builtin_elementwise_fma(a2, a2, ss2); ss2 = __builtin_elementwise_fma(a3, a3, ss2);
            const bf16x8 xb = __builtin_bit_cast(bf16x8, t);
            acc = MFMA16(*(const LAS bf16x8*)(WF + ((s * 2 + 0) * 64 + F.lane) * 16), xb, acc);
            acc = MFMA16(*(const LAS bf16x8*)(WF + ((s * 2 + 1) * 64 + F.lane) * 16), xb, acc);
            if ((s & 1) == 1) asm volatile("" ::: "memory");
        }
#pragma unroll
        for (int s = 0; s < 32; ++s) asm volatile("" : "+v"(xv[s]));
        float ss = ss2.x + ss2.y; ss += __shfl_xor(ss, 16); ss += __shfl_xor(ss, 32);
        const float rstd = rsqrtf(ss * (1.f / D) + EPS);
        float lg[4]; float mx = -3.0e38f;
#pragma unroll
        for (int r = 0; r < 4; ++r) { lg[r] = rstd * acc[r] + CB[4 * fq + r]; mx = fmaxf(mx, lg[r]); }
        mx = fmaxf(mx, __shfl_xor(mx, 16)); mx = fmaxf(mx, __shfl_xor(mx, 32));
        float ex[4], den = 0.f;
#pragma unroll
        for (int r = 0; r < 4; ++r) { ex[r] = __expf(lg[r] - mx); den += ex[r]; }
        den += __shfl_xor(den, 16); den += __shfl_xor(den, 32);
        const float inv = 1.f / den; const int t = row & (T - 1);
#pragma unroll
        for (int r = 0; r < 4; ++r) aff[((size_t)b * NE + 4 * fq + r) * T + t] = ex[r] * inv;
        unsigned char* hr = H8 + (size_t)row * D + 8 * fq;
#pragma unroll
        for (int s = 0; s < 32; ++s) {
            const u32x4 t4 = xv[s]; const int k0 = 32 * s + 8 * fq;
            const f32x4 g0 = *(const LAS f32x4*)(GS + k0), g1 = *(const LAS f32x4*)(GS + k0 + 4), h0 = *(const LAS f32x4*)(SH + k0), h1 = *(const LAS f32x4*)(SH + k0 + 4);
            f32x4 y0 = (f32x4){bflo(t4.x), bfhi(t4.x), bflo(t4.y), bfhi(t4.y)} * rstd * g0 + h0, y1 = (f32x4){bflo(t4.z), bfhi(t4.z), bflo(t4.w), bfhi(t4.w)} * rstd * g1 + h1;
            const f32x4 lim = (f32x4){448.f, 448.f, 448.f, 448.f};
            y0 = __builtin_elementwise_min(__builtin_elementwise_max(y0, -lim), lim); y1 = __builtin_elementwise_min(__builtin_elementwise_max(y1, -lim), lim);
            int w0 = __builtin_amdgcn_cvt_pk_fp8_f32(y0.x, y0.y, 0, false); w0 = __builtin_amdgcn_cvt_pk_fp8_f32(y0.z, y0.w, w0, true);
            int w1 = __builtin_amdgcn_cvt_pk_fp8_f32(y1.x, y1.y, 0, false); w1 = __builtin_amdgcn_cvt_pk_fp8_f32(y1.z, y1.w, w1, true);
            u32x2 wv; wv.x = (unsigned)w0; wv.y = (unsigned)w1;
            *(u32x2*)(hr + 32 * s) = wv;
            if ((s & 1) == 1) asm volatile("" ::: "memory");
        }
    }
    __syncthreads();
}

__device__ __forceinline__ void ph_topk(Frame& F, const Args& A) {
    LAS int* red = (LAS int*)F.lds;
    const float* aff = (const float*)(A.ws + WS_AFF); int* slot = (int*)(A.ws + WS_SLOT); int* rowlist = (int*)(A.ws + WS_ROWLIST); float* selval = (float*)(A.ws + WS_SELVAL);
    for (int item = blockIdx.x; item < NB * NE; item += F.G) {
        const int b = item / NE, e = item % NE;
        const float* a = aff + ((size_t)b * NE + e) * T + F.tid * 32;
        unsigned v[32];
#pragma unroll
        for (int q = 0; q < 8; ++q) { const u32x4 x = *(const u32x4*)(a + 4 * q); v[4 * q] = x.x; v[4 * q + 1] = x.y; v[4 * q + 2] = x.z; v[4 * q + 3] = x.w; }
        unsigned prefix = 0u; int par = 0;
        for (int bit = 30; bit >= 0; --bit) {
            const unsigned cand = prefix | (1u << bit); int cnt = 0;
#pragma unroll
            for (int i = 0; i < 32; ++i) cnt += (v[i] >= cand) ? 1 : 0;
            cnt = wave_sum_i(cnt);
            if (F.lane == 0) red[par * 16 + F.wave] = cnt;
            __syncthreads();
            int tot = 0;
#pragma unroll
            for (int w8 = 0; w8 < 8; ++w8) tot += red[par * 16 + w8];
            if (tot >= CAP) prefix = cand;
            par ^= 1;
        }
        __syncthreads();
        int mgt = 0, meq = 0;
#pragma unroll
        for (int i = 0; i < 32; ++i) { mgt += (v[i] > prefix) ? 1 : 0; meq += (v[i] == prefix) ? 1 : 0; }
        int igt = mgt, ieq = meq;
#pragma unroll
        for (int o = 1; o < 64; o <<= 1) { const int ug = __shfl_up(igt, o), ue = __shfl_up(ieq, o); if (F.lane >= o) { igt += ug; ieq += ue; } }
        if (F.lane == 63) { red[F.wave] = igt; red[16 + F.wave] = ieq; }
        __syncthreads();
        int bgt = 0, beq = 0, totgt = 0;
#pragma unroll
        for (int w8 = 0; w8 < 8; ++w8) { const int xg = red[w8], xe = red[16 + w8]; if (w8 < F.wave) { bgt += xg; beq += xe; } totgt += xg; }
        const int need_eq = CAP - totgt;
        int gtb = bgt + igt - mgt, eqb = beq + ieq - meq;
        const int t0 = F.tid * 32;
#pragma unroll
        for (int q = 0; q < 2; ++q) {
            int sl[16];
#pragma unroll
            for (int i = 0; i < 16; ++i) {
                const unsigned x = v[q * 16 + i]; const bool gt = x > prefix, eq = x == prefix; const bool sel = gt || (eq && eqb < need_eq);
                const int pos = gtb + (eqb < need_eq ? eqb : need_eq);
                sl[i] = sel ? pos : -1;
                if (sel) { rowlist[e * 4096 + b * CAP + pos] = b * T + t0 + q * 16 + i; selval[e * 4096 + b * CAP + pos] = __builtin_bit_cast(float, x); }
                gtb += gt ? 1 : 0; eqb += eq ? 1 : 0;
            }
#pragma unroll
            for (int i4 = 0; i4 < 4; ++i4) *(i32x4*)(slot + ((size_t)b * NE + e) * T + t0 + q * 16 + 4 * i4) = (i32x4){sl[4 * i4], sl[4 * i4 + 1], sl[4 * i4 + 2], sl[4 * i4 + 3]};
        }
        __syncthreads();
    }
}

__device__ __forceinline__ void ph_combine(Frame& F, const Args& A, int l) {
    const float* mod = (const float*)(A.ws + WS_MOD); bf16_t* X = (bf16_t*)(A.ws + WS_X); bf16_t* H = (bf16_t*)(A.ws + WS_H);
    const int* slot = (const int*)(A.ws + WS_SLOT); const unsigned char* ye = A.ws + WS_YE; const float* selval = (const float*)(A.ws + WS_SELVAL);
    for (int grp = F.gw; grp < NLAT / 16; grp += F.ngw) {
        const int row0 = grp * 16, b = row0 >> 14, t0 = row0 & (T - 1);
        const i32x4 sv4 = *(const i32x4*)(slot + ((size_t)b * NE + (F.lane & 15)) * T + t0 + 4 * (F.lane >> 4));
        f32x4 g2v[4], pa[4], pb[4], pc[4];
#pragma unroll
        for (int j = 0; j < 4; ++j) { const int c = 4 * F.lane + 256 * j;
            g2v[j] = *(const f32x4*)(mod + (l * 3 + b) * 6 * D + 5 * D + c);
            if (l == 0) { pa[j] = *(const f32x4*)(A.in[P_NORMG] + (1 * 2 + 0) * D + c); pb[j] = *(const f32x4*)(mod + (1 * 3 + b) * 6 * D + 0 * D + c); pc[j] = *(const f32x4*)(mod + (1 * 3 + b) * 6 * D + 1 * D + c) + 1.f; }
            else { pa[j] = *(const f32x4*)(A.in[P_FINALG] + c); pb[j] = pa[j]; pc[j] = pa[j]; } }
#pragma unroll 1
        for (int rq = 0; rq < 4; ++rq) {
#pragma unroll
          for (int rh = 0; rh < 2; ++rh) {
            unsigned mask[2]; int yrow[2][4]; float wv[2][4]; u32x2 xr[2][4]; int yv[2][4][4];
#pragma unroll
            for (int p2 = 0; p2 < 2; ++p2) {
                const int ri = 2 * rh + p2, row = row0 + 4 * rq + ri, svr = sv4[ri];
                unsigned m = (unsigned)(__ballot(svr >= 0) >> (16 * rq)) & 0xFFFFu;
                const int e0 = m ? __builtin_ctz(m) : 0;
#pragma unroll
                for (int q = 0; q < 4; ++q) { const bool valid = m != 0u; const int e = valid ? __builtin_ctz(m) : e0; m &= m - 1u;
                    const int sq = __builtin_amdgcn_readlane(svr, 16 * rq + e); yrow[p2][q] = e * 4096 + b * CAP + (sq < 0 ? 0 : sq); wv[p2][q] = valid ? selval[yrow[p2][q]] * (1.f / 32) : 0.f; }
                mask[p2] = m;
#pragma unroll
                for (int j = 0; j < 4; ++j) xr[p2][j] = *(const u32x2*)(X + (size_t)row * D + 4 * F.lane + 256 * j);
#pragma unroll
                for (int q = 0; q < 4; ++q)
#pragma unroll
                    for (int j = 0; j < 4; ++j) yv[p2][q][j] = *(const int*)(ye + (size_t)yrow[p2][q] * D + 4 * F.lane + 256 * j);
            }
#pragma unroll
            for (int p2 = 0; p2 < 2; ++p2) {
                const int ri = 2 * rh + p2, row = row0 + 4 * rq + ri, svr = sv4[ri];
                f32x4 acc[4];
#pragma unroll
                for (int j = 0; j < 4; ++j) acc[j] = (f32x4){0.f, 0.f, 0.f, 0.f};
#pragma unroll
                for (int q = 0; q < 4; ++q)
#pragma unroll
                    for (int j = 0; j < 4; ++j) { const f32x2 lo = __builtin_amdgcn_cvt_pk_f32_fp8(yv[p2][q][j], false), hi = __builtin_amdgcn_cvt_pk_f32_fp8(yv[p2][q][j], true);
                        acc[j].x += wv[p2][q] * lo.x; acc[j].y += wv[p2][q] * lo.y; acc[j].z += wv[p2][q] * hi.x; acc[j].w += wv[p2][q] * hi.y; }
                unsigned m = mask[p2];
                while (m) {
                    const int e = __builtin_ctz(m); m &= m - 1u;
                    const int sq = __builtin_amdgcn_readlane(svr, 16 * rq + e), yr_ = e * 4096 + b * CAP + sq; const float w1 = selval[yr_] * (1.f / 32);
#pragma unroll
                    for (int j = 0; j < 4; ++j) { const int y = *(const int*)(ye + (size_t)yr_ * D + 4 * F.lane + 256 * j); const f32x2 lo = __builtin_amdgcn_cvt_pk_f32_fp8(y, false), hi = __builtin_amdgcn_cvt_pk_f32_fp8(y, true);
                        acc[j].x += w1 * lo.x; acc[j].y += w1 * lo.y; acc[j].z += w1 * hi.x; acc[j].w += w1 * hi.y; }
                }
                f32x4 v[4]; float ssq = 0.f;
#pragma unroll
                for (int j = 0; j < 4; ++j) { const u32x2 t = xr[p2][j]; v[j] = (f32x4){bflo(t.x), bfhi(t.x), bflo(t.y), bfhi(t.y)} + g2v[j] * acc[j];
                    ssq += (v[j].x * v[j].x + v[j].y * v[j].y) + (v[j].z * v[j].z + v[j].w * v[j].w); }
                const float rstd = rsqrtf(wave_sum(ssq) * (1.f / D) + EPS);
                if (l == 0) {
#pragma unroll
                    for (int j = 0; j < 4; ++j) { const int c = 4 * F.lane + 256 * j;
                        u32x2 w; w.x = pk2(v[j].x, v[j].y); w.y = pk2(v[j].z, v[j].w); *(u32x2*)(X + (size_t)row * D + c) = w;
                        const f32x4 y = v[j] * rstd * pa[j] * pc[j] + pb[j];
                        u32x2 hw; hw.x = pk2(y.x, y.y); hw.y = pk2(y.z, y.w); *(u32x2*)(H + (size_t)row * D + c) = hw; }
                } else {
#pragma unroll
                    for (int j = 0; j < 4; ++j) { const int c = 4 * F.lane + 256 * j; *(f32x4*)(A.out + (size_t)row * D + c) = v[j] * rstd * pa[j]; }
                }
            }
          }
        }
    }
}

constexpr int N_PHASES = 20;
__global__ void __launch_bounds__(NTHR, 2) fwd_kernel(Args A) {
    extern __shared__ __attribute__((aligned(16))) unsigned char lds_raw[];
    Frame F;
    F.lds = (LAS unsigned char*)lds_raw;
    F.tid = threadIdx.x; F.lane = F.tid & 63; F.wave = __builtin_amdgcn_readfirstlane(F.tid >> 6);
    F.G = gridDim.x; F.gw = blockIdx.x * NWAVES + F.wave; F.ngw = F.G * NWAVES;
    const int lo = A.ph_lo, hi = A.ph_hi;
#ifdef ONLY_PH
#define IN(k) ((k) == ONLY_PH && lo <= (k) && (k) < hi)
#else
#define IN(k) (lo <= (k) && (k) < hi)
#endif
#if MK_MULTI
#define SEAM(k) do { } while (0)
#else
    cg::grid_group grid = cg::this_grid();
    volatile LAS unsigned* bst = (volatile LAS unsigned*)(F.lds + LDS_BYTES - 64);
    if (F.tid < 16) bst[F.tid] = 0u;
    __syncthreads();
    XcdBarrier xbar = xcd_barrier_post((unsigned*)(A.ws + WS_CTL) + 4096, bst);
    if (lo < 0) { __threadfence(); grid.sync(); }
#define SEAM(k) do { if (IN(k) && IN((k) + 1)) xcd_barrier(xbar); } while (0)
#endif
    const int c = blockIdx.x;
    #define H ((bf16_t*)(A.ws + WS_H))
#define X ((bf16_t*)(A.ws + WS_X))
#define mod ((const float*)(A.ws + WS_MOD))
#define MOE_GU(l) { eng::Gemm g{(const char*)(A.ws + WS_H), (const char*)(A.ws + WS_W8 + (size_t)(l) * W8_LAYER), (const int*)(A.ws + WS_ROWLIST), (size_t)4096 * D, D / 2, 16, 16, NE}; \
        eng::EpiSwiglu E{0x79797979, 0x7F7F7F7F, A.ws + WS_HID}; eng::gemm_phase(F.lds, g, E, F.G, c); }
#define MOE_DN(l) { eng::Gemm g{(const char*)(A.ws + WS_HID), (const char*)(A.ws + WS_W8 + (size_t)(l) * W8_LAYER + W8_WD), nullptr, (size_t)D * DEXP, DEXP / 2, 16, 4, NE}; g.rev = 1; \
        eng::EpiDown E{0x79797979, 0x7D7D7D7D, A.ws + WS_YE}; eng::gemm_phase(F.lds, g, E, F.G, c); }

    if (IN(0)) ph_prep(F, A);
    SEAM(0);
    if (IN(1)) ph_norm0(F, A);
    SEAM(1);
    if (IN(2)) { eng::Gemm g{(const char*)H, (const char*)(A.ws + WS_WIN0T), nullptr, 0, D, NROW / 256, NIN0P / 256, 1};
        eng::EpiProj0 E{(bf16_t*)(A.ws + WS_QK), A.ws + WS_VTP, (bf16_t*)(A.ws + WS_R), (float*)(A.ws + WS_AFB)}; eng::gemm_phase(F.lds, g, E, F.G, c);
        if (6 * F.G + c >= (NROW / 256) * (NIN0P / 256)) convert_expert_fixed<3>(A, F.lds, F.tid, F.wave, F.lane); }
    SEAM(2);
    if (IN(3)) ph_gla_prep(F, A);
    SEAM(3);
    if (IN(4)) ph_gla_main(F, A);
    SEAM(4);
    if (IN(5)) ph_gla_finish(F, A);
    SEAM(5);
    if (IN(6)) { eng::Gemm g{(const char*)H, (const char*)(A.ws + WS_WOUT0T), nullptr, 0, D, NLAT / 256, D / 256, 1};
        eng::EpiResidT<true> E{A.in[P_X], X, mod + (0 * 3) * 6 * D + 2 * D}; eng::gemm_phase(F.lds, g, E, F.G, c); }
    SEAM(6);
    if (IN(7)) ph_norm2_router(F, A, 0);
    SEAM(7);
    if (IN(8)) ph_topk(F, A);
    SEAM(8);
    if (IN(9)) MOE_GU(0)
    SEAM(9);
    if (IN(10)) MOE_DN(0)
    SEAM(10);
    if (IN(11)) ph_combine(F, A, 0);
    SEAM(11);
    if (IN(12)) { eng::Gemm g{(const char*)H, (const char*)(A.ws + WS_WCINT), nullptr, 0, D, NLAT / 256, NCIN / 256, 1};
        g.trip = 1;
        eng::EpiConvFused E{A.ws + WS_CDUMP + (size_t)c * 131072, (bf16_t*)(A.ws + WS_H2), A.in[P_CK]}; eng::gemm_phase(F.lds, g, E, F.G, c); }
    SEAM(12);
    if (IN(14)) { eng::Gemm g{(const char*)(A.ws + WS_H2), (const char*)(A.ws + WS_WCOUTT), nullptr, 0, D, NLAT / 256, D / 256, 1};
        eng::EpiResidT<false> E{X, X, mod + (1 * 3) * 6 * D + 2 * D}; eng::gemm_phase(F.lds, g, E, F.G, c); }
    SEAM(14);
    if (IN(15)) ph_norm2_router(F, A, 1);
    SEAM(15);
    if (IN(16)) ph_topk(F, A);
    SEAM(16);
    if (IN(17)) MOE_GU(1)
    SEAM(17);
    if (IN(18)) MOE_DN(1)
    SEAM(18);
    if (IN(19)) ph_combine(F, A, 1);
#undef IN
#undef SEAM
#undef H
#undef X
#undef mod
#undef MOE_GU
#undef MOE_DN
}

extern "C" void kernel_launch(void* const* d_in, const int* in_sizes, int n_in, void* d_out, int out_size, void* d_ws, size_t ws_size, hipStream_t stream) {
    static int grid = 0;
    if (grid == 0) {
        if (n_in != 20 || in_sizes[0] != NLAT * D || out_size != NLAT * D || ws_size < WS_END) {
            fprintf(stderr, "kernel_launch: unexpected problem: n_in %d in0 %d out %d ws %zu (need %zu)\n", n_in, n_in > 0 ? in_sizes[0] : -1, out_size, ws_size, (size_t)WS_END); grid = -1; return; }
        int dev = 0, cus = 0, per_cu = 0;
        if (hipGetDevice(&dev) != hipSuccess || hipDeviceGetAttribute(&cus, hipDeviceAttributeMultiprocessorCount, dev) != hipSuccess) { grid = -1; return; }
        if (hipFuncSetAttribute((const void*)fwd_kernel, hipFuncAttributeMaxDynamicSharedMemorySize, LDS_BYTES) != hipSuccess) { fprintf(stderr, "kernel_launch: hipFuncSetAttribute failed\n"); grid = -1; return; }
        if (hipOccupancyMaxActiveBlocksPerMultiprocessor(&per_cu, (const void*)fwd_kernel, NTHR, LDS_BYTES) != hipSuccess || per_cu < 1) { fprintf(stderr, "kernel_launch: occupancy query says %d\n", per_cu); per_cu = 1; }
        (void)hipGetLastError();
        if (cus != 256) { fprintf(stderr, "kernel_launch: built for a 256-CU device (one workgroup per CU); found %d CUs\n", cus); grid = -1; return; }
        grid = cus;
    }
    if (grid < 0) return;
    Args a{};
    for (int i = 0; i < 20; ++i) a.in[i] = (const float*)d_in[i];
    a.out = (float*)d_out; a.ws = (unsigned char*)d_ws;
#if MK_MULTI
    for (int p = 0; p < N_PHASES; ++p) {
        a.ph_lo = p; a.ph_hi = p + 1;
        hipLaunchKernelGGL(fwd_kernel, dim3(grid), dim3(NTHR), LDS_BYTES, stream, a);
    }
#else
    if (hipMemsetAsync((char*)d_ws + WS_CTL, 0, 64 * 1024, stream) != hipSuccess) { fprintf(stderr, "kernel_launch: memset failed\n"); return; }
    a.ph_lo = 0; a.ph_hi = N_PHASES;
    void* kargs[] = {&a};
    hipError_t e = hipLaunchCooperativeKernel((const void*)fwd_kernel, dim3(grid), dim3(NTHR), kargs, LDS_BYTES, stream);
    if (e != hipSuccess) fprintf(stderr, "kernel_launch: cooperative launch failed: %s (grid %d)\n", hipGetErrorString(e), grid);
#endif
}
```

```cpp
#include <hip/hip_runtime.h>
#include <hip/hip_cooperative_groups.h>
#include <cstdio>
#include <cstdint>
namespace cg = cooperative_groups;

#ifndef MK_MULTI
#define MK_MULTI 0
#endif

#define LAS __attribute__((address_space(3)))
#define GAS __attribute__((address_space(1)))
typedef unsigned short bf16_t;
typedef short bf16x8 __attribute__((ext_vector_type(8)));
typedef float f32x4 __attribute__((ext_vector_type(4)));
typedef float f32x2 __attribute__((ext_vector_type(2)));
typedef unsigned u32x4 __attribute__((ext_vector_type(4)));
typedef unsigned u32x2 __attribute__((ext_vector_type(2)));
typedef int i32x4 __attribute__((ext_vector_type(4)));
typedef int i32x8 __attribute__((ext_vector_type(8)));

constexpr int D = 1024, NB = 2, T = 16384, NLAT = NB * T, CTXL = 256, NCTX = NB * CTXL, NROW = NLAT + NCTX;
constexpr int NE = 16, CAP = 2048, DEXP = 2048;
constexpr int HEADS = 4, HK = 128, HV = 256, DK = 512, DV = 1024, RANK = 16;
constexpr int NIN0 = 3104, NIN0P = 3328;
constexpr int NCIN = 3072;
constexpr float EPS = 1e-6f;
constexpr int NWAVES = 8, NTHR = 512;

constexpr size_t MiB = 1u << 20;
constexpr size_t WS_CTL = 0;
constexpr size_t WS_MOD = 1 * MiB;
constexpr size_t WS_WIN0T = 2 * MiB;
constexpr size_t WS_WOUT0T = 9 * MiB;
constexpr size_t WS_WCINT = 11 * MiB;
constexpr size_t WS_WCOUTT = 17 * MiB;
constexpr size_t WS_AFF = 19 * MiB;
constexpr size_t WS_SLOT = 21 * MiB;
constexpr size_t WS_ROWLIST = 23 * MiB;
constexpr size_t WS_SELVAL = 23 * MiB + 512 * 1024;
constexpr size_t WS_AFB = 24 * MiB;
constexpr size_t WS_W8 = 32 * MiB;
constexpr size_t W8_LAYER = 96 * MiB, W8_WD = 64 * MiB;
constexpr size_t WS_X = 224 * MiB;
constexpr size_t WS_H = 354 * MiB;
constexpr size_t WS_ARENA = 420 * MiB;
constexpr size_t WS_QK = WS_ARENA;
constexpr size_t WS_V = WS_ARENA + 65 * MiB;
constexpr size_t WS_R = WS_ARENA + 130 * MiB;
constexpr size_t WS_QP = WS_ARENA + 195 * MiB;
constexpr size_t WS_KP = WS_ARENA + 260 * MiB;
constexpr size_t WS_KTP = WS_ARENA + 325 * MiB;
constexpr size_t WS_VTP = WS_ARENA + 390 * MiB;
constexpr size_t WS_OI = WS_ARENA + 455 * MiB;
constexpr size_t WS_GAM = WS_ARENA + 519 * MiB;
constexpr size_t WS_OF = WS_QK;
constexpr size_t WS_OB = WS_V;
constexpr size_t WS_HID = WS_ARENA;
constexpr size_t WS_YE = WS_ARENA + 128 * MiB;
constexpr size_t WS_H2 = WS_ARENA;
constexpr size_t WS_CDUMP = WS_ARENA + 64 * MiB;
constexpr size_t WS_END = WS_ARENA + 522 * MiB;
static_assert(WS_R - WS_QK == 130 * MiB, "EpiProj0 strides");
constexpr size_t BLOB = 16384;
constexpr int NCHUNK = NROW / 64;

__device__ __forceinline__ float wave_sum(float v) {
#pragma unroll
    for (int o = 1; o < 64; o <<= 1) v += __shfl_xor(v, o);
    return v;
}
__device__ __forceinline__ int wave_sum_i(int v) {
#pragma unroll
    for (int o = 1; o < 64; o <<= 1) v += __shfl_xor(v, o);
    return v;
}
__device__ __forceinline__ unsigned f2bf(float f) { unsigned u = __builtin_bit_cast(unsigned, f); return (u + 0x7fffu + ((u >> 16) & 1u)) >> 16; }
typedef __bf16 bf16x2_t __attribute__((ext_vector_type(2)));
__device__ __forceinline__ unsigned pk2(float lo, float hi) { const f32x2 v = {lo, hi}; return __builtin_bit_cast(unsigned, __builtin_convertvector(v, bf16x2_t)); }
__device__ __forceinline__ float bflo(unsigned u) { return __builtin_bit_cast(float, u << 16); }
__device__ __forceinline__ float bfhi(unsigned u) { return __builtin_bit_cast(float, u & 0xffff0000u); }
__device__ __forceinline__ float silu_f(float x) { return x / (1.f + __expf(-x)); }
#define LDS_WAIT() asm volatile("s_waitcnt lgkmcnt(0)" ::: "memory")


#define XB_TMO      128
#define XB_XCNT(j)  (256  + 64 * (j))
#define XB_XSUB(j)  (1280 + 64 * (j))
#define XB_XGEN(j)  (2304 + 64 * (j))
#define XB_TOP      3328
#define XB_TOPGEN   3392
#define XCD_BAR_WORDS 3456
#define XB_SPIN_CAP (1u << 22)
__device__ __forceinline__ unsigned xb_ld(unsigned* p)              { return __hip_atomic_load(p, __ATOMIC_RELAXED, __HIP_MEMORY_SCOPE_AGENT); }
__device__ __forceinline__ unsigned xb_add(unsigned* p, unsigned v) { return __hip_atomic_fetch_add(p, v, __ATOMIC_RELAXED, __HIP_MEMORY_SCOPE_AGENT); }
__device__ __forceinline__ unsigned xb_xcc_id() { return (unsigned)__builtin_amdgcn_s_getreg((3 << 11) | 20) & 0xFu; }
#define XB_SPIN(cond, bar) do { unsigned _sp = 0; while (cond) { \
    if ((++_sp & 255u) == 0u) { if (xb_ld(&(bar)[XB_TMO])) break; if (_sp > XB_SPIN_CAP) { atomicAdd(&(bar)[XB_TMO], 1u); break; } } } } while (0)
struct XcdBarrier { unsigned* bar; unsigned x; volatile LAS unsigned* st; };
__device__ __forceinline__ XcdBarrier xcd_barrier_post(unsigned* bar, volatile LAS unsigned* st) {
    XcdBarrier b; b.bar = bar; b.x = xb_xcc_id(); b.st = st;
    if (threadIdx.x == 0) (void)xb_add(&bar[XB_XCNT(b.x)], 1u);
    return b;
}
__device__ __forceinline__ void xcd_barrier_complete(unsigned* bar, unsigned x, unsigned& nloc, unsigned& nx) {
    const unsigned G = gridDim.x * gridDim.y * gridDim.z;
    unsigned sum, cnt, mine, sp = 0u;
    for (;;) {
        sum = 0u; cnt = 0u; mine = 0u;
#pragma unroll
        for (unsigned j = 0; j < 16; ++j) { const unsigned c = xb_ld(&bar[XB_XCNT(j)]); sum += c; cnt += (c > 0u) ? 1u : 0u; mine = (j == x) ? c : mine; }
        if (sum == G) break;
        __builtin_amdgcn_s_sleep(1);
        if ((++sp & 255u) == 0u) { if (xb_ld(&bar[XB_TMO])) break; if (sp > XB_SPIN_CAP) { atomicAdd(&bar[XB_TMO], 1u); break; } }
    }
    nloc = mine > 0u ? mine : 1u; nx = cnt > 0u ? cnt : 1u;
}
__device__ __forceinline__ void xcd_barrier(const XcdBarrier& b) {
    asm volatile("s_waitcnt vmcnt(0)" ::: "memory");
    __syncthreads();
    if (threadIdx.x == 0) {
        unsigned* bar = b.bar;
        __builtin_amdgcn_s_waitcnt(0);
        unsigned nloc = b.st[0], nx = b.st[1];
        if (nloc == 0u) { xcd_barrier_complete(bar, b.x, nloc, nx); b.st[0] = nloc; b.st[1] = nx; }
        const unsigned old = xb_add(&bar[XB_XSUB(b.x)], 1u);
        const unsigned gen = old / nloc;
        if (old + 1u == (gen + 1u) * nloc) {
            __builtin_amdgcn_fence(__ATOMIC_RELEASE, "agent");
            asm volatile("s_waitcnt vmcnt(0)" ::: "memory");
            const unsigned og = xb_add(&bar[XB_TOP], 1u);
            const unsigned tg = og / nx;
            __builtin_amdgcn_fence(__ATOMIC_ACQUIRE, "agent");
            if (og + 1u == (tg + 1u) * nx) xb_add(&bar[XB_TOPGEN], 1u);
            else XB_SPIN(xb_ld(&bar[XB_TOPGEN]) == tg, bar);
            xb_add(&bar[XB_XGEN(b.x)], 1u);
            asm volatile("s_waitcnt vmcnt(0)" ::: "memory");
        } else {
            __builtin_amdgcn_fence(__ATOMIC_ACQUIRE, "agent");
            XB_SPIN(xb_ld(&bar[XB_XGEN(b.x)]) == gen, bar);
            asm volatile("s_waitcnt vmcnt(0)" ::: "memory");
        }
    }
    __syncthreads();
}

namespace eng {
constexpr int BM = 256, BK = 64, HALF = 128, HTB = HALF * BK * 2, STAGE_BYTES = 8 * HTB, NXCD = 8, WGM = 8;
__host__ __device__ __forceinline__ int lds_byte(int r, int c) { const int st = (r >> 4) * 2 + (c >> 5), rr = r & 15, cc = c & 31, ob = rr * 64 + cc * 2; return st * 1024 + (ob ^ (((ob >> 9) & 1) << 5)); }
__host__ __device__ __forceinline__ void stage_rc(int b, int& R, int& C) { const int st = b / 1024, sb = b % 1024, swz = sb ^ (((sb >> 9) & 1) << 5); R = (st >> 1) * 16 + swz / 64; C = (st & 1) * 32 + (swz % 64) / 2; }
__host__ __device__ __forceinline__ int perm32(int rho) { const int n = rho >> 4, i = rho & 15; return 8 * (i >> 2) + 4 * n + (i & 3); }

struct Unit { int e, pm, pn; };
struct Gemm {
    const char* A;
    const char* Bt;
    const int* rows;
    size_t bstride;
    int K, nM, nN, ngroups;
    int rev = 0;
    int trip = 0;
};
__device__ __forceinline__ bool next_unit(const Gemm& g, int i, int G, int c, Unit& u) {
    if (g.trip) {
        const int per3 = g.nM * (g.nN / 3), j = i / 3, sec = i - 3 * j; int s = j * G + c; if (s >= per3) return false;
        { const int q = per3 / NXCD, r = per3 % NXCD, xcd = s % NXCD, off = s / NXCD; s = (xcd < r ? xcd * (q + 1) : r * (q + 1) + (xcd - r) * q) + off; }
        const int ncb = g.nN / 3; u.e = 0; u.pm = s / ncb; u.pn = 3 * (s % ncb) + sec; return true;
    }
    const int per = g.nM * g.nN;
    const long L = (long)i * G + c; if (L >= (long)per * g.ngroups) return false;
    u.e = (int)(L / per); int wgid = (int)(L % per);
    if (g.rev) u.e = g.ngroups - 1 - u.e;
    { const int nwg = per, q = nwg / NXCD, r = nwg % NXCD, xcd = wgid % NXCD, off = wgid / NXCD; wgid = (xcd < r ? xcd * (q + 1) : r * (q + 1) + (xcd - r) * q) + off; }
    const int nig = WGM * g.nN, gid = wgid / nig, fm = gid * WGM, gsz = (g.nM - fm) < WGM ? (g.nM - fm) : WGM;
    u.pm = fm + ((wgid % nig) % gsz); u.pn = (wgid % nig) / gsz; return true;
}
__device__ __forceinline__ bf16x8 lo8(const i32x8& f) { return __builtin_bit_cast(bf16x8, (i32x4)__builtin_shufflevector(f, f, 0, 1, 2, 3)); }
__device__ __forceinline__ bf16x8 hi8(const i32x8& f) { return __builtin_bit_cast(bf16x8, (i32x4)__builtin_shufflevector(f, f, 4, 5, 6, 7)); }
__device__ __forceinline__ i32x8 cat8(bf16x8 lo, bf16x8 hi) { const i32x4 a = __builtin_bit_cast(i32x4, lo), b = __builtin_bit_cast(i32x4, hi); return __builtin_shufflevector(a, b, 0, 1, 2, 3, 4, 5, 6, 7); }
__device__ __forceinline__ unsigned cvt_pk_bf16(float lo, float hi) { unsigned r; asm volatile("v_cvt_pk_bf16_f32 %0, %1, %2" : "=v"(r) : "v"(lo), "v"(hi)); return r; }

#ifndef ENG_SP2
#define ENG_SP2 true
#endif
#ifndef ENG_ALIGN
#define ENG_ALIGN true
#endif
template <class Epi, bool SP2 = ENG_SP2, bool ALIGN_EPI = ENG_ALIGN>
__device__ __forceinline__ void gemm_phase(LAS unsigned char* lds, const Gemm g, const Epi& E, int G, int c) {
    int tid = threadIdx.x; asm volatile("" : "+v"(tid));
    const int wid = __builtin_amdgcn_readfirstlane(tid >> 6), lane = tid & 63, wr = wid >> 2, wc = wid & 3, fr = lane & 15, fq = lane >> 4;
    const int K = g.K, nt = K / BK;
    int R0, C0; stage_rc(tid * 16, R0, C0);
    const int Rb0 = Epi::PERM ? ((R0 & ~31) + perm32(R0 & 31)) : R0;
    unsigned voffB[2]; voffB[0] = (unsigned)(Rb0 * K + C0) * 2u; voffB[1] = (unsigned)((Rb0 + 64) * K + C0) * 2u;
    constexpr bool SW = Epi::SWAPV;
    const char* const abase = SW ? g.Bt : g.A;
    const unsigned adelta = SW ? (unsigned)(size_t)(g.A - g.Bt) : 0u;
    const unsigned dltB = SW ? (unsigned)((R0 - Rb0) * K) * 2u : 0u;
    const size_t hstepB = (size_t)HALF * K * 2;
    const unsigned ldsw = (unsigned)wid * 1024u;
    const int aoff = lds_byte(wr * 64 + fr, fq * 8), boff = lds_byte(wc * 32 + fr, fq * 8);
#define PG8_SA(b, h) (((b) * 2 + (h)) * HTB)
#define PG8_SB(b, h) ((4 + (b) * 2 + (h)) * HTB)
#define PG8_GLDS(gp, bufoff, i) __builtin_amdgcn_global_load_lds((const unsigned*)(gp), (LAS unsigned*)(lds + (bufoff) + ldsw + (i) * 8192), 16, 0, 0)
#define PG8_STAGE_B(bufoff, bp, h, kt) do { const char* _p = (bp) + (size_t)(h) * hstepB + (size_t)(kt) * 128; asm volatile("" : "+s"(_p)); PG8_GLDS(_p + (voffB[0] + (SW ? dselB : 0u)), bufoff, 0); PG8_GLDS(_p + (voffB[1] + (SW ? dselB : 0u)), bufoff, 1); } while (0)
#define PG8_STAGE_A(bufoff, v0, v1, kt) do { const char* _p = abase + (size_t)(kt) * 128; asm volatile("" : "+s"(_p)); PG8_GLDS(_p + (v0), bufoff, 0); PG8_GLDS(_p + (v1), bufoff, 1); } while (0)
#define PG8_LDA(dst, b, h) do { _Pragma("unroll") for (int m = 0; m < 4; ++m) dst[m] = cat8(*(const LAS bf16x8*)(lds + PG8_SA(b, h) + aoff + m * 2048), *(const LAS bf16x8*)(lds + PG8_SA(b, h) + aoff + m * 2048 + 1024)); } while (0)
#define PG8_LDB(dst, b, h) do { _Pragma("unroll") for (int n = 0; n < 2; ++n) dst[n] = cat8(*(const LAS bf16x8*)(lds + PG8_SB(b, h) + boff + n * 2048), *(const LAS bf16x8*)(lds + PG8_SB(b, h) + boff + n * 2048 + 1024)); } while (0)
#define PG8_MMA(ai, bj, At, Bt) do { __builtin_amdgcn_s_setprio(1); \
        if constexpr (Epi::FP8) { _Pragma("unroll") for (int m = 0; m < 4; ++m) _Pragma("unroll") for (int n = 0; n < 2; ++n) \
            asm volatile("v_mfma_scale_f32_16x16x128_f8f6f4 %0, %1, %2, %0, %3, %4 op_sel_hi:[0,0,0]" : "+v"(acc[ai][bj][m][n]) : "v"(Bt[n]), "v"(At[m]), "v"(sc_w), "v"(sc_a)); } \
        else { _Pragma("unroll") for (int m = 0; m < 4; ++m) _Pragma("unroll") for (int n = 0; n < 2; ++n) { \
            acc[ai][bj][m][n] = __builtin_amdgcn_mfma_f32_16x16x32_bf16(lo8(Bt[n]), lo8(At[m]), acc[ai][bj][m][n], 0, 0, 0); \
            acc[ai][bj][m][n] = __builtin_amdgcn_mfma_f32_16x16x32_bf16(hi8(Bt[n]), hi8(At[m]), acc[ai][bj][m][n], 0, 0, 0); } } \
        __builtin_amdgcn_s_setprio(0); } while (0)
#define PG8_WAIT_V(n) asm volatile("s_waitcnt vmcnt(" #n ")" ::: "memory")
#define PG8_WAIT_L(n) asm volatile("s_waitcnt lgkmcnt(" #n ")" ::: "memory")
#define PG8_BAR __builtin_amdgcn_s_barrier()
#define PG8_SCHED __builtin_amdgcn_sched_barrier(0)
#define PG8_ROWOFF(u, h, i) ((SW && E.swapv(u)) ? (unsigned)(((u).pn * 256 + (h) * 128 + R0 + 64 * (i)) * K + C0) * 2u : adelta + ((unsigned)(((g.rows ? g.rows[((u).e * g.nM + (u).pm) * 256 + (h) * 128 + R0 + 64 * (i)] : (((u).e * g.nM + (u).pm) * 256 + (h) * 128 + R0 + 64 * (i))) * K + C0)) * 2u))
#define PG8_BPTR(u) ((SW && E.swapv(u)) ? g.A + (size_t)(u).pm * 2 * hstepB : g.Bt + (size_t)(u).e * g.bstride + (size_t)(u).pn * 2 * hstepB)
    Unit cur, nxt; int ui = 0;
    if (!next_unit(g, 0, G, c, cur)) return;
    f32x4 acc[2][2][4][2];
#pragma unroll
    for (int a = 0; a < 2; ++a)
#pragma unroll
        for (int b = 0; b < 2; ++b)
#pragma unroll
            for (int m = 0; m < 4; ++m)
#pragma unroll
                for (int n = 0; n < 2; ++n) acc[a][b][m][n] = (f32x4){0.f, 0.f, 0.f, 0.f};
    int sc_w = E.scale_w, sc_a = E.scale_a;
    asm volatile("" : "+v"(sc_w), "+v"(sc_a));
    i32x8 At[4], B0[2], B1[2];
    unsigned c00 = PG8_ROWOFF(cur, 0, 0), c01 = PG8_ROWOFF(cur, 0, 1), c10 = PG8_ROWOFF(cur, 1, 0), c11 = PG8_ROWOFF(cur, 1, 1);
    const char* cB = PG8_BPTR(cur);
    unsigned cD = (SW && E.swapv(cur)) ? dltB : 0u, dselB = cD;
    if constexpr (SP2) {
        PG8_STAGE_B(PG8_SB(0, 0), cB, 0, 0); PG8_STAGE_B(PG8_SB(0, 1), cB, 1, 0); PG8_STAGE_A(PG8_SA(0, 0), c00, c01, 0); PG8_STAGE_A(PG8_SA(0, 1), c10, c11, 0);
        if (wr == 1) PG8_BAR;
        PG8_WAIT_V(2); PG8_BAR;
        PG8_STAGE_B(PG8_SB(1, 0), cB, 0, 1); PG8_STAGE_A(PG8_SA(1, 0), c00, c01, 1); PG8_STAGE_B(PG8_SB(1, 1), cB, 1, 1);
        PG8_WAIT_V(6); PG8_BAR;
    } else {
        PG8_STAGE_B(PG8_SB(0, 0), cB, 0, 0); PG8_STAGE_A(PG8_SA(0, 0), c00, c01, 0); PG8_STAGE_B(PG8_SB(0, 1), cB, 1, 0); PG8_STAGE_A(PG8_SA(0, 1), c10, c11, 0);
        if (wr == 1) PG8_BAR;
        PG8_WAIT_V(4); PG8_BAR;
        PG8_STAGE_B(PG8_SB(1, 0), cB, 0, 1); PG8_STAGE_A(PG8_SA(1, 0), c00, c01, 1); PG8_STAGE_B(PG8_SB(1, 1), cB, 1, 1);
        PG8_WAIT_V(6); PG8_BAR;
    }
    for (;;) {
        const bool has_next = next_unit(g, ui + 1, G, c, nxt);
        unsigned n00 = c00, n01 = c01, n10 = c10, n11 = c11; const char* nB = cB; unsigned nD = cD;
        if (has_next) { n00 = PG8_ROWOFF(nxt, 0, 0); n01 = PG8_ROWOFF(nxt, 0, 1); n10 = PG8_ROWOFF(nxt, 1, 0); n11 = PG8_ROWOFF(nxt, 1, 1);
                        nB = PG8_BPTR(nxt); nD = (SW && E.swapv(nxt)) ? dltB : 0u; }
#pragma unroll 1
        for (int t = 0; t < nt; t += 2) {
            const bool last = (t == nt - 2);
            const int kt2 = last ? 0 : t + 2, kt3 = kt2 + 1;
            const char* b2 = last ? nB : cB; dselB = last ? nD : cD;
            const unsigned s00 = last ? n00 : c00, s01 = last ? n01 : c01, s10 = last ? n10 : c10, s11 = last ? n11 : c11;
            if constexpr (SP2) {
            PG8_LDB(B0, 0, 0); PG8_LDB(B1, 0, 1); PG8_SCHED; PG8_LDA(At, 0, 0); PG8_STAGE_A(PG8_SA(1, 1), c10, c11, t + 1);
            PG8_WAIT_V(8); PG8_WAIT_L(0); PG8_BAR; PG8_MMA(0, 0, At, B0); PG8_MMA(0, 1, At, B1); PG8_BAR; PG8_SCHED;
            PG8_LDA(At, 0, 1); PG8_STAGE_B(PG8_SB(0, 0), b2, 0, kt2); PG8_STAGE_B(PG8_SB(0, 1), b2, 1, kt2); PG8_STAGE_A(PG8_SA(0, 0), s00, s01, kt2);
            PG8_WAIT_V(8); PG8_WAIT_L(0); PG8_BAR; PG8_MMA(1, 0, At, B0); PG8_MMA(1, 1, At, B1); PG8_BAR; PG8_SCHED;
            PG8_LDB(B0, 1, 0); PG8_LDB(B1, 1, 1); PG8_SCHED; PG8_LDA(At, 1, 0); PG8_STAGE_A(PG8_SA(0, 1), s10, s11, kt2);
            PG8_WAIT_V(8); PG8_WAIT_L(0); PG8_BAR; PG8_MMA(0, 0, At, B0); PG8_MMA(0, 1, At, B1); PG8_BAR; PG8_SCHED;
            PG8_LDA(At, 1, 1); PG8_STAGE_B(PG8_SB(1, 0), b2, 0, kt3); PG8_STAGE_B(PG8_SB(1, 1), b2, 1, kt3); PG8_STAGE_A(PG8_SA(1, 0), s00, s01, kt3);
            PG8_WAIT_V(8); PG8_WAIT_L(0); PG8_BAR; PG8_MMA(1, 0, At, B0); PG8_MMA(1, 1, At, B1); PG8_BAR; PG8_SCHED;
            } else {
            PG8_LDB(B0, 0, 0); PG8_SCHED; PG8_LDA(At, 0, 0); PG8_STAGE_A(PG8_SA(1, 1), c10, c11, t + 1);
            PG8_WAIT_L(8); PG8_BAR; PG8_WAIT_L(0); PG8_MMA(0, 0, At, B0); PG8_BAR; PG8_SCHED;
            PG8_LDB(B1, 0, 1); PG8_STAGE_B(PG8_SB(0, 0), b2, 0, kt2);
            PG8_BAR; PG8_WAIT_L(0); PG8_MMA(0, 1, At, B1); PG8_BAR;
            PG8_LDA(At, 0, 1); PG8_STAGE_A(PG8_SA(0, 0), s00, s01, kt2);
            PG8_BAR; PG8_WAIT_L(0); PG8_MMA(1, 0, At, B0); PG8_BAR; PG8_SCHED;
            PG8_STAGE_B(PG8_SB(0, 1), b2, 1, kt2);
            PG8_WAIT_V(6); PG8_BAR; PG8_MMA(1, 1, At, B1); PG8_BAR;
            PG8_LDB(B0, 1, 0); PG8_SCHED; PG8_LDA(At, 1, 0); PG8_STAGE_A(PG8_SA(0, 1), s10, s11, kt2);
            PG8_WAIT_L(8); PG8_BAR; PG8_WAIT_L(0); PG8_MMA(0, 0, At, B0); PG8_BAR; PG8_SCHED;
            PG8_LDB(B1, 1, 1); PG8_STAGE_B(PG8_SB(1, 0), b2, 0, kt3);
            PG8_BAR; PG8_WAIT_L(0); PG8_MMA(0, 1, At, B1); PG8_BAR;
            PG8_LDA(At, 1, 1); PG8_STAGE_A(PG8_SA(1, 0), s00, s01, kt3);
            PG8_BAR; PG8_WAIT_L(0); PG8_MMA(1, 0, At, B0); PG8_BAR; PG8_SCHED;
            PG8_STAGE_B(PG8_SB(1, 1), b2, 1, kt3);
            PG8_WAIT_V(6); PG8_BAR; PG8_MMA(1, 1, At, B1); PG8_BAR;
            }
        }
        if constexpr (Epi::FP8) {
            _Pragma("unroll") for (int a = 0; a < 2; ++a)
                asm volatile("s_nop 15\n\ts_nop 15" : "+v"(acc[a][0][0][0]), "+v"(acc[a][0][0][1]), "+v"(acc[a][0][1][0]), "+v"(acc[a][0][1][1]), "+v"(acc[a][0][2][0]), "+v"(acc[a][0][2][1]), "+v"(acc[a][0][3][0]), "+v"(acc[a][0][3][1]),
                             "+v"(acc[a][1][0][0]), "+v"(acc[a][1][0][1]), "+v"(acc[a][1][1][0]), "+v"(acc[a][1][1][1]), "+v"(acc[a][1][2][0]), "+v"(acc[a][1][2][1]), "+v"(acc[a][1][3][0]), "+v"(acc[a][1][3][1]));
        }
        if constexpr (ALIGN_EPI) { if (wr == 0) PG8_BAR; }
        E(acc, cur, wr, wc, fr, fq);
        if (!has_next) break;
#pragma unroll
        for (int a = 0; a < 2; ++a)
#pragma unroll
            for (int b = 0; b < 2; ++b)
#pragma unroll
                for (int m = 0; m < 4; ++m)
#pragma unroll
                    for (int n = 0; n < 2; ++n) acc[a][b][m][n] = (f32x4){0.f, 0.f, 0.f, 0.f};
        cur = nxt; cB = nB; cD = nD; c00 = n00; c01 = n01; c10 = n10; c11 = n11; ++ui;
        if constexpr (ALIGN_EPI) { if (wr == 1) PG8_BAR; }
    }
    PG8_WAIT_V(0);
    if constexpr (!ALIGN_EPI) { if (wr == 0) PG8_BAR; }
    PG8_BAR;
#undef PG8_SA
#undef PG8_SB
#undef PG8_GLDS
#undef PG8_STAGE_A
#undef PG8_STAGE_B
#undef PG8_LDA
#undef PG8_LDB
#undef PG8_MMA
#undef PG8_WAIT_V
#undef PG8_WAIT_L
#undef PG8_BAR
#undef PG8_SCHED
#undef PG8_ROWOFF
#undef PG8_BPTR
}

struct EpiProj0 {
    static constexpr bool FP8 = false; static constexpr int scale_w = 0, scale_a = 0;
    static constexpr bool PERM = true; static constexpr bool SWAPV = true;
    __device__ __forceinline__ bool swapv(const Unit& u) const { return u.pn >= 4 && u.pn < 8; }
    bf16_t* qk; unsigned char* vtp; bf16_t* r; float* afb;
    __device__ __forceinline__ void operator()(const f32x4 (&acc)[2][2][4][2], const Unit& u, int wr, int wc, int fr, int fq) const {
        const int row0 = u.pm * BM + wr * 64 + fr;
        if (swapv(u)) {
            unsigned char* p0 = vtp + (size_t)(4 * u.pm + (wc >> 1)) * 131072 + (size_t)((((16 * (u.pn - 4) + 4 * wr) * 2 + (wc & 1)) * 64 + fr + 16 * fq) * 16);
#pragma unroll
            for (int ai = 0; ai < 2; ++ai)
#pragma unroll
                for (int m = 0; m < 4; ++m)
#pragma unroll
                    for (int bj = 0; bj < 2; ++bj) { const f32x4 v0 = acc[ai][bj][m][0], v1 = acc[ai][bj][m][1];
                        u32x4 w; w.x = cvt_pk_bf16(v0[0], v0[1]); w.y = cvt_pk_bf16(v0[2], v0[3]); w.z = cvt_pk_bf16(v1[0], v1[1]); w.w = cvt_pk_bf16(v1[2], v1[3]);
                        *(u32x4*)(p0 + (size_t)bj * 2 * 131072 + (size_t)(8 * ai + m) * 2048) = w; }
        } else if (u.pn < 12) {
            const float sc = (u.pn < 2) ? 0.08838834764831845f : 1.f;
            bf16_t* base = qk + (size_t)(u.pn >> 3) * (size_t)(130 * MiB / 2);
            const int col0 = (u.pn & 3) * BM + wc * 32 + 8 * fq;
#pragma unroll
            for (int ai = 0; ai < 2; ++ai)
#pragma unroll
                for (int m = 0; m < 4; ++m) { bf16_t* rowp = base + (size_t)(row0 + ai * HALF + m * 16) * D + col0;
#pragma unroll
                    for (int bj = 0; bj < 2; ++bj) { const f32x4 v0 = acc[ai][bj][m][0] * sc, v1 = acc[ai][bj][m][1] * sc;
                        u32x4 w; w.x = cvt_pk_bf16(v0[0], v0[1]); w.y = cvt_pk_bf16(v0[2], v0[3]); w.z = cvt_pk_bf16(v1[0], v1[1]); w.w = cvt_pk_bf16(v1[2], v1[3]);
                        *(u32x4*)(rowp + bj * HALF) = w; } }
        } else if (wc == 0) {
#pragma unroll
            for (int ai = 0; ai < 2; ++ai)
#pragma unroll
                for (int m = 0; m < 4; ++m) { float* rowp = afb + (size_t)(row0 + ai * HALF + m * 16) * 32 + 8 * fq;
                    *(f32x4*)(rowp) = acc[ai][0][m][0]; *(f32x4*)(rowp + 4) = acc[ai][0][m][1]; }
        }
    }
};
template <bool SRC_F32>
struct EpiResidT {
    static constexpr bool FP8 = false; static constexpr int scale_w = 0, scale_a = 0;
    static constexpr bool PERM = true; static constexpr bool SWAPV = false; __device__ __forceinline__ bool swapv(const Unit&) const { return false; }
    const void* src; bf16_t* dst; const float* gate;
    __device__ __forceinline__ void operator()(const f32x4 (&acc)[2][2][4][2], const Unit& u, int wr, int wc, int fr, int fq) const {
        const int row0 = u.pm * BM + wr * 64 + fr, col0 = u.pn * BM + wc * 32 + 8 * fq;
        const int b = (u.pm * BM) >> 14;
        f32x4 gv[2][2];
#pragma unroll
        for (int bj = 0; bj < 2; ++bj)
#pragma unroll
            for (int n = 0; n < 2; ++n) gv[bj][n] = *(const f32x4*)(gate + (size_t)b * 6 * D + col0 + bj * HALF + n * 4);
#pragma unroll
        for (int ai = 0; ai < 2; ++ai) {
            f32x4 sv[4][2][2];
#pragma unroll
            for (int m = 0; m < 4; ++m)
#pragma unroll
                for (int bj = 0; bj < 2; ++bj) { const size_t off = (size_t)(row0 + ai * HALF + m * 16) * D + col0 + bj * HALF;
                    if constexpr (SRC_F32) { sv[m][bj][0] = *(const f32x4*)((const float*)src + off); sv[m][bj][1] = *(const f32x4*)((const float*)src + off + 4); }
                    else { const u32x4 t = *(const u32x4*)((const bf16_t*)src + off);
                        sv[m][bj][0] = (f32x4){bflo(t.x), bfhi(t.x), bflo(t.y), bfhi(t.y)}; sv[m][bj][1] = (f32x4){bflo(t.z), bfhi(t.z), bflo(t.w), bfhi(t.w)}; } }
            asm volatile("" ::: "memory");
#pragma unroll
            for (int m = 0; m < 4; ++m)
#pragma unroll
                for (int bj = 0; bj < 2; ++bj) { const f32x4 y0 = sv[m][bj][0] + gv[bj][0] * acc[ai][bj][m][0], y1 = sv[m][bj][1] + gv[bj][1] * acc[ai][bj][m][1];
                    u32x4 w; w.x = cvt_pk_bf16(y0[0], y0[1]); w.y = cvt_pk_bf16(y0[2], y0[3]); w.z = cvt_pk_bf16(y1[0], y1[1]); w.w = cvt_pk_bf16(y1[2], y1[3]);
                    *(u32x4*)(dst + (size_t)(row0 + ai * HALF + m * 16) * D + col0 + bj * HALF) = w; }
        }
    }
};
struct EpiBf16Plain {
    static constexpr bool FP8 = false; static constexpr int scale_w = 0, scale_a = 0;
    static constexpr bool PERM = true; static constexpr bool SWAPV = false; __device__ __forceinline__ bool swapv(const Unit&) const { return false; }
    bf16_t* O; int ldc;
    __device__ __forceinline__ void operator()(const f32x4 (&acc)[2][2][4][2], const Unit& u, int wr, int wc, int fr, int fq) const {
        const int row0 = u.pm * BM + wr * 64 + fr, col0 = u.pn * BM + wc * 32 + 8 * fq;
#pragma unroll
        for (int ai = 0; ai < 2; ++ai)
#pragma unroll
            for (int m = 0; m < 4; ++m) { bf16_t* rowp = O + (size_t)(row0 + ai * HALF + m * 16) * ldc + col0;
#pragma unroll
                for (int bj = 0; bj < 2; ++bj) { const f32x4 v0 = acc[ai][bj][m][0], v1 = acc[ai][bj][m][1];
                    u32x4 w; w.x = cvt_pk_bf16(v0[0], v0[1]); w.y = cvt_pk_bf16(v0[2], v0[3]); w.z = cvt_pk_bf16(v1[0], v1[1]); w.w = cvt_pk_bf16(v1[2], v1[3]);
                    *(u32x4*)(rowp + bj * HALF) = w; } }
    }
};
__device__ __forceinline__ float dpp_shr1(float oldv, float x) { return __builtin_bit_cast(float, __builtin_amdgcn_update_dpp(__builtin_bit_cast(int, oldv), __builtin_bit_cast(int, x), 0x111, 0xF, 0xF, false)); }
__device__ __forceinline__ float dpp_shl1(float oldv, float x) { return __builtin_bit_cast(float, __builtin_amdgcn_update_dpp(__builtin_bit_cast(int, oldv), __builtin_bit_cast(int, x), 0x101, 0xF, 0xF, false)); }
__device__ __forceinline__ float dpp_ror1(float x) { return __builtin_bit_cast(float, __builtin_amdgcn_update_dpp(0, __builtin_bit_cast(int, x), 0x121, 0xF, 0xF, false)); }
__device__ __forceinline__ float dpp_rol1(float x) { return __builtin_bit_cast(float, __builtin_amdgcn_update_dpp(0, __builtin_bit_cast(int, x), 0x12F, 0xF, 0xF, false)); }
struct EpiConvFused {
    static constexpr bool FP8 = false; static constexpr int scale_w = 0, scale_a = 0;
    static constexpr bool PERM = true; static constexpr bool SWAPV = false; __device__ __forceinline__ bool swapv(const Unit&) const { return false; }
    unsigned char* dump;
    bf16_t* O; const float* ck;
    __device__ __forceinline__ void operator()(const f32x4 (&acc)[2][2][4][2], const Unit& u, int wr, int wc, int fr, int fq) const {
        const int cb = u.pn / 3, sec = u.pn - 3 * cb, tid = threadIdx.x;
        if (sec < 2) {
            const int cc = 256 * cb + 128 * sec + wc * 32 + 8 * fq;
            unsigned char* dp = dump + (size_t)sec * 65536 + tid * 16;
#pragma unroll
            for (int n = 0; n < 2; ++n) {
                const f32x4 k0 = *(const f32x4*)(ck + cc + 4 * n), k1 = *(const f32x4*)(ck + D + cc + 4 * n), k2 = *(const f32x4*)(ck + 2 * D + cc + 4 * n);
#pragma unroll
                for (int ai = 0; ai < 2; ++ai) {
                    f32x4 y[4];
#pragma unroll
                    for (int j = 0; j < 4; ++j) {
                        float x[4];
#pragma unroll
                        for (int m = 0; m < 4; ++m) x[m] = acc[ai][0][m][n][j] * acc[ai][1][m][n][j];
#pragma unroll
                        for (int m = 0; m < 4; ++m) {
                            const float up = dpp_shr1(m > 0 ? dpp_ror1(x[m - 1]) : 0.f, x[m]);
                            const float dn = dpp_shl1(m < 3 ? dpp_rol1(x[m + 1]) : 0.f, x[m]);
                            y[m][j] = k0[j] * up + k1[j] * x[m] + k2[j] * dn; }
                    }
#pragma unroll
                    for (int m = 0; m < 4; ++m) { u32x2 w; w.x = cvt_pk_bf16(y[m][0], y[m][1]); w.y = cvt_pk_bf16(y[m][2], y[m][3]);
                        *(u32x2*)(dp + (ai * 4 + m) * 8192 + n * 8) = w; }
                }
            }
        } else {
            const int row0 = u.pm * BM + wr * 64 + fr, col0 = 256 * cb + wc * 32 + 8 * fq;
            const unsigned loff = (unsigned)tid * 16u;
#pragma unroll
            for (int ai = 0; ai < 2; ++ai) {
                u32x4 qq[4][2];
#pragma unroll
                for (int m = 0; m < 4; ++m) {
                    const unsigned char* sb = dump + (ai * 4 + m) * 8192; asm volatile("" : "+s"(sb));
                    qq[m][0] = *(const u32x4*)(sb + loff); qq[m][1] = *(const u32x4*)(sb + 65536 + loff); }
#pragma unroll
                for (int m = 0; m < 4; ++m) {
                    bf16_t* rowp = O + (size_t)(row0 + ai * HALF + m * 16) * D + col0;
#pragma unroll
                    for (int bj = 0; bj < 2; ++bj) { const f32x4 v0 = acc[ai][bj][m][0], v1 = acc[ai][bj][m][1]; const u32x4 q = qq[m][bj];
                        u32x4 w; w.x = cvt_pk_bf16(v0[0] * bflo(q.x), v0[1] * bfhi(q.x)); w.y = cvt_pk_bf16(v0[2] * bflo(q.y), v0[3] * bfhi(q.y));
                        w.z = cvt_pk_bf16(v1[0] * bflo(q.z), v1[1] * bfhi(q.z)); w.w = cvt_pk_bf16(v1[2] * bflo(q.w), v1[3] * bfhi(q.w));
                        *(u32x4*)(rowp + bj * HALF) = w; } }
                asm volatile("" ::: "memory");
            }
        }
    }
};
struct EpiSwiglu {
    static constexpr bool FP8 = true; int scale_w, scale_a;
    static constexpr bool PERM = true; static constexpr bool SWAPV = false; __device__ __forceinline__ bool swapv(const Unit&) const { return false; }
    unsigned char* hid;
    __device__ __forceinline__ void operator()(const f32x4 (&acc)[2][2][4][2], const Unit& u, int wr, int wc, int fr, int fq) const {
        const int row0 = u.e * 4096 + u.pm * BM + wr * 64 + fr, col0 = u.pn * HALF + wc * 32 + 8 * fq;
#pragma unroll
        for (int ai = 0; ai < 2; ++ai)
#pragma unroll
            for (int m = 0; m < 4; ++m) { unsigned char* rowp = hid + (size_t)(row0 + ai * HALF + m * 16) * DEXP + col0;
                float h[8];
#pragma unroll
                for (int n = 0; n < 2; ++n)
#pragma unroll
                    for (int j2 = 0; j2 < 2; ++j2) {
                        const f32x2 gt = {acc[ai][0][m][n][2 * j2], acc[ai][0][m][n][2 * j2 + 1]}, up = {acc[ai][1][m][n][2 * j2], acc[ai][1][m][n][2 * j2 + 1]};
                        const f32x2 a = gt * (f32x2){-1.4426950408889634f, -1.4426950408889634f};
                        f32x2 t; t.x = __builtin_amdgcn_exp2f(a.x); t.y = __builtin_amdgcn_exp2f(a.y);
                        const f32x2 d4 = t * (f32x2){0.25f, 0.25f} + (f32x2){0.25f, 0.25f};
                        f32x2 r4; r4.x = __builtin_amdgcn_rcpf(d4.x); r4.y = __builtin_amdgcn_rcpf(d4.y);
                        const f32x2 hv = (gt * up) * r4;
                        h[n * 4 + 2 * j2] = __builtin_amdgcn_fmed3f(hv.x, -448.f, 448.f); h[n * 4 + 2 * j2 + 1] = __builtin_amdgcn_fmed3f(hv.y, -448.f, 448.f); }
                int w0 = __builtin_amdgcn_cvt_pk_fp8_f32(h[0], h[1], 0, false); w0 = __builtin_amdgcn_cvt_pk_fp8_f32(h[2], h[3], w0, true);
                int w1 = __builtin_amdgcn_cvt_pk_fp8_f32(h[4], h[5], 0, false); w1 = __builtin_amdgcn_cvt_pk_fp8_f32(h[6], h[7], w1, true);
                u32x2 w; w.x = (unsigned)w0; w.y = (unsigned)w1;
                *(u32x2*)(rowp) = w; }
    }
};
struct EpiDown {
    static constexpr bool FP8 = true; int scale_w, scale_a;
    static constexpr bool PERM = true; static constexpr bool SWAPV = false; __device__ __forceinline__ bool swapv(const Unit&) const { return false; }
    unsigned char* ye;
    __device__ __forceinline__ void operator()(const f32x4 (&acc)[2][2][4][2], const Unit& u, int wr, int wc, int fr, int fq) const {
        const int row0 = u.e * 4096 + u.pm * BM + wr * 64 + fr, col0 = u.pn * BM + wc * 32 + 8 * fq;
#pragma unroll
        for (int ai = 0; ai < 2; ++ai)
#pragma unroll
            for (int m = 0; m < 4; ++m) { const int row = row0 + ai * HALF + m * 16; unsigned char* rowp = ye + (size_t)row * D + col0;
#pragma unroll
                for (int bj = 0; bj < 2; ++bj) { f32x4 v0 = acc[ai][bj][m][0] * 32.f, v1 = acc[ai][bj][m][1] * 32.f;
#pragma unroll
                    for (int i = 0; i < 4; ++i) { v0[i] = __builtin_amdgcn_fmed3f(v0[i], -448.f, 448.f); v1[i] = __builtin_amdgcn_fmed3f(v1[i], -448.f, 448.f); }
                    int w0 = __builtin_amdgcn_cvt_pk_fp8_f32(v0[0], v0[1], 0, false); w0 = __builtin_amdgcn_cvt_pk_fp8_f32(v0[2], v0[3], w0, true);
                    int w1 = __builtin_amdgcn_cvt_pk_fp8_f32(v1[0], v1[1], 0, false); w1 = __builtin_amdgcn_cvt_pk_fp8_f32(v1[2], v1[3], w1, true);
                    u32x2 w; w.x = (unsigned)w0; w.y = (unsigned)w1;
                    *(u32x2*)(rowp + bj * HALF) = w; } }
    }
};
}

constexpr int RING_BYTES = 131072, LDS_BYTES = 147456;
struct Args { const float* in[20]; float* out; unsigned char* ws; int ph_lo, ph_hi; };
struct Frame {
    LAS unsigned char* lds;
    int tid, lane, wave, gw, ngw, G;
};
#define P_X 0
#define P_C 1
#define P_CTX 2
#define P_CCTX 3
#define P_ADAW 4
#define P_ADAB 5
#define P_NORMG 6
#define P_GWIN 7
#define P_GWA2 8
#define P_GBA2 9
#define P_GNORMG 10
#define P_GWOUT 11
#define P_CWIN 12
#define P_CK 13
#define P_CWOUT 14
#define P_ROUTER 15
#define P_EGATE 16
#define P_EUP 17
#define P_EDOWN 18
#define P_FINALG 19

constexpr int TR_SCR = 64 * 65 * 4;
__device__ __forceinline__ void tr_item(const float* W, int ldw, int k0, int n0, bf16_t* WT, int ldo, int drow0, LAS float* scr, int lane) {
    f32x4 v[16];
#pragma unroll
    for (int i = 0; i < 16; ++i) v[i] = *(const f32x4*)(W + (size_t)(k0 + 4 * i + (lane >> 4)) * ldw + n0 + 4 * (lane & 15));
#pragma unroll
    for (int i = 0; i < 16; ++i) { LAS float* p = scr + (4 * i + (lane >> 4)) * 65 + 4 * (lane & 15); p[0] = v[i].x; p[1] = v[i].y; p[2] = v[i].z; p[3] = v[i].w; }
    LDS_WAIT(); asm volatile("" ::: "memory");
    const int c = lane & 7;
#pragma unroll
    for (int j = 0; j < 8; ++j) { const int n = (lane >> 3) + 8 * j; const LAS float* sp = scr + (8 * c) * 65 + n;
        u32x4 o; o.x = pk2(sp[0 * 65], sp[1 * 65]); o.y = pk2(sp[2 * 65], sp[3 * 65]); o.z = pk2(sp[4 * 65], sp[5 * 65]); o.w = pk2(sp[6 * 65], sp[7 * 65]);
        *(u32x4*)(WT + (size_t)(drow0 + n) * ldo + k0 + 8 * c) = o; }
    LDS_WAIT(); asm volatile("" ::: "memory");
}
__device__ __forceinline__ void tr_plain(Frame& F, const Args& A, const float* W, int K, int N, bf16_t* WT, int item, LAS float* scr) {
    const int nblk = (N + 63) / 64, kb = item / nblk, nb = item % nblk; int n0 = 64 * nb; if (n0 + 64 > N) n0 = N - 64;
    tr_item(W, N, 64 * kb, n0, WT, K, n0, scr, F.lane);
}
constexpr int TR_SCR8 = 128 * 33 * 4;
static_assert(TR_SCR8 >= TR_SCR, "per-wave scratch stride");
struct Tr8Item { const float* W; unsigned char* WT; int ldw, ldo, rowmap; };
constexpr int I8_G = (D / 128) * (DEXP / 256);
constexpr int I8_D = (DEXP / 128) * (D / 256);
constexpr int N_EXPERT_ITEMS = NE * (2 * I8_G + I8_D);
__device__ __forceinline__ Tr8Item expert_item(const Args& A, int gi) {
    const int l = gi / N_EXPERT_ITEMS, it = gi % N_EXPERT_ITEMS;
    unsigned char* wgu = A.ws + WS_W8 + (size_t)l * W8_LAYER; unsigned char* wd = wgu + W8_WD;
    constexpr int PER_E = 2 * I8_G + I8_D;
    const int e = it / PER_E; int r = it % PER_E;
    Tr8Item t;
    if (r < 2 * I8_G) {
        const int up = r / I8_G; r %= I8_G;
        const float* W = A.in[up ? P_EUP : P_EGATE] + ((size_t)l * NE + e) * D * DEXP;
        const int nblk = DEXP / 256, kb = r / nblk, nb = r % nblk, h0 = 256 * nb;
        t.W = W + (size_t)(128 * kb) * DEXP + h0; t.ldw = DEXP; t.WT = wgu + (size_t)e * 4096 * D + (size_t)(2 * h0 + 128 * up) * D + 128 * kb; t.ldo = D; t.rowmap = 1;
    } else {
        r -= 2 * I8_G;
        const float* W = A.in[P_EDOWN] + ((size_t)l * NE + e) * DEXP * D;
        const int nblk = D / 256, kb = r / nblk, nb = r % nblk;
        t.W = W + (size_t)(128 * kb) * D + 256 * nb; t.ldw = D; t.WT = wd + (size_t)e * D * DEXP + (size_t)(256 * nb) * DEXP + 128 * kb; t.ldo = DEXP; t.rowmap = 0;
    }
    return t;
}
__device__ __forceinline__ void tr8_load(const Tr8Item& t, f32x4 (&v)[16], int wave, int lane) {
#pragma unroll
    for (int i = 0; i < 16; ++i) v[i] = __builtin_nontemporal_load((const f32x4*)(t.W + (size_t)(16 * wave + i) * t.ldw + 4 * lane));
}
__device__ __forceinline__ void tr8_finish(const Tr8Item& t, const f32x4 (&v)[16], LAS unsigned char* tile, int tid, int wave, int lane) {
#pragma unroll
    for (int q = 0; q < 4; ++q) {
        int o[4];
#pragma unroll
        for (int g = 0; g < 4; ++g) { int w = __builtin_amdgcn_cvt_pk_fp8_f32(64.f * v[4 * g][q], 64.f * v[4 * g + 1][q], 0, false);
            o[g] = __builtin_amdgcn_cvt_pk_fp8_f32(64.f * v[4 * g + 2][q], 64.f * v[4 * g + 3][q], w, true); }
        u32x4 ov; ov.x = (unsigned)o[0]; ov.y = (unsigned)o[1]; ov.z = (unsigned)o[2]; ov.w = (unsigned)o[3];
        const int n = 4 * lane + q;
        *(LAS u32x4*)(tile + n * 128 + ((wave ^ (n & 7)) << 4)) = ov; }
    __syncthreads();
#pragma unroll
    for (int j = 0; j < 4; ++j) { const int p = tid + 512 * j, n = p >> 3, c = p & 7;
        const u32x4 ov = *(const LAS u32x4*)(tile + n * 128 + ((c ^ (n & 7)) << 4));
        const int drow = t.rowmap ? (256 * (n >> 7) + (n & 127)) : n;
        *(u32x4*)(t.WT + (size_t)drow * t.ldo + 16 * c) = ov; }
    __syncthreads();
}
__device__ __forceinline__ void convert_expert_dyn(const Args& A, unsigned* ctr, int end, LAS unsigned char* tile, volatile LAS int* slot, int tid, int wave, int lane) {
    if (tid == 0) { slot[0] = (int)__hip_atomic_fetch_add(ctr, 1u, __ATOMIC_RELAXED, __HIP_MEMORY_SCOPE_AGENT); slot[1] = (int)__hip_atomic_fetch_add(ctr, 1u, __ATOMIC_RELAXED, __HIP_MEMORY_SCOPE_AGENT); }
    __syncthreads();
    int ia = slot[0], ib = slot[1];
    if (ia >= end) return;
    f32x4 va[16], vb[16];
    Tr8Item ta = expert_item(A, ia), tb;
    tr8_load(ta, va, wave, lane);
    for (;;) {
        int rc = 0;
        tb = expert_item(A, min(ib, end - 1)); tr8_load(tb, vb, wave, lane);
        if (tid == 0) rc = (int)__hip_atomic_fetch_add(ctr, 1u, __ATOMIC_RELAXED, __HIP_MEMORY_SCOPE_AGENT);
        tr8_finish(ta, va, tile, tid, wave, lane);
        if (tid == 0) slot[0] = rc;
        __syncthreads();
        ia = ib; ib = slot[0];
        if (ia >= end) break;
        ta = expert_item(A, min(ib, end - 1)); tr8_load(ta, va, wave, lane);
        if (tid == 0) rc = (int)__hip_atomic_fetch_add(ctr, 1u, __ATOMIC_RELAXED, __HIP_MEMORY_SCOPE_AGENT);
        tr8_finish(tb, vb, tile, tid, wave, lane);
        if (tid == 0) slot[1] = rc;
        __syncthreads();
        ia = ib; ib = slot[1];
        if (ia >= end) break;
    }
}
template <int N>
__device__ __forceinline__ void convert_expert_fixed(const Args& A, LAS unsigned char* lds, int tid, int wave, int lane) {
    unsigned* ctr = (unsigned*)(A.ws + WS_CTL) + 2048; LAS unsigned char* tile = lds + 49152; volatile LAS int* slot = (volatile LAS int*)(lds + 40960);
    constexpr int end = 2 * N_EXPERT_ITEMS;
    __syncthreads();
    if (tid == 0) slot[0] = (int)__hip_atomic_fetch_add(ctr, (unsigned)N, __ATOMIC_RELAXED, __HIP_MEMORY_SCOPE_AGENT);
    __syncthreads();
    const int base = slot[0];
    if (base >= end) return;
    f32x4 va[16], vb[16];
    Tr8Item ta = expert_item(A, base), tb = ta;
    tr8_load(ta, va, wave, lane);
#pragma unroll
    for (int j = 0; j < N; ++j) {
        if ((j & 1) == 0) { if (j + 1 < N) { tb = expert_item(A, min(base + j + 1, end - 1)); tr8_load(tb, vb, wave, lane); } tr8_finish(ta, va, tile, tid, wave, lane); }
        else              { if (j + 1 < N) { ta = expert_item(A, min(base + j + 1, end - 1)); tr8_load(ta, va, wave, lane); } tr8_finish(tb, vb, tile, tid, wave, lane); }
    }
}

__device__ __forceinline__ void ph_prep(Frame& F, const Args& A) {
    LAS float* scr = (LAS float*)(F.lds + F.wave * TR_SCR8);
    bf16_t* win0 = (bf16_t*)(A.ws + WS_WIN0T); bf16_t* wout0 = (bf16_t*)(A.ws + WS_WOUT0T); bf16_t* wcin = (bf16_t*)(A.ws + WS_WCINT); bf16_t* wcout = (bf16_t*)(A.ws + WS_WCOUTT);
    {
        float* mod = (float*)(A.ws + WS_MOD);
        LAS float* red = (LAS float*)(F.lds + 8 * TR_SCR8);
        if ((int)blockIdx.x < 2 * 96) {
            LAS float* sl = (LAS float*)F.lds;
            for (int i = F.tid; i < 3 * D; i += NTHR) sl[i] = silu_f(i < 2 * D ? A.in[P_C][i] : A.in[P_CCTX][i - 2 * D]);
            __syncthreads();
        }
        for (int it = blockIdx.x; it < 2 * 96; it += F.G) {
            const LAS float* sl = (const LAS float*)F.lds;
            const int l = it / 96, n0 = (it % 96) * 64, kq = F.lane >> 4, c4 = F.lane & 15;
            const float* w = A.in[P_ADAW] + (size_t)l * D * 6 * D + n0 + 4 * c4;
            f32x4 a0 = (f32x4){0.f, 0.f, 0.f, 0.f}, a1 = a0, a2 = a0;
#pragma unroll 8
            for (int st = 0; st < 32; ++st) { const int k = F.wave * 128 + 4 * st + kq; const f32x4 wv = *(const f32x4*)(w + (size_t)k * 6 * D);
                a0 += sl[k] * wv; a1 += sl[D + k] * wv; a2 += sl[2 * D + k] * wv; }
#pragma unroll
            for (int i = 0; i < 4; ++i) { a0[i] += __shfl_xor(a0[i], 16); a0[i] += __shfl_xor(a0[i], 32); a1[i] += __shfl_xor(a1[i], 16); a1[i] += __shfl_xor(a1[i], 32); a2[i] += __shfl_xor(a2[i], 16); a2[i] += __shfl_xor(a2[i], 32); }
            if (kq == 0) { *(LAS f32x4*)(red + (F.wave * 3 + 0) * 64 + 4 * c4) = a0; *(LAS f32x4*)(red + (F.wave * 3 + 1) * 64 + 4 * c4) = a1; *(LAS f32x4*)(red + (F.wave * 3 + 2) * 64 + 4 * c4) = a2; }
            __syncthreads();
            if (F.wave < 3) { const int n = n0 + F.lane; float sacc = A.in[P_ADAB][l * 6 * D + n];
#pragma unroll
                for (int w8 = 0; w8 < 8; ++w8) sacc += red[(w8 * 3 + F.wave) * 64 + F.lane];
                mod[(l * 3 + F.wave) * 6 * D + n] = sacc; }
            __syncthreads();
        }
    }
    constexpr int I0 = (D / 64) * ((NIN0 + 63) / 64), I1 = (D / 64) * (D / 64), I2 = (D / 64) * (NCIN / 64), I3 = I1;
    for (int it = F.gw; it < I0 + I1 + I2 + I3; it += F.ngw) {
        int r = it;
        if (r < I0) { tr_plain(F, A, A.in[P_GWIN], D, NIN0, win0, r, scr); continue; } r -= I0;
        if (r < I1) { tr_plain(F, A, A.in[P_GWOUT], D, D, wout0, r, scr); continue; } r -= I1;
        if (r < I2) {
            constexpr int nblk = NCIN / 64; const int kb = r / nblk, n0 = 64 * (r % nblk), sct = n0 >> 10, ch = n0 & 1023, cb = ch >> 8, hf = (ch >> 7) & 1;
            const int drow0 = sct == 0 ? (3 * cb + 2) * 256 + (ch & 255) : (3 * cb + hf) * 256 + 128 * (sct - 1) + (ch & 127);
            tr_item(A.in[P_CWIN], NCIN, 64 * kb, n0, wcin, D, drow0, scr, F.lane); continue; } r -= I2;
        tr_plain(F, A, A.in[P_CWOUT], D, D, wcout, r, scr);
    }
    { u32x4* z = (u32x4*)(win0 + (size_t)NIN0 * D); const int n16 = (NIN0P - NIN0) * D * 2 / 16;
      for (int i = F.gw * 64 + F.lane; i < n16; i += F.ngw * 64) z[i] = (u32x4){0u, 0u, 0u, 0u}; }
}

__device__ __forceinline__ void normmod_row(const f32x4 (&v)[4], const float* g, const float* sh, const float* sc, bf16_t* orow, int lane) {
    float s = 0.f;
#pragma unroll
    for (int j = 0; j < 4; ++j) s += (v[j].x * v[j].x + v[j].y * v[j].y) + (v[j].z * v[j].z + v[j].w * v[j].w);
    const float rstd = rsqrtf(wave_sum(s) * (1.f / D) + EPS);
#pragma unroll
    for (int j = 0; j < 4; ++j) { const int c = 4 * lane + 256 * j;
        const f32x4 gg = *(const f32x4*)(g + c), s1 = *(const f32x4*)(sh + c), s2 = *(const f32x4*)(sc + c);
        const f32x4 y = v[j] * rstd * gg * (s2 + 1.f) + s1;
        u32x2 w; w.x = pk2(y.x, y.y); w.y = pk2(y.z, y.w);
        *(u32x2*)(orow + c) = w; }
}
__device__ __forceinline__ void ph_norm0(Frame& F, const Args& A) {
    const float* mod = (const float*)(A.ws + WS_MOD); bf16_t* H = (bf16_t*)(A.ws + WS_H);
    for (int row = F.gw; row < NROW; row += F.ngw) {
        const float* xr = row < NLAT ? A.in[P_X] + (size_t)row * D : A.in[P_CTX] + (size_t)(row - NLAT) * D;
        const int s = row < NLAT ? (row >> 14) : 2;
        f32x4 v[4];
#pragma unroll
        for (int j = 0; j < 4; ++j) v[j] = *(const f32x4*)(xr + 4 * F.lane + 256 * j);
        normmod_row(v, A.in[P_NORMG] + 0 * D, mod + (0 * 3 + s) * 6 * D + 0 * D, mod + (0 * 3 + s) * 6 * D + 1 * D, H + (size_t)row * D, F.lane);
    }
}

__device__ __forceinline__ int jperm(int ks, int fq, int jj) { return 32 * ks + 16 * (jj >> 2) + 4 * fq + (jj & 3); }
__device__ __forceinline__ bf16x8 ldfrag(const unsigned char* blob, int blk, int lane) { return *(const bf16x8*)(blob + blk * 1024 + lane * 16); }
__device__ __forceinline__ unsigned cvtpk(float lo, float hi) { return pk2(lo, hi); }
__device__ __forceinline__ bf16x8 pack8(const f32x4& a, const f32x4& b) {
    u32x4 w; w.x = cvtpk(a[0], a[1]); w.y = cvtpk(a[2], a[3]); w.z = cvtpk(b[0], b[1]); w.w = cvtpk(b[2], b[3]);
    return __builtin_bit_cast(bf16x8, w);
}
__device__ __forceinline__ void ph_gla_prep(Frame& F, const Args& A) {
    constexpr int LSTR = 1040;
    LAS unsigned char* QS = F.lds; LAS unsigned char* KS = F.lds + 64 * LSTR;
    const bf16_t* qk = (const bf16_t*)(A.ws + WS_QK); const float* afb = (const float*)(A.ws + WS_AFB);
    float* gam = (float*)(A.ws + WS_GAM);
    const bool has_conv = blockIdx.x + 4 * F.G >= 2 * NCHUNK;
    const int pre = has_conv ? (int)(blockIdx.x & 3) : 0;
    if (pre == 1) convert_expert_fixed<1>(A, F.lds, F.tid, F.wave, F.lane);
    else if (pre == 2) convert_expert_fixed<2>(A, F.lds, F.tid, F.wave, F.lane);
    else if (pre == 3) convert_expert_fixed<3>(A, F.lds, F.tid, F.wave, F.lane);
    __syncthreads();
    const int dir = blockIdx.x & 1, d = F.tid;
    f32x2 w2[8];
#pragma unroll
    for (int r = 0; r < 8; ++r) { w2[r].x = A.in[P_GWA2][(dir * 16 + 2 * r) * DK + d]; w2[r].y = A.in[P_GWA2][(dir * 16 + 2 * r + 1) * DK + d]; }
    const float bias = A.in[P_GBA2][dir * DK + d];
    u32x4 t16[16]; f32x4 av = (f32x4){0.f, 0.f, 0.f, 0.f};
#define PREP_LOAD(it_) do { const int row0_ = ((it_) >> 1) * 64; \
        _Pragma("unroll") for (int u = 0; u < 16; ++u) { const int q16 = F.tid + NTHR * u, j = q16 >> 7, cp = q16 & 127; t16[u] = *(const u32x4*)((const unsigned char*)qk + ((size_t)(row0_ + j) * D) * 2 + cp * 16); } \
        if (F.tid < 256) av = *(const f32x4*)(afb + (size_t)(row0_ + (F.tid >> 2)) * 32 + dir * 16 + 4 * (F.tid & 3)); } while (0)
    if ((int)blockIdx.x < 2 * NCHUNK) PREP_LOAD((int)blockIdx.x);
    for (int item = blockIdx.x; item < 2 * NCHUNK; item += F.G) {
        {
            const int ch = item >> 1, row0 = ch * 64; (void)row0;
            LAS float* AFL = (LAS float*)(F.lds + 2 * 64 * LSTR);
            {
#pragma unroll
                for (int u = 0; u < 16; ++u) { const int q16 = F.tid + NTHR * u, j = q16 >> 7, cp = q16 & 127; *(LAS u32x4*)(((cp < 64) ? QS : KS) + j * LSTR + (cp & 63) * 16) = t16[u]; }
                if (F.tid < 256) *(LAS f32x4*)(AFL + (F.tid >> 2) * 16 + 4 * (F.tid & 3)) = av;
            }
            if (item + F.G < 2 * NCHUNK) PREP_LOAD(item + F.G);
            __syncthreads();
            float cum2 = 0.f;
#pragma unroll 1
            for (int jq = 0; jq < 64; jq += 4) {
                f32x4 ar[4][4]; unsigned qv[4], kv[4];
#pragma unroll
                for (int u = 0; u < 4; ++u) { const int j = dir ? 63 - (jq + u) : jq + u;
#pragma unroll
                    for (int r4 = 0; r4 < 4; ++r4) ar[u][r4] = *(const LAS f32x4*)(AFL + j * 16 + 4 * r4); }
#pragma unroll
                for (int u = 0; u < 4; ++u) { const int j = dir ? 63 - (jq + u) : jq + u;
                    qv[u] = *(const LAS bf16_t*)(QS + j * LSTR + d * 2); kv[u] = *(const LAS bf16_t*)(KS + j * LSTR + d * 2); }
                asm volatile("" ::: "memory");
                float ls2[4];
#pragma unroll
                for (int u = 0; u < 4; ++u) {
                    f32x2 za = (f32x2){bias, 0.f}, zb = (f32x2){0.f, 0.f};
#pragma unroll
                    for (int r4 = 0; r4 < 4; ++r4) { za = __builtin_elementwise_fma((f32x2){ar[u][r4].x, ar[u][r4].y}, w2[2 * r4], za); zb = __builtin_elementwise_fma((f32x2){ar[u][r4].z, ar[u][r4].w}, w2[2 * r4 + 1], zb); }
                    const float z = (za.x + za.y) + (zb.x + zb.y);
                    const float zl = z * 1.4426950408889634f;
                    ls2[u] = fminf(zl, 0.f) - __builtin_amdgcn_logf(1.f + __builtin_amdgcn_exp2f(-fabsf(zl)));
                }
                unsigned qk2[4];
#pragma unroll
                for (int u = 0; u < 4; ++u) {
                    cum2 += ls2[u] * (1.f / 16.f);
                    const float e = __builtin_amdgcn_exp2f(cum2), ei = __builtin_amdgcn_exp2f(-cum2);
                    qk2[u] = pk2(bflo(qv[u]) * e, bflo(kv[u]) * ei);
                }
#pragma unroll
                for (int u = 0; u < 4; ++u) { const int j = dir ? 63 - (jq + u) : jq + u;
                    *(LAS bf16_t*)(QS + j * LSTR + d * 2) = (bf16_t)(qk2[u] & 0xffffu); *(LAS bf16_t*)(KS + j * LSTR + d * 2) = (bf16_t)(qk2[u] >> 16); }
            }
            const float cum = cum2 * 0.6931471805599453f;
            gam[((size_t)dir * NCHUNK + ch) * DK + d] = __expf(cum);
            __syncthreads();
            {
                const int fr = F.lane & 15, fq = F.lane >> 4;
                unsigned char* blob0 = A.ws + (((size_t)dir * NCHUNK + ch) * 4) * BLOB + (size_t)F.tid * 16;
#pragma unroll
                for (int typ = 0; typ < 2; ++typ) {
                    const LAS unsigned char* src = (typ == 0) ? QS : KS;
                    u32x4 o[8];
#pragma unroll
                    for (int i8 = 0; i8 < 8; ++i8) { const int h = i8 >> 1, blk = F.wave + 8 * (i8 & 1), it = blk >> 2, sd = blk & 3, i = 16 * it + fr, d0 = h * HK + 32 * sd + 4 * fq;
                        const u32x2 lo = *(const LAS u32x2*)(src + i * LSTR + d0 * 2), hi = *(const LAS u32x2*)(src + i * LSTR + (d0 + 16) * 2);
                        o[i8].x = lo.x; o[i8].y = lo.y; o[i8].z = hi.x; o[i8].w = hi.y; }
                    unsigned char* dst = blob0 + (typ == 0 ? WS_QP : WS_KP);
#pragma unroll
                    for (int i8 = 0; i8 < 8; ++i8) *(u32x4*)(dst + (size_t)(i8 >> 1) * BLOB + (size_t)(i8 & 1) * 8192) = o[i8];
                }
                {
                    u32x4 o[8];
#pragma unroll
                    for (int i8 = 0; i8 < 8; ++i8) { const int h = i8 >> 1, blk = F.wave + 8 * (i8 & 1), mt = blk >> 1, ks = blk & 1, dd = h * HK + 16 * mt + fr; unsigned e[8];
#pragma unroll
                        for (int jj = 0; jj < 8; ++jj) e[jj] = *(const LAS bf16_t*)(KS + jperm(ks, fq, jj) * LSTR + dd * 2);
                        o[i8].x = e[0] | (e[1] << 16); o[i8].y = e[2] | (e[3] << 16); o[i8].z = e[4] | (e[5] << 16); o[i8].w = e[6] | (e[7] << 16); }
                    unsigned char* dst = blob0 + WS_KTP;
#pragma unroll
                    for (int i8 = 0; i8 < 8; ++i8) *(u32x4*)(dst + (size_t)(i8 >> 1) * BLOB + (size_t)(i8 & 1) * 8192) = o[i8];
                }
            }
            __syncthreads();
        }
    }
#undef PREP_LOAD
    if (has_conv) {
        if (pre == 0) convert_expert_fixed<4>(A, F.lds, F.tid, F.wave, F.lane);
        else if (pre == 1) convert_expert_fixed<3>(A, F.lds, F.tid, F.wave, F.lane);
        else if (pre == 2) convert_expert_fixed<2>(A, F.lds, F.tid, F.wave, F.lane);
        else convert_expert_fixed<1>(A, F.lds, F.tid, F.wave, F.lane);
    }
}

#define MFMA16(a, b, c) __builtin_amdgcn_mfma_f32_16x16x32_bf16((a), (b), (c), 0, 0, 0)
__device__ __forceinline__ void gla_intra_item(Frame& F, const Args& A, int item) {
    const int ch = item >> 2, h = item & 3, fr = F.lane & 15, fq = F.lane >> 4;
    const unsigned char* qpf = A.ws + WS_QP + (((size_t)0 * NCHUNK + ch) * 4 + h) * BLOB; const unsigned char* kpf = A.ws + WS_KP + (((size_t)0 * NCHUNK + ch) * 4 + h) * BLOB;
    const unsigned char* qpb = A.ws + WS_QP + (((size_t)1 * NCHUNK + ch) * 4 + h) * BLOB; const unsigned char* kpb = A.ws + WS_KP + (((size_t)1 * NCHUNK + ch) * 4 + h) * BLOB;
    bf16x8 Pf[4][2];
#pragma unroll
    for (int it = 0; it < 4; ++it) {
        f32x4 P[4];
#pragma unroll
        for (int jt = 0; jt < 4; ++jt) P[jt] = (f32x4){0.f, 0.f, 0.f, 0.f};
#pragma unroll
        for (int dirp = 0; dirp < 2; ++dirp) {
            const unsigned char* qp = dirp ? qpb : qpf; const unsigned char* kp = dirp ? kpb : kpf;
            bf16x8 kk[16], qq[4];
#pragma unroll
            for (int sd = 0; sd < 4; ++sd) qq[sd] = ldfrag(qp, it * 4 + sd, F.lane);
#pragma unroll
            for (int jt = 0; jt < 4; ++jt) if (dirp ? (jt >= it) : (jt <= it)) {
#pragma unroll
                for (int sd = 0; sd < 4; ++sd) kk[jt * 4 + sd] = ldfrag(kp, jt * 4 + sd, F.lane); }
#pragma unroll
            for (int jt = 0; jt < 4; ++jt) if (dirp ? (jt >= it) : (jt <= it)) {
                f32x4 a = (f32x4){0.f, 0.f, 0.f, 0.f};
#pragma unroll
                for (int sd = 0; sd < 4; ++sd) a = MFMA16(kk[jt * 4 + sd], qq[sd], a);
                if (jt == it) {
#pragma unroll
                    for (int r = 0; r < 4; ++r) { const int j = 4 * fq + r; const bool keep = dirp ? (j >= fr) : (j <= fr); a[r] = keep ? a[r] : 0.f; }
                }
                P[jt] += a;
            }
        }
        Pf[it][0] = pack8(P[0], P[1]); Pf[it][1] = pack8(P[2], P[3]);
    }
    const unsigned char* vt = A.ws + WS_VTP + (size_t)ch * 131072 + (size_t)(h * 16) * 2048;
    bf16_t* oi = (bf16_t*)(A.ws + WS_OI) + (size_t)(ch * 64 + fr) * DV + h * HV + 4 * fq;
#pragma unroll 1
    for (int ng = 0; ng < 4; ++ng) {
        bf16x8 va[8];
#pragma unroll
        for (int i = 0; i < 8; ++i) va[i] = ldfrag(vt, ng * 8 + i, F.lane);
#pragma unroll
        for (int n4 = 0; n4 < 4; ++n4)
#pragma unroll
            for (int it = 0; it < 4; ++it) {
                f32x4 acc = (f32x4){0.f, 0.f, 0.f, 0.f};
                acc = MFMA16(va[n4 * 2], Pf[it][0], acc); acc = MFMA16(va[n4 * 2 + 1], Pf[it][1], acc);
                u32x2 w; w.x = pk2(acc[0], acc[1]); w.y = pk2(acc[2], acc[3]);
                *(u32x2*)(oi + (size_t)(16 * it) * DV + 16 * (ng * 4 + n4)) = w;
            }
    }
}
struct ScanRegs { bf16x8 q[4], k[4], v[2][2]; f32x4 g[2]; };
__device__ __forceinline__ int scan_chunk(int b, int dir, int step) { return step >= 4 ? (256 * b + (dir ? 255 - (step - 4) : step - 4)) : (512 + 4 * b + (dir ? 3 - step : step)); }
__device__ __forceinline__ void scan_load(const Args& A, ScanRegs& R, int b, int h, int dir, int sp, int w, int step, int lane) {
    const int ch = scan_chunk(b, dir, step), fq = lane >> 4;
    const size_t bo = (((size_t)dir * NCHUNK + ch) * 4 + h) * BLOB;
    const unsigned char* qp = A.ws + WS_QP + bo; const unsigned char* ktp = A.ws + WS_KTP + bo;
    const unsigned char* vt = A.ws + WS_VTP + (size_t)ch * 131072 + (size_t)(h * 16 + 2 * sp) * 2048;
    const float* gp = (const float*)(A.ws + WS_GAM) + ((size_t)dir * NCHUNK + ch) * DK + h * HK + 32 * w + 4 * fq;
#pragma unroll
    for (int sd = 0; sd < 4; ++sd) R.q[sd] = ldfrag(qp, w * 4 + sd, lane);
#pragma unroll
    for (int m = 0; m < 2; ++m)
#pragma unroll
        for (int ks = 0; ks < 2; ++ks) R.k[m * 2 + ks] = ldfrag(ktp, (2 * w + m) * 2 + ks, lane);
#pragma unroll
    for (int s2 = 0; s2 < 2; ++s2) {
        const int o = 8 * ((lane & 15) >> 2) + 4 * s2 + (lane & 3);
        const unsigned char* vp = vt + (o >> 4) * 2048 + ((o & 15) + (lane & 48)) * 16;
        R.v[s2][0] = *(const bf16x8*)(vp); R.v[s2][1] = *(const bf16x8*)(vp + 1024); }
    R.g[0] = *(const f32x4*)(gp); R.g[1] = *(const f32x4*)(gp + 16);
}
#define LDS_ORDER() asm volatile("" ::: "memory")
__device__ __forceinline__ void scan_ds(const ScanRegs& R, f32x4 (&dS)[2][2]) {
#pragma unroll
    for (int s2 = 0; s2 < 2; ++s2)
#pragma unroll
        for (int m = 0; m < 2; ++m) { f32x4 d = (f32x4){0.f, 0.f, 0.f, 0.f}; d = MFMA16(R.k[m * 2], R.v[s2][0], d); d = MFMA16(R.k[m * 2 + 1], R.v[s2][1], d); dS[s2][m] = d; }
}
__device__ __forceinline__ void scan_step(const Args& A, const ScanRegs& R, const ScanRegs& Rn, f32x4 (&S)[2][2], f32x4 (&dS)[2][2], LAS unsigned char* xs, LAS unsigned* flags, bf16_t* O, int b, int h, int dir, int sp, int w, int step, int lane) {
    const int fr = lane & 15, fq = lane >> 4;
#pragma unroll
    for (int s2 = 0; s2 < 2; ++s2) {
        S[s2][0] = R.g[0] * (S[s2][0] + dS[s2][0]); S[s2][1] = R.g[1] * (S[s2][1] + dS[s2][1]);
        *(volatile LAS bf16x8*)(xs + ((step + 1) & 3) * 8192 + (s2 * 4 + w) * 1024 + lane * 16) = pack8(S[s2][0], S[s2][1]);
    }
    LDS_ORDER();
    if (lane == 0) *(volatile LAS unsigned*)(flags + w) = (unsigned)step + 2u;
    LDS_ORDER();
    scan_ds(Rn, dS);
    if (step >= 4) {
        { const unsigned need = (unsigned)step + 1u; unsigned spn = 0;
          for (;;) { const unsigned f = (lane < 4) ? *(volatile LAS unsigned*)(flags + lane) : need;
              if (__all((int)(f >= need))) break; if (++spn > (1u << 26)) break; }
          LDS_ORDER(); }
        const LAS unsigned char* slot = xs + (step & 3) * 8192 + lane * 16;
        bf16x8 sf[2][4];
#pragma unroll
        for (int s2 = 0; s2 < 2; ++s2)
#pragma unroll
            for (int sd = 0; sd < 4; ++sd) sf[s2][sd] = *(const LAS bf16x8*)(slot + (s2 * 4 + sd) * 1024);
        LDS_ORDER();
        const int ch = scan_chunk(b, dir, step);
        f32x4 acc0 = (f32x4){0.f, 0.f, 0.f, 0.f}, acc1 = acc0;
#pragma unroll
        for (int sd = 0; sd < 4; ++sd) { acc0 = MFMA16(sf[0][sd], R.q[sd], acc0); acc1 = MFMA16(sf[1][sd], R.q[sd], acc1); }
        u32x4 wv; wv.x = pk2(acc0[0], acc0[1]); wv.y = pk2(acc0[2], acc0[3]); wv.z = pk2(acc1[0], acc1[1]); wv.w = pk2(acc1[2], acc1[3]);
        *(u32x4*)(O + (size_t)(ch * 64 + 16 * w + fr) * DV + h * HV + 32 * sp + 8 * fq) = wv;
    }
}
__device__ __forceinline__ void gla_scan_item(Frame& F, const Args& A, int item, LAS unsigned char* xs, LAS unsigned* flags) {
    const int chain = item >> 3, sp = item & 7, b = chain >> 3, h = (chain >> 1) & 3, dir = chain & 1, w = F.wave;
    bf16_t* O = (bf16_t*)(A.ws + (dir ? WS_OB : WS_OF));
    f32x4 S[2][2], dS[2][2];
#pragma unroll
    for (int s2 = 0; s2 < 2; ++s2) { S[s2][0] = (f32x4){0.f, 0.f, 0.f, 0.f}; S[s2][1] = S[s2][0];
        *(volatile LAS bf16x8*)(xs + (s2 * 4 + w) * 1024 + F.lane * 16) = pack8(S[s2][0], S[s2][1]); }
    LDS_ORDER();
    if (F.lane == 0) *(volatile LAS unsigned*)(flags + w) = 1u;
    LDS_ORDER();
    ScanRegs Ra, Rb, Rc;
    scan_load(A, Ra, b, h, dir, sp, w, 0, F.lane);
    scan_load(A, Rb, b, h, dir, sp, w, 1, F.lane);
    scan_ds(Ra, dS);
    for (int step = 0; step < 261; step += 3) {
        scan_load(A, Rc, b, h, dir, sp, w, min(step + 2, 259), F.lane);
        scan_step(A, Ra, Rb, S, dS, xs, flags, O, b, h, dir, sp, w, step, F.lane);
        scan_load(A, Ra, b, h, dir, sp, w, min(step + 3, 259), F.lane);
        scan_step(A, Rb, Rc, S, dS, xs, flags, O, b, h, dir, sp, w, step + 1, F.lane);
        scan_load(A, Rb, b, h, dir, sp, w, min(step + 4, 259), F.lane);
        if (step + 2 < 260) scan_step(A, Rc, Ra, S, dS, xs, flags, O, b, h, dir, sp, w, step + 2, F.lane);
    }
}
__device__ __forceinline__ void ph_gla_main(Frame& F, const Args& A) {
    LAS unsigned char* xs = F.lds; LAS unsigned* flags = (LAS unsigned*)(F.lds + 32768);
    if (F.tid < 16) flags[F.tid] = 0u;
    __syncthreads();
    const int bi = blockIdx.x;
    unsigned* ctr = (unsigned*)(A.ws + WS_CTL) + 2048;
    volatile LAS int* slot = (volatile LAS int*)(F.lds + 40960);
    if (bi < 128) {
        if (F.wave < 4) gla_scan_item(F, A, ((2 * (bi & 7) + ((bi >> 3) & 1)) << 3) | ((bi >> 4) & 7), xs, flags);
        __syncthreads();
    } else {
        const int sw = (bi - 128) * NWAVES + F.wave, nsw = (F.G - 128) * NWAVES;
        for (int it = sw; it < 512 * 4; it += nsw) gla_intra_item(F, A, it);
        __syncthreads();
    }
    convert_expert_dyn(A, ctr, 2 * N_EXPERT_ITEMS, F.lds + 49152, slot, F.tid, F.wave, F.lane);
    __syncthreads();
}

__device__ __forceinline__ void ph_gla_finish(Frame& F, const Args& A) {
    const bf16_t* rp = (const bf16_t*)(A.ws + WS_R); const bf16_t* OFp = (const bf16_t*)(A.ws + WS_OF); const bf16_t* OBp = (const bf16_t*)(A.ws + WS_OB); const bf16_t* OIp = (const bf16_t*)(A.ws + WS_OI);
    bf16_t* Hh = (bf16_t*)(A.ws + WS_H);
    const f32x4 gn = *(const f32x4*)(A.in[P_GNORMG] + 4 * F.lane);
    for (int row = F.gw; row < NLAT; row += F.ngw) {
#pragma unroll
        for (int j = 0; j < 4; ++j) {
            const int cc = 4 * F.lane + 256 * j;
            const u32x2 a = *(const u32x2*)(OFp + (size_t)row * DV + cc), bq = *(const u32x2*)(OBp + (size_t)row * DV + cc), ci = *(const u32x2*)(OIp + (size_t)row * DV + cc);
            const u32x2 rr = *(const u32x2*)(rp + (size_t)row * D + cc);
            f32x4 o; o.x = bflo(a.x) + bflo(bq.x) + bflo(ci.x); o.y = bfhi(a.x) + bfhi(bq.x) + bfhi(ci.x); o.z = bflo(a.y) + bflo(bq.y) + bflo(ci.y); o.w = bfhi(a.y) + bfhi(bq.y) + bfhi(ci.y);
            const float ss = wave_sum((o.x * o.x + o.y * o.y) + (o.z * o.z + o.w * o.w));
            const float rstd = rsqrtf(ss * (1.f / HV) + EPS);
            f32x4 r; r.x = bflo(rr.x); r.y = bfhi(rr.x); r.z = bflo(rr.y); r.w = bfhi(rr.y);
            f32x4 y;
#pragma unroll
            for (int i = 0; i < 4; ++i) y[i] = o[i] * rstd * gn[i] * silu_f(r[i]);
            u32x2 w; w.x = pk2(y.x, y.y); w.y = pk2(y.z, y.w);
            *(u32x2*)(Hh + (size_t)row * D + cc) = w;
        }
    }
}

__device__ __forceinline__ void stage_router(Frame& F, const Args& A, int l) {
    LAS float* wl = (LAS float*)F.lds;
    const float* rw = A.in[P_ROUTER] + (size_t)l * D * NE;
    for (int idx = F.tid; idx < D * NE; idx += NTHR) { const int k = idx >> 4, e = idx & 15, j = k >> 8, ln = (k & 255) >> 2, i = k & 3; wl[((((j * 4 + i) * 4 + (e >> 2)) * 64) + ln) * 4 + (e & 3)] = rw[idx]; }
    __syncthreads();
}
template <int N, int M>
__device__ __forceinline__ void rs_step(const float (&v)[N], float (&w)[N / 2], int lane) {
    const bool hi = (lane & M) != 0;
#pragma unroll
    for (int e = 0; e < N / 2; ++e) { const float mine = hi ? v[N / 2 + e] : v[e], other = hi ? v[e] : v[N / 2 + e]; w[e] = mine + __shfl_xor(other, M); }
}
__device__ __forceinline__ void ph_norm2_router(Frame& F, const Args& A, int l) {
    const float* mod = (const float*)(A.ws + WS_MOD); unsigned char* H8 = A.ws + WS_H; const bf16_t* X = (const bf16_t*)(A.ws + WS_X); float* aff = (float*)(A.ws + WS_AFF);
    const float* g = A.in[P_NORMG] + (l * 2 + 1) * D; const float* rw = A.in[P_ROUTER] + (size_t)l * D * NE;
    LAS unsigned char* WF = F.lds;
    LAS float* GS = (LAS float*)(F.lds + 65536); LAS float* SH = GS + D; LAS float* CB = SH + D; LAS float* RED = CB + 16;
    const int fr = F.lane & 15, fq = F.lane >> 4;
    const int b = (int)((blockIdx.x * NWAVES * 16) >> 14);
    const float* sh = mod + (l * 3 + b) * 6 * D + 3 * D; const float* sc = mod + (l * 3 + b) * 6 * D + 4 * D;
    for (int k = F.tid; k < D; k += NTHR) { GS[k] = g[k] * (1.f + sc[k]); SH[k] = sh[k]; }
    __syncthreads();
    for (int p = F.tid; p < 32 * 64; p += NTHR) {
        const int s = p >> 6, ln = p & 63, e = ln & 15, k0 = 32 * s + 8 * (ln >> 4);
        float w[8];
#pragma unroll
        for (int i = 0; i < 8; ++i) w[i] = rw[(k0 + i) * NE + e] * GS[k0 + i];
        u32x4 hi, lo;
        hi.x = pk2(w[0], w[1]); hi.y = pk2(w[2], w[3]); hi.z = pk2(w[4], w[5]); hi.w = pk2(w[6], w[7]);
        lo.x = pk2(w[0] - bflo(hi.x), w[1] - bfhi(hi.x)); lo.y = pk2(w[2] - bflo(hi.y), w[3] - bfhi(hi.y)); lo.z = pk2(w[4] - bflo(hi.z), w[5] - bfhi(hi.z)); lo.w = pk2(w[6] - bflo(hi.w), w[7] - bfhi(hi.w));
        *(LAS u32x4*)(WF + ((s * 2 + 0) * 64 + ln) * 16) = hi; *(LAS u32x4*)(WF + ((s * 2 + 1) * 64 + ln) * 16) = lo;
    }
    { const int e = F.tid & 15, part = F.tid >> 4; float acc = 0.f;
#pragma unroll 8
      for (int i = 0; i < 32; ++i) { const int k = part * 32 + i; acc += SH[k] * rw[k * NE + e]; }
      RED[part * 16 + e] = acc; }
    __syncthreads();
    if (F.tid < 16) { float acc = 0.f;
#pragma unroll
        for (int q = 0; q < 32; ++q) acc += RED[q * 16 + F.tid];
        CB[F.tid] = acc; }
    __syncthreads();
    for (int grp = F.gw; grp < NLAT / 16; grp += F.ngw) {
        const int row0 = grp * 16, row = row0 + fr;
        const bf16_t* xr = X + (size_t)row * D + 8 * fq;
        u32x4 xv[32];
#pragma unroll
        for (int s = 0; s < 32; ++s) xv[s] = *(const u32x4*)(xr + 32 * s);
        f32x2 ss2 = (f32x2){0.f, 0.f};
        f32x4 acc = (f32x4){0.f, 0.f, 0.f, 0.f};
#pragma unroll
        for (int s = 0; s < 32; ++s) {
            const u32x4 t = xv[s];
            const f32x2 a0 = {bflo(t.x), bfhi(t.x)}, a1 = {bflo(t.y), bfhi(t.y)}, a2 = {bflo(t.z), bfhi(t.z)}, a3 = {bflo(t.w), bfhi(t.w)};
            ss2 = __builtin_elementwise_fma(a0, a0, ss2); ss2 = __builtin_elementwise_fma(a1, a1, ss2); ss2 = __builtin_elementwise_fma(a2, a2, ss2); ss2 = __builtin_elementwise_fma(a3, a3, ss2);
            const bf16x8 xb = __builtin_bit_cast(bf16x8, t);
            acc = MFMA16(*(const LAS bf16x8*)(WF + ((s * 2 + 0) * 64 + F.lane) * 16), xb, acc);
            acc = MFMA16(*(const LAS bf16x8*)(WF + ((s * 2 + 1) * 64 + F.lane) * 16), xb, acc);
            if ((s & 1) == 1) asm volatile("" ::: "memory");
        }
#pragma unroll
        for (int s = 0; s < 32; ++s) asm volatile("" : "+v"(xv[s]));
        float ss = ss2.x + ss2.y; ss += __shfl_xor(ss, 16); ss += __shfl_xor(ss, 32);
        const float rstd = rsqrtf(ss * (1.f / D) + EPS);
        float lg[4]; float mx = -3.0e38f;
#pragma unroll
        for (int r = 0; r < 4; ++r) { lg[r] = rstd * acc[r] + CB[4 * fq + r]; mx = fmaxf(mx, lg[r]); }
        mx = fmaxf(mx, __shfl_xor(mx, 16)); mx = fmaxf(mx, __shfl_xor(mx, 32));
        float ex[4], den = 0.f;
#pragma unroll
        for (int r = 0; r < 4; ++r) { ex[r] = __expf(lg[r] - mx); den += ex[r]; }
        den += __shfl_xor(den, 16); den += __shfl_xor(den, 32);
        const float inv = 1.f / den; const int t = row & (T - 1);
#pragma unroll
        for (int r = 0; r < 4; ++r) aff[((size_t)b * NE + 4 * fq + r) * T + t] = ex[r] * inv;
        unsigned char* hr = H8 + (size_t)row * D + 8 * fq;
#pragma unroll
        for (int s = 0; s < 32; ++s) {
            const u32x4 t4 = xv[s]; const int k0 = 32 * s + 8 * fq;
            const f32x4 g0 = *(const LAS f32x4*)(GS + k0), g1 = *(const LAS f32x4*)(GS + k0 + 4), h0 = *(const LAS f32x4*)(SH + k0), h1 = *(const LAS f32x4*)(SH + k0 + 4);
            f32x4 y0 = (f32x4){bflo(t4.x), bfhi(t4.x), bflo(t4.y), bfhi(t4.y)} * rstd * g0 + h0, y1 = (f32x4){bflo(t4.z), bfhi(t4.z), bflo(t4.w), bfhi(t4.w)} * rstd * g1 + h1;
            const f32x4 lim = (f32x4){448.f, 448.f, 448.f, 448.f};
            y0 = __builtin_elementwise_min(__builtin_elementwise_max(y0, -lim), lim); y1 = __builtin_elementwise_min(__builtin_elementwise_max(y1, -lim), lim);
            int w0 = __builtin_amdgcn_cvt_pk_fp8_f32(y0.x, y0.y, 0, false); w0 = __builtin_amdgcn_cvt_pk_fp8_f32(y0.z, y0.w, w0, true);
            int w1 = __builtin_amdgcn_cvt_pk_fp8_f32(y1.x, y1.y, 0, false); w1 = __builtin_amdgcn_cvt_pk_fp8_f32(y1.z, y1.w, w1, true);
            u32x2 wv; wv.x = (unsigned)w0; wv.y = (unsigned)w1;
            *(u32x2*)(hr + 32 * s) = wv;
            if ((s & 1) == 1) asm volatile("" ::: "memory");
        }
    }
    __syncthreads();
}

__device__ __forceinline__ void ph_topk(Frame& F, const Args& A) {
    LAS int* red = (LAS int*)F.lds;
    const float* aff = (const float*)(A.ws + WS_AFF); int* slot = (int*)(A.ws + WS_SLOT); int* rowlist = (int*)(A.ws + WS_ROWLIST); float* selval = (float*)(A.ws + WS_SELVAL);
    for (int item = blockIdx.x; item < NB * NE; item += F.G) {
        const int b = item / NE, e = item % NE;
        const float* a = aff + ((size_t)b * NE + e) * T + F.tid * 32;
        unsigned v[32];
#pragma unroll
        for (int q = 0; q < 8; ++q) { const u32x4 x = *(const u32x4*)(a + 4 * q); v[4 * q] = x.x; v[4 * q + 1] = x.y; v[4 * q + 2] = x.z; v[4 * q + 3] = x.w; }
        unsigned prefix = 0u; int par = 0;
        for (int bit = 30; bit >= 0; --bit) {
            const unsigned cand = prefix | (1u << bit); int cnt = 0;
#pragma unroll
            for (int i = 0; i < 32; ++i) cnt += (v[i] >= cand) ? 1 : 0;
            cnt = wave_sum_i(cnt);
            if (F.lane == 0) red[par * 16 + F.wave] = cnt;
            __syncthreads();
            int tot = 0;
#pragma unroll
            for (int w8 = 0; w8 < 8; ++w8) tot += red[par * 16 + w8];
            if (tot >= CAP) prefix = cand;
            par ^= 1;
        }
        __syncthreads();
        int mgt = 0, meq = 0;
#pragma unroll
        for (int i = 0; i < 32; ++i) { mgt += (v[i] > prefix) ? 1 : 0; meq += (v[i] == prefix) ? 1 : 0; }
        int igt = mgt, ieq = meq;
#pragma unroll
        for (int o = 1; o < 64; o <<= 1) { const int ug = __shfl_up(igt, o), ue = __shfl_up(ieq, o); if (F.lane >= o) { igt += ug; ieq += ue; } }
        if (F.lane == 63) { red[F.wave] = igt; red[16 + F.wave] = ieq; }
        __syncthreads();
        int bgt = 0, beq = 0, totgt = 0;
#pragma unroll
        for (int w8 = 0; w8 < 8; ++w8) { const int xg = red[w8], xe = red[16 + w8]; if (w8 < F.wave) { bgt += xg; beq += xe; } totgt += xg; }
        const int need_eq = CAP - totgt;
        int gtb = bgt + igt - mgt, eqb = beq + ieq - meq;
        const int t0 = F.tid * 32;
#pragma unroll
        for (int q = 0; q < 2; ++q) {
            int sl[16];
#pragma unroll
            for (int i = 0; i < 16; ++i) {
                const unsigned x = v[q * 16 + i]; const bool gt = x > prefix, eq = x == prefix; const bool sel = gt || (eq && eqb < need_eq);
                const int pos = gtb + (eqb < need_eq ? eqb : need_eq);
                sl[i] = sel ? pos : -1;
                if (sel) { rowlist[e * 4096 + b * CAP + pos] = b * T + t0 + q * 16 + i; selval[e * 4096 + b * CAP + pos] = __builtin_bit_cast(float, x); }
                gtb += gt ? 1 : 0; eqb += eq ? 1 : 0;
            }
#pragma unroll
            for (int i4 = 0; i4 < 4; ++i4) *(i32x4*)(slot + ((size_t)b * NE + e) * T + t0 + q * 16 + 4 * i4) = (i32x4){sl[4 * i4], sl[4 * i4 + 1], sl[4 * i4 + 2], sl[4 * i4 + 3]};
        }
        __syncthreads();
    }
}

__device__ __forceinline__ void ph_combine(Frame& F, const Args& A, int l) {
    const float* mod = (const float*)(A.ws + WS_MOD); bf16_t* X = (bf16_t*)(A.ws + WS_X); bf16_t* H = (bf16_t*)(A.ws + WS_H);
    const int* slot = (const int*)(A.ws + WS_SLOT); const unsigned char* ye = A.ws + WS_YE; const float* selval = (const float*)(A.ws + WS_SELVAL);
    for (int grp = F.gw; grp < NLAT / 16; grp += F.ngw) {
        const int row0 = grp * 16, b = row0 >> 14, t0 = row0 & (T - 1);
        const i32x4 sv4 = *(const i32x4*)(slot + ((size_t)b * NE + (F.lane & 15)) * T + t0 + 4 * (F.lane >> 4));
        f32x4 g2v[4], pa[4], pb[4], pc[4];
#pragma unroll
        for (int j = 0; j < 4; ++j) { const int c = 4 * F.lane + 256 * j;
            g2v[j] = *(const f32x4*)(mod + (l * 3 + b) * 6 * D + 5 * D + c);
            if (l == 0) { pa[j] = *(const f32x4*)(A.in[P_NORMG] + (1 * 2 + 0) * D + c); pb[j] = *(const f32x4*)(mod + (1 * 3 + b) * 6 * D + 0 * D + c); pc[j] = *(const f32x4*)(mod + (1 * 3 + b) * 6 * D + 1 * D + c) + 1.f; }
            else { pa[j] = *(const f32x4*)(A.in[P_FINALG] + c); pb[j] = pa[j]; pc[j] = pa[j]; } }
#pragma unroll 1
        for (int rq = 0; rq < 4; ++rq) {
#pragma unroll
          for (int rh = 0; rh < 2; ++rh) {
            unsigned mask[2]; int yrow[2][4]; float wv[2][4]; u32x2 xr[2][4]; int yv[2][4][4];
#pragma unroll
            for (int p2 = 0; p2 < 2; ++p2) {
                const int ri = 2 * rh + p2, row = row0 + 4 * rq + ri, svr = sv4[ri];
                unsigned m = (unsigned)(__ballot(svr >= 0) >> (16 * rq)) & 0xFFFFu;
                const int e0 = m ? __builtin_ctz(m) : 0;
#pragma unroll
                for (int q = 0; q < 4; ++q) { const bool valid = m != 0u; const int e = valid ? __builtin_ctz(m) : e0; m &= m - 1u;
                    const int sq = __builtin_amdgcn_readlane(svr, 16 * rq + e); yrow[p2][q] = e * 4096 + b * CAP + (sq < 0 ? 0 : sq); wv[p2][q] = valid ? selval[yrow[p2][q]] * (1.f / 32) : 0.f; }
                mask[p2] = m;
#pragma unroll
                for (int j = 0; j < 4; ++j) xr[p2][j] = *(const u32x2*)(X + (size_t)row * D + 4 * F.lane + 256 * j);
#pragma unroll
                for (int q = 0; q < 4; ++q)
#pragma unroll
                    for (int j = 0; j < 4; ++j) yv[p2][q][j] = *(const int*)(ye + (size_t)yrow[p2][q] * D + 4 * F.lane + 256 * j);
            }
#pragma unroll
            for (int p2 = 0; p2 < 2; ++p2) {
                const int ri = 2 * rh + p2, row = row0 + 4 * rq + ri, svr = sv4[ri];
                f32x4 acc[4];
#pragma unroll
                for (int j = 0; j < 4; ++j) acc[j] = (f32x4){0.f, 0.f, 0.f, 0.f};
#pragma unroll
                for (int q = 0; q < 4; ++q)
#pragma unroll
                    for (int j = 0; j < 4; ++j) { const f32x2 lo = __builtin_amdgcn_cvt_pk_f32_fp8(yv[p2][q][j], false), hi = __builtin_amdgcn_cvt_pk_f32_fp8(yv[p2][q][j], true);
                        acc[j].x += wv[p2][q] * lo.x; acc[j].y += wv[p2][q] * lo.y; acc[j].z += wv[p2][q] * hi.x; acc[j].w += wv[p2][q] * hi.y; }
                unsigned m = mask[p2];
                while (m) {
                    const int e = __builtin_ctz(m); m &= m - 1u;
                    const int sq = __builtin_amdgcn_readlane(svr, 16 * rq + e), yr_ = e * 4096 + b * CAP + sq; const float w1 = selval[yr_] * (1.f / 32);
#pragma unroll
                    for (int j = 0; j < 4; ++j) { const int y = *(const int*)(ye + (size_t)yr_ * D + 4 * F.lane + 256 * j); const f32x2 lo = __builtin_amdgcn_cvt_pk_f32_fp8(y, false), hi = __builtin_amdgcn_cvt_pk_f32_fp8(y, true);
                        acc[j].x += w1 * lo.x; acc[j].y += w1 * lo.y; acc[j].z += w1 * hi.x; acc[j].w += w1 * hi.y; }
                }
                f32x4 v[4]; float ssq = 0.f;
#pragma unroll
                for (int j = 0; j < 4; ++j) { const u32x2 t = xr[p2][j]; v[j] = (f32x4){bflo(t.x), bfhi(t.x), bflo(t.y), bfhi(t.y)} + g2v[j] * acc[j];
                    ssq += (v[j].x * v[j].x + v[j].y * v[j].y) + (v[j].z * v[j].z + v[j].w * v[j].w); }
                const float rstd = rsqrtf(wave_sum(ssq) * (1.f / D) + EPS);
                if (l == 0) {
#pragma unroll
                    for (int j = 0; j < 4; ++j) { const int c = 4 * F.lane + 256 * j;
                        u32x2 w; w.x = pk2(v[j].x, v[j].y); w.y = pk2(v[j].z, v[j].w); *(u32x2*)(X + (size_t)row * D + c) = w;
                        const f32x4 y = v[j] * rstd * pa[j] * pc[j] + pb[j];
                        u32x2 hw; hw.x = pk2(y.x, y.y); hw.y = pk2(y.z, y.w); *(u32x2*)(H + (size_t)row * D + c) = hw; }
                } else {
#pragma unroll
                    for (int j = 0; j < 4; ++j) { const int c = 4 * F.lane + 256 * j; *(f32x4*)(A.out + (size_t)row * D + c) = v[j] * rstd * pa[j]; }
                }
            }
          }
        }
    }
}

constexpr int N_PHASES = 20;
__global__ void __launch_bounds__(NTHR, 2) fwd_kernel(Args A) {
    extern __shared__ __attribute__((aligned(16))) unsigned char lds_raw[];
    Frame F;
    F.lds = (LAS unsigned char*)lds_raw;
    F.tid = threadIdx.x; F.lane = F.tid & 63; F.wave = __builtin_amdgcn_readfirstlane(F.tid >> 6);
    F.G = gridDim.x; F.gw = blockIdx.x * NWAVES + F.wave; F.ngw = F.G * NWAVES;
    const int lo = A.ph_lo, hi = A.ph_hi;
#ifdef ONLY_PH
#define IN(k) ((k) == ONLY_PH && lo <= (k) && (k) < hi)
#else
#define IN(k) (lo <= (k) && (k) < hi)
#endif
#if MK_MULTI
#define SEAM(k) do { } while (0)
#else
    cg::grid_group grid = cg::this_grid();
    volatile LAS unsigned* bst = (volatile LAS unsigned*)(F.lds + LDS_BYTES - 64);
    if (F.tid < 16) bst[F.tid] = 0u;
    __syncthreads();
    XcdBarrier xbar = xcd_barrier_post((unsigned*)(A.ws + WS_CTL) + 4096, bst);
    if (lo < 0) { __threadfence(); grid.sync(); }
#define SEAM(k) do { if (IN(k) && IN((k) + 1)) xcd_barrier(xbar); } while (0)
#endif
    const int c = blockIdx.x;
    #define H ((bf16_t*)(A.ws + WS_H))
#define X ((bf16_t*)(A.ws + WS_X))
#define mod ((const float*)(A.ws + WS_MOD))
#define MOE_GU(l) { eng::Gemm g{(const char*)(A.ws + WS_H), (const char*)(A.ws + WS_W8 + (size_t)(l) * W8_LAYER), (const int*)(A.ws + WS_ROWLIST), (size_t)4096 * D, D / 2, 16, 16, NE}; \
        eng::EpiSwiglu E{0x79797979, 0x7F7F7F7F, A.ws + WS_HID}; eng::gemm_phase(F.lds, g, E, F.G, c); }
#define MOE_DN(l) { eng::Gemm g{(const char*)(A.ws + WS_HID), (const char*)(A.ws + WS_W8 + (size_t)(l) * W8_LAYER + W8_WD), nullptr, (size_t)D * DEXP, DEXP / 2, 16, 4, NE}; g.rev = 1; \
        eng::EpiDown E{0x79797979, 0x7D7D7D7D, A.ws + WS_YE}; eng::gemm_phase(F.lds, g, E, F.G, c); }

    if (IN(0)) ph_prep(F, A);
    SEAM(0);
    if (IN(1)) ph_norm0(F, A);
    SEAM(1);
    if (IN(2)) { eng::Gemm g{(const char*)H, (const char*)(A.ws + WS_WIN0T), nullptr, 0, D, NROW / 256, NIN0P / 256, 1};
        eng::EpiProj0 E{(bf16_t*)(A.ws + WS_QK), A.ws + WS_VTP, (bf16_t*)(A.ws + WS_R), (float*)(A.ws + WS_AFB)}; eng::gemm_phase(F.lds, g, E, F.G, c);
        if (6 * F.G + c >= (NROW / 256) * (NIN0P / 256)) convert_expert_fixed<3>(A, F.lds, F.tid, F.wave, F.lane); }
    SEAM(2);
    if (IN(3)) ph_gla_prep(F, A);
    SEAM(3);
    if (IN(4)) ph_gla_main(F, A);
    SEAM(4);
    if (IN(5)) ph_gla_finish(F, A);
    SEAM(5);
    if (IN(6)) { eng::Gemm g{(const char*)H, (const char*)(A.ws + WS_WOUT0T), nullptr, 0, D, NLAT / 256, D / 256, 1};
        eng::EpiResidT<true> E{A.in[P_X], X, mod + (0 * 3) * 6 * D + 2 * D}; eng::gemm_phase(F.lds, g, E, F.G, c); }
    SEAM(6);
    if (IN(7)) ph_norm2_router(F, A, 0);
    SEAM(7);
    if (IN(8)) ph_topk(F, A);
    SEAM(8);
    if (IN(9)) MOE_GU(0)
    SEAM(9);
    if (IN(10)) MOE_DN(0)
    SEAM(10);
    if (IN(11)) ph_combine(F, A, 0);
    SEAM(11);
    if (IN(12)) { eng::Gemm g{(const char*)H, (const char*)(A.ws + WS_WCINT), nullptr, 0, D, NLAT / 256, NCIN / 256, 1};
        g.trip = 1;
        eng::EpiConvFused E{A.ws + WS_CDUMP + (size_t)c * 131072, (bf16_t*)(A.ws + WS_H2), A.in[P_CK]}; eng::gemm_phase(F.lds, g, E, F.G, c); }
    SEAM(12);
    if (IN(14)) { eng::Gemm g{(const char*)(A.ws + WS_H2), (const char*)(A.ws + WS_WCOUTT), nullptr, 0, D, NLAT / 256, D / 256, 1};
        eng::EpiResidT<false> E{X, X, mod + (1 * 3) * 6 * D + 2 * D}; eng::gemm_phase(F.lds, g, E, F.G, c); }
    SEAM(14);
    if (IN(15)) ph_norm2_router(F, A, 1);
    SEAM(15);
    if (IN(16)) ph_topk(F, A);
    SEAM(16);
    if (IN(17)) MOE_GU(1)
    SEAM(17);
    if (IN(18)) MOE_DN(1)
    SEAM(18);
    if (IN(19)) ph_combine(F, A, 1);
#undef IN
#undef SEAM
#undef H
#undef X
#undef mod
#undef MOE_GU
#undef MOE_DN
}

extern "C" void kernel_launch(void* const* d_in, const int* in_sizes, int n_in, void* d_out, int out_size, void* d_ws, size_t ws_size, hipStream_t stream) {
    static int grid = 0;
    if (grid == 0) {
        if (n_in != 20 || in_sizes[0] != NLAT * D || out_size != NLAT * D || ws_size < WS_END) {
            fprintf(stderr, "kernel_launch: unexpected problem: n_in %d in0 %d out %d ws %zu (need %zu)\n", n_in, n_in > 0 ? in_sizes[0] : -1, out_size, ws_size, (size_t)WS_END); grid = -1; return; }
        int dev = 0, cus = 0, per_cu = 0;
        if (hipGetDevice(&dev) != hipSuccess || hipDeviceGetAttribute(&cus, hipDeviceAttributeMultiprocessorCount, dev) != hipSuccess) { grid = -1; return; }
        if (hipFuncSetAttribute((const void*)fwd_kernel, hipFuncAttributeMaxDynamicSharedMemorySize, LDS_BYTES) != hipSuccess) { fprintf(stderr, "kernel_launch: hipFuncSetAttribute failed\n"); grid = -1; return; }
        if (hipOccupancyMaxActiveBlocksPerMultiprocessor(&per_cu, (const void*)fwd_kernel, NTHR, LDS_BYTES) != hipSuccess || per_cu < 1) { fprintf(stderr, "kernel_launch: occupancy query says %d\n", per_cu); per_cu = 1; }
        (void)hipGetLastError();
        if (cus != 256) { fprintf(stderr, "kernel_launch: built for a 256-CU device (one workgroup per CU); found %d CUs\n", cus); grid = -1; return; }
        grid = cus;
    }
    if (grid < 0) return;
    Args a{};
    for (int i = 0; i < 20; ++i) a.in[i] = (const float*)d_in[i];
    a.out = (float*)d_out; a.ws = (unsigned char*)d_ws;
#if MK_MULTI
    for (int p = 0; p < N_PHASES; ++p) {
        a.ph_lo = p; a.ph_hi = p + 1;
        hipLaunchKernelGGL(fwd_kernel, dim3(grid), dim3(NTHR), LDS_BYTES, stream, a);
    }
#else
    if (hipMemsetAsync((char*)d_ws + WS_CTL, 0, 64 * 1024, stream) != hipSuccess) { fprintf(stderr, "kernel_launch: memset failed\n"); return; }
    a.ph_lo = 0; a.ph_hi = N_PHASES;
    void* kargs[] = {&a};
    hipError_t e = hipLaunchCooperativeKernel((const void*)fwd_kernel, dim3(grid), dim3(NTHR), kargs, LDS_BYTES, stream);
    if (e != hipSuccess) fprintf(stderr, "kernel_launch: cooperative launch failed: %s (grid %d)\n", hipGetErrorString(e), grid);
#endif
}
```

```cpp
#include <hip/hip_runtime.h>
#include <hip/hip_cooperative_groups.h>
#include <cstdio>
#include <cstdint>
namespace cg = cooperative_groups;

#ifndef MK_MULTI
#define MK_MULTI 0
#endif

#define LAS __attribute__((address_space(3)))
#define GAS __attribute__((address_space(1)))
typedef unsigned short bf16_t;
typedef short bf16x8 __attribute__((ext_vector_type(8)));
typedef float f32x4 __attribute__((ext_vector_type(4)));
typedef float f32x2 __attribute__((ext_vector_type(2)));
typedef unsigned u32x4 __attribute__((ext_vector_type(4)));
typedef unsigned u32x2 __attribute__((ext_vector_type(2)));
typedef int i32x4 __attribute__((ext_vector_type(4)));
typedef int i32x8 __attribute__((ext_vector_type(8)));

constexpr int D = 1024, NB = 2, T = 16384, NLAT = NB * T, CTXL = 256, NCTX = NB * CTXL, NROW = NLAT + NCTX;
constexpr int NE = 16, CAP = 2048, DEXP = 2048;
constexpr int HEADS = 4, HK = 128, HV = 256, DK = 512, DV = 1024, RANK = 16;
constexpr int NIN0 = 3104, NIN0P = 3328;
constexpr int NCIN = 3072;
constexpr float EPS = 1e-6f;
constexpr int NWAVES = 8, NTHR = 512;

constexpr size_t MiB = 1u << 20;
constexpr size_t WS_CTL = 0;
constexpr size_t WS_MOD = 1 * MiB;
constexpr size_t WS_WIN0T = 2 * MiB;
constexpr size_t WS_WOUT0T = 9 * MiB;
constexpr size_t WS_WCINT = 11 * MiB;
constexpr size_t WS_WCOUTT = 17 * MiB;
constexpr size_t WS_AFF = 19 * MiB;
constexpr size_t WS_SLOT = 21 * MiB;
constexpr size_t WS_ROWLIST = 23 * MiB;
constexpr size_t WS_SELVAL = 23 * MiB + 512 * 1024;
constexpr size_t WS_AFB = 24 * MiB;
constexpr size_t WS_W8 = 32 * MiB;
constexpr size_t W8_LAYER = 96 * MiB, W8_WD = 64 * MiB;
constexpr size_t WS_X = 224 * MiB;
constexpr size_t WS_H = 354 * MiB;
constexpr size_t WS_ARENA = 420 * MiB;
constexpr size_t WS_QK = WS_ARENA;
constexpr size_t WS_V = WS_ARENA + 65 * MiB;
constexpr size_t WS_R = WS_ARENA + 130 * MiB;
constexpr size_t WS_QP = WS_ARENA + 195 * MiB;
constexpr size_t WS_KP = WS_ARENA + 260 * MiB;
constexpr size_t WS_KTP = WS_ARENA + 325 * MiB;
constexpr size_t WS_VTP = WS_ARENA + 390 * MiB;
constexpr size_t WS_OI = WS_ARENA + 455 * MiB;
constexpr size_t WS_GAM = WS_ARENA + 519 * MiB;
constexpr size_t WS_OF = WS_QK;
constexpr size_t WS_OB = WS_V;
constexpr size_t WS_HID = WS_ARENA;
constexpr size_t WS_YE = WS_ARENA + 128 * MiB;
constexpr size_t WS_H2 = WS_ARENA;
constexpr size_t WS_CDUMP = WS_ARENA + 64 * MiB;
constexpr size_t WS_END = WS_ARENA + 522 * MiB;
static_assert(WS_R - WS_QK == 130 * MiB, "EpiProj0 strides");
constexpr size_t BLOB = 16384;
constexpr int NCHUNK = NROW / 64;

__device__ __forceinline__ float wave_sum(float v) {
#pragma unroll
    for (int o = 1; o < 64; o <<= 1) v += __shfl_xor(v, o);
    return v;
}
__device__ __forceinline__ int wave_sum_i(int v) {
#pragma unroll
    for (int o = 1; o < 64; o <<= 1) v += __shfl_xor(v, o);
    return v;
}
__device__ __forceinline__ unsigned f2bf(float f) { unsigned u = __builtin_bit_cast(unsigned, f); return (u + 0x7fffu + ((u >> 16) & 1u)) >> 16; }
typedef __bf16 bf16x2_t __attribute__((ext_vector_type(2)));
__device__ __forceinline__ unsigned pk2(float lo, float hi) { const f32x2 v = {lo, hi}; return __builtin_bit_cast(unsigned, __builtin_convertvector(v, bf16x2_t)); }
__device__ __forceinline__ float bflo(unsigned u) { return __builtin_bit_cast(float, u << 16); }
__device__ __forceinline__ float bfhi(unsigned u) { return __builtin_bit_cast(float, u & 0xffff0000u); }
__device__ __forceinline__ float silu_f(float x) { return x / (1.f + __expf(-x)); }
#define LDS_WAIT() asm volatile("s_waitcnt lgkmcnt(0)" ::: "memory")


#define XB_TMO      128
#define XB_XCNT(j)  (256  + 64 * (j))
#define XB_XSUB(j)  (1280 + 64 * (j))
#define XB_XGEN(j)  (2304 + 64 * (j))
#define XB_TOP      3328
#define XB_TOPGEN   3392
#define XCD_BAR_WORDS 3456
#define XB_SPIN_CAP (1u << 22)
__device__ __forceinline__ unsigned xb_ld(unsigned* p)              { return __hip_atomic_load(p, __ATOMIC_RELAXED, __HIP_MEMORY_SCOPE_AGENT); }
__device__ __forceinline__ unsigned xb_add(unsigned* p, unsigned v) { return __hip_atomic_fetch_add(p, v, __ATOMIC_RELAXED, __HIP_MEMORY_SCOPE_AGENT); }
__device__ __forceinline__ unsigned xb_xcc_id() { return (unsigned)__builtin_amdgcn_s_getreg((3 << 11) | 20) & 0xFu; }
#define XB_SPIN(cond, bar) do { unsigned _sp = 0; while (cond) { \
    if ((++_sp & 255u) == 0u) { if (xb_ld(&(bar)[XB_TMO])) break; if (_sp > XB_SPIN_CAP) { atomicAdd(&(bar)[XB_TMO], 1u); break; } } } } while (0)
struct XcdBarrier { unsigned* bar; unsigned x; volatile LAS unsigned* st; };
__device__ __forceinline__ XcdBarrier xcd_barrier_post(unsigned* bar, volatile LAS unsigned* st) {
    XcdBarrier b; b.bar = bar; b.x = xb_xcc_id(); b.st = st;
    if (threadIdx.x == 0) (void)xb_add(&bar[XB_XCNT(b.x)], 1u);
    return b;
}
__device__ __forceinline__ void xcd_barrier_complete(unsigned* bar, unsigned x, unsigned& nloc, unsigned& nx) {
    const unsigned G = gridDim.x * gridDim.y * gridDim.z;
    unsigned sum, cnt, mine, sp = 0u;
    for (;;) {
        sum = 0u; cnt = 0u; mine = 0u;
#pragma unroll
        for (unsigned j = 0; j < 16; ++j) { const unsigned c = xb_ld(&bar[XB_XCNT(j)]); sum += c; cnt += (c > 0u) ? 1u : 0u; mine = (j == x) ? c : mine; }
        if (sum == G) break;
        __builtin_amdgcn_s_sleep(1);
        if ((++sp & 255u) == 0u) { if (xb_ld(&bar[XB_TMO])) break; if (sp > XB_SPIN_CAP) { atomicAdd(&bar[XB_TMO], 1u); break; } }
    }
    nloc = mine > 0u ? mine : 1u; nx = cnt > 0u ? cnt : 1u;
}
__device__ __forceinline__ void xcd_barrier(const XcdBarrier& b) {
    asm volatile("s_waitcnt vmcnt(0)" ::: "memory");
    __syncthreads();
    if (threadIdx.x == 0) {
        unsigned* bar = b.bar;
        __builtin_amdgcn_s_waitcnt(0);
        unsigned nloc = b.st[0], nx = b.st[1];
        if (nloc == 0u) { xcd_barrier_complete(bar, b.x, nloc, nx); b.st[0] = nloc; b.st[1] = nx; }
        const unsigned old = xb_add(&bar[XB_XSUB(b.x)], 1u);
        const unsigned gen = old / nloc;
        if (old + 1u == (gen + 1u) * nloc) {
            __builtin_amdgcn_fence(__ATOMIC_RELEASE, "agent");
            asm volatile("s_waitcnt vmcnt(0)" ::: "memory");
            const unsigned og = xb_add(&bar[XB_TOP], 1u);
            const unsigned tg = og / nx;
            __builtin_amdgcn_fence(__ATOMIC_ACQUIRE, "agent");
            if (og + 1u == (tg + 1u) * nx) xb_add(&bar[XB_TOPGEN], 1u);
            else XB_SPIN(xb_ld(&bar[XB_TOPGEN]) == tg, bar);
            xb_add(&bar[XB_XGEN(b.x)], 1u);
            asm volatile("s_waitcnt vmcnt(0)" ::: "memory");
        } else {
            __builtin_amdgcn_fence(__ATOMIC_ACQUIRE, "agent");
            XB_SPIN(xb_ld(&bar[XB_XGEN(b.x)]) == gen, bar);
            asm volatile("s_waitcnt vmcnt(0)" ::: "memory");
        }
    }
    __syncthreads();
}

namespace eng {
constexpr int BM = 256, BK = 64, HALF = 128, HTB = HALF * BK * 2, STAGE_BYTES = 8 * HTB, NXCD = 8, WGM = 8;
__host__ __device__ __forceinline__ int lds_byte(int r, int c) { const int st = (r >> 4) * 2 + (c >> 5), rr = r & 15, cc = c & 31, ob = rr * 64 + cc * 2; return st * 1024 + (ob ^ (((ob >> 9) & 1) << 5)); }
__host__ __device__ __forceinline__ void stage_rc(int b, int& R, int& C) { const int st = b / 1024, sb = b % 1024, swz = sb ^ (((sb >> 9) & 1) << 5); R = (st >> 1) * 16 + swz / 64; C = (st & 1) * 32 + (swz % 64) / 2; }
__host__ __device__ __forceinline__ int perm32(int rho) { const int n = rho >> 4, i = rho & 15; return 8 * (i >> 2) + 4 * n + (i & 3); }

struct Unit { int e, pm, pn; };
struct Gemm {
    const char* A;
    const char* Bt;
    const int* rows;
    size_t bstride;
    int K, nM, nN, ngroups;
    int rev = 0;
    int trip = 0;
};
__device__ __forceinline__ bool next_unit(const Gemm& g, int i, int G, int c, Unit& u) {
    if (g.trip) {
        const int per3 = g.nM * (g.nN / 3), j = i / 3, sec = i - 3 * j; int s = j * G + c; if (s >= per3) return false;
        { const int q = per3 / NXCD, r = per3 % NXCD, xcd = s % NXCD, off = s / NXCD; s = (xcd < r ? xcd * (q + 1) : r * (q + 1) + (xcd - r) * q) + off; }
        const int ncb = g.nN / 3; u.e = 0; u.pm = s / ncb; u.pn = 3 * (s % ncb) + sec; return true;
    }
    const int per = g.nM * g.nN;
    const long L = (long)i * G + c; if (L >= (long)per * g.ngroups) return false;
    u.e = (int)(L / per); int wgid = (int)(L % per);
    if (g.rev) u.e = g.ngroups - 1 - u.e;
    { const int nwg = per, q = nwg / NXCD, r = nwg % NXCD, xcd = wgid % NXCD, off = wgid / NXCD; wgid = (xcd < r ? xcd * (q + 1) : r * (q + 1) + (xcd - r) * q) + off; }
    const int nig = WGM * g.nN, gid = wgid / nig, fm = gid * WGM, gsz = (g.nM - fm) < WGM ? (g.nM - fm) : WGM;
    u.pm = fm + ((wgid % nig) % gsz); u.pn = (wgid % nig) / gsz; return true;
}
__device__ __forceinline__ bf16x8 lo8(const i32x8& f) { return __builtin_bit_cast(bf16x8, (i32x4)__builtin_shufflevector(f, f, 0, 1, 2, 3)); }
__device__ __forceinline__ bf16x8 hi8(const i32x8& f) { return __builtin_bit_cast(bf16x8, (i32x4)__builtin_shufflevector(f, f, 4, 5, 6, 7)); }
__device__ __forceinline__ i32x8 cat8(bf16x8 lo, bf16x8 hi) { const i32x4 a = __builtin_bit_cast(i32x4, lo), b = __builtin_bit_cast(i32x4, hi); return __builtin_shufflevector(a, b, 0, 1, 2, 3, 4, 5, 6, 7); }
__device__ __forceinline__ unsigned cvt_pk_bf16(float lo, float hi) { unsigned r; asm volatile("v_cvt_pk_bf16_f32 %0, %1, %2" : "=v"(r) : "v"(lo), "v"(hi)); return r; }

#ifndef ENG_SP2
#define ENG_SP2 true
#endif
#ifndef ENG_ALIGN
#define ENG_ALIGN true
#endif
template <class Epi, bool SP2 = ENG_SP2, bool ALIGN_EPI = ENG_ALIGN>
__device__ __forceinline__ void gemm_phase(LAS unsigned char* lds, const Gemm g, const Epi& E, int G, int c) {
    int tid = threadIdx.x; asm volatile("" : "+v"(tid));
    const int wid = __builtin_amdgcn_readfirstlane(tid >> 6), lane = tid & 63, wr = wid >> 2, wc = wid & 3, fr = lane & 15, fq = lane >> 4;
    const int K = g.K, nt = K / BK;
    int R0, C0; stage_rc(tid * 16, R0, C0);
    const int Rb0 = Epi::PERM ? ((R0 & ~31) + perm32(R0 & 31)) : R0;
    unsigned voffB[2]; voffB[0] = (unsigned)(Rb0 * K + C0) * 2u; voffB[1] = (unsigned)((Rb0 + 64) * K + C0) * 2u;
    constexpr bool SW = Epi::SWAPV;
    const char* const abase = SW ? g.Bt : g.A;
    const unsigned adelta = SW ? (unsigned)(size_t)(g.A - g.Bt) : 0u;
    const unsigned dltB = SW ? (unsigned)((R0 - Rb0) * K) * 2u : 0u;
    const size_t hstepB = (size_t)HALF * K * 2;
    const unsigned ldsw = (unsigned)wid * 1024u;
    const int aoff = lds_byte(wr * 64 + fr, fq * 8), boff = lds_byte(wc * 32 + fr, fq * 8);
#define PG8_SA(b, h) (((b) * 2 + (h)) * HTB)
#define PG8_SB(b, h) ((4 + (b) * 2 + (h)) * HTB)
#define PG8_GLDS(gp, bufoff, i) __builtin_amdgcn_global_load_lds((const unsigned*)(gp), (LAS unsigned*)(lds + (bufoff) + ldsw + (i) * 8192), 16, 0, 0)
#define PG8_STAGE_B(bufoff, bp, h, kt) do { const char* _p = (bp) + (size_t)(h) * hstepB + (size_t)(kt) * 128; asm volatile("" : "+s"(_p)); PG8_GLDS(_p + (voffB[0] + (SW ? dselB : 0u)), bufoff, 0); PG8_GLDS(_p + (voffB[1] + (SW ? dselB : 0u)), bufoff, 1); } while (0)
#define PG8_STAGE_A(bufoff, v0, v1, kt) do { const char* _p = abase + (size_t)(kt) * 128; asm volatile("" : "+s"(_p)); PG8_GLDS(_p + (v0), bufoff, 0); PG8_GLDS(_p + (v1), bufoff, 1); } while (0)
#define PG8_LDA(dst, b, h) do { _Pragma("unroll") for (int m = 0; m < 4; ++m) dst[m] = cat8(*(const LAS bf16x8*)(lds + PG8_SA(b, h) + aoff + m * 2048), *(const LAS bf16x8*)(lds + PG8_SA(b, h) + aoff + m * 2048 + 1024)); } while (0)
#define PG8_LDB(dst, b, h) do { _Pragma("unroll") for (int n = 0; n < 2; ++n) dst[n] = cat8(*(const LAS bf16x8*)(lds + PG8_SB(b, h) + boff + n * 2048), *(const LAS bf16x8*)(lds + PG8_SB(b, h) + boff + n * 2048 + 1024)); } while (0)
#define PG8_MMA(ai, bj, At, Bt) do { __builtin_amdgcn_s_setprio(1); \
        if constexpr (Epi::FP8) { _Pragma("unroll") for (int m = 0; m < 4; ++m) _Pragma("unroll") for (int n = 0; n < 2; ++n) \
            asm volatile("v_mfma_scale_f32_16x16x128_f8f6f4 %0, %1, %2, %0, %3, %4 op_sel_hi:[0,0,0]" : "+v"(acc[ai][bj][m][n]) : "v"(Bt[n]), "v"(At[m]), "v"(sc_w), "v"(sc_a)); } \
        else { _Pragma("unroll") for (int m = 0; m < 4; ++m) _Pragma("unroll") for (int n = 0; n < 2; ++n) { \
            acc[ai][bj][m][n] = __builtin_amdgcn_mfma_f32_16x16x32_bf16(lo8(Bt[n]), lo8(At[m]), acc[ai][bj][m][n], 0, 0, 0); \
            acc[ai][bj][m][n] = __builtin_amdgcn_mfma_f32_16x16x32_bf16(hi8(Bt[n]), hi8(At[m]), acc[ai][bj][m][n], 0, 0, 0); } } \
        __builtin_amdgcn_s_setprio(0); } while (0)
#define PG8_WAIT_V(n) asm volatile("s_waitcnt vmcnt(" #n ")" ::: "memory")
#define PG8_WAIT_L(n) asm volatile("s_waitcnt lgkmcnt(" #n ")" ::: "memory")
#define PG8_BAR __builtin_amdgcn_s_barrier()
#define PG8_SCHED __builtin_amdgcn_sched_barrier(0)
#define PG8_ROWOFF(u, h, i) ((SW && E.swapv(u)) ? (unsigned)(((u).pn * 256 + (h) * 128 + R0 + 64 * (i)) * K + C0) * 2u : adelta + ((unsigned)(((g.rows ? g.rows[((u).e * g.nM + (u).pm) * 256 + (h) * 128 + R0 + 64 * (i)] : (((u).e * g.nM + (u).pm) * 256 + (h) * 128 + R0 + 64 * (i))) * K + C0)) * 2u))
#define PG8_BPTR(u) ((SW && E.swapv(u)) ? g.A + (size_t)(u).pm * 2 * hstepB : g.Bt + (size_t)(u).e * g.bstride + (size_t)(u).pn * 2 * hstepB)
    Unit cur, nxt; int ui = 0;
    if (!next_unit(g, 0, G, c, cur)) return;
    f32x4 acc[2][2][4][2];
#pragma unroll
    for (int a = 0; a < 2; ++a)
#pragma unroll
        for (int b = 0; b < 2; ++b)
#pragma unroll
            for (int m = 0; m < 4; ++m)
#pragma unroll
                for (int n = 0; n < 2; ++n) acc[a][b][m][n] = (f32x4){0.f, 0.f, 0.f, 0.f};
    int sc_w = E.scale_w, sc_a = E.scale_a;
    asm volatile("" : "+v"(sc_w), "+v"(sc_a));
    i32x8 At[4], B0[2], B1[2];
    unsigned c00 = PG8_ROWOFF(cur, 0, 0), c01 = PG8_ROWOFF(cur, 0, 1), c10 = PG8_ROWOFF(cur, 1, 0), c11 = PG8_ROWOFF(cur, 1, 1);
    const char* cB = PG8_BPTR(cur);
    unsigned cD = (SW && E.swapv(cur)) ? dltB : 0u, dselB = cD;
    if constexpr (SP2) {
        PG8_STAGE_B(PG8_SB(0, 0), cB, 0, 0); PG8_STAGE_B(PG8_SB(0, 1), cB, 1, 0); PG8_STAGE_A(PG8_SA(0, 0), c00, c01, 0); PG8_STAGE_A(PG8_SA(0, 1), c10, c11, 0);
        if (wr == 1) PG8_BAR;
        PG8_WAIT_V(2); PG8_BAR;
        PG8_STAGE_B(PG8_SB(1, 0), cB, 0, 1); PG8_STAGE_A(PG8_SA(1, 0), c00, c01, 1); PG8_STAGE_B(PG8_SB(1, 1), cB, 1, 1);
        PG8_WAIT_V(6); PG8_BAR;
    } else {
        PG8_STAGE_B(PG8_SB(0, 0), cB, 0, 0); PG8_STAGE_A(PG8_SA(0, 0), c00, c01, 0); PG8_STAGE_B(PG8_SB(0, 1), cB, 1, 0); PG8_STAGE_A(PG8_SA(0, 1), c10, c11, 0);
        if (wr == 1) PG8_BAR;
        PG8_WAIT_V(4); PG8_BAR;
        PG8_STAGE_B(PG8_SB(1, 0), cB, 0, 1); PG8_STAGE_A(PG8_SA(1, 0), c00, c01, 1); PG8_STAGE_B(PG8_SB(1, 1), cB, 1, 1);
        PG8_WAIT_V(6); PG8_BAR;
    }
    for (;;) {
        const bool has_next = next_unit(g, ui + 1, G, c, nxt);
        unsigned n00 = c00, n01 = c01, n10 = c10, n11 = c11; const char* nB = cB; unsigned nD = cD;
        if (has_next) { n00 = PG8_ROWOFF(nxt, 0, 0); n01 = PG8_ROWOFF(nxt, 0, 1); n10 = PG8_ROWOFF(nxt, 1, 0); n11 = PG8_ROWOFF(nxt, 1, 1);
                        nB = PG8_BPTR(nxt); nD = (SW && E.swapv(nxt)) ? dltB : 0u; }
#pragma unroll 1
        for (int t = 0; t < nt; t += 2) {
            const bool last = (t == nt - 2);
            const int kt2 = last ? 0 : t + 2, kt3 = kt2 + 1;
            const char* b2 = last ? nB : cB; dselB = last ? nD : cD;
            const unsigned s00 = last ? n00 : c00, s01 = last ? n01 : c01, s10 = last ? n10 : c10, s11 = last ? n11 : c11;
            if constexpr (SP2) {
            PG8_LDB(B0, 0, 0); PG8_LDB(B1, 0, 1); PG8_SCHED; PG8_LDA(At, 0, 0); PG8_STAGE_A(PG8_SA(1, 1), c10, c11, t + 1);
            PG8_WAIT_V(8); PG8_WAIT_L(0); PG8_BAR; PG8_MMA(0, 0, At, B0); PG8_MMA(0, 1, At, B1); PG8_BAR; PG8_SCHED;
            PG8_LDA(At, 0, 1); PG8_STAGE_B(PG8_SB(0, 0), b2, 0, kt2); PG8_STAGE_B(PG8_SB(0, 1), b2, 1, kt2); PG8_STAGE_A(PG8_SA(0, 0), s00, s01, kt2);
            PG8_WAIT_V(8); PG8_WAIT_L(0); PG8_BAR; PG8_MMA(1, 0, At, B0); PG8_MMA(1, 1, At, B1); PG8_BAR; PG8_SCHED;
            PG8_LDB(B0, 1, 0); PG8_LDB(B1, 1, 1); PG8_SCHED; PG8_LDA(At, 1, 0); PG8_STAGE_A(PG8_SA(0, 1), s10, s11, kt2);
            PG8_WAIT_V(8); PG8_WAIT_L(0); PG8_BAR; PG8_MMA(0, 0, At, B0); PG8_MMA(0, 1, At, B1); PG8_BAR; PG8_SCHED;
            PG8_LDA(At, 1, 1); PG8_STAGE_B(PG8_SB(1, 0), b2, 0, kt3); PG8_STAGE_B(PG8_SB(1, 1), b2, 1, kt3); PG8_STAGE_A(PG8_SA(1, 0), s00, s01, kt3);
            PG8_WAIT_V(8); PG8_WAIT_L(0); PG8_BAR; PG8_MMA(1, 0, At, B0); PG8_MMA(1, 1, At, B1); PG8_BAR; PG8_SCHED;
            } else {
            PG8_LDB(B0, 0, 0); PG8_SCHED; PG8_LDA(At, 0, 0); PG8_STAGE_A(PG8_SA(1, 1), c10, c11, t + 1);
            PG8_WAIT_L(8); PG8_BAR; PG8_WAIT_L(0); PG8_MMA(0, 0, At, B0); PG8_BAR; PG8_SCHED;
            PG8_LDB(B1, 0, 1); PG8_STAGE_B(PG8_SB(0, 0), b2, 0, kt2);
            PG8_BAR; PG8_WAIT_L(0); PG8_MMA(0, 1, At, B1); PG8_BAR;
            PG8_LDA(At, 0, 1); PG8_STAGE_A(PG8_SA(0, 0), s00, s01, kt2);
            PG8_BAR; PG8_WAIT_L(0); PG8_MMA(1, 0, At, B0); PG8_BAR; PG8_SCHED;
            PG8_STAGE_B(PG8_SB(0, 1), b2, 1, kt2);
            PG8_WAIT_V(6); PG8_BAR; PG8_MMA(1, 1, At, B1); PG8_BAR;
            PG8_LDB(B0, 1, 0); PG8_SCHED; PG8_LDA(At, 1, 0); PG8_STAGE_A(PG8_SA(0, 1), s10, s11, kt2);
            PG8_WAIT_L(8); PG8_BAR; PG8_WAIT_L(0); PG8_MMA(0, 0, At, B0); PG8_BAR; PG8_SCHED;
            PG8_LDB(B1, 1, 1); PG8_STAGE_B(PG8_SB(1, 0), b2, 0, kt3);
            PG8_BAR; PG8_WAIT_L(0); PG8_MMA(0, 1, At, B1); PG8_BAR;
            PG8_LDA(At, 1, 1); PG8_STAGE_A(PG8_SA(1, 0), s00, s01, kt3);
            PG8_BAR; PG8_WAIT_L(0); PG8_MMA(1, 0, At, B0); PG8_BAR; PG8_SCHED;
            PG8_STAGE_B(PG8_SB(1, 1), b2, 1, kt3);
            PG8_WAIT_V(6); PG8_BAR; PG8_MMA(1, 1, At, B1); PG8_BAR;
            }
        }
        if constexpr (Epi::FP8) {
            _Pragma("unroll") for (int a = 0; a < 2; ++a)
                asm volatile("s_nop 15\n\ts_nop 15" : "+v"(acc[a][0][0][0]), "+v"(acc[a][0][0][1]), "+v"(acc[a][0][1][0]), "+v"(acc[a][0][1][1]), "+v"(acc[a][0][2][0]), "+v"(acc[a][0][2][1]), "+v"(acc[a][0][3][0]), "+v"(acc[a][0][3][1]),
                             "+v"(acc[a][1][0][0]), "+v"(acc[a][1][0][1]), "+v"(acc[a][1][1][0]), "+v"(acc[a][1][1][1]), "+v"(acc[a][1][2][0]), "+v"(acc[a][1][2][1]), "+v"(acc[a][1][3][0]), "+v"(acc[a][1][3][1]));
        }
        if constexpr (ALIGN_EPI) { if (wr == 0) PG8_BAR; }
        E(acc, cur, wr, wc, fr, fq);
        if (!has_next) break;
#pragma unroll
        for (int a = 0; a < 2; ++a)
#pragma unroll
            for (int b = 0; b < 2; ++b)
#pragma unroll
                for (int m = 0; m < 4; ++m)
#pragma unroll
                    for (int n = 0; n < 2; ++n) acc[a][b][m][n] = (f32x4){0.f, 0.f, 0.f, 0.f};
        cur = nxt; cB = nB; cD = nD; c00 = n00; c01 = n01; c10 = n10; c11 = n11; ++ui;
        if constexpr (ALIGN_EPI) { if (wr == 1) PG8_BAR; }
    }
    PG8_WAIT_V(0);
    if constexpr (!ALIGN_EPI) { if (wr == 0) PG8_BAR; }
    PG8_BAR;
#undef PG8_SA
#undef PG8_SB
#undef PG8_GLDS
#undef PG8_STAGE_A
#undef PG8_STAGE_B
#undef PG8_LDA
#undef PG8_LDB
#undef PG8_MMA
#undef PG8_WAIT_V
#undef PG8_WAIT_L
#undef PG8_BAR
#undef PG8_SCHED
#undef PG8_ROWOFF
#undef PG8_BPTR
}

struct EpiProj0 {
    static constexpr bool FP8 = false; static constexpr int scale_w = 0, scale_a = 0;
    static constexpr bool PERM = true; static constexpr bool SWAPV = true;
    __device__ __forceinline__ bool swapv(const Unit& u) const { return u.pn >= 4 && u.pn < 8; }
    bf16_t* qk; unsigned char* vtp; bf16_t* r; float* afb;
    __device__ __forceinline__ void operator()(const f32x4 (&acc)[2][2][4][2], const Unit& u, int wr, int wc, int fr, int fq) const {
        const int row0 = u.pm * BM + wr * 64 + fr;
        if (swapv(u)) {
            unsigned char* p0 = vtp + (size_t)(4 * u.pm + (wc >> 1)) * 131072 + (size_t)((((16 * (u.pn - 4) + 4 * wr) * 2 + (wc & 1)) * 64 + fr + 16 * fq) * 16);
#pragma unroll
            for (int ai = 0; ai < 2; ++ai)
#pragma unroll
                for (int m = 0; m < 4; ++m)
#pragma unroll
                    for (int bj = 0; bj < 2; ++bj) { const f32x4 v0 = acc[ai][bj][m][0], v1 = acc[ai][bj][m][1];
                        u32x4 w; w.x = cvt_pk_bf16(v0[0], v0[1]); w.y = cvt_pk_bf16(v0[2], v0[3]); w.z = cvt_pk_bf16(v1[0], v1[1]); w.w = cvt_pk_bf16(v1[2], v1[3]);
                        *(u32x4*)(p0 + (size_t)bj * 2 * 131072 + (size_t)(8 * ai + m) * 2048) = w; }
        } else if (u.pn < 12) {
            const float sc = (u.pn < 2) ? 0.08838834764831845f : 1.f;
            bf16_t* base = qk + (size_t)(u.pn >> 3) * (size_t)(130 * MiB / 2);
            const int col0 = (u.pn & 3) * BM + wc * 32 + 8 * fq;
#pragma unroll
            for (int ai = 0; ai < 2; ++ai)
#pragma unroll
                for (int m = 0; m < 4; ++m) { bf16_t* rowp = base + (size_t)(row0 + ai * HALF + m * 16) * D + col0;
#pragma unroll
                    for (int bj = 0; bj < 2; ++bj) { const f32x4 v0 = acc[ai][bj][m][0] * sc, v1 = acc[ai][bj][m][1] * sc;
                        u32x4 w; w.x = cvt_pk_bf16(v0[0], v0[1]); w.y = cvt_pk_bf16(v0[2], v0[3]); w.z = cvt_pk_bf16(v1[0], v1[1]); w.w = cvt_pk_bf16(v1[2], v1[3]);
                        *(u32x4*)(rowp + bj * HALF) = w; } }
        } else if (wc == 0) {
#pragma unroll
            for (int ai = 0; ai < 2; ++ai)
#pragma unroll
                for (int m = 0; m < 4; ++m) { float* rowp = afb + (size_t)(row0 + ai * HALF + m * 16) * 32 + 8 * fq;
                    *(f32x4*)(rowp) = acc[ai][0][m][0]; *(f32x4*)(rowp + 4) = acc[ai][0][m][1]; }
        }
    }
};
template <bool SRC_F32>
struct EpiResidT {
    static constexpr bool FP8 = false; static constexpr int scale_w = 0, scale_a = 0;
    static constexpr bool PERM = true; static constexpr bool SWAPV = false; __device__ __forceinline__ bool swapv(const Unit&) const { return false; }
    const void* src; bf16_t* dst; const float* gate;
    __device__ __forceinline__ void operator()(const f32x4 (&acc)[2][2][4][2], const Unit& u, int wr, int wc, int fr, int fq) const {
        const int row0 = u.pm * BM + wr * 64 + fr, col0 = u.pn * BM + wc * 32 + 8 * fq;
        const int b = (u.pm * BM) >> 14;
        f32x4 gv[2][2];
#pragma unroll
        for (int bj = 0; bj < 2; ++bj)
#pragma unroll
            for (int n = 0; n < 2; ++n) gv[bj][n] = *(const f32x4*)(gate + (size_t)b * 6 * D + col0 + bj * HALF + n * 4);
#pragma unroll
        for (int ai = 0; ai < 2; ++ai) {
            f32x4 sv[4][2][2];
#pragma unroll
            for (int m = 0; m < 4; ++m)
#pragma unroll
                for (int bj = 0; bj < 2; ++bj) { const size_t off = (size_t)(row0 + ai * HALF + m * 16) * D + col0 + bj * HALF;
                    if constexpr (SRC_F32) { sv[m][bj][0] = *(const f32x4*)((const float*)src + off); sv[m][bj][1] = *(const f32x4*)((const float*)src + off + 4); }
                    else { const u32x4 t = *(const u32x4*)((const bf16_t*)src + off);
                        sv[m][bj][0] = (f32x4){bflo(t.x), bfhi(t.x), bflo(t.y), bfhi(t.y)}; sv[m][bj][1] = (f32x4){bflo(t.z), bfhi(t.z), bflo(t.w), bfhi(t.w)}; } }
            asm volatile("" ::: "memory");
#pragma unroll
            for (int m = 0; m < 4; ++m)
#pragma unroll
                for (int bj = 0; bj < 2; ++bj) { const f32x4 y0 = sv[m][bj][0] + gv[bj][0] * acc[ai][bj][m][0], y1 = sv[m][bj][1] + gv[bj][1] * acc[ai][bj][m][1];
                    u32x4 w; w.x = cvt_pk_bf16(y0[0], y0[1]); w.y = cvt_pk_bf16(y0[2], y0[3]); w.z = cvt_pk_bf16(y1[0], y1[1]); w.w = cvt_pk_bf16(y1[2], y1[3]);
                    *(u32x4*)(dst + (size_t)(row0 + ai * HALF + m * 16) * D + col0 + bj * HALF) = w; }
        }
    }
};
struct EpiBf16Plain {
    static constexpr bool FP8 = false; static constexpr int scale_w = 0, scale_a = 0;
    static constexpr bool PERM = true; static constexpr bool SWAPV = false; __device__ __forceinline__ bool swapv(const Unit&) const { return false; }
    bf16_t* O; int ldc;
    __device__ __forceinline__ void operator()(const f32x4 (&acc)[2][2][4][2], const Unit& u, int wr, int wc, int fr, int fq) const {
        const int row0 = u.pm * BM + wr * 64 + fr, col0 = u.pn * BM + wc * 32 + 8 * fq;
#pragma unroll
        for (int ai = 0; ai < 2; ++ai)
#pragma unroll
            for (int m = 0; m < 4; ++m) { bf16_t* rowp = O + (size_t)(row0 + ai * HALF + m * 16) * ldc + col0;
#pragma unroll
                for (int bj = 0; bj < 2; ++bj) { const f32x4 v0 = acc[ai][bj][m][0], v1 = acc[ai][bj][m][1];
                    u32x4 w; w.x = cvt_pk_bf16(v0[0], v0[1]); w.y = cvt_pk_bf16(v0[2], v0[3]); w.z = cvt_pk_bf16(v1[0], v1[1]); w.w = cvt_pk_bf16(v1[2], v1[3]);
                    *(u32x4*)(rowp + bj * HALF) = w; } }
    }
};
__device__ __forceinline__ float dpp_shr1(float oldv, float x) { return __builtin_bit_cast(float, __builtin_amdgcn_update_dpp(__builtin_bit_cast(int, oldv), __builtin_bit_cast(int, x), 0x111, 0xF, 0xF, false)); }
__device__ __forceinline__ float dpp_shl1(float oldv, float x) { return __builtin_bit_cast(float, __builtin_amdgcn_update_dpp(__builtin_bit_cast(int, oldv), __builtin_bit_cast(int, x), 0x101, 0xF, 0xF, false)); }
__device__ __forceinline__ float dpp_ror1(float x) { return __builtin_bit_cast(float, __builtin_amdgcn_update_dpp(0, __builtin_bit_cast(int, x), 0x121, 0xF, 0xF, false)); }
__device__ __forceinline__ float dpp_rol1(float x) { return __builtin_bit_cast(float, __builtin_amdgcn_update_dpp(0, __builtin_bit_cast(int, x), 0x12F, 0xF, 0xF, false)); }
struct EpiConvFused {
    static constexpr bool FP8 = false; static constexpr int scale_w = 0, scale_a = 0;
    static constexpr bool PERM = true; static constexpr bool SWAPV = false; __device__ __forceinline__ bool swapv(const Unit&) const { return false; }
    unsigned char* dump;
    bf16_t* O; const float* ck;
    __device__ __forceinline__ void operator()(const f32x4 (&acc)[2][2][4][2], const Unit& u, int wr, int wc, int fr, int fq) const {
        const int cb = u.pn / 3, sec = u.pn - 3 * cb, tid = threadIdx.x;
        if (sec < 2) {
            const int cc = 256 * cb + 128 * sec + wc * 32 + 8 * fq;
            unsigned char* dp = dump + (size_t)sec * 65536 + tid * 16;
#pragma unroll
            for (int n = 0; n < 2; ++n) {
                const f32x4 k0 = *(const f32x4*)(ck + cc + 4 * n), k1 = *(const f32x4*)(ck + D + cc + 4 * n), k2 = *(const f32x4*)(ck + 2 * D + cc + 4 * n);
#pragma unroll
                for (int ai = 0; ai < 2; ++ai) {
                    f32x4 y[4];
#pragma unroll
                    for (int j = 0; j < 4; ++j) {
                        float x[4];
#pragma unroll
                        for (int m = 0; m < 4; ++m) x[m] = acc[ai][0][m][n][j] * acc[ai][1][m][n][j];
#pragma unroll
                        for (int m = 0; m < 4; ++m) {
                            const float up = dpp_shr1(m > 0 ? dpp_ror1(x[m - 1]) : 0.f, x[m]);
                            const float dn = dpp_shl1(m < 3 ? dpp_rol1(x[m + 1]) : 0.f, x[m]);
                            y[m][j] = k0[j] * up + k1[j] * x[m] + k2[j] * dn; }
                    }
#pragma unroll
                    for (int m = 0; m < 4; ++m) { u32x2 w; w.x = cvt_pk_bf16(y[m][0], y[m][1]); w.y = cvt_pk_bf16(y[m][2], y[m][3]);
                        *(u32x2*)(dp + (ai * 4 + m) * 8192 + n * 8) = w; }
                }
            }
        } else {
            const int row0 = u.pm * BM + wr * 64 + fr, col0 = 256 * cb + wc * 32 + 8 * fq;
            const unsigned loff = (unsigned)tid * 16u;
#pragma unroll
            for (int ai = 0; ai < 2; ++ai) {
                u32x4 qq[4][2];
#pragma unroll
                for (int m = 0; m < 4; ++m) {
                    const unsigned char* sb = dump + (ai * 4 + m) * 8192; asm volatile("" : "+s"(sb));
                    qq[m][0] = *(const u32x4*)(sb + loff); qq[m][1] = *(const u32x4*)(sb + 65536 + loff); }
#pragma unroll
                for (int m = 0; m < 4; ++m) {
                    bf16_t* rowp = O + (size_t)(row0 + ai * HALF + m * 16) * D + col0;
#pragma unroll
                    for (int bj = 0; bj < 2; ++bj) { const f32x4 v0 = acc[ai][bj][m][0], v1 = acc[ai][bj][m][1]; const u32x4 q = qq[m][bj];
                        u32x4 w; w.x = cvt_pk_bf16(v0[0] * bflo(q.x), v0[1] * bfhi(q.x)); w.y = cvt_pk_bf16(v0[2] * bflo(q.y), v0[3] * bfhi(q.y));
                        w.z = cvt_pk_bf16(v1[0] * bflo(q.z), v1[1] * bfhi(q.z)); w.w = cvt_pk_bf16(v1[2] * bflo(q.w), v1[3] * bfhi(q.w));
                        *(u32x4*)(rowp + bj * HALF) = w; } }
                asm volatile("" ::: "memory");
            }
        }
    }
};
struct EpiSwiglu {
    static constexpr bool FP8 = true; int scale_w, scale_a;
    static constexpr bool PERM = true; static constexpr bool SWAPV = false; __device__ __forceinline__ bool swapv(const Unit&) const { return false; }
    unsigned char* hid;
    __device__ __forceinline__ void operator()(const f32x4 (&acc)[2][2][4][2], const Unit& u, int wr, int wc, int fr, int fq) const {
        const int row0 = u.e * 4096 + u.pm * BM + wr * 64 + fr, col0 = u.pn * HALF + wc * 32 + 8 * fq;
#pragma unroll
        for (int ai = 0; ai < 2; ++ai)
#pragma unroll
            for (int m = 0; m < 4; ++m) { unsigned char* rowp = hid + (size_t)(row0 + ai * HALF + m * 16) * DEXP + col0;
                float h[8];
#pragma unroll
                for (int n = 0; n < 2; ++n)
#pragma unroll
                    for (int j2 = 0; j2 < 2; ++j2) {
                        const f32x2 gt = {acc[ai][0][m][n][2 * j2], acc[ai][0][m][n][2 * j2 + 1]}, up = {acc[ai][1][m][n][2 * j2], acc[ai][1][m][n][2 * j2 + 1]};
                        const f32x2 a = gt * (f32x2){-1.4426950408889634f, -1.4426950408889634f};
                        f32x2 t; t.x = __builtin_amdgcn_exp2f(a.x); t.y = __builtin_amdgcn_exp2f(a.y);
                        const f32x2 d4 = t * (f32x2){0.25f, 0.25f} + (f32x2){0.25f, 0.25f};
                        f32x2 r4; r4.x = __builtin_amdgcn_rcpf(d4.x); r4.y = __builtin_amdgcn_rcpf(d4.y);
                        const f32x2 hv = (gt * up) * r4;
                        h[n * 4 + 2 * j2] = __builtin_amdgcn_fmed3f(hv.x, -448.f, 448.f); h[n * 4 + 2 * j2 + 1] = __builtin_amdgcn_fmed3f(hv.y, -448.f, 448.f); }
                int w0 = __builtin_amdgcn_cvt_pk_fp8_f32(h[0], h[1], 0, false); w0 = __builtin_amdgcn_cvt_pk_fp8_f32(h[2], h[3], w0, true);
                int w1 = __builtin_amdgcn_cvt_pk_fp8_f32(h[4], h[5], 0, false); w1 = __builtin_amdgcn_cvt_pk_fp8_f32(h[6], h[7], w1, true);
                u32x2 w; w.x = (unsigned)w0; w.y = (unsigned)w1;
                *(u32x2*)(rowp) = w; }
    }
};
struct EpiDown {
    static constexpr bool FP8 = true; int scale_w, scale_a;
    static constexpr bool PERM = true; static constexpr bool SWAPV = false; __device__ __forceinline__ bool swapv(const Unit&) const { return false; }
    unsigned char* ye;
    __device__ __forceinline__ void operator()(const f32x4 (&acc)[2][2][4][2], const Unit& u, int wr, int wc, int fr, int fq) const {
        const int row0 = u.e * 4096 + u.pm * BM + wr * 64 + fr, col0 = u.pn * BM + wc * 32 + 8 * fq;
#pragma unroll
        for (int ai = 0; ai < 2; ++ai)
#pragma unroll
            for (int m = 0; m < 4; ++m) { const int row = row0 + ai * HALF + m * 16; unsigned char* rowp = ye + (size_t)row * D + col0;
#pragma unroll
                for (int bj = 0; bj < 2; ++bj) { f32x4 v0 = acc[ai][bj][m][0] * 32.f, v1 = acc[ai][bj][m][1] * 32.f;
#pragma unroll
                    for (int i = 0; i < 4; ++i) { v0[i] = __builtin_amdgcn_fmed3f(v0[i], -448.f, 448.f); v1[i] = __builtin_amdgcn_fmed3f(v1[i], -448.f, 448.f); }
                    int w0 = __builtin_amdgcn_cvt_pk_fp8_f32(v0[0], v0[1], 0, false); w0 = __builtin_amdgcn_cvt_pk_fp8_f32(v0[2], v0[3], w0, true);
                    int w1 = __builtin_amdgcn_cvt_pk_fp8_f32(v1[0], v1[1], 0, false); w1 = __builtin_amdgcn_cvt_pk_fp8_f32(v1[2], v1[3], w1, true);
                    u32x2 w; w.x = (unsigned)w0; w.y = (unsigned)w1;
                    *(u32x2*)(rowp + bj * HALF) = w; } }
    }
};
}

constexpr int RING_BYTES = 131072, LDS_BYTES = 147456;
struct Args { const float* in[20]; float* out; unsigned char* ws; int ph_lo, ph_hi; };
struct Frame {
    LAS unsigned char* lds;
    int tid, lane, wave, gw, ngw, G;
};
#define P_X 0
#define P_C 1
#define P_CTX 2
#define P_CCTX 3
#define P_ADAW 4
#define P_ADAB 5
#define P_NORMG 6
#define P_GWIN 7
#define P_GWA2 8
#define P_GBA2 9
#define P_GNORMG 10
#define P_GWOUT 11
#define P_CWIN 12
#define P_CK 13
#define P_CWOUT 14
#define P_ROUTER 15
#define P_EGATE 16
#define P_EUP 17
#define P_EDOWN 18
#define P_FINALG 19

constexpr int TR_SCR = 64 * 65 * 4;
__device__ __forceinline__ void tr_item(const float* W, int ldw, int k0, int n0, bf16_t* WT, int ldo, int drow0, LAS float* scr, int lane) {
    f32x4 v[16];
#pragma unroll
    for (int i = 0; i < 16; ++i) v[i] = *(const f32x4*)(W + (size_t)(k0 + 4 * i + (lane >> 4)) * ldw + n0 + 4 * (lane & 15));
#pragma unroll
    for (int i = 0; i < 16; ++i) { LAS float* p = scr + (4 * i + (lane >> 4)) * 65 + 4 * (lane & 15); p[0] = v[i].x; p[1] = v[i].y; p[2] = v[i].z; p[3] = v[i].w; }
    LDS_WAIT(); asm volatile("" ::: "memory");
    const int c = lane & 7;
#pragma unroll
    for (int j = 0; j < 8; ++j) { const int n = (lane >> 3) + 8 * j; const LAS float* sp = scr + (8 * c) * 65 + n;
        u32x4 o; o.x = pk2(sp[0 * 65], sp[1 * 65]); o.y = pk2(sp[2 * 65], sp[3 * 65]); o.z = pk2(sp[4 * 65], sp[5 * 65]); o.w = pk2(sp[6 * 65], sp[7 * 65]);
        *(u32x4*)(WT + (size_t)(drow0 + n) * ldo + k0 + 8 * c) = o; }
    LDS_WAIT(); asm volatile("" ::: "memory");
}
__device__ __forceinline__ void tr_plain(Frame& F, const Args& A, const float* W, int K, int N, bf16_t* WT, int item, LAS float* scr) {
    const int nblk = (N + 63) / 64, kb = item / nblk, nb = item % nblk; int n0 = 64 * nb; if (n0 + 64 > N) n0 = N - 64;
    tr_item(W, N, 64 * kb, n0, WT, K, n0, scr, F.lane);
}
constexpr int TR_SCR8 = 128 * 33 * 4;
static_assert(TR_SCR8 >= TR_SCR, "per-wave scratch stride");
struct Tr8Item { const float* W; unsigned char* WT; int ldw, ldo, rowmap; };
constexpr int I8_G = (D / 128) * (DEXP / 256);
constexpr int I8_D = (DEXP / 128) * (D / 256);
constexpr int N_EXPERT_ITEMS = NE * (2 * I8_G + I8_D);
__device__ __forceinline__ Tr8Item expert_item(const Args& A, int gi) {
    const int l = gi / N_EXPERT_ITEMS, it = gi % N_EXPERT_ITEMS;
    unsigned char* wgu = A.ws + WS_W8 + (size_t)l * W8_LAYER; unsigned char* wd = wgu + W8_WD;
    constexpr int PER_E = 2 * I8_G + I8_D;
    const int e = it / PER_E; int r = it % PER_E;
    Tr8Item t;
    if (r < 2 * I8_G) {
        const int up = r / I8_G; r %= I8_G;
        const float* W = A.in[up ? P_EUP : P_EGATE] + ((size_t)l * NE + e) * D * DEXP;
        const int nblk = DEXP / 256, kb = r / nblk, nb = r % nblk, h0 = 256 * nb;
        t.W = W + (size_t)(128 * kb) * DEXP + h0; t.ldw = DEXP; t.WT = wgu + (size_t)e * 4096 * D + (size_t)(2 * h0 + 128 * up) * D + 128 * kb; t.ldo = D; t.rowmap = 1;
    } else {
        r -= 2 * I8_G;
        const float* W = A.in[P_EDOWN] + ((size_t)l * NE + e) * DEXP * D;
        const int nblk = D / 256, kb = r / nblk, nb = r % nblk;
        t.W = W + (size_t)(128 * kb) * D + 256 * nb; t.ldw = D; t.WT = wd + (size_t)e * D * DEXP + (size_t)(256 * nb) * DEXP + 128 * kb; t.ldo = DEXP; t.rowmap = 0;
    }
    return t;
}
__device__ __forceinline__ void tr8_load(const Tr8Item& t, f32x4 (&v)[16], int wave, int lane) {
#pragma unroll
    for (int i = 0; i < 16; ++i) v[i] = __builtin_nontemporal_load((const f32x4*)(t.W + (size_t)(16 * wave + i) * t.ldw + 4 * lane));
}
__device__ __forceinline__ void tr8_finish(const Tr8Item& t, const f32x4 (&v)[16], LAS unsigned char* tile, int tid, int wave, int lane) {
#pragma unroll
    for (int q = 0; q < 4; ++q) {
        int o[4];
#pragma unroll
        for (int g = 0; g < 4; ++g) { int w = __builtin_amdgcn_cvt_pk_fp8_f32(64.f * v[4 * g][q], 64.f * v[4 * g + 1][q], 0, false);
            o[g] = __builtin_amdgcn_cvt_pk_fp8_f32(64.f * v[4 * g + 2][q], 64.f * v[4 * g + 3][q], w, true); }
        u32x4 ov; ov.x = (unsigned)o[0]; ov.y = (unsigned)o[1]; ov.z = (unsigned)o[2]; ov.w = (unsigned)o[3];
        const int n = 4 * lane + q;
        *(LAS u32x4*)(tile + n * 128 + ((wave ^ (n & 7)) << 4)) = ov; }
    __syncthreads();
#pragma unroll
    for (int j = 0; j < 4; ++j) { const int p = tid + 512 * j, n = p >> 3, c = p & 7;
        const u32x4 ov = *(const LAS u32x4*)(tile + n * 128 + ((c ^ (n & 7)) << 4));
        const int drow = t.rowmap ? (256 * (n >> 7) + (n & 127)) : n;
        *(u32x4*)(t.WT + (size_t)drow * t.ldo + 16 * c) = ov; }
    __syncthreads();
}
__device__ __forceinline__ void convert_expert_dyn(const Args& A, unsigned* ctr, int end, LAS unsigned char* tile, volatile LAS int* slot, int tid, int wave, int lane) {
    if (tid == 0) { slot[0] = (int)__hip_atomic_fetch_add(ctr, 1u, __ATOMIC_RELAXED, __HIP_MEMORY_SCOPE_AGENT); slot[1] = (int)__hip_atomic_fetch_add(ctr, 1u, __ATOMIC_RELAXED, __HIP_MEMORY_SCOPE_AGENT); }
    __syncthreads();
    int ia = slot[0], ib = slot[1];
    if (ia >= end) return;
    f32x4 va[16], vb[16];
    Tr8Item ta = expert_item(A, ia), tb;
    tr8_load(ta, va, wave, lane);
    for (;;) {
        int rc = 0;
        tb = expert_item(A, min(ib, end - 1)); tr8_load(tb, vb, wave, lane);
        if (tid == 0) rc = (int)__hip_atomic_fetch_add(ctr, 1u, __ATOMIC_RELAXED, __HIP_MEMORY_SCOPE_AGENT);
        tr8_finish(ta, va, tile, tid, wave, lane);
        if (tid == 0) slot[0] = rc;
        __syncthreads();
        ia = ib; ib = slot[0];
        if (ia >= end) break;
        ta = expert_item(A, min(ib, end - 1)); tr8_load(ta, va, wave, lane);
        if (tid == 0) rc = (int)__hip_atomic_fetch_add(ctr, 1u, __ATOMIC_RELAXED, __HIP_MEMORY_SCOPE_AGENT);
        tr8_finish(tb, vb, tile, tid, wave, lane);
        if (tid == 0) slot[1] = rc;
        __syncthreads();
        ia = ib; ib = slot[1];
        if (ia >= end) break;
    }
}
template <int N>
__device__ __forceinline__ void convert_expert_fixed(const Args& A, LAS unsigned char* lds, int tid, int wave, int lane) {
    unsigned* ctr = (unsigned*)(A.ws + WS_CTL) + 2048; LAS unsigned char* tile = lds + 49152; volatile LAS int* slot = (volatile LAS int*)(lds + 40960);
    constexpr int end = 2 * N_EXPERT_ITEMS;
    __syncthreads();
    if (tid == 0) slot[0] = (int)__hip_atomic_fetch_add(ctr, (unsigned)N, __ATOMIC_RELAXED, __HIP_MEMORY_SCOPE_AGENT);
    __syncthreads();
    const int base = slot[0];
    if (base >= end) return;
    f32x4 va[16], vb[16];
    Tr8Item ta = expert_item(A, base), tb = ta;
    tr8_load(ta, va, wave, lane);
#pragma unroll
    for (int j = 0; j < N; ++j) {
        if ((j & 1) == 0) { if (j + 1 < N) { tb = expert_item(A, min(base + j + 1, end - 1)); tr8_load(tb, vb, wave, lane); } tr8_finish(ta, va, tile, tid, wave, lane); }
        else              { if (j + 1 < N) { ta = expert_item(A, min(base + j + 1, end - 1)); tr8_load(ta, va, wave, lane); } tr8_finish(tb, vb, tile, tid, wave, lane); }
    }
}

__device__ __forceinline__ void ph_prep(Frame& F, const Args& A) {
    LAS float* scr = (LAS float*)(F.lds + F.wave * TR_SCR8);
    bf16_t* win0 = (bf16_t*)(A.ws + WS_WIN0T); bf16_t* wout0 = (bf16_t*)(A.ws + WS_WOUT0T); bf16_t* wcin = (bf16_t*)(A.ws + WS_WCINT); bf16_t* wcout = (bf16_t*)(A.ws + WS_WCOUTT);
    {
        float* mod = (float*)(A.ws + WS_MOD);
        LAS float* red = (LAS float*)(F.lds + 8 * TR_SCR8);
        if ((int)blockIdx.x < 2 * 96) {
            LAS float* sl = (LAS float*)F.lds;
            for (int i = F.tid; i < 3 * D; i += NTHR) sl[i] = silu_f(i < 2 * D ? A.in[P_C][i] : A.in[P_CCTX][i - 2 * D]);
            __syncthreads();
        }
        for (int it = blockIdx.x; it < 2 * 96; it += F.G) {
            const LAS float* sl = (const LAS float*)F.lds;
            const int l = it / 96, n0 = (it % 96) * 64, kq = F.lane >> 4, c4 = F.lane & 15;
            const float* w = A.in[P_ADAW] + (size_t)l * D * 6 * D + n0 + 4 * c4;
            f32x4 a0 = (f32x4){0.f, 0.f, 0.f, 0.f}, a1 = a0, a2 = a0;
#pragma unroll 8
            for (int st = 0; st < 32; ++st) { const int k = F.wave * 128 + 4 * st + kq; const f32x4 wv = *(const f32x4*)(w + (size_t)k * 6 * D);
                a0 += sl[k] * wv; a1 += sl[D + k] * wv; a2 += sl[2 * D + k] * wv; }
#pragma unroll
            for (int i = 0; i < 4; ++i) { a0[i] += __shfl_xor(a0[i], 16); a0[i] += __shfl_xor(a0[i], 32); a1[i] += __shfl_xor(a1[i], 16); a1[i] += __shfl_xor(a1[i], 32); a2[i] += __shfl_xor(a2[i], 16); a2[i] += __shfl_xor(a2[i], 32); }
            if (kq == 0) { *(LAS f32x4*)(red + (F.wave * 3 + 0) * 64 + 4 * c4) = a0; *(LAS f32x4*)(red + (F.wave * 3 + 1) * 64 + 4 * c4) = a1; *(LAS f32x4*)(red + (F.wave * 3 + 2) * 64 + 4 * c4) = a2; }
            __syncthreads();
            if (F.wave < 3) { const int n = n0 + F.lane; float sacc = A.in[P_ADAB][l * 6 * D + n];
#pragma unroll
                for (int w8 = 0; w8 < 8; ++w8) sacc += red[(w8 * 3 + F.wave) * 64 + F.lane];
                mod[(l * 3 + F.wave) * 6 * D + n] = sacc; }
            __syncthreads();
        }
    }
    constexpr int I0 = (D / 64) * ((NIN0 + 63) / 64), I1 = (D / 64) * (D / 64), I2 = (D / 64) * (NCIN / 64), I3 = I1;
    for (int it = F.ngw - 1 - F.gw; it < I0 + I1 + I2 + I3; it += F.ngw) {
        int r = it;
        if (r < I0) { tr_plain(F, A, A.in[P_GWIN], D, NIN0, win0, r, scr); continue; } r -= I0;
        if (r < I1) { tr_plain(F, A, A.in[P_GWOUT], D, D, wout0, r, scr); continue; } r -= I1;
        if (r < I2) {
            constexpr int nblk = NCIN / 64; const int kb = r / nblk, n0 = 64 * (r % nblk), sct = n0 >> 10, ch = n0 & 1023, cb = ch >> 8, hf = (ch >> 7) & 1;
            const int drow0 = sct == 0 ? (3 * cb + 2) * 256 + (ch & 255) : (3 * cb + hf) * 256 + 128 * (sct - 1) + (ch & 127);
            tr_item(A.in[P_CWIN], NCIN, 64 * kb, n0, wcin, D, drow0, scr, F.lane); continue; } r -= I2;
        tr_plain(F, A, A.in[P_CWOUT], D, D, wcout, r, scr);
    }
    { u32x4* z = (u32x4*)(win0 + (size_t)NIN0 * D); const int n16 = (NIN0P - NIN0) * D * 2 / 16;
      for (int i = F.gw * 64 + F.lane; i < n16; i += F.ngw * 64) z[i] = (u32x4){0u, 0u, 0u, 0u}; }
}

__device__ __forceinline__ void normmod_row(const f32x4 (&v)[4], const float* g, const float* sh, const float* sc, bf16_t* orow, int lane) {
    float s = 0.f;
#pragma unroll
    for (int j = 0; j < 4; ++j) s += (v[j].x * v[j].x + v[j].y * v[j].y) + (v[j].z * v[j].z + v[j].w * v[j].w);
    const float rstd = rsqrtf(wave_sum(s) * (1.f / D) + EPS);
#pragma unroll
    for (int j = 0; j < 4; ++j) { const int c = 4 * lane + 256 * j;
        const f32x4 gg = *(const f32x4*)(g + c), s1 = *(const f32x4*)(sh + c), s2 = *(const f32x4*)(sc + c);
        const f32x4 y = v[j] * rstd * gg * (s2 + 1.f) + s1;
        u32x2 w; w.x = pk2(y.x, y.y); w.y = pk2(y.z, y.w);
        *(u32x2*)(orow + c) = w; }
}
__device__ __forceinline__ void ph_norm0(Frame& F, const Args& A) {
    const float* mod = (const float*)(A.ws + WS_MOD); bf16_t* H = (bf16_t*)(A.ws + WS_H);
    int scur = -1; f32x4 pg[4], p1[4], p2[4];
    for (int row = F.gw; row < NROW; row += 2 * F.ngw) {
        const int row2 = row + F.ngw; const bool has2 = row2 < NROW;
        const float* xa = row < NLAT ? A.in[P_X] + (size_t)row * D : A.in[P_CTX] + (size_t)(row - NLAT) * D;
        const int r2c = has2 ? row2 : row;
        const float* xb = r2c < NLAT ? A.in[P_X] + (size_t)r2c * D : A.in[P_CTX] + (size_t)(r2c - NLAT) * D;
        f32x4 va[4], vb[4];
#pragma unroll
        for (int j = 0; j < 4; ++j) { va[j] = *(const f32x4*)(xa + 4 * F.lane + 256 * j); vb[j] = *(const f32x4*)(xb + 4 * F.lane + 256 * j); }
#pragma unroll
        for (int h = 0; h < 2; ++h) {
            const int r = h ? r2c : row; if (h && !has2) break;
            const int sset = r < NLAT ? (r >> 14) : 2;
            if (sset != scur) { scur = sset;
#pragma unroll
                for (int j = 0; j < 4; ++j) { const int c = 4 * F.lane + 256 * j; pg[j] = *(const f32x4*)(A.in[P_NORMG] + c);
                    p1[j] = *(const f32x4*)(mod + (0 * 3 + sset) * 6 * D + 0 * D + c); p2[j] = *(const f32x4*)(mod + (0 * 3 + sset) * 6 * D + 1 * D + c) + 1.f; } }
            float ssq = 0.f;
#pragma unroll
            for (int j = 0; j < 4; ++j) { const f32x4 v = h ? vb[j] : va[j]; ssq += (v.x * v.x + v.y * v.y) + (v.z * v.z + v.w * v.w); }
            const float rstd = rsqrtf(wave_sum(ssq) * (1.f / D) + EPS);
#pragma unroll
            for (int j = 0; j < 4; ++j) { const f32x4 v = h ? vb[j] : va[j]; const f32x4 y = v * rstd * pg[j] * p2[j] + p1[j];
                u32x2 w; w.x = pk2(y.x, y.y); w.y = pk2(y.z, y.w); *(u32x2*)(H + (size_t)r * D + 4 * F.lane + 256 * j) = w; }
        }
    }
}

__device__ __forceinline__ int jperm(int ks, int fq, int jj) { return 32 * ks + 16 * (jj >> 2) + 4 * fq + (jj & 3); }
__device__ __forceinline__ bf16x8 ldfrag(const unsigned char* blob, int blk, int lane) { return *(const bf16x8*)(blob + blk * 1024 + lane * 16); }
__device__ __forceinline__ unsigned cvtpk(float lo, float hi) { return pk2(lo, hi); }
__device__ __forceinline__ bf16x8 pack8(const f32x4& a, const f32x4& b) {
    u32x4 w; w.x = cvtpk(a[0], a[1]); w.y = cvtpk(a[2], a[3]); w.z = cvtpk(b[0], b[1]); w.w = cvtpk(b[2], b[3]);
    return __builtin_bit_cast(bf16x8, w);
}
__device__ __forceinline__ void ph_gla_prep(Frame& F, const Args& A) {
    constexpr int LSTR = 1040;
    LAS unsigned char* QS = F.lds; LAS unsigned char* KS = F.lds + 64 * LSTR;
    const bf16_t* qk = (const bf16_t*)(A.ws + WS_QK); const float* afb = (const float*)(A.ws + WS_AFB);
    float* gam = (float*)(A.ws + WS_GAM);
    const bool has_conv = blockIdx.x + 4 * F.G >= 2 * NCHUNK;
    const int pre = has_conv ? (int)(blockIdx.x & 3) : 0;
    if (pre == 1) convert_expert_fixed<1>(A, F.lds, F.tid, F.wave, F.lane);
    else if (pre == 2) convert_expert_fixed<2>(A, F.lds, F.tid, F.wave, F.lane);
    else if (pre == 3) convert_expert_fixed<3>(A, F.lds, F.tid, F.wave, F.lane);
    __syncthreads();
    const int dir = blockIdx.x & 1, d = F.tid;
    f32x2 w2[8];
#pragma unroll
    for (int r = 0; r < 8; ++r) { w2[r].x = A.in[P_GWA2][(dir * 16 + 2 * r) * DK + d]; w2[r].y = A.in[P_GWA2][(dir * 16 + 2 * r + 1) * DK + d]; }
    const float bias = A.in[P_GBA2][dir * DK + d];
    u32x4 t16[16]; f32x4 av = (f32x4){0.f, 0.f, 0.f, 0.f};
#define PREP_LOAD(it_) do { const int row0_ = ((it_) >> 1) * 64; \
        _Pragma("unroll") for (int u = 0; u < 16; ++u) { const int q16 = F.tid + NTHR * u, j = q16 >> 7, cp = q16 & 127; t16[u] = *(const u32x4*)((const unsigned char*)qk + ((size_t)(row0_ + j) * D) * 2 + cp * 16); } \
        if (F.tid < 256) av = *(const f32x4*)(afb + (size_t)(row0_ + (F.tid >> 2)) * 32 + dir * 16 + 4 * (F.tid & 3)); } while (0)
    if ((int)blockIdx.x < 2 * NCHUNK) PREP_LOAD((int)blockIdx.x);
    for (int item = blockIdx.x; item < 2 * NCHUNK; item += F.G) {
        {
            const int ch = item >> 1, row0 = ch * 64; (void)row0;
            LAS float* AFL = (LAS float*)(F.lds + 2 * 64 * LSTR);
            {
#pragma unroll
                for (int u = 0; u < 16; ++u) { const int q16 = F.tid + NTHR * u, j = q16 >> 7, cp = q16 & 127; *(LAS u32x4*)(((cp < 64) ? QS : KS) + j * LSTR + (cp & 63) * 16) = t16[u]; }
                if (F.tid < 256) *(LAS f32x4*)(AFL + (F.tid >> 2) * 16 + 4 * (F.tid & 3)) = av;
            }
            if (item + F.G < 2 * NCHUNK) PREP_LOAD(item + F.G);
            __syncthreads();
            float cum2 = 0.f;
#pragma unroll 1
            for (int jq = 0; jq < 64; jq += 4) {
                f32x4 ar[4][4]; unsigned qv[4], kv[4];
#pragma unroll
                for (int u = 0; u < 4; ++u) { const int j = dir ? 63 - (jq + u) : jq + u;
#pragma unroll
                    for (int r4 = 0; r4 < 4; ++r4) ar[u][r4] = *(const LAS f32x4*)(AFL + j * 16 + 4 * r4); }
#pragma unroll
                for (int u = 0; u < 4; ++u) { const int j = dir ? 63 - (jq + u) : jq + u;
                    qv[u] = *(const LAS bf16_t*)(QS + j * LSTR + d * 2); kv[u] = *(const LAS bf16_t*)(KS + j * LSTR + d * 2); }
                asm volatile("" ::: "memory");
                float ls2[4];
#pragma unroll
                for (int u = 0; u < 4; ++u) {
                    f32x2 za = (f32x2){bias, 0.f}, zb = (f32x2){0.f, 0.f};
#pragma unroll
                    for (int r4 = 0; r4 < 4; ++r4) { za = __builtin_elementwise_fma((f32x2){ar[u][r4].x, ar[u][r4].y}, w2[2 * r4], za); zb = __builtin_elementwise_fma((f32x2){ar[u][r4].z, ar[u][r4].w}, w2[2 * r4 + 1], zb); }
                    const float z = (za.x + za.y) + (zb.x + zb.y);
                    const float zl = z * 1.4426950408889634f;
                    ls2[u] = fminf(zl, 0.f) - __builtin_amdgcn_logf(1.f + __builtin_amdgcn_exp2f(-fabsf(zl)));
                }
                unsigned qk2[4];
#pragma unroll
                for (int u = 0; u < 4; ++u) {
                    cum2 += ls2[u] * (1.f / 16.f);
                    const float e = __builtin_amdgcn_exp2f(cum2), ei = __builtin_amdgcn_exp2f(-cum2);
                    qk2[u] = pk2(bflo(qv[u]) * e, bflo(kv[u]) * ei);
                }
#pragma unroll
                for (int u = 0; u < 4; ++u) { const int j = dir ? 63 - (jq + u) : jq + u;
                    *(LAS bf16_t*)(QS + j * LSTR + d * 2) = (bf16_t)(qk2[u] & 0xffffu); *(LAS bf16_t*)(KS + j * LSTR + d * 2) = (bf16_t)(qk2[u] >> 16); }
            }
            const float cum = cum2 * 0.6931471805599453f;
            gam[((size_t)dir * NCHUNK + ch) * DK + d] = __expf(cum);
            __syncthreads();
            {
                const int fr = F.lane & 15, fq = F.lane >> 4;
                unsigned char* blob0 = A.ws + (((size_t)dir * NCHUNK + ch) * 4) * BLOB + (size_t)F.tid * 16;
#pragma unroll
                for (int typ = 0; typ < 2; ++typ) {
                    const LAS unsigned char* src = (typ == 0) ? QS : KS;
                    u32x4 o[8];
#pragma unroll
                    for (int i8 = 0; i8 < 8; ++i8) { const int h = i8 >> 1, blk = F.wave + 8 * (i8 & 1), it = blk >> 2, sd = blk & 3, i = 16 * it + fr, d0 = h * HK + 32 * sd + 4 * fq;
                        const u32x2 lo = *(const LAS u32x2*)(src + i * LSTR + d0 * 2), hi = *(const LAS u32x2*)(src + i * LSTR + (d0 + 16) * 2);
                        o[i8].x = lo.x; o[i8].y = lo.y; o[i8].z = hi.x; o[i8].w = hi.y; }
                    unsigned char* dst = blob0 + (typ == 0 ? WS_QP : WS_KP);
#pragma unroll
                    for (int i8 = 0; i8 < 8; ++i8) *(u32x4*)(dst + (size_t)(i8 >> 1) * BLOB + (size_t)(i8 & 1) * 8192) = o[i8];
                }
                {
                    u32x4 o[8];
#pragma unroll
                    for (int i8 = 0; i8 < 8; ++i8) { const int h = i8 >> 1, blk = F.wave + 8 * (i8 & 1), mt = blk >> 1, ks = blk & 1, dd = h * HK + 16 * mt + fr; unsigned e[8];
#pragma unroll
                        for (int jj = 0; jj < 8; ++jj) e[jj] = *(const LAS bf16_t*)(KS + jperm(ks, fq, jj) * LSTR + dd * 2);
                        o[i8].x = e[0] | (e[1] << 16); o[i8].y = e[2] | (e[3] << 16); o[i8].z = e[4] | (e[5] << 16); o[i8].w = e[6] | (e[7] << 16); }
                    unsigned char* dst = blob0 + WS_KTP;
#pragma unroll
                    for (int i8 = 0; i8 < 8; ++i8) *(u32x4*)(dst + (size_t)(i8 >> 1) * BLOB + (size_t)(i8 & 1) * 8192) = o[i8];
                }
            }
            __syncthreads();
        }
    }
#undef PREP_LOAD
    if (has_conv) {
        if (pre == 0) convert_expert_fixed<4>(A, F.lds, F.tid, F.wave, F.lane);
        else if (pre == 1) convert_expert_fixed<3>(A, F.lds, F.tid, F.wave, F.lane);
        else if (pre == 2) convert_expert_fixed<2>(A, F.lds, F.tid, F.wave, F.lane);
        else convert_expert_fixed<1>(A, F.lds, F.tid, F.wave, F.lane);
    }
}

#define MFMA16(a, b, c) __builtin_amdgcn_mfma_f32_16x16x32_bf16((a), (b), (c), 0, 0, 0)
__device__ __forceinline__ void gla_intra_item(Frame& F, const Args& A, int item) {
    const int ch = item >> 2, h = item & 3, fr = F.lane & 15, fq = F.lane >> 4;
    const unsigned char* qpf = A.ws + WS_QP + (((size_t)0 * NCHUNK + ch) * 4 + h) * BLOB; const unsigned char* kpf = A.ws + WS_KP + (((size_t)0 * NCHUNK + ch) * 4 + h) * BLOB;
    const unsigned char* qpb = A.ws + WS_QP + (((size_t)1 * NCHUNK + ch) * 4 + h) * BLOB; const unsigned char* kpb = A.ws + WS_KP + (((size_t)1 * NCHUNK + ch) * 4 + h) * BLOB;
    bf16x8 Pf[4][2];
#pragma unroll
    for (int it = 0; it < 4; ++it) {
        f32x4 P[4];
#pragma unroll
        for (int jt = 0; jt < 4; ++jt) P[jt] = (f32x4){0.f, 0.f, 0.f, 0.f};
#pragma unroll
        for (int dirp = 0; dirp < 2; ++dirp) {
            const unsigned char* qp = dirp ? qpb : qpf; const unsigned char* kp = dirp ? kpb : kpf;
            bf16x8 kk[16], qq[4];
#pragma unroll
            for (int sd = 0; sd < 4; ++sd) qq[sd] = ldfrag(qp, it * 4 + sd, F.lane);
#pragma unroll
            for (int jt = 0; jt < 4; ++jt) if (dirp ? (jt >= it) : (jt <= it)) {
#pragma unroll
                for (int sd = 0; sd < 4; ++sd) kk[jt * 4 + sd] = ldfrag(kp, jt * 4 + sd, F.lane); }
#pragma unroll
            for (int jt = 0; jt < 4; ++jt) if (dirp ? (jt >= it) : (jt <= it)) {
                f32x4 a = (f32x4){0.f, 0.f, 0.f, 0.f};
#pragma unroll
                for (int sd = 0; sd < 4; ++sd) a = MFMA16(kk[jt * 4 + sd], qq[sd], a);
                if (jt == it) {
#pragma unroll
                    for (int r = 0; r < 4; ++r) { const int j = 4 * fq + r; const bool keep = dirp ? (j >= fr) : (j <= fr); a[r] = keep ? a[r] : 0.f; }
                }
                P[jt] += a;
            }
        }
        Pf[it][0] = pack8(P[0], P[1]); Pf[it][1] = pack8(P[2], P[3]);
    }
    const unsigned char* vt = A.ws + WS_VTP + (size_t)ch * 131072 + (size_t)(h * 16) * 2048;
    bf16_t* oi = (bf16_t*)(A.ws + WS_OI) + (size_t)(ch * 64 + fr) * DV + h * HV + 4 * fq;
#pragma unroll 1
    for (int ng = 0; ng < 4; ++ng) {
        bf16x8 va[8];
#pragma unroll
        for (int i = 0; i < 8; ++i) va[i] = ldfrag(vt, ng * 8 + i, F.lane);
#pragma unroll
        for (int n4 = 0; n4 < 4; ++n4)
#pragma unroll
            for (int it = 0; it < 4; ++it) {
                f32x4 acc = (f32x4){0.f, 0.f, 0.f, 0.f};
                acc = MFMA16(va[n4 * 2], Pf[it][0], acc); acc = MFMA16(va[n4 * 2 + 1], Pf[it][1], acc);
                u32x2 w; w.x = pk2(acc[0], acc[1]); w.y = pk2(acc[2], acc[3]);
                *(u32x2*)(oi + (size_t)(16 * it) * DV + 16 * (ng * 4 + n4)) = w;
            }
    }
}
struct ScanRegs { bf16x8 q[4], k[4], v[2][2]; f32x4 g[2]; };
__device__ __forceinline__ int scan_chunk(int b, int dir, int step) { return step >= 4 ? (256 * b + (dir ? 255 - (step - 4) : step - 4)) : (512 + 4 * b + (dir ? 3 - step : step)); }
__device__ __forceinline__ void scan_load(const Args& A, ScanRegs& R, int b, int h, int dir, int sp, int w, int step, int lane) {
    const int ch = scan_chunk(b, dir, step), fq = lane >> 4;
    const size_t bo = (((size_t)dir * NCHUNK + ch) * 4 + h) * BLOB;
    const unsigned char* qp = A.ws + WS_QP + bo; const unsigned char* ktp = A.ws + WS_KTP + bo;
    const unsigned char* vt = A.ws + WS_VTP + (size_t)ch * 131072 + (size_t)(h * 16 + 2 * sp) * 2048;
    const float* gp = (const float*)(A.ws + WS_GAM) + ((size_t)dir * NCHUNK + ch) * DK + h * HK + 32 * w + 4 * fq;
#pragma unroll
    for (int sd = 0; sd < 4; ++sd) R.q[sd] = ldfrag(qp, w * 4 + sd, lane);
#pragma unroll
    for (int m = 0; m < 2; ++m)
#pragma unroll
        for (int ks = 0; ks < 2; ++ks) R.k[m * 2 + ks] = ldfrag(ktp, (2 * w + m) * 2 + ks, lane);
#pragma unroll
    for (int s2 = 0; s2 < 2; ++s2) {
        const int o = 8 * ((lane & 15) >> 2) + 4 * s2 + (lane & 3);
        const unsigned char* vp = vt + (o >> 4) * 2048 + ((o & 15) + (lane & 48)) * 16;
        R.v[s2][0] = *(const bf16x8*)(vp); R.v[s2][1] = *(const bf16x8*)(vp + 1024); }
    R.g[0] = *(const f32x4*)(gp); R.g[1] = *(const f32x4*)(gp + 16);
}
#define LDS_ORDER() asm volatile("" ::: "memory")
__device__ __forceinline__ void scan_ds(const ScanRegs& R, f32x4 (&dS)[2][2]) {
#pragma unroll
    for (int s2 = 0; s2 < 2; ++s2)
#pragma unroll
        for (int m = 0; m < 2; ++m) { f32x4 d = (f32x4){0.f, 0.f, 0.f, 0.f}; d = MFMA16(R.k[m * 2], R.v[s2][0], d); d = MFMA16(R.k[m * 2 + 1], R.v[s2][1], d); dS[s2][m] = d; }
}
__device__ __forceinline__ void scan_step(const Args& A, const ScanRegs& R, const ScanRegs& Rn, f32x4 (&S)[2][2], f32x4 (&dS)[2][2], LAS unsigned char* xs, LAS unsigned* flags, bf16_t* O, int b, int h, int dir, int sp, int w, int step, int lane) {
    const int fr = lane & 15, fq = lane >> 4;
#pragma unroll
    for (int s2 = 0; s2 < 2; ++s2) {
        S[s2][0] = R.g[0] * (S[s2][0] + dS[s2][0]); S[s2][1] = R.g[1] * (S[s2][1] + dS[s2][1]);
        *(volatile LAS bf16x8*)(xs + ((step + 1) & 3) * 8192 + (s2 * 4 + w) * 1024 + lane * 16) = pack8(S[s2][0], S[s2][1]);
    }
    LDS_ORDER();
    if (lane == 0) *(volatile LAS unsigned*)(flags + w) = (unsigned)step + 2u;
    LDS_ORDER();
    scan_ds(Rn, dS);
    if (step >= 4) {
        { const unsigned need = (unsigned)step + 1u; unsigned spn = 0;
          for (;;) { const unsigned f = (lane < 4) ? *(volatile LAS unsigned*)(flags + lane) : need;
              if (__all((int)(f >= need))) break; if (++spn > (1u << 26)) break; }
          LDS_ORDER(); }
        const LAS unsigned char* slot = xs + (step & 3) * 8192 + lane * 16;
        bf16x8 sf[2][4];
#pragma unroll
        for (int s2 = 0; s2 < 2; ++s2)
#pragma unroll
            for (int sd = 0; sd < 4; ++sd) sf[s2][sd] = *(const LAS bf16x8*)(slot + (s2 * 4 + sd) * 1024);
        LDS_ORDER();
        const int ch = scan_chunk(b, dir, step);
        f32x4 acc0 = (f32x4){0.f, 0.f, 0.f, 0.f}, acc1 = acc0;
#pragma unroll
        for (int sd = 0; sd < 4; ++sd) { acc0 = MFMA16(sf[0][sd], R.q[sd], acc0); acc1 = MFMA16(sf[1][sd], R.q[sd], acc1); }
        u32x4 wv; wv.x = pk2(acc0[0], acc0[1]); wv.y = pk2(acc0[2], acc0[3]); wv.z = pk2(acc1[0], acc1[1]); wv.w = pk2(acc1[2], acc1[3]);
        *(u32x4*)(O + (size_t)(ch * 64 + 16 * w + fr) * DV + h * HV + 32 * sp + 8 * fq) = wv;
    }
}
__device__ __forceinline__ void gla_scan_item(Frame& F, const Args& A, int item, LAS unsigned char* xs, LAS unsigned* flags) {
    const int chain = item >> 3, sp = item & 7, b = chain >> 3, h = (chain >> 1) & 3, dir = chain & 1, w = F.wave;
    bf16_t* O = (bf16_t*)(A.ws + (dir ? WS_OB : WS_OF));
    f32x4 S[2][2], dS[2][2];
#pragma unroll
    for (int s2 = 0; s2 < 2; ++s2) { S[s2][0] = (f32x4){0.f, 0.f, 0.f, 0.f}; S[s2][1] = S[s2][0];
        *(volatile LAS bf16x8*)(xs + (s2 * 4 + w) * 1024 + F.lane * 16) = pack8(S[s2][0], S[s2][1]); }
    LDS_ORDER();
    if (F.lane == 0) *(volatile LAS unsigned*)(flags + w) = 1u;
    LDS_ORDER();
    ScanRegs Ra, Rb, Rc;
    scan_load(A, Ra, b, h, dir, sp, w, 0, F.lane);
    scan_load(A, Rb, b, h, dir, sp, w, 1, F.lane);
    scan_ds(Ra, dS);
    for (int step = 0; step < 261; step += 3) {
        scan_load(A, Rc, b, h, dir, sp, w, min(step + 2, 259), F.lane);
        scan_step(A, Ra, Rb, S, dS, xs, flags, O, b, h, dir, sp, w, step, F.lane);
        scan_load(A, Ra, b, h, dir, sp, w, min(step + 3, 259), F.lane);
        scan_step(A, Rb, Rc, S, dS, xs, flags, O, b, h, dir, sp, w, step + 1, F.lane);
        scan_load(A, Rb, b, h, dir, sp, w, min(step + 4, 259), F.lane);
        if (step + 2 < 260) scan_step(A, Rc, Ra, S, dS, xs, flags, O, b, h, dir, sp, w, step + 2, F.lane);
    }
}
__device__ __forceinline__ void ph_gla_main(Frame& F, const Args& A) {
    LAS unsigned char* xs = F.lds; LAS unsigned* flags = (LAS unsigned*)(F.lds + 32768);
    if (F.tid < 16) flags[F.tid] = 0u;
    __syncthreads();
    const int bi = blockIdx.x;
    unsigned* ctr = (unsigned*)(A.ws + WS_CTL) + 2048;
    volatile LAS int* slot = (volatile LAS int*)(F.lds + 40960);
    if (bi < 128) {
        if (F.wave < 4) gla_scan_item(F, A, ((2 * (bi & 7) + ((bi >> 3) & 1)) << 3) | ((bi >> 4) & 7), xs, flags);
        __syncthreads();
    } else {
        const int sw = (bi - 128) * NWAVES + F.wave, nsw = (F.G - 128) * NWAVES;
        for (int it = sw; it < 512 * 4; it += nsw) gla_intra_item(F, A, it);
        __syncthreads();
    }
    convert_expert_dyn(A, ctr, 2 * N_EXPERT_ITEMS, F.lds + 49152, slot, F.tid, F.wave, F.lane);
    __syncthreads();
}

__device__ __forceinline__ void ph_gla_finish(Frame& F, const Args& A) {
    const bf16_t* rp = (const bf16_t*)(A.ws + WS_R); const bf16_t* OFp = (const bf16_t*)(A.ws + WS_OF); const bf16_t* OBp = (const bf16_t*)(A.ws + WS_OB); const bf16_t* OIp = (const bf16_t*)(A.ws + WS_OI);
    bf16_t* Hh = (bf16_t*)(A.ws + WS_H);
    const f32x4 gn = *(const f32x4*)(A.in[P_GNORMG] + 4 * F.lane);
    for (int row = F.gw; row < NLAT; row += 2 * F.ngw) {
        u32x2 a[2][4], bq[2][4], ci[2][4], rr[2][4];
#pragma unroll
        for (int h2 = 0; h2 < 2; ++h2)
#pragma unroll
            for (int j = 0; j < 4; ++j) { const size_t o = (size_t)(row + h2 * F.ngw) * DV + 4 * F.lane + 256 * j;
                a[h2][j] = *(const u32x2*)(OFp + o); bq[h2][j] = *(const u32x2*)(OBp + o); ci[h2][j] = *(const u32x2*)(OIp + o); rr[h2][j] = *(const u32x2*)(rp + o); }
#pragma unroll
        for (int h2 = 0; h2 < 2; ++h2)
#pragma unroll
            for (int j = 0; j < 4; ++j) {
                const u32x2 av = a[h2][j], bv = bq[h2][j], cv = ci[h2][j], rv = rr[h2][j];
                f32x4 o; o.x = bflo(av.x) + bflo(bv.x) + bflo(cv.x); o.y = bfhi(av.x) + bfhi(bv.x) + bfhi(cv.x); o.z = bflo(av.y) + bflo(bv.y) + bflo(cv.y); o.w = bfhi(av.y) + bfhi(bv.y) + bfhi(cv.y);
                const float ss = wave_sum((o.x * o.x + o.y * o.y) + (o.z * o.z + o.w * o.w));
                const float rstd = rsqrtf(ss * (1.f / HV) + EPS);
                f32x4 r; r.x = bflo(rv.x); r.y = bfhi(rv.x); r.z = bflo(rv.y); r.w = bfhi(rv.y);
                f32x4 y;
#pragma unroll
                for (int i = 0; i < 4; ++i) y[i] = o[i] * rstd * gn[i] * silu_f(r[i]);
                u32x2 w; w.x = pk2(y.x, y.y); w.y = pk2(y.z, y.w);
                *(u32x2*)(Hh + (size_t)(row + h2 * F.ngw) * D + 4 * F.lane + 256 * j) = w;
            }
    }
}

__device__ __forceinline__ void stage_router(Frame& F, const Args& A, int l) {
    LAS float* wl = (LAS float*)F.lds;
    const float* rw = A.in[P_ROUTER] + (size_t)l * D * NE;
    for (int idx = F.tid; idx < D * NE; idx += NTHR) { const int k = idx >> 4, e = idx & 15, j = k >> 8, ln = (k & 255) >> 2, i = k & 3; wl[((((j * 4 + i) * 4 + (e >> 2)) * 64) + ln) * 4 + (e & 3)] = rw[idx]; }
    __syncthreads();
}
template <int N, int M>
__device__ __forceinline__ void rs_step(const float (&v)[N], float (&w)[N / 2], int lane) {
    const bool hi = (lane & M) != 0;
#pragma unroll
    for (int e = 0; e < N / 2; ++e) { const float mine = hi ? v[N / 2 + e] : v[e], other = hi ? v[e] : v[N / 2 + e]; w[e] = mine + __shfl_xor(other, M); }
}
__device__ __forceinline__ void ph_norm2_router(Frame& F, const Args& A, int l) {
    const float* mod = (const float*)(A.ws + WS_MOD); unsigned char* H8 = A.ws + WS_H; const bf16_t* X = (const bf16_t*)(A.ws + WS_X); float* aff = (float*)(A.ws + WS_AFF);
    const float* g = A.in[P_NORMG] + (l * 2 + 1) * D; const float* rw = A.in[P_ROUTER] + (size_t)l * D * NE;
    LAS unsigned char* WF = F.lds;
    LAS float* GS = (LAS float*)(F.lds + 65536); LAS float* SH = GS + D; LAS float* CB = SH + D; LAS float* RED = CB + 16;
    const int fr = F.lane & 15, fq = F.lane >> 4;
    const int b = (int)((blockIdx.x * NWAVES * 16) >> 14);
    const float* sh = mod + (l * 3 + b) * 6 * D + 3 * D; const float* sc = mod + (l * 3 + b) * 6 * D + 4 * D;
    for (int k = F.tid; k < D; k += NTHR) { GS[k] = g[k] * (1.f + sc[k]); SH[k] = sh[k]; }
    __syncthreads();
    for (int p = F.tid; p < 32 * 64; p += NTHR) {
        const int s = p >> 6, ln = p & 63, e = ln & 15, k0 = 32 * s + 8 * (ln >> 4);
        float w[8];
#pragma unroll
        for (int i = 0; i < 8; ++i) w[i] = rw[(k0 + i) * NE + e] * GS[k0 + i];
        u32x4 hi, lo;
        hi.x = pk2(w[0], w[1]); hi.y = pk2(w[2], w[3]); hi.z = pk2(w[4], w[5]); hi.w = pk2(w[6], w[7]);
        lo.x = pk2(w[0] - bflo(hi.x), w[1] - bfhi(hi.x)); lo.y = pk2(w[2] - bflo(hi.y), w[3] - bfhi(hi.y)); lo.z = pk2(w[4] - bflo(hi.z), w[5] - bfhi(hi.z)); lo.w = pk2(w[6] - bflo(hi.w), w[7] - bfhi(hi.w));
        *(LAS u32x4*)(WF + ((s * 2 + 0) * 64 + ln) * 16) = hi; *(LAS u32x4*)(WF + ((s * 2 + 1) * 64 + ln) * 16) = lo;
    }
    { const int e = F.tid & 15, part = F.tid >> 4; float acc = 0.f;
#pragma unroll 8
      for (int i = 0; i < 32; ++i) { const int k = part * 32 + i; acc += SH[k] * rw[k * NE + e]; }
      RED[part * 16 + e] = acc; }
    __syncthreads();
    if (F.tid < 16) { float acc = 0.f;
#pragma unroll
        for (int q = 0; q < 32; ++q) acc += RED[q * 16 + F.tid];
        CB[F.tid] = acc; }
    __syncthreads();
    for (int grp = F.gw; grp < NLAT / 16; grp += F.ngw) {
        const int row0 = grp * 16, row = row0 + fr;
        const bf16_t* xr = X + (size_t)row * D + 8 * fq;
        u32x4 xv[32];
#pragma unroll
        for (int s = 0; s < 32; ++s) xv[s] = *(const u32x4*)(xr + 32 * s);
        f32x2 ss2 = (f32x2){0.f, 0.f};
        f32x4 acc = (f32x4){0.f, 0.f, 0.f, 0.f};
#pragma unroll
        for (int s = 0; s < 32; ++s) {
            const u32x4 t = xv[s];
            const f32x2 a0 = {bflo(t.x), bfhi(t.x)}, a1 = {bflo(t.y), bfhi(t.y)}, a2 = {bflo(t.z), bfhi(t.z)}, a3 = {bflo(t.w), bfhi(t.w)};
            ss2 = __builtin_elementwise_fma(a0, a0, ss2); ss2 = __builtin_elementwise_fma(a1, a1, ss2); ss2 = __builtin_elementwise_fma(a2, a2, ss2); ss2 = __builtin_elementwise_fma(a3, a3, ss2);
            const bf16x8 xb = __builtin_bit_cast(bf16x8, t);
            acc = MFMA16(*(const LAS bf16x8*)(WF + ((s * 2 + 0) * 64 + F.lane) * 16), xb, acc);
            acc = MFMA16(*(const LAS bf16x8*)(WF + ((s * 2 + 1) * 64 + F.lane) * 16), xb, acc);
            if ((s & 1) == 1) asm volatile("" ::: "memory");
        }
#pragma unroll
        for (int s = 0; s < 32; ++s) asm volatile("" : "+v"(xv[s]));
        float ss = ss2.x + ss2.y; ss += __shfl_xor(ss, 16); ss += __shfl_xor(ss, 32);
        const float rstd = rsqrtf(ss * (1.f / D) + EPS);
        float lg[4]; float mx = -3.0e38f;
#pragma unroll
        for (int r = 0; r < 4; ++r) { lg[r] = rstd * acc[r] + CB[4 * fq + r]; mx = fmaxf(mx, lg[r]); }
        mx = fmaxf(mx, __shfl_xor(mx, 16)); mx = fmaxf(mx, __shfl_xor(mx, 32));
        float ex[4], den = 0.f;
#pragma unroll
        for (int r = 0; r < 4; ++r) { ex[r] = __expf(lg[r] - mx); den += ex[r]; }
        den += __shfl_xor(den, 16); den += __shfl_xor(den, 32);
        const float inv = 1.f / den; const int t = row & (T - 1);
#pragma unroll
        for (int r = 0; r < 4; ++r) aff[((size_t)b * NE + 4 * fq + r) * T + t] = ex[r] * inv;
        unsigned char* hr = H8 + (size_t)row * D + 8 * fq;
#pragma unroll
        for (int s = 0; s < 32; ++s) {
            const u32x4 t4 = xv[s]; const int k0 = 32 * s + 8 * fq;
            const f32x4 g0 = *(const LAS f32x4*)(GS + k0), g1 = *(const LAS f32x4*)(GS + k0 + 4), h0 = *(const LAS f32x4*)(SH + k0), h1 = *(const LAS f32x4*)(SH + k0 + 4);
            f32x4 y0 = (f32x4){bflo(t4.x), bfhi(t4.x), bflo(t4.y), bfhi(t4.y)} * rstd * g0 + h0, y1 = (f32x4){bflo(t4.z), bfhi(t4.z), bflo(t4.w), bfhi(t4.w)} * rstd * g1 + h1;
            const f32x4 lim = (f32x4){448.f, 448.f, 448.f, 448.f};
            y0 = __builtin_elementwise_min(__builtin_elementwise_max(y0, -lim), lim); y1 = __builtin_elementwise_min(__builtin_elementwise_max(y1, -lim), lim);
            int w0 = __builtin_amdgcn_cvt_pk_fp8_f32(y0.x, y0.y, 0, false); w0 = __builtin_amdgcn_cvt_pk_fp8_f32(y0.z, y0.w, w0, true);
            int w1 = __builtin_amdgcn_cvt_pk_fp8_f32(y1.x, y1.y, 0, false); w1 = __builtin_amdgcn_cvt_pk_fp8_f32(y1.z, y1.w, w1, true);
            u32x2 wv; wv.x = (unsigned)w0; wv.y = (unsigned)w1;
            *(u32x2*)(hr + 32 * s) = wv;
            if ((s & 1) == 1) asm volatile("" ::: "memory");
        }
    }
    __syncthreads();
}

__device__ __forceinline__ void ph_topk(Frame& F, const Args& A) {
    LAS int* red = (LAS int*)F.lds;
    const float* aff = (const float*)(A.ws + WS_AFF); int* slot = (int*)(A.ws + WS_SLOT); int* rowlist = (int*)(A.ws + WS_ROWLIST); float* selval = (float*)(A.ws + WS_SELVAL);
    for (int item = blockIdx.x; item < NB * NE; item += F.G) {
        const int b = item / NE, e = item % NE;
        const float* a = aff + ((size_t)b * NE + e) * T + F.tid * 32;
        unsigned v[32];
#pragma unroll
        for (int q = 0; q < 8; ++q) { const u32x4 x = *(const u32x4*)(a + 4 * q); v[4 * q] = x.x; v[4 * q + 1] = x.y; v[4 * q + 2] = x.z; v[4 * q + 3] = x.w; }
        unsigned prefix = 0u; int par = 0;
        for (int bit = 30; bit >= 0; --bit) {
            const unsigned cand = prefix | (1u << bit); int cnt = 0;
#pragma unroll
            for (int i = 0; i < 32; ++i) cnt += (v[i] >= cand) ? 1 : 0;
            cnt = wave_sum_i(cnt);
            if (F.lane == 0) red[par * 16 + F.wave] = cnt;
            __syncthreads();
            int tot = 0;
#pragma unroll
            for (int w8 = 0; w8 < 8; ++w8) tot += red[par * 16 + w8];
            if (tot >= CAP) prefix = cand;
            par ^= 1;
        }
        __syncthreads();
        int mgt = 0, meq = 0;
#pragma unroll
        for (int i = 0; i < 32; ++i) { mgt += (v[i] > prefix) ? 1 : 0; meq += (v[i] == prefix) ? 1 : 0; }
        int igt = mgt, ieq = meq;
#pragma unroll
        for (int o = 1; o < 64; o <<= 1) { const int ug = __shfl_up(igt, o), ue = __shfl_up(ieq, o); if (F.lane >= o) { igt += ug; ieq += ue; } }
        if (F.lane == 63) { red[F.wave] = igt; red[16 + F.wave] = ieq; }
        __syncthreads();
        int bgt = 0, beq = 0, totgt = 0;
#pragma unroll
        for (int w8 = 0; w8 < 8; ++w8) { const int xg = red[w8], xe = red[16 + w8]; if (w8 < F.wave) { bgt += xg; beq += xe; } totgt += xg; }
        const int need_eq = CAP - totgt;
        int gtb = bgt + igt - mgt, eqb = beq + ieq - meq;
        const int t0 = F.tid * 32;
#pragma unroll
        for (int q = 0; q < 2; ++q) {
            int sl[16];
#pragma unroll
            for (int i = 0; i < 16; ++i) {
                const unsigned x = v[q * 16 + i]; const bool gt = x > prefix, eq = x == prefix; const bool sel = gt || (eq && eqb < need_eq);
                const int pos = gtb + (eqb < need_eq ? eqb : need_eq);
                sl[i] = sel ? pos : -1;
                if (sel) { rowlist[e * 4096 + b * CAP + pos] = b * T + t0 + q * 16 + i; selval[e * 4096 + b * CAP + pos] = __builtin_bit_cast(float, x); }
                gtb += gt ? 1 : 0; eqb += eq ? 1 : 0;
            }
#pragma unroll
            for (int i4 = 0; i4 < 4; ++i4) *(i32x4*)(slot + ((size_t)b * NE + e) * T + t0 + q * 16 + 4 * i4) = (i32x4){sl[4 * i4], sl[4 * i4 + 1], sl[4 * i4 + 2], sl[4 * i4 + 3]};
        }
        __syncthreads();
    }
}

__device__ __forceinline__ void ph_combine(Frame& F, const Args& A, int l) {
    const float* mod = (const float*)(A.ws + WS_MOD); bf16_t* X = (bf16_t*)(A.ws + WS_X); bf16_t* H = (bf16_t*)(A.ws + WS_H);
    const int* slot = (const int*)(A.ws + WS_SLOT); const unsigned char* ye = A.ws + WS_YE; const float* selval = (const float*)(A.ws + WS_SELVAL);
    for (int grp = F.gw; grp < NLAT / 16; grp += F.ngw) {
        const int row0 = grp * 16, b = row0 >> 14, t0 = row0 & (T - 1);
        const i32x4 sv4 = *(const i32x4*)(slot + ((size_t)b * NE + (F.lane & 15)) * T + t0 + 4 * (F.lane >> 4));
        f32x4 g2v[4], pa[4], pb[4], pc[4];
#pragma unroll
        for (int j = 0; j < 4; ++j) { const int c = 4 * F.lane + 256 * j;
            g2v[j] = *(const f32x4*)(mod + (l * 3 + b) * 6 * D + 5 * D + c);
            if (l == 0) { pa[j] = *(const f32x4*)(A.in[P_NORMG] + (1 * 2 + 0) * D + c); pb[j] = *(const f32x4*)(mod + (1 * 3 + b) * 6 * D + 0 * D + c); pc[j] = *(const f32x4*)(mod + (1 * 3 + b) * 6 * D + 1 * D + c) + 1.f; }
            else { pa[j] = *(const f32x4*)(A.in[P_FINALG] + c); pb[j] = pa[j]; pc[j] = pa[j]; } }
#pragma unroll 1
        for (int rq = 0; rq < 4; ++rq) {
#pragma unroll
          for (int rh = 0; rh < 2; ++rh) {
            unsigned mask[2]; int yrow[2][4]; float wv[2][4]; u32x2 xr[2][4]; int yv[2][4][4];
#pragma unroll
            for (int p2 = 0; p2 < 2; ++p2) {
                const int ri = 2 * rh + p2, row = row0 + 4 * rq + ri, svr = sv4[ri];
                unsigned m = (unsigned)(__ballot(svr >= 0) >> (16 * rq)) & 0xFFFFu;
                const int e0 = m ? __builtin_ctz(m) : 0;
#pragma unroll
                for (int q = 0; q < 4; ++q) { const bool valid = m != 0u; const int e = valid ? __builtin_ctz(m) : e0; m &= m - 1u;
                    const int sq = __builtin_amdgcn_readlane(svr, 16 * rq + e); yrow[p2][q] = e * 4096 + b * CAP + (sq < 0 ? 0 : sq); wv[p2][q] = valid ? selval[yrow[p2][q]] * (1.f / 32) : 0.f; }
                mask[p2] = m;
#pragma unroll
                for (int j = 0; j < 4; ++j) xr[p2][j] = *(const u32x2*)(X + (size_t)row * D + 4 * F.lane + 256 * j);
#pragma unroll
                for (int q = 0; q < 4; ++q)
#pragma unroll
                    for (int j = 0; j < 4; ++j) yv[p2][q][j] = *(const int*)(ye + (size_t)yrow[p2][q] * D + 4 * F.lane + 256 * j);
            }
#pragma unroll
            for (int p2 = 0; p2 < 2; ++p2) {
                const int ri = 2 * rh + p2, row = row0 + 4 * rq + ri, svr = sv4[ri];
                f32x4 acc[4];
#pragma unroll
                for (int j = 0; j < 4; ++j) acc[j] = (f32x4){0.f, 0.f, 0.f, 0.f};
#pragma unroll
                for (int q = 0; q < 4; ++q)
#pragma unroll
                    for (int j = 0; j < 4; ++j) { const f32x2 lo = __builtin_amdgcn_cvt_pk_f32_fp8(yv[p2][q][j], false), hi = __builtin_amdgcn_cvt_pk_f32_fp8(yv[p2][q][j], true);
                        acc[j].x += wv[p2][q] * lo.x; acc[j].y += wv[p2][q] * lo.y; acc[j].z += wv[p2][q] * hi.x; acc[j].w += wv[p2][q] * hi.y; }
                unsigned m = mask[p2];
                while (m) {
                    const int e = __builtin_ctz(m); m &= m - 1u;
                    const int sq = __builtin_amdgcn_readlane(svr, 16 * rq + e), yr_ = e * 4096 + b * CAP + sq; const float w1 = selval[yr_] * (1.f / 32);
#pragma unroll
                    for (int j = 0; j < 4; ++j) { const int y = *(const int*)(ye + (size_t)yr_ * D + 4 * F.lane + 256 * j); const f32x2 lo = __builtin_amdgcn_cvt_pk_f32_fp8(y, false), hi = __builtin_amdgcn_cvt_pk_f32_fp8(y, true);
                        acc[j].x += w1 * lo.x; acc[j].y += w1 * lo.y; acc[j].z += w1 * hi.x; acc[j].w += w1 * hi.y; }
                }
                f32x4 v[4]; float ssq = 0.f;
#pragma unroll
                for (int j = 0; j < 4; ++j) { const u32x2 t = xr[p2][j]; v[j] = (f32x4){bflo(t.x), bfhi(t.x), bflo(t.y), bfhi(t.y)} + g2v[j] * acc[j];
                    ssq += (v[j].x * v[j].x + v[j].y * v[j].y) + (v[j].z * v[j].z + v[j].w * v[j].w); }
                const float rstd = rsqrtf(wave_sum(ssq) * (1.f / D) + EPS);
                if (l == 0) {
#pragma unroll
                    for (int j = 0; j < 4; ++j) { const int c = 4 * F.lane + 256 * j;
                        u32x2 w; w.x = pk2(v[j].x, v[j].y); w.y = pk2(v[j].z, v[j].w); *(u32x2*)(X + (size_t)row * D + c) = w;
                        const f32x4 y = v[j] * rstd * pa[j] * pc[j] + pb[j];
                        u32x2 hw; hw.x = pk2(y.x, y.y); hw.y = pk2(y.z, y.w); *(u32x2*)(H + (size_t)row * D + c) = hw; }
                } else {
#pragma unroll
                    for (int j = 0; j < 4; ++j) { const int c = 4 * F.lane + 256 * j; *(f32x4*)(A.out + (size_t)row * D + c) = v[j] * rstd * pa[j]; }
                }
            }
          }
        }
    }
}

constexpr int N_PHASES = 20;
__global__ void __launch_bounds__(NTHR, 2) fwd_kernel(Args A) {
    extern __shared__ __attribute__((aligned(16))) unsigned char lds_raw[];
    Frame F;
    F.lds = (LAS unsigned char*)lds_raw;
    F.tid = threadIdx.x; F.lane = F.tid & 63; F.wave = __builtin_amdgcn_readfirstlane(F.tid >> 6);
    F.G = gridDim.x; F.gw = blockIdx.x * NWAVES + F.wave; F.ngw = F.G * NWAVES;
    const int lo = A.ph_lo, hi = A.ph_hi;
#ifdef ONLY_PH
#define IN(k) ((k) == ONLY_PH && lo <= (k) && (k) < hi)
#else
#define IN(k) (lo <= (k) && (k) < hi)
#endif
#if MK_MULTI
#define SEAM(k) do { } while (0)
#else
    cg::grid_group grid = cg::this_grid();
    volatile LAS unsigned* bst = (volatile LAS unsigned*)(F.lds + LDS_BYTES - 64);
    if (F.tid < 16) bst[F.tid] = 0u;
    __syncthreads();
    XcdBarrier xbar = xcd_barrier_post((unsigned*)(A.ws + WS_CTL) + 4096, bst);
    if (lo < 0) { __threadfence(); grid.sync(); }
#define SEAM(k) do { if (IN(k) && IN((k) + 1)) xcd_barrier(xbar); } while (0)
#endif
    const int c = blockIdx.x;
    #define H ((bf16_t*)(A.ws + WS_H))
#define X ((bf16_t*)(A.ws + WS_X))
#define mod ((const float*)(A.ws + WS_MOD))
#define MOE_GU(l) { eng::Gemm g{(const char*)(A.ws + WS_H), (const char*)(A.ws + WS_W8 + (size_t)(l) * W8_LAYER), (const int*)(A.ws + WS_ROWLIST), (size_t)4096 * D, D / 2, 16, 16, NE}; \
        eng::EpiSwiglu E{0x79797979, 0x7F7F7F7F, A.ws + WS_HID}; eng::gemm_phase(F.lds, g, E, F.G, c); }
#define MOE_DN(l) { eng::Gemm g{(const char*)(A.ws + WS_HID), (const char*)(A.ws + WS_W8 + (size_t)(l) * W8_LAYER + W8_WD), nullptr, (size_t)D * DEXP, DEXP / 2, 16, 4, NE}; g.rev = 1; \
        eng::EpiDown E{0x79797979, 0x7D7D7D7D, A.ws + WS_YE}; eng::gemm_phase(F.lds, g, E, F.G, c); }

    if (IN(0)) ph_prep(F, A);
    SEAM(0);
    if (IN(1)) ph_norm0(F, A);
    SEAM(1);
    if (IN(2)) { eng::Gemm g{(const char*)H, (const char*)(A.ws + WS_WIN0T), nullptr, 0, D, NROW / 256, NIN0P / 256, 1};
        eng::EpiProj0 E{(bf16_t*)(A.ws + WS_QK), A.ws + WS_VTP, (bf16_t*)(A.ws + WS_R), (float*)(A.ws + WS_AFB)}; eng::gemm_phase(F.lds, g, E, F.G, c);
        if (6 * F.G + c >= (NROW / 256) * (NIN0P / 256)) convert_expert_fixed<3>(A, F.lds, F.tid, F.wave, F.lane); }
    SEAM(2);
    if (IN(3)) ph_gla_prep(F, A);
    SEAM(3);
    if (IN(4)) ph_gla_main(F, A);
    SEAM(4);
    if (IN(5)) ph_gla_finish(F, A);
    SEAM(5);
    if (IN(6)) { eng::Gemm g{(const char*)H, (const char*)(A.ws + WS_WOUT0T), nullptr, 0, D, NLAT / 256, D / 256, 1};
        eng::EpiResidT<true> E{A.in[P_X], X, mod + (0 * 3) * 6 * D + 2 * D}; eng::gemm_phase(F.lds, g, E, F.G, c); }
    SEAM(6);
    if (IN(7)) ph_norm2_router(F, A, 0);
    SEAM(7);
    if (IN(8)) ph_topk(F, A);
    SEAM(8);
    if (IN(9)) MOE_GU(0)
    SEAM(9);
    if (IN(10)) MOE_DN(0)
    SEAM(10);
    if (IN(11)) ph_combine(F, A, 0);
    SEAM(11);
    if (IN(12)) { eng::Gemm g{(const char*)H, (const char*)(A.ws + WS_WCINT), nullptr, 0, D, NLAT / 256, NCIN / 256, 1};
        g.trip = 1;
        eng::EpiConvFused E{A.ws + WS_CDUMP + (size_t)c * 131072, (bf16_t*)(A.ws + WS_H2), A.in[P_CK]}; eng::gemm_phase(F.lds, g, E, F.G, c); }
    SEAM(12);
    if (IN(14)) { eng::Gemm g{(const char*)(A.ws + WS_H2), (const char*)(A.ws + WS_WCOUTT), nullptr, 0, D, NLAT / 256, D / 256, 1};
        eng::EpiResidT<false> E{X, X, mod + (1 * 3) * 6 * D + 2 * D}; eng::gemm_phase(F.lds, g, E, F.G, c); }
    SEAM(14);
    if (IN(15)) ph_norm2_router(F, A, 1);
    SEAM(15);
    if (IN(16)) ph_topk(F, A);
    SEAM(16);
    if (IN(17)) MOE_GU(1)
    SEAM(17);
    if (IN(18)) MOE_DN(1)
    SEAM(18);
    if (IN(19)) ph_combine(F, A, 1);
#undef IN
#undef SEAM
#undef H
#undef X
#undef mod
#undef MOE_GU
#undef MOE_DN
}

extern "C" void kernel_launch(void* const* d_in, const int* in_sizes, int n_in, void* d_out, int out_size, void* d_ws, size_t ws_size, hipStream_t stream) {
    static int grid = 0;
    if (grid == 0) {
        if (n_in != 20 || in_sizes[0] != NLAT * D || out_size != NLAT * D || ws_size < WS_END) {
            fprintf(stderr, "kernel_launch: unexpected problem: n_in %d in0 %d out %d ws %zu (need %zu)\n", n_in, n_in > 0 ? in_sizes[0] : -1, out_size, ws_size, (size_t)WS_END); grid = -1; return; }
        int dev = 0, cus = 0, per_cu = 0;
        if (hipGetDevice(&dev) != hipSuccess || hipDeviceGetAttribute(&cus, hipDeviceAttributeMultiprocessorCount, dev) != hipSuccess) { grid = -1; return; }
        if (hipFuncSetAttribute((const void*)fwd_kernel, hipFuncAttributeMaxDynamicSharedMemorySize, LDS_BYTES) != hipSuccess) { fprintf(stderr, "kernel_launch: hipFuncSetAttribute failed\n"); grid = -1; return; }
        if (hipOccupancyMaxActiveBlocksPerMultiprocessor(&per_cu, (const void*)fwd_kernel, NTHR, LDS_BYTES) != hipSuccess || per_cu < 1) { fprintf(stderr, "kernel_launch: occupancy query says %d\n", per_cu); per_cu = 1; }
        (void)hipGetLastError();
        if (cus != 256) { fprintf(stderr, "kernel_launch: built for a 256-CU device (one workgroup per CU); found %d CUs\n", cus); grid = -1; return; }
        grid = cus;
    }
    if (grid < 0) return;
    Args a{};
    for (int i = 0; i < 20; ++i) a.in[i] = (const float*)d_in[i];
    a.out = (float*)d_out; a.ws = (unsigned char*)d_ws;
#if MK_MULTI
    for (int p = 0; p < N_PHASES; ++p) {
        a.ph_lo = p; a.ph_hi = p + 1;
        hipLaunchKernelGGL(fwd_kernel, dim3(grid), dim3(NTHR), LDS_BYTES, stream, a);
    }
#else
    if (hipMemsetAsync((char*)d_ws + WS_CTL, 0, 64 * 1024, stream) != hipSuccess) { fprintf(stderr, "kernel_launch: memset failed\n"); return; }
    a.ph_lo = 0; a.ph_hi = N_PHASES;
    void* kargs[] = {&a};
    hipError_t e = hipLaunchCooperativeKernel((const void*)fwd_kernel, dim3(grid), dim3(NTHR), kargs, LDS_BYTES, stream);
    if (e != hipSuccess) fprintf(stderr, "kernel_launch: cooperative launch failed: %s (grid %d)\n", hipGetErrorString(e), grid);
#endif
}
```

```cpp
#include <hip/hip_runtime.h>
#include <hip/hip_cooperative_groups.h>
#include <cstdio>
#include <cstdint>
namespace cg = cooperative_groups;

#ifndef MK_MULTI
#define MK_MULTI 0
#endif

#define LAS __attribute__((address_space(3)))
#define GAS __attribute__((address_space(1)))
typedef unsigned short bf16_t;
typedef short bf16x8 __attribute__((ext_vector_type(8)));
typedef float f32x4 __attribute__((ext_vector_type(4)));
typedef float f32x2 __attribute__((ext_vector_type(2)));
typedef unsigned u32x4 __attribute__((ext_vector_type(4)));
typedef unsigned u32x2 __attribute__((ext_vector_type(2)));
typedef int i32x4 __attribute__((ext_vector_type(4)));
typedef int i32x8 __attribute__((ext_vector_type(8)));

constexpr int D = 1024, NB = 2, T = 16384, NLAT = NB * T, CTXL = 256, NCTX = NB * CTXL, NROW = NLAT + NCTX;
constexpr int NE = 16, CAP = 2048, DEXP = 2048;
constexpr int HEADS = 4, HK = 128, HV = 256, DK = 512, DV = 1024, RANK = 16;
constexpr int NIN0 = 3104, NIN0P = 3328;
constexpr int NCIN = 3072;
constexpr float EPS = 1e-6f;
constexpr int NWAVES = 8, NTHR = 512;

constexpr size_t MiB = 1u << 20;
constexpr size_t WS_CTL = 0;
constexpr size_t WS_MOD = 1 * MiB;
constexpr size_t WS_WIN0T = 2 * MiB;
constexpr size_t WS_WOUT0T = 9 * MiB;
constexpr size_t WS_WCINT = 11 * MiB;
constexpr size_t WS_WCOUTT = 17 * MiB;
constexpr size_t WS_AFF = 19 * MiB;
constexpr size_t WS_SLOT = 21 * MiB;
constexpr size_t WS_ROWLIST = 23 * MiB;
constexpr size_t WS_SELVAL = 23 * MiB + 512 * 1024;
constexpr size_t WS_AFB = 24 * MiB;
constexpr size_t WS_W8 = 32 * MiB;
constexpr size_t W8_LAYER = 96 * MiB, W8_WD = 64 * MiB;
constexpr size_t WS_X = 224 * MiB;
constexpr size_t WS_H = 354 * MiB;
constexpr size_t WS_ARENA = 420 * MiB;
constexpr size_t WS_QK = WS_ARENA;
constexpr size_t WS_V = WS_ARENA + 65 * MiB;
constexpr size_t WS_R = WS_ARENA + 130 * MiB;
constexpr size_t WS_QP = WS_ARENA + 195 * MiB;
constexpr size_t WS_KP = WS_ARENA + 260 * MiB;
constexpr size_t WS_KTP = WS_ARENA + 325 * MiB;
constexpr size_t WS_VTP = WS_ARENA + 390 * MiB;
constexpr size_t WS_OI = WS_ARENA + 455 * MiB;
constexpr size_t WS_GAM = WS_ARENA + 519 * MiB;
constexpr size_t WS_OF = WS_QK;
constexpr size_t WS_OB = WS_V;
constexpr size_t WS_HID = WS_ARENA;
constexpr size_t WS_YE = WS_ARENA + 128 * MiB;
constexpr size_t WS_H2 = WS_ARENA;
constexpr size_t WS_CDUMP = WS_ARENA + 64 * MiB;
constexpr size_t WS_END = WS_ARENA + 522 * MiB;
static_assert(WS_R - WS_QK == 130 * MiB, "EpiProj0 strides");
constexpr size_t BLOB = 16384;
constexpr int NCHUNK = NROW / 64;

__device__ __forceinline__ float wave_sum(float v) {
#pragma unroll
    for (int o = 1; o < 64; o <<= 1) v += __shfl_xor(v, o);
    return v;
}
__device__ __forceinline__ int wave_sum_i(int v) {
#pragma unroll
    for (int o = 1; o < 64; o <<= 1) v += __shfl_xor(v, o);
    return v;
}
__device__ __forceinline__ unsigned f2bf(float f) { unsigned u = __builtin_bit_cast(unsigned, f); return (u + 0x7fffu + ((u >> 16) & 1u)) >> 16; }
typedef __bf16 bf16x2_t __attribute__((ext_vector_type(2)));
__device__ __forceinline__ unsigned pk2(float lo, float hi) { const f32x2 v = {lo, hi}; return __builtin_bit_cast(unsigned, __builtin_convertvector(v, bf16x2_t)); }
__device__ __forceinline__ float bflo(unsigned u) { return __builtin_bit_cast(float, u << 16); }
__device__ __forceinline__ float bfhi(unsigned u) { return __builtin_bit_cast(float, u & 0xffff0000u); }
__device__ __forceinline__ float silu_f(float x) { return x / (1.f + __expf(-x)); }
#define LDS_WAIT() asm volatile("s_waitcnt lgkmcnt(0)" ::: "memory")


#define XB_TMO      128
#define XB_XCNT(j)  (256  + 64 * (j))
#define XB_XSUB(j)  (1280 + 64 * (j))
#define XB_XGEN(j)  (2304 + 64 * (j))
#define XB_TOP      3328
#define XB_TOPGEN   3392
#define XCD_BAR_WORDS 3456
#define XB_SPIN_CAP (1u << 22)
__device__ __forceinline__ unsigned xb_ld(unsigned* p)              { return __hip_atomic_load(p, __ATOMIC_RELAXED, __HIP_MEMORY_SCOPE_AGENT); }
__device__ __forceinline__ unsigned xb_add(unsigned* p, unsigned v) { return __hip_atomic_fetch_add(p, v, __ATOMIC_RELAXED, __HIP_MEMORY_SCOPE_AGENT); }
__device__ __forceinline__ unsigned xb_xcc_id() { return (unsigned)__builtin_amdgcn_s_getreg((3 << 11) | 20) & 0xFu; }
#define XB_SPIN(cond, bar) do { unsigned _sp = 0; while (cond) { \
    if ((++_sp & 255u) == 0u) { if (xb_ld(&(bar)[XB_TMO])) break; if (_sp > XB_SPIN_CAP) { atomicAdd(&(bar)[XB_TMO], 1u); break; } } } } while (0)
struct XcdBarrier { unsigned* bar; unsigned x; volatile LAS unsigned* st; };
__device__ __forceinline__ XcdBarrier xcd_barrier_post(unsigned* bar, volatile LAS unsigned* st) {
    XcdBarrier b; b.bar = bar; b.x = xb_xcc_id(); b.st = st;
    if (threadIdx.x == 0) (void)xb_add(&bar[XB_XCNT(b.x)], 1u);
    return b;
}
__device__ __forceinline__ void xcd_barrier_complete(unsigned* bar, unsigned x, unsigned& nloc, unsigned& nx) {
    const unsigned G = gridDim.x * gridDim.y * gridDim.z;
    unsigned sum, cnt, mine, sp = 0u;
    for (;;) {
        sum = 0u; cnt = 0u; mine = 0u;
#pragma unroll
        for (unsigned j = 0; j < 16; ++j) { const unsigned c = xb_ld(&bar[XB_XCNT(j)]); sum += c; cnt += (c > 0u) ? 1u : 0u; mine = (j == x) ? c : mine; }
        if (sum == G) break;
        __builtin_amdgcn_s_sleep(1);
        if ((++sp & 255u) == 0u) { if (xb_ld(&bar[XB_TMO])) break; if (sp > XB_SPIN_CAP) { atomicAdd(&bar[XB_TMO], 1u); break; } }
    }
    nloc = mine > 0u ? mine : 1u; nx = cnt > 0u ? cnt : 1u;
}
__device__ __forceinline__ void xcd_barrier(const XcdBarrier& b) {
    asm volatile("s_waitcnt vmcnt(0)" ::: "memory");
    __syncthreads();
    if (threadIdx.x == 0) {
        unsigned* bar = b.bar;
        __builtin_amdgcn_s_waitcnt(0);
        unsigned nloc = b.st[0], nx = b.st[1];
        if (nloc == 0u) { xcd_barrier_complete(bar, b.x, nloc, nx); b.st[0] = nloc; b.st[1] = nx; }
        const unsigned old = xb_add(&bar[XB_XSUB(b.x)], 1u);
        const unsigned gen = old / nloc;
        if (old + 1u == (gen + 1u) * nloc) {
            __builtin_amdgcn_fence(__ATOMIC_RELEASE, "agent");
            asm volatile("s_waitcnt vmcnt(0)" ::: "memory");
            const unsigned og = xb_add(&bar[XB_TOP], 1u);
            const unsigned tg = og / nx;
            __builtin_amdgcn_fence(__ATOMIC_ACQUIRE, "agent");
            if (og + 1u == (tg + 1u) * nx) xb_add(&bar[XB_TOPGEN], 1u);
            else XB_SPIN(xb_ld(&bar[XB_TOPGEN]) == tg, bar);
            xb_add(&bar[XB_XGEN(b.x)], 1u);
            asm volatile("s_waitcnt vmcnt(0)" ::: "memory");
        } else {
            __builtin_amdgcn_fence(__ATOMIC_ACQUIRE, "agent");
            XB_SPIN(xb_ld(&bar[XB_XGEN(b.x)]) == gen, bar);
            asm volatile("s_waitcnt vmcnt(0)" ::: "memory");
        }
    }
    __syncthreads();
}

namespace eng {
constexpr int BM = 256, BK = 64, HALF = 128, HTB = HALF * BK * 2, STAGE_BYTES = 8 * HTB, NXCD = 8, WGM = 8;
__host__ __device__ __forceinline__ int lds_byte(int r, int c) { const int st = (r >> 4) * 2 + (c >> 5), rr = r & 15, cc = c & 31, ob = rr * 64 + cc * 2; return st * 1024 + (ob ^ (((ob >> 9) & 1) << 5)); }
__host__ __device__ __forceinline__ void stage_rc(int b, int& R, int& C) { const int st = b / 1024, sb = b % 1024, swz = sb ^ (((sb >> 9) & 1) << 5); R = (st >> 1) * 16 + swz / 64; C = (st & 1) * 32 + (swz % 64) / 2; }
__host__ __device__ __forceinline__ int perm32(int rho) { const int n = rho >> 4, i = rho & 15; return 8 * (i >> 2) + 4 * n + (i & 3); }

struct Unit { int e, pm, pn; };
struct Gemm {
    const char* A;
    const char* Bt;
    const int* rows;
    size_t bstride;
    int K, nM, nN, ngroups;
    int rev = 0;
    int trip = 0;
};
__device__ __forceinline__ bool next_unit(const Gemm& g, int i, int G, int c, Unit& u) {
    if (g.trip) {
        const int per3 = g.nM * (g.nN / 3), j = i / 3, sec = i - 3 * j; int s = j * G + c; if (s >= per3) return false;
        { const int q = per3 / NXCD, r = per3 % NXCD, xcd = s % NXCD, off = s / NXCD; s = (xcd < r ? xcd * (q + 1) : r * (q + 1) + (xcd - r) * q) + off; }
        const int ncb = g.nN / 3; u.e = 0; u.pm = s / ncb; u.pn = 3 * (s % ncb) + sec; return true;
    }
    const int per = g.nM * g.nN;
    const long L = (long)i * G + c; if (L >= (long)per * g.ngroups) return false;
    u.e = (int)(L / per); int wgid = (int)(L % per);
    if (g.rev) u.e = g.ngroups - 1 - u.e;
    { const int nwg = per, q = nwg / NXCD, r = nwg % NXCD, xcd = wgid % NXCD, off = wgid / NXCD; wgid = (xcd < r ? xcd * (q + 1) : r * (q + 1) + (xcd - r) * q) + off; }
    const int nig = WGM * g.nN, gid = wgid / nig, fm = gid * WGM, gsz = (g.nM - fm) < WGM ? (g.nM - fm) : WGM;
    u.pm = fm + ((wgid % nig) % gsz); u.pn = (wgid % nig) / gsz; return true;
}
__device__ __forceinline__ bf16x8 lo8(const i32x8& f) { return __builtin_bit_cast(bf16x8, (i32x4)__builtin_shufflevector(f, f, 0, 1, 2, 3)); }
__device__ __forceinline__ bf16x8 hi8(const i32x8& f) { return __builtin_bit_cast(bf16x8, (i32x4)__builtin_shufflevector(f, f, 4, 5, 6, 7)); }
__device__ __forceinline__ i32x8 cat8(bf16x8 lo, bf16x8 hi) { const i32x4 a = __builtin_bit_cast(i32x4, lo), b = __builtin_bit_cast(i32x4, hi); return __builtin_shufflevector(a, b, 0, 1, 2, 3, 4, 5, 6, 7); }
__device__ __forceinline__ unsigned cvt_pk_bf16(float lo, float hi) { unsigned r; asm volatile("v_cvt_pk_bf16_f32 %0, %1, %2" : "=v"(r) : "v"(lo), "v"(hi)); return r; }

#ifndef ENG_SP2
#define ENG_SP2 true
#endif
#ifndef ENG_ALIGN
#define ENG_ALIGN true
#endif
template <class Epi, bool SP2 = ENG_SP2, bool ALIGN_EPI = ENG_ALIGN>
__device__ __forceinline__ void gemm_phase(LAS unsigned char* lds, const Gemm g, const Epi& E, int G, int c) {
    int tid = threadIdx.x; asm volatile("" : "+v"(tid));
    const int wid = __builtin_amdgcn_readfirstlane(tid >> 6), lane = tid & 63, wr = wid >> 2, wc = wid & 3, fr = lane & 15, fq = lane >> 4;
    const int K = g.K, nt = K / BK;
    int R0, C0; stage_rc(tid * 16, R0, C0);
    const int Rb0 = Epi::PERM ? ((R0 & ~31) + perm32(R0 & 31)) : R0;
    unsigned voffB[2]; voffB[0] = (unsigned)(Rb0 * K + C0) * 2u; voffB[1] = (unsigned)((Rb0 + 64) * K + C0) * 2u;
    constexpr bool SW = Epi::SWAPV;
    const char* const abase = SW ? g.Bt : g.A;
    const unsigned adelta = SW ? (unsigned)(size_t)(g.A - g.Bt) : 0u;
    const unsigned dltB = SW ? (unsigned)((R0 - Rb0) * K) * 2u : 0u;
    const size_t hstepB = (size_t)HALF * K * 2;
    const unsigned ldsw = (unsigned)wid * 1024u;
    const int aoff = lds_byte(wr * 64 + fr, fq * 8), boff = lds_byte(wc * 32 + fr, fq * 8);
#define PG8_SA(b, h) (((b) * 2 + (h)) * HTB)
#define PG8_SB(b, h) ((4 + (b) * 2 + (h)) * HTB)
#define PG8_GLDS(gp, bufoff, i) __builtin_amdgcn_global_load_lds((const unsigned*)(gp), (LAS unsigned*)(lds + (bufoff) + ldsw + (i) * 8192), 16, 0, 0)
#define PG8_STAGE_B(bufoff, bp, h, kt) do { const char* _p = (bp) + (size_t)(h) * hstepB + (size_t)(kt) * 128; asm volatile("" : "+s"(_p)); PG8_GLDS(_p + (voffB[0] + (SW ? dselB : 0u)), bufoff, 0); PG8_GLDS(_p + (voffB[1] + (SW ? dselB : 0u)), bufoff, 1); } while (0)
#define PG8_STAGE_A(bufoff, v0, v1, kt) do { const char* _p = abase + (size_t)(kt) * 128; asm volatile("" : "+s"(_p)); PG8_GLDS(_p + (v0), bufoff, 0); PG8_GLDS(_p + (v1), bufoff, 1); } while (0)
#define PG8_LDA(dst, b, h) do { _Pragma("unroll") for (int m = 0; m < 4; ++m) dst[m] = cat8(*(const LAS bf16x8*)(lds + PG8_SA(b, h) + aoff + m * 2048), *(const LAS bf16x8*)(lds + PG8_SA(b, h) + aoff + m * 2048 + 1024)); } while (0)
#define PG8_LDB(dst, b, h) do { _Pragma("unroll") for (int n = 0; n < 2; ++n) dst[n] = cat8(*(const LAS bf16x8*)(lds + PG8_SB(b, h) + boff + n * 2048), *(const LAS bf16x8*)(lds + PG8_SB(b, h) + boff + n * 2048 + 1024)); } while (0)
#define PG8_MMA(ai, bj, At, Bt) do { __builtin_amdgcn_s_setprio(1); \
        if constexpr (Epi::FP8) { _Pragma("unroll") for (int m = 0; m < 4; ++m) _Pragma("unroll") for (int n = 0; n < 2; ++n) \
            asm volatile("v_mfma_scale_f32_16x16x128_f8f6f4 %0, %1, %2, %0, %3, %4 op_sel_hi:[0,0,0]" : "+v"(acc[ai][bj][m][n]) : "v"(Bt[n]), "v"(At[m]), "v"(sc_w), "v"(sc_a)); } \
        else { _Pragma("unroll") for (int m = 0; m < 4; ++m) _Pragma("unroll") for (int n = 0; n < 2; ++n) { \
            acc[ai][bj][m][n] = __builtin_amdgcn_mfma_f32_16x16x32_bf16(lo8(Bt[n]), lo8(At[m]), acc[ai][bj][m][n], 0, 0, 0); \
            acc[ai][bj][m][n] = __builtin_amdgcn_mfma_f32_16x16x32_bf16(hi8(Bt[n]), hi8(At[m]), acc[ai][bj][m][n], 0, 0, 0); } } \
        __builtin_amdgcn_s_setprio(0); } while (0)
#define PG8_WAIT_V(n) asm volatile("s_waitcnt vmcnt(" #n ")" ::: "memory")
#define PG8_WAIT_L(n) asm volatile("s_waitcnt lgkmcnt(" #n ")" ::: "memory")
#define PG8_BAR __builtin_amdgcn_s_barrier()
#define PG8_SCHED __builtin_amdgcn_sched_barrier(0)
#define PG8_ROWOFF(u, h, i) ((SW && E.swapv(u)) ? (unsigned)(((u).pn * 256 + (h) * 128 + R0 + 64 * (i)) * K + C0) * 2u : adelta + ((unsigned)(((g.rows ? g.rows[((u).e * g.nM + (u).pm) * 256 + (h) * 128 + R0 + 64 * (i)] : (((u).e * g.nM + (u).pm) * 256 + (h) * 128 + R0 + 64 * (i))) * K + C0)) * 2u))
#define PG8_BPTR(u) ((SW && E.swapv(u)) ? g.A + (size_t)(u).pm * 2 * hstepB : g.Bt + (size_t)(u).e * g.bstride + (size_t)(u).pn * 2 * hstepB)
    Unit cur, nxt; int ui = 0;
    if (!next_unit(g, 0, G, c, cur)) return;
    f32x4 acc[2][2][4][2];
#pragma unroll
    for (int a = 0; a < 2; ++a)
#pragma unroll
        for (int b = 0; b < 2; ++b)
#pragma unroll
            for (int m = 0; m < 4; ++m)
#pragma unroll
                for (int n = 0; n < 2; ++n) acc[a][b][m][n] = (f32x4){0.f, 0.f, 0.f, 0.f};
    int sc_w = E.scale_w, sc_a = E.scale_a;
    asm volatile("" : "+v"(sc_w), "+v"(sc_a));
    i32x8 At[4], B0[2], B1[2];
    unsigned c00 = PG8_ROWOFF(cur, 0, 0), c01 = PG8_ROWOFF(cur, 0, 1), c10 = PG8_ROWOFF(cur, 1, 0), c11 = PG8_ROWOFF(cur, 1, 1);
    const char* cB = PG8_BPTR(cur);
    unsigned cD = (SW && E.swapv(cur)) ? dltB : 0u, dselB = cD;
    if constexpr (SP2) {
        PG8_STAGE_B(PG8_SB(0, 0), cB, 0, 0); PG8_STAGE_B(PG8_SB(0, 1), cB, 1, 0); PG8_STAGE_A(PG8_SA(0, 0), c00, c01, 0); PG8_STAGE_A(PG8_SA(0, 1), c10, c11, 0);
        if (wr == 1) PG8_BAR;
        PG8_WAIT_V(2); PG8_BAR;
        PG8_STAGE_B(PG8_SB(1, 0), cB, 0, 1); PG8_STAGE_A(PG8_SA(1, 0), c00, c01, 1); PG8_STAGE_B(PG8_SB(1, 1), cB, 1, 1);
        PG8_WAIT_V(6); PG8_BAR;
    } else {
        PG8_STAGE_B(PG8_SB(0, 0), cB, 0, 0); PG8_STAGE_A(PG8_SA(0, 0), c00, c01, 0); PG8_STAGE_B(PG8_SB(0, 1), cB, 1, 0); PG8_STAGE_A(PG8_SA(0, 1), c10, c11, 0);
        if (wr == 1) PG8_BAR;
        PG8_WAIT_V(4); PG8_BAR;
        PG8_STAGE_B(PG8_SB(1, 0), cB, 0, 1); PG8_STAGE_A(PG8_SA(1, 0), c00, c01, 1); PG8_STAGE_B(PG8_SB(1, 1), cB, 1, 1);
        PG8_WAIT_V(6); PG8_BAR;
    }
    for (;;) {
        const bool has_next = next_unit(g, ui + 1, G, c, nxt);
        unsigned n00 = c00, n01 = c01, n10 = c10, n11 = c11; const char* nB = cB; unsigned nD = cD;
        if (has_next) { n00 = PG8_ROWOFF(nxt, 0, 0); n01 = PG8_ROWOFF(nxt, 0, 1); n10 = PG8_ROWOFF(nxt, 1, 0); n11 = PG8_ROWOFF(nxt, 1, 1);
                        nB = PG8_BPTR(nxt); nD = (SW && E.swapv(nxt)) ? dltB : 0u; }
#pragma unroll 1
        for (int t = 0; t < nt; t += 2) {
            const bool last = (t == nt - 2);
            const int kt2 = last ? 0 : t + 2, kt3 = kt2 + 1;
            const char* b2 = last ? nB : cB; dselB = last ? nD : cD;
            const unsigned s00 = last ? n00 : c00, s01 = last ? n01 : c01, s10 = last ? n10 : c10, s11 = last ? n11 : c11;
            if constexpr (SP2) {
            PG8_LDB(B0, 0, 0); PG8_LDB(B1, 0, 1); PG8_SCHED; PG8_LDA(At, 0, 0); PG8_STAGE_A(PG8_SA(1, 1), c10, c11, t + 1);
            PG8_WAIT_V(8); PG8_WAIT_L(0); PG8_BAR; PG8_MMA(0, 0, At, B0); PG8_MMA(0, 1, At, B1); PG8_BAR; PG8_SCHED;
            PG8_LDA(At, 0, 1); PG8_STAGE_B(PG8_SB(0, 0), b2, 0, kt2); PG8_STAGE_B(PG8_SB(0, 1), b2, 1, kt2); PG8_STAGE_A(PG8_SA(0, 0), s00, s01, kt2);
            PG8_WAIT_V(8); PG8_WAIT_L(0); PG8_BAR; PG8_MMA(1, 0, At, B0); PG8_MMA(1, 1, At, B1); PG8_BAR; PG8_SCHED;
            PG8_LDB(B0, 1, 0); PG8_LDB(B1, 1, 1); PG8_SCHED; PG8_LDA(At, 1, 0); PG8_STAGE_A(PG8_SA(0, 1), s10, s11, kt2);
            PG8_WAIT_V(8); PG8_WAIT_L(0); PG8_BAR; PG8_MMA(0, 0, At, B0); PG8_MMA(0, 1, At, B1); PG8_BAR; PG8_SCHED;
            PG8_LDA(At, 1, 1); PG8_STAGE_B(PG8_SB(1, 0), b2, 0, kt3); PG8_STAGE_B(PG8_SB(1, 1), b2, 1, kt3); PG8_STAGE_A(PG8_SA(1, 0), s00, s01, kt3);
            PG8_WAIT_V(8); PG8_WAIT_L(0); PG8_BAR; PG8_MMA(1, 0, At, B0); PG8_MMA(1, 1, At, B1); PG8_BAR; PG8_SCHED;
            } else {
            PG8_LDB(B0, 0, 0); PG8_SCHED; PG8_LDA(At, 0, 0); PG8_STAGE_A(PG8_SA(1, 1), c10, c11, t + 1);
            PG8_WAIT_L(8); PG8_BAR; PG8_WAIT_L(0); PG8_MMA(0, 0, At, B0); PG8_BAR; PG8_SCHED;
            PG8_LDB(B1, 0, 1); PG8_STAGE_B(PG8_SB(0, 0), b2, 0, kt2);
            PG8_BAR; PG8_WAIT_L(0); PG8_MMA(0, 1, At, B1); PG8_BAR;
            PG8_LDA(At, 0, 1); PG8_STAGE_A(PG8_SA(0, 0), s00, s01, kt2);
            PG8_BAR; PG8_WAIT_L(0); PG8_MMA(1, 0, At, B0); PG8_BAR; PG8_SCHED;
            PG8_STAGE_B(PG8_SB(0, 1), b2, 1, kt2);
            PG8_WAIT_V(6); PG8_BAR; PG8_MMA(1, 1, At, B1); PG8_BAR;
            PG8_LDB(B0, 1, 0); PG8_SCHED; PG8_LDA(At, 1, 0); PG8_STAGE_A(PG8_SA(0, 1), s10, s11, kt2);
            PG8_WAIT_L(8); PG8_BAR; PG8_WAIT_L(0); PG8_MMA(0, 0, At, B0); PG8_BAR; PG8_SCHED;
            PG8_LDB(B1, 1, 1); PG8_STAGE_B(PG8_SB(1, 0), b2, 0, kt3);
            PG8_BAR; PG8_WAIT_L(0); PG8_MMA(0, 1, At, B1); PG8_BAR;
            PG8_LDA(At, 1, 1); PG8_STAGE_A(PG8_SA(1, 0), s00, s01, kt3);
            PG8_BAR; PG8_WAIT_L(0); PG8_MMA(1, 0, At, B0); PG8_BAR; PG8_SCHED;
            PG8_STAGE_B(PG8_SB(1, 1), b2, 1, kt3);
            PG8_WAIT_V(6); PG8_BAR; PG8_MMA(1, 1, At, B1); PG8_BAR;
            }
        }
        if constexpr (Epi::FP8) {
            _Pragma("unroll") for (int a = 0; a < 2; ++a)
                asm volatile("s_nop 15\n\ts_nop 15" : "+v"(acc[a][0][0][0]), "+v"(acc[a][0][0][1]), "+v"(acc[a][0][1][0]), "+v"(acc[a][0][1][1]), "+v"(acc[a][0][2][0]), "+v"(acc[a][0][2][1]), "+v"(acc[a][0][3][0]), "+v"(acc[a][0][3][1]),
                             "+v"(acc[a][1][0][0]), "+v"(acc[a][1][0][1]), "+v"(acc[a][1][1][0]), "+v"(acc[a][1][1][1]), "+v"(acc[a][1][2][0]), "+v"(acc[a][1][2][1]), "+v"(acc[a][1][3][0]), "+v"(acc[a][1][3][1]));
        }
        if constexpr (ALIGN_EPI) { if (wr == 0) PG8_BAR; }
        E(acc, cur, wr, wc, fr, fq);
        if (!has_next) break;
#pragma unroll
        for (int a = 0; a < 2; ++a)
#pragma unroll
            for (int b = 0; b < 2; ++b)
#pragma unroll
                for (int m = 0; m < 4; ++m)
#pragma unroll
                    for (int n = 0; n < 2; ++n) acc[a][b][m][n] = (f32x4){0.f, 0.f, 0.f, 0.f};
        cur = nxt; cB = nB; cD = nD; c00 = n00; c01 = n01; c10 = n10; c11 = n11; ++ui;
        if constexpr (ALIGN_EPI) { if (wr == 1) PG8_BAR; }
    }
    PG8_WAIT_V(0);
    if constexpr (!ALIGN_EPI) { if (wr == 0) PG8_BAR; }
    PG8_BAR;
#undef PG8_SA
#undef PG8_SB
#undef PG8_GLDS
#undef PG8_STAGE_A
#undef PG8_STAGE_B
#undef PG8_LDA
#undef PG8_LDB
#undef PG8_MMA
#undef PG8_WAIT_V
#undef PG8_WAIT_L
#undef PG8_BAR
#undef PG8_SCHED
#undef PG8_ROWOFF
#undef PG8_BPTR
}

struct EpiProj0 {
    static constexpr bool FP8 = false; static constexpr int scale_w = 0, scale_a = 0;
    static constexpr bool PERM = true; static constexpr bool SWAPV = true;
    __device__ __forceinline__ bool swapv(const Unit& u) const { return u.pn >= 4 && u.pn < 8; }
    bf16_t* qk; unsigned char* vtp; bf16_t* r; float* afb;
    __device__ __forceinline__ void operator()(const f32x4 (&acc)[2][2][4][2], const Unit& u, int wr, int wc, int fr, int fq) const {
        const int row0 = u.pm * BM + wr * 64 + fr;
        if (swapv(u)) {
            unsigned char* p0 = vtp + (size_t)(4 * u.pm + (wc >> 1)) * 131072 + (size_t)((((16 * (u.pn - 4) + 4 * wr) * 2 + (wc & 1)) * 64 + fr + 16 * fq) * 16);
#pragma unroll
            for (int ai = 0; ai < 2; ++ai)
#pragma unroll
                for (int m = 0; m < 4; ++m)
#pragma unroll
                    for (int bj = 0; bj < 2; ++bj) { const f32x4 v0 = acc[ai][bj][m][0], v1 = acc[ai][bj][m][1];
                        u32x4 w; w.x = cvt_pk_bf16(v0[0], v0[1]); w.y = cvt_pk_bf16(v0[2], v0[3]); w.z = cvt_pk_bf16(v1[0], v1[1]); w.w = cvt_pk_bf16(v1[2], v1[3]);
                        *(u32x4*)(p0 + (size_t)bj * 2 * 131072 + (size_t)(8 * ai + m) * 2048) = w; }
        } else if (u.pn < 12) {
            const float sc = (u.pn < 2) ? 0.08838834764831845f : 1.f;
            bf16_t* base = qk + (size_t)(u.pn >> 3) * (size_t)(130 * MiB / 2);
            const int col0 = (u.pn & 3) * BM + wc * 32 + 8 * fq;
#pragma unroll
            for (int ai = 0; ai < 2; ++ai)
#pragma unroll
                for (int m = 0; m < 4; ++m) { bf16_t* rowp = base + (size_t)(row0 + ai * HALF + m * 16) * D + col0;
#pragma unroll
                    for (int bj = 0; bj < 2; ++bj) { const f32x4 v0 = acc[ai][bj][m][0] * sc, v1 = acc[ai][bj][m][1] * sc;
                        u32x4 w; w.x = cvt_pk_bf16(v0[0], v0[1]); w.y = cvt_pk_bf16(v0[2], v0[3]); w.z = cvt_pk_bf16(v1[0], v1[1]); w.w = cvt_pk_bf16(v1[2], v1[3]);
                        *(u32x4*)(rowp + bj * HALF) = w; } }
        } else if (wc == 0) {
#pragma unroll
            for (int ai = 0; ai < 2; ++ai)
#pragma unroll
                for (int m = 0; m < 4; ++m) { float* rowp = afb + (size_t)(row0 + ai * HALF + m * 16) * 32 + 8 * fq;
                    *(f32x4*)(rowp) = acc[ai][0][m][0]; *(f32x4*)(rowp + 4) = acc[ai][0][m][1]; }
        }
    }
};
template <bool SRC_F32>
struct EpiResidT {
    static constexpr bool FP8 = false; static constexpr int scale_w = 0, scale_a = 0;
    static constexpr bool PERM = true; static constexpr bool SWAPV = false; __device__ __forceinline__ bool swapv(const Unit&) const { return false; }
    const void* src; bf16_t* dst; const float* gate;
    __device__ __forceinline__ void operator()(const f32x4 (&acc)[2][2][4][2], const Unit& u, int wr, int wc, int fr, int fq) const {
        const int row0 = u.pm * BM + wr * 64 + fr, col0 = u.pn * BM + wc * 32 + 8 * fq;
        const int b = (u.pm * BM) >> 14;
        f32x4 gv[2][2];
#pragma unroll
        for (int bj = 0; bj < 2; ++bj)
#pragma unroll
            for (int n = 0; n < 2; ++n) gv[bj][n] = *(const f32x4*)(gate + (size_t)b * 6 * D + col0 + bj * HALF + n * 4);
#pragma unroll
        for (int ai = 0; ai < 2; ++ai) {
            f32x4 sv[4][2][2];
#pragma unroll
            for (int m = 0; m < 4; ++m)
#pragma unroll
                for (int bj = 0; bj < 2; ++bj) { const size_t off = (size_t)(row0 + ai * HALF + m * 16) * D + col0 + bj * HALF;
                    if constexpr (SRC_F32) { sv[m][bj][0] = *(const f32x4*)((const float*)src + off); sv[m][bj][1] = *(const f32x4*)((const float*)src + off + 4); }
                    else { const u32x4 t = *(const u32x4*)((const bf16_t*)src + off);
                        sv[m][bj][0] = (f32x4){bflo(t.x), bfhi(t.x), bflo(t.y), bfhi(t.y)}; sv[m][bj][1] = (f32x4){bflo(t.z), bfhi(t.z), bflo(t.w), bfhi(t.w)}; } }
            asm volatile("" ::: "memory");
#pragma unroll
            for (int m = 0; m < 4; ++m)
#pragma unroll
                for (int bj = 0; bj < 2; ++bj) { const f32x4 y0 = sv[m][bj][0] + gv[bj][0] * acc[ai][bj][m][0], y1 = sv[m][bj][1] + gv[bj][1] * acc[ai][bj][m][1];
                    u32x4 w; w.x = cvt_pk_bf16(y0[0], y0[1]); w.y = cvt_pk_bf16(y0[2], y0[3]); w.z = cvt_pk_bf16(y1[0], y1[1]); w.w = cvt_pk_bf16(y1[2], y1[3]);
                    *(u32x4*)(dst + (size_t)(row0 + ai * HALF + m * 16) * D + col0 + bj * HALF) = w; }
        }
    }
};
struct EpiBf16Plain {
    static constexpr bool FP8 = false; static constexpr int scale_w = 0, scale_a = 0;
    static constexpr bool PERM = true; static constexpr bool SWAPV = false; __device__ __forceinline__ bool swapv(const Unit&) const { return false; }
    bf16_t* O; int ldc;
    __device__ __forceinline__ void operator()(const f32x4 (&acc)[2][2][4][2], const Unit& u, int wr, int wc, int fr, int fq) const {
        const int row0 = u.pm * BM + wr * 64 + fr, col0 = u.pn * BM + wc * 32 + 8 * fq;
#pragma unroll
        for (int ai = 0; ai < 2; ++ai)
#pragma unroll
            for (int m = 0; m < 4; ++m) { bf16_t* rowp = O + (size_t)(row0 + ai * HALF + m * 16) * ldc + col0;
#pragma unroll
                for (int bj = 0; bj < 2; ++bj) { const f32x4 v0 = acc[ai][bj][m][0], v1 = acc[ai][bj][m][1];
                    u32x4 w; w.x = cvt_pk_bf16(v0[0], v0[1]); w.y = cvt_pk_bf16(v0[2], v0[3]); w.z = cvt_pk_bf16(v1[0], v1[1]); w.w = cvt_pk_bf16(v1[2], v1[3]);
                    *(u32x4*)(rowp + bj * HALF) = w; } }
    }
};
__device__ __forceinline__ float dpp_shr1(float oldv, float x) { return __builtin_bit_cast(float, __builtin_amdgcn_update_dpp(__builtin_bit_cast(int, oldv), __builtin_bit_cast(int, x), 0x111, 0xF, 0xF, false)); }
__device__ __forceinline__ float dpp_shl1(float oldv, float x) { return __builtin_bit_cast(float, __builtin_amdgcn_update_dpp(__builtin_bit_cast(int, oldv), __builtin_bit_cast(int, x), 0x101, 0xF, 0xF, false)); }
__device__ __forceinline__ float dpp_ror1(float x) { return __builtin_bit_cast(float, __builtin_amdgcn_update_dpp(0, __builtin_bit_cast(int, x), 0x121, 0xF, 0xF, false)); }
__device__ __forceinline__ float dpp_rol1(float x) { return __builtin_bit_cast(float, __builtin_amdgcn_update_dpp(0, __builtin_bit_cast(int, x), 0x12F, 0xF, 0xF, false)); }
struct EpiConvFused {
    static constexpr bool FP8 = false; static constexpr int scale_w = 0, scale_a = 0;
    static constexpr bool PERM = true; static constexpr bool SWAPV = false; __device__ __forceinline__ bool swapv(const Unit&) const { return false; }
    unsigned char* dump;
    bf16_t* O; const float* ck;
    __device__ __forceinline__ void operator()(const f32x4 (&acc)[2][2][4][2], const Unit& u, int wr, int wc, int fr, int fq) const {
        const int cb = u.pn / 3, sec = u.pn - 3 * cb, tid = threadIdx.x;
        if (sec < 2) {
            const int cc = 256 * cb + 128 * sec + wc * 32 + 8 * fq;
            unsigned char* dp = dump + (size_t)sec * 65536 + tid * 16;
#pragma unroll
            for (int n = 0; n < 2; ++n) {
                const f32x4 k0 = *(const f32x4*)(ck + cc + 4 * n), k1 = *(const f32x4*)(ck + D + cc + 4 * n), k2 = *(const f32x4*)(ck + 2 * D + cc + 4 * n);
#pragma unroll
                for (int ai = 0; ai < 2; ++ai) {
                    f32x4 y[4];
#pragma unroll
                    for (int j = 0; j < 4; ++j) {
                        float x[4];
#pragma unroll
                        for (int m = 0; m < 4; ++m) x[m] = acc[ai][0][m][n][j] * acc[ai][1][m][n][j];
#pragma unroll
                        for (int m = 0; m < 4; ++m) {
                            const float up = dpp_shr1(m > 0 ? dpp_ror1(x[m - 1]) : 0.f, x[m]);
                            const float dn = dpp_shl1(m < 3 ? dpp_rol1(x[m + 1]) : 0.f, x[m]);
                            y[m][j] = k0[j] * up + k1[j] * x[m] + k2[j] * dn; }
                    }
#pragma unroll
                    for (int m = 0; m < 4; ++m) { u32x2 w; w.x = cvt_pk_bf16(y[m][0], y[m][1]); w.y = cvt_pk_bf16(y[m][2], y[m][3]);
                        *(u32x2*)(dp + (ai * 4 + m) * 8192 + n * 8) = w; }
                }
            }
        } else {
            const int row0 = u.pm * BM + wr * 64 + fr, col0 = 256 * cb + wc * 32 + 8 * fq;
            const unsigned loff = (unsigned)tid * 16u;
#pragma unroll
            for (int ai = 0; ai < 2; ++ai) {
                u32x4 qq[4][2];
#pragma unroll
                for (int m = 0; m < 4; ++m) {
                    const unsigned char* sb = dump + (ai * 4 + m) * 8192; asm volatile("" : "+s"(sb));
                    qq[m][0] = *(const u32x4*)(sb + loff); qq[m][1] = *(const u32x4*)(sb + 65536 + loff); }
#pragma unroll
                for (int m = 0; m < 4; ++m) {
                    bf16_t* rowp = O + (size_t)(row0 + ai * HALF + m * 16) * D + col0;
#pragma unroll
                    for (int bj = 0; bj < 2; ++bj) { const f32x4 v0 = acc[ai][bj][m][0], v1 = acc[ai][bj][m][1]; const u32x4 q = qq[m][bj];
                        u32x4 w; w.x = cvt_pk_bf16(v0[0] * bflo(q.x), v0[1] * bfhi(q.x)); w.y = cvt_pk_bf16(v0[2] * bflo(q.y), v0[3] * bfhi(q.y));
                        w.z = cvt_pk_bf16(v1[0] * bflo(q.z), v1[1] * bfhi(q.z)); w.w = cvt_pk_bf16(v1[2] * bflo(q.w), v1[3] * bfhi(q.w));
                        *(u32x4*)(rowp + bj * HALF) = w; } }
                asm volatile("" ::: "memory");
            }
        }
    }
};
struct EpiSwiglu {
    static constexpr bool FP8 = true; int scale_w, scale_a;
    static constexpr bool PERM = true; static constexpr bool SWAPV = false; __device__ __forceinline__ bool swapv(const Unit&) const { return false; }
    unsigned char* hid;
    __device__ __forceinline__ void operator()(const f32x4 (&acc)[2][2][4][2], const Unit& u, int wr, int wc, int fr, int fq) const {
        const int row0 = u.e * 4096 + u.pm * BM + wr * 64 + fr, col0 = u.pn * HALF + wc * 32 + 8 * fq;
#pragma unroll
        for (int ai = 0; ai < 2; ++ai)
#pragma unroll
            for (int m = 0; m < 4; ++m) { unsigned char* rowp = hid + (size_t)(row0 + ai * HALF + m * 16) * DEXP + col0;
                float h[8];
#pragma unroll
                for (int n = 0; n < 2; ++n)
#pragma unroll
                    for (int j2 = 0; j2 < 2; ++j2) {
                        const f32x2 gt = {acc[ai][0][m][n][2 * j2], acc[ai][0][m][n][2 * j2 + 1]}, up = {acc[ai][1][m][n][2 * j2], acc[ai][1][m][n][2 * j2 + 1]};
                        const f32x2 a = gt * (f32x2){-1.4426950408889634f, -1.4426950408889634f};
                        f32x2 t; t.x = __builtin_amdgcn_exp2f(a.x); t.y = __builtin_amdgcn_exp2f(a.y);
                        const f32x2 d4 = t * (f32x2){0.25f, 0.25f} + (f32x2){0.25f, 0.25f};
                        f32x2 r4; r4.x = __builtin_amdgcn_rcpf(d4.x); r4.y = __builtin_amdgcn_rcpf(d4.y);
                        const f32x2 hv = (gt * up) * r4;
                        h[n * 4 + 2 * j2] = __builtin_amdgcn_fmed3f(hv.x, -448.f, 448.f); h[n * 4 + 2 * j2 + 1] = __builtin_amdgcn_fmed3f(hv.y, -448.f, 448.f); }
                int w0 = __builtin_amdgcn_cvt_pk_fp8_f32(h[0], h[1], 0, false); w0 = __builtin_amdgcn_cvt_pk_fp8_f32(h[2], h[3], w0, true);
                int w1 = __builtin_amdgcn_cvt_pk_fp8_f32(h[4], h[5], 0, false); w1 = __builtin_amdgcn_cvt_pk_fp8_f32(h[6], h[7], w1, true);
                u32x2 w; w.x = (unsigned)w0; w.y = (unsigned)w1;
                *(u32x2*)(rowp) = w; }
    }
};
struct EpiDown {
    static constexpr bool FP8 = true; int scale_w, scale_a;
    static constexpr bool PERM = true; static constexpr bool SWAPV = false; __device__ __forceinline__ bool swapv(const Unit&) const { return false; }
    unsigned char* ye;
    __device__ __forceinline__ void operator()(const f32x4 (&acc)[2][2][4][2], const Unit& u, int wr, int wc, int fr, int fq) const {
        const int row0 = u.e * 4096 + u.pm * BM + wr * 64 + fr, col0 = u.pn * BM + wc * 32 + 8 * fq;
#pragma unroll
        for (int ai = 0; ai < 2; ++ai)
#pragma unroll
            for (int m = 0; m < 4; ++m) { const int row = row0 + ai * HALF + m * 16; unsigned char* rowp = ye + (size_t)row * D + col0;
#pragma unroll
                for (int bj = 0; bj < 2; ++bj) { f32x4 v0 = acc[ai][bj][m][0] * 32.f, v1 = acc[ai][bj][m][1] * 32.f;
#pragma unroll
                    for (int i = 0; i < 4; ++i) { v0[i] = __builtin_amdgcn_fmed3f(v0[i], -448.f, 448.f); v1[i] = __builtin_amdgcn_fmed3f(v1[i], -448.f, 448.f); }
                    int w0 = __builtin_amdgcn_cvt_pk_fp8_f32(v0[0], v0[1], 0, false); w0 = __builtin_amdgcn_cvt_pk_fp8_f32(v0[2], v0[3], w0, true);
                    int w1 = __builtin_amdgcn_cvt_pk_fp8_f32(v1[0], v1[1], 0, false); w1 = __builtin_amdgcn_cvt_pk_fp8_f32(v1[2], v1[3], w1, true);
                    u32x2 w; w.x = (unsigned)w0; w.y = (unsigned)w1;
                    *(u32x2*)(rowp + bj * HALF) = w; } }
    }
};
}

constexpr int RING_BYTES = 131072, LDS_BYTES = 147456;
struct Args { const float* in[20]; float* out; unsigned char* ws; int ph_lo, ph_hi; };
struct Frame {
    LAS unsigned char* lds;
    int tid, lane, wave, gw, ngw, G;
};
#define P_X 0
#define P_C 1
#define P_CTX 2
#define P_CCTX 3
#define P_ADAW 4
#define P_ADAB 5
#define P_NORMG 6
#define P_GWIN 7
#define P_GWA2 8
#define P_GBA2 9
#define P_GNORMG 10
#define P_GWOUT 11
#define P_CWIN 12
#define P_CK 13
#define P_CWOUT 14
#define P_ROUTER 15
#define P_EGATE 16
#define P_EUP 17
#define P_EDOWN 18
#define P_FINALG 19

constexpr int TR_SCR = 64 * 65 * 4;
__device__ __forceinline__ void tr_item(const float* W, int ldw, int k0, int n0, bf16_t* WT, int ldo, int drow0, LAS float* scr, int lane) {
    f32x4 v[16];
#pragma unroll
    for (int i = 0; i < 16; ++i) v[i] = *(const f32x4*)(W + (size_t)(k0 + 4 * i + (lane >> 4)) * ldw + n0 + 4 * (lane & 15));
#pragma unroll
    for (int i = 0; i < 16; ++i) { LAS float* p = scr + (4 * i + (lane >> 4)) * 65 + 4 * (lane & 15); p[0] = v[i].x; p[1] = v[i].y; p[2] = v[i].z; p[3] = v[i].w; }
    LDS_WAIT(); asm volatile("" ::: "memory");
    const int c = lane & 7;
#pragma unroll
    for (int j = 0; j < 8; ++j) { const int n = (lane >> 3) + 8 * j; const LAS float* sp = scr + (8 * c) * 65 + n;
        u32x4 o; o.x = pk2(sp[0 * 65], sp[1 * 65]); o.y = pk2(sp[2 * 65], sp[3 * 65]); o.z = pk2(sp[4 * 65], sp[5 * 65]); o.w = pk2(sp[6 * 65], sp[7 * 65]);
        *(u32x4*)(WT + (size_t)(drow0 + n) * ldo + k0 + 8 * c) = o; }
    LDS_WAIT(); asm volatile("" ::: "memory");
}
__device__ __forceinline__ void tr_plain(Frame& F, const Args& A, const float* W, int K, int N, bf16_t* WT, int item, LAS float* scr) {
    const int nblk = (N + 63) / 64, kb = item / nblk, nb = item % nblk; int n0 = 64 * nb; if (n0 + 64 > N) n0 = N - 64;
    tr_item(W, N, 64 * kb, n0, WT, K, n0, scr, F.lane);
}
constexpr int TR_SCR8 = 128 * 33 * 4;
static_assert(TR_SCR8 >= TR_SCR, "per-wave scratch stride");
struct Tr8Item { const float* W; unsigned char* WT; int ldw, ldo, rowmap; };
constexpr int I8_G = (D / 128) * (DEXP / 256);
constexpr int I8_D = (DEXP / 128) * (D / 256);
constexpr int N_EXPERT_ITEMS = NE * (2 * I8_G + I8_D);
__device__ __forceinline__ Tr8Item expert_item(const Args& A, int gi) {
    const int l = gi / N_EXPERT_ITEMS, it = gi % N_EXPERT_ITEMS;
    unsigned char* wgu = A.ws + WS_W8 + (size_t)l * W8_LAYER; unsigned char* wd = wgu + W8_WD;
    constexpr int PER_E = 2 * I8_G + I8_D;
    const int e = it / PER_E; int r = it % PER_E;
    Tr8Item t;
    if (r < 2 * I8_G) {
        const int up = r / I8_G; r %= I8_G;
        const float* W = A.in[up ? P_EUP : P_EGATE] + ((size_t)l * NE + e) * D * DEXP;
        const int nblk = DEXP / 256, kb = r / nblk, nb = r % nblk, h0 = 256 * nb;
        t.W = W + (size_t)(128 * kb) * DEXP + h0; t.ldw = DEXP; t.WT = wgu + (size_t)e * 4096 * D + (size_t)(2 * h0 + 128 * up) * D + 128 * kb; t.ldo = D; t.rowmap = 1;
    } else {
        r -= 2 * I8_G;
        const float* W = A.in[P_EDOWN] + ((size_t)l * NE + e) * DEXP * D;
        const int nblk = D / 256, kb = r / nblk, nb = r % nblk;
        t.W = W + (size_t)(128 * kb) * D + 256 * nb; t.ldw = D; t.WT = wd + (size_t)e * D * DEXP + (size_t)(256 * nb) * DEXP + 128 * kb; t.ldo = DEXP; t.rowmap = 0;
    }
    return t;
}
__device__ __forceinline__ void tr8_load(const Tr8Item& t, f32x4 (&v)[16], int wave, int lane) {
#pragma unroll
    for (int i = 0; i < 16; ++i) v[i] = __builtin_nontemporal_load((const f32x4*)(t.W + (size_t)(16 * wave + i) * t.ldw + 4 * lane));
}
__device__ __forceinline__ void tr8_finish(const Tr8Item& t, const f32x4 (&v)[16], LAS unsigned char* tile, int tid, int wave, int lane) {
#pragma unroll
    for (int q = 0; q < 4; ++q) {
        int o[4];
#pragma unroll
        for (int g = 0; g < 4; ++g) { int w = __builtin_amdgcn_cvt_pk_fp8_f32(64.f * v[4 * g][q], 64.f * v[4 * g + 1][q], 0, false);
            o[g] = __builtin_amdgcn_cvt_pk_fp8_f32(64.f * v[4 * g + 2][q], 64.f * v[4 * g + 3][q], w, true); }
        u32x4 ov; ov.x = (unsigned)o[0]; ov.y = (unsigned)o[1]; ov.z = (unsigned)o[2]; ov.w = (unsigned)o[3];
        const int n = 4 * lane + q;
        *(LAS u32x4*)(tile + n * 128 + ((wave ^ (n & 7)) << 4)) = ov; }
    __syncthreads();
#pragma unroll
    for (int j = 0; j < 4; ++j) { const int p = tid + 512 * j, n = p >> 3, c = p & 7;
        const u32x4 ov = *(const LAS u32x4*)(tile + n * 128 + ((c ^ (n & 7)) << 4));
        const int drow = t.rowmap ? (256 * (n >> 7) + (n & 127)) : n;
        *(u32x4*)(t.WT + (size_t)drow * t.ldo + 16 * c) = ov; }
    __syncthreads();
}
__device__ __forceinline__ void convert_expert_dyn(const Args& A, unsigned* ctr, int end, LAS unsigned char* tile, volatile LAS int* slot, int tid, int wave, int lane) {
    if (tid == 0) { slot[0] = (int)__hip_atomic_fetch_add(ctr, 1u, __ATOMIC_RELAXED, __HIP_MEMORY_SCOPE_AGENT); slot[1] = (int)__hip_atomic_fetch_add(ctr, 1u, __ATOMIC_RELAXED, __HIP_MEMORY_SCOPE_AGENT); }
    __syncthreads();
    int ia = slot[0], ib = slot[1];
    if (ia >= end) return;
    f32x4 va[16], vb[16];
    Tr8Item ta = expert_item(A, ia), tb;
    tr8_load(ta, va, wave, lane);
    for (;;) {
        int rc = 0;
        tb = expert_item(A, min(ib, end - 1)); tr8_load(tb, vb, wave, lane);
        if (tid == 0) rc = (int)__hip_atomic_fetch_add(ctr, 1u, __ATOMIC_RELAXED, __HIP_MEMORY_SCOPE_AGENT);
        tr8_finish(ta, va, tile, tid, wave, lane);
        if (tid == 0) slot[0] = rc;
        __syncthreads();
        ia = ib; ib = slot[0];
        if (ia >= end) break;
        ta = expert_item(A, min(ib, end - 1)); tr8_load(ta, va, wave, lane);
        if (tid == 0) rc = (int)__hip_atomic_fetch_add(ctr, 1u, __ATOMIC_RELAXED, __HIP_MEMORY_SCOPE_AGENT);
        tr8_finish(tb, vb, tile, tid, wave, lane);
        if (tid == 0) slot[1] = rc;
        __syncthreads();
        ia = ib; ib = slot[1];
        if (ia >= end) break;
    }
}
template <int N>
__device__ __forceinline__ void convert_expert_fixed(const Args& A, LAS unsigned char* lds, int tid, int wave, int lane) {
    unsigned* ctr = (unsigned*)(A.ws + WS_CTL) + 2048; LAS unsigned char* tile = lds + 49152; volatile LAS int* slot = (volatile LAS int*)(lds + 40960);
    constexpr int end = 2 * N_EXPERT_ITEMS;
    __syncthreads();
    if (tid == 0) slot[0] = (int)__hip_atomic_fetch_add(ctr, (unsigned)N, __ATOMIC_RELAXED, __HIP_MEMORY_SCOPE_AGENT);
    __syncthreads();
    const int base = slot[0];
    if (base >= end) return;
    f32x4 va[16], vb[16];
    Tr8Item ta = expert_item(A, base), tb = ta;
    tr8_load(ta, va, wave, lane);
#pragma unroll
    for (int j = 0; j < N; ++j) {
        if ((j & 1) == 0) { if (j + 1 < N) { tb = expert_item(A, min(base + j + 1, end - 1)); tr8_load(tb, vb, wave, lane); } tr8_finish(ta, va, tile, tid, wave, lane); }
        else              { if (j + 1 < N) { ta = expert_item(A, min(base + j + 1, end - 1)); tr8_load(ta, va, wave, lane); } tr8_finish(tb, vb, tile, tid, wave, lane); }
    }
}

__device__ __forceinline__ void ph_prep(Frame& F, const Args& A) {
    LAS float* scr = (LAS float*)(F.lds + F.wave * TR_SCR8);
    bf16_t* win0 = (bf16_t*)(A.ws + WS_WIN0T); bf16_t* wout0 = (bf16_t*)(A.ws + WS_WOUT0T); bf16_t* wcin = (bf16_t*)(A.ws + WS_WCINT); bf16_t* wcout = (bf16_t*)(A.ws + WS_WCOUTT);
    {
        float* mod = (float*)(A.ws + WS_MOD);
        LAS float* red = (LAS float*)(F.lds + 8 * TR_SCR8);
        if ((int)blockIdx.x < 2 * 96) {
            LAS float* sl = (LAS float*)F.lds;
            for (int i = F.tid; i < 3 * D; i += NTHR) sl[i] = silu_f(i < 2 * D ? A.in[P_C][i] : A.in[P_CCTX][i - 2 * D]);
            __syncthreads();
        }
        for (int it = blockIdx.x; it < 2 * 96; it += F.G) {
            const LAS float* sl = (const LAS float*)F.lds;
            const int l = it / 96, n0 = (it % 96) * 64, kq = F.lane >> 4, c4 = F.lane & 15;
            const float* w = A.in[P_ADAW] + (size_t)l * D * 6 * D + n0 + 4 * c4;
            f32x4 a0 = (f32x4){0.f, 0.f, 0.f, 0.f}, a1 = a0, a2 = a0;
#pragma unroll 8
            for (int st = 0; st < 32; ++st) { const int k = F.wave * 128 + 4 * st + kq; const f32x4 wv = *(const f32x4*)(w + (size_t)k * 6 * D);
                a0 += sl[k] * wv; a1 += sl[D + k] * wv; a2 += sl[2 * D + k] * wv; }
#pragma unroll
            for (int i = 0; i < 4; ++i) { a0[i] += __shfl_xor(a0[i], 16); a0[i] += __shfl_xor(a0[i], 32); a1[i] += __shfl_xor(a1[i], 16); a1[i] += __shfl_xor(a1[i], 32); a2[i] += __shfl_xor(a2[i], 16); a2[i] += __shfl_xor(a2[i], 32); }
            if (kq == 0) { *(LAS f32x4*)(red + (F.wave * 3 + 0) * 64 + 4 * c4) = a0; *(LAS f32x4*)(red + (F.wave * 3 + 1) * 64 + 4 * c4) = a1; *(LAS f32x4*)(red + (F.wave * 3 + 2) * 64 + 4 * c4) = a2; }
            __syncthreads();
            if (F.wave < 3) { const int n = n0 + F.lane; float sacc = A.in[P_ADAB][l * 6 * D + n];
#pragma unroll
                for (int w8 = 0; w8 < 8; ++w8) sacc += red[(w8 * 3 + F.wave) * 64 + F.lane];
                mod[(l * 3 + F.wave) * 6 * D + n] = sacc; }
            __syncthreads();
            if (it < 32 && F.tid == 0) { __builtin_amdgcn_fence(__ATOMIC_RELEASE, "agent"); (void)xb_add((unsigned*)(A.ws + WS_CTL) + 2050, 1u); }
        }
    }
    constexpr int I0 = (D / 64) * ((NIN0 + 63) / 64), I1 = (D / 64) * (D / 64), I2 = (D / 64) * (NCIN / 64), I3 = I1;
    for (int it = F.ngw - 1 - F.gw; it < I0 + I1 + I2 + I3; it += F.ngw) {
        int r = it;
        if (r < I0) { tr_plain(F, A, A.in[P_GWIN], D, NIN0, win0, r, scr); continue; } r -= I0;
        if (r < I1) { tr_plain(F, A, A.in[P_GWOUT], D, D, wout0, r, scr); continue; } r -= I1;
        if (r < I2) {
            constexpr int nblk = NCIN / 64; const int kb = r / nblk, n0 = 64 * (r % nblk), sct = n0 >> 10, ch = n0 & 1023, cb = ch >> 8, hf = (ch >> 7) & 1;
            const int drow0 = sct == 0 ? (3 * cb + 2) * 256 + (ch & 255) : (3 * cb + hf) * 256 + 128 * (sct - 1) + (ch & 127);
            tr_item(A.in[P_CWIN], NCIN, 64 * kb, n0, wcin, D, drow0, scr, F.lane); continue; } r -= I2;
        tr_plain(F, A, A.in[P_CWOUT], D, D, wcout, r, scr);
    }
    { u32x4* z = (u32x4*)(win0 + (size_t)NIN0 * D); const int n16 = (NIN0P - NIN0) * D * 2 / 16;
      for (int i = F.gw * 64 + F.lane; i < n16; i += F.ngw * 64) z[i] = (u32x4){0u, 0u, 0u, 0u}; }
}

__device__ __forceinline__ void normmod_row(const f32x4 (&v)[4], const float* g, const float* sh, const float* sc, bf16_t* orow, int lane) {
    float s = 0.f;
#pragma unroll
    for (int j = 0; j < 4; ++j) s += (v[j].x * v[j].x + v[j].y * v[j].y) + (v[j].z * v[j].z + v[j].w * v[j].w);
    const float rstd = rsqrtf(wave_sum(s) * (1.f / D) + EPS);
#pragma unroll
    for (int j = 0; j < 4; ++j) { const int c = 4 * lane + 256 * j;
        const f32x4 gg = *(const f32x4*)(g + c), s1 = *(const f32x4*)(sh + c), s2 = *(const f32x4*)(sc + c);
        const f32x4 y = v[j] * rstd * gg * (s2 + 1.f) + s1;
        u32x2 w; w.x = pk2(y.x, y.y); w.y = pk2(y.z, y.w);
        *(u32x2*)(orow + c) = w; }
}
__device__ __forceinline__ void ph_norm0(Frame& F, const Args& A) {
    const float* mod = (const float*)(A.ws + WS_MOD); bf16_t* H = (bf16_t*)(A.ws + WS_H);
    int scur = -1; f32x4 pg[4], p1[4], p2[4];
    for (int row = F.gw; row < NROW; row += 2 * F.ngw) {
        const int row2 = row + F.ngw; const bool has2 = row2 < NROW;
        const float* xa = row < NLAT ? A.in[P_X] + (size_t)row * D : A.in[P_CTX] + (size_t)(row - NLAT) * D;
        const int r2c = has2 ? row2 : row;
        const float* xb = r2c < NLAT ? A.in[P_X] + (size_t)r2c * D : A.in[P_CTX] + (size_t)(r2c - NLAT) * D;
        f32x4 va[4], vb[4];
#pragma unroll
        for (int j = 0; j < 4; ++j) { va[j] = *(const f32x4*)(xa + 4 * F.lane + 256 * j); vb[j] = *(const f32x4*)(xb + 4 * F.lane + 256 * j); }
#pragma unroll
        for (int h = 0; h < 2; ++h) {
            const int r = h ? r2c : row; if (h && !has2) break;
            const int sset = r < NLAT ? (r >> 14) : 2;
            if (sset != scur) { scur = sset;
#pragma unroll
                for (int j = 0; j < 4; ++j) { const int c = 4 * F.lane + 256 * j; pg[j] = *(const f32x4*)(A.in[P_NORMG] + c);
                    p1[j] = *(const f32x4*)(mod + (0 * 3 + sset) * 6 * D + 0 * D + c); p2[j] = *(const f32x4*)(mod + (0 * 3 + sset) * 6 * D + 1 * D + c) + 1.f; } }
            float ssq = 0.f;
#pragma unroll
            for (int j = 0; j < 4; ++j) { const f32x4 v = h ? vb[j] : va[j]; ssq += (v.x * v.x + v.y * v.y) + (v.z * v.z + v.w * v.w); }
            const float rstd = rsqrtf(wave_sum(ssq) * (1.f / D) + EPS);
#pragma unroll
            for (int j = 0; j < 4; ++j) { const f32x4 v = h ? vb[j] : va[j]; const f32x4 y = v * rstd * pg[j] * p2[j] + p1[j];
                u32x2 w; w.x = pk2(y.x, y.y); w.y = pk2(y.z, y.w); *(u32x2*)(H + (size_t)r * D + 4 * F.lane + 256 * j) = w; }
        }
    }
}

__device__ __forceinline__ int jperm(int ks, int fq, int jj) { return 32 * ks + 16 * (jj >> 2) + 4 * fq + (jj & 3); }
__device__ __forceinline__ bf16x8 ldfrag(const unsigned char* blob, int blk, int lane) { return *(const bf16x8*)(blob + blk * 1024 + lane * 16); }
__device__ __forceinline__ unsigned cvtpk(float lo, float hi) { return pk2(lo, hi); }
__device__ __forceinline__ bf16x8 pack8(const f32x4& a, const f32x4& b) {
    u32x4 w; w.x = cvtpk(a[0], a[1]); w.y = cvtpk(a[2], a[3]); w.z = cvtpk(b[0], b[1]); w.w = cvtpk(b[2], b[3]);
    return __builtin_bit_cast(bf16x8, w);
}
__device__ __forceinline__ void ph_gla_prep(Frame& F, const Args& A) {
    constexpr int LSTR = 1040;
    LAS unsigned char* QS = F.lds; LAS unsigned char* KS = F.lds + 64 * LSTR;
    const bf16_t* qk = (const bf16_t*)(A.ws + WS_QK); const float* afb = (const float*)(A.ws + WS_AFB);
    float* gam = (float*)(A.ws + WS_GAM);
    const bool has_conv = blockIdx.x + 4 * F.G >= 2 * NCHUNK;
    const int pre = has_conv ? (int)(blockIdx.x & 3) : 0;
    if (pre == 1) convert_expert_fixed<1>(A, F.lds, F.tid, F.wave, F.lane);
    else if (pre == 2) convert_expert_fixed<2>(A, F.lds, F.tid, F.wave, F.lane);
    else if (pre == 3) convert_expert_fixed<3>(A, F.lds, F.tid, F.wave, F.lane);
    __syncthreads();
    const int dir = blockIdx.x & 1, d = F.tid;
    f32x2 w2[8];
#pragma unroll
    for (int r = 0; r < 8; ++r) { w2[r].x = A.in[P_GWA2][(dir * 16 + 2 * r) * DK + d]; w2[r].y = A.in[P_GWA2][(dir * 16 + 2 * r + 1) * DK + d]; }
    const float bias = A.in[P_GBA2][dir * DK + d];
    u32x4 t16[16]; f32x4 av = (f32x4){0.f, 0.f, 0.f, 0.f};
#define PREP_LOAD(it_) do { const int row0_ = ((it_) >> 1) * 64; \
        _Pragma("unroll") for (int u = 0; u < 16; ++u) { const int q16 = F.tid + NTHR * u, j = q16 >> 7, cp = q16 & 127; t16[u] = *(const u32x4*)((const unsigned char*)qk + ((size_t)(row0_ + j) * D) * 2 + cp * 16); } \
        if (F.tid < 256) av = *(const f32x4*)(afb + (size_t)(row0_ + (F.tid >> 2)) * 32 + dir * 16 + 4 * (F.tid & 3)); } while (0)
    if ((int)blockIdx.x < 2 * NCHUNK) PREP_LOAD((int)blockIdx.x);
    for (int item = blockIdx.x; item < 2 * NCHUNK; item += F.G) {
        {
            const int ch = item >> 1, row0 = ch * 64; (void)row0;
            LAS float* AFL = (LAS float*)(F.lds + 2 * 64 * LSTR);
            {
#pragma unroll
                for (int u = 0; u < 16; ++u) { const int q16 = F.tid + NTHR * u, j = q16 >> 7, cp = q16 & 127; *(LAS u32x4*)(((cp < 64) ? QS : KS) + j * LSTR + (cp & 63) * 16) = t16[u]; }
                if (F.tid < 256) *(LAS f32x4*)(AFL + (F.tid >> 2) * 16 + 4 * (F.tid & 3)) = av;
            }
            if (item + F.G < 2 * NCHUNK) PREP_LOAD(item + F.G);
            __syncthreads();
            float cum2 = 0.f;
#pragma unroll 1
            for (int jq = 0; jq < 64; jq += 4) {
                f32x4 ar[4][4]; unsigned qv[4], kv[4];
#pragma unroll
                for (int u = 0; u < 4; ++u) { const int j = dir ? 63 - (jq + u) : jq + u;
#pragma unroll
                    for (int r4 = 0; r4 < 4; ++r4) ar[u][r4] = *(const LAS f32x4*)(AFL + j * 16 + 4 * r4); }
#pragma unroll
                for (int u = 0; u < 4; ++u) { const int j = dir ? 63 - (jq + u) : jq + u;
                    qv[u] = *(const LAS bf16_t*)(QS + j * LSTR + d * 2); kv[u] = *(const LAS bf16_t*)(KS + j * LSTR + d * 2); }
                asm volatile("" ::: "memory");
                float ls2[4];
#pragma unroll
                for (int u = 0; u < 4; ++u) {
                    f32x2 za = (f32x2){bias, 0.f}, zb = (f32x2){0.f, 0.f};
#pragma unroll
                    for (int r4 = 0; r4 < 4; ++r4) { za = __builtin_elementwise_fma((f32x2){ar[u][r4].x, ar[u][r4].y}, w2[2 * r4], za); zb = __builtin_elementwise_fma((f32x2){ar[u][r4].z, ar[u][r4].w}, w2[2 * r4 + 1], zb); }
                    const float z = (za.x + za.y) + (zb.x + zb.y);
                    const float zl = z * 1.4426950408889634f;
                    ls2[u] = fminf(zl, 0.f) - __builtin_amdgcn_logf(1.f + __builtin_amdgcn_exp2f(-fabsf(zl)));
                }
                unsigned qk2[4];
#pragma unroll
                for (int u = 0; u < 4; ++u) {
                    cum2 += ls2[u] * (1.f / 16.f);
                    const float e = __builtin_amdgcn_exp2f(cum2), ei = __builtin_amdgcn_exp2f(-cum2);
                    qk2[u] = pk2(bflo(qv[u]) * e, bflo(kv[u]) * ei);
                }
#pragma unroll
                for (int u = 0; u < 4; ++u) { const int j = dir ? 63 - (jq + u) : jq + u;
                    *(LAS bf16_t*)(QS + j * LSTR + d * 2) = (bf16_t)(qk2[u] & 0xffffu); *(LAS bf16_t*)(KS + j * LSTR + d * 2) = (bf16_t)(qk2[u] >> 16); }
            }
            const float cum = cum2 * 0.6931471805599453f;
            gam[((size_t)dir * NCHUNK + ch) * DK + d] = __expf(cum);
            __syncthreads();
            {
                const int fr = F.lane & 15, fq = F.lane >> 4;
                unsigned char* blob0 = A.ws + (((size_t)dir * NCHUNK + ch) * 4) * BLOB + (size_t)F.tid * 16;
#pragma unroll
                for (int typ = 0; typ < 2; ++typ) {
                    const LAS unsigned char* src = (typ == 0) ? QS : KS;
                    u32x4 o[8];
#pragma unroll
                    for (int i8 = 0; i8 < 8; ++i8) { const int h = i8 >> 1, blk = F.wave + 8 * (i8 & 1), it = blk >> 2, sd = blk & 3, i = 16 * it + fr, d0 = h * HK + 32 * sd + 4 * fq;
                        const u32x2 lo = *(const LAS u32x2*)(src + i * LSTR + d0 * 2), hi = *(const LAS u32x2*)(src + i * LSTR + (d0 + 16) * 2);
                        o[i8].x = lo.x; o[i8].y = lo.y; o[i8].z = hi.x; o[i8].w = hi.y; }
                    unsigned char* dst = blob0 + (typ == 0 ? WS_QP : WS_KP);
#pragma unroll
                    for (int i8 = 0; i8 < 8; ++i8) *(u32x4*)(dst + (size_t)(i8 >> 1) * BLOB + (size_t)(i8 & 1) * 8192) = o[i8];
                }
                {
                    u32x4 o[8];
#pragma unroll
                    for (int i8 = 0; i8 < 8; ++i8) { const int h = i8 >> 1, blk = F.wave + 8 * (i8 & 1), mt = blk >> 1, ks = blk & 1, dd = h * HK + 16 * mt + fr; unsigned e[8];
#pragma unroll
                        for (int jj = 0; jj < 8; ++jj) e[jj] = *(const LAS bf16_t*)(KS + jperm(ks, fq, jj) * LSTR + dd * 2);
                        o[i8].x = e[0] | (e[1] << 16); o[i8].y = e[2] | (e[3] << 16); o[i8].z = e[4] | (e[5] << 16); o[i8].w = e[6] | (e[7] << 16); }
                    unsigned char* dst = blob0 + WS_KTP;
#pragma unroll
                    for (int i8 = 0; i8 < 8; ++i8) *(u32x4*)(dst + (size_t)(i8 >> 1) * BLOB + (size_t)(i8 & 1) * 8192) = o[i8];
                }
            }
            __syncthreads();
        }
    }
#undef PREP_LOAD
    if (has_conv) {
        if (pre == 0) convert_expert_fixed<4>(A, F.lds, F.tid, F.wave, F.lane);
        else if (pre == 1) convert_expert_fixed<3>(A, F.lds, F.tid, F.wave, F.lane);
        else if (pre == 2) convert_expert_fixed<2>(A, F.lds, F.tid, F.wave, F.lane);
        else convert_expert_fixed<1>(A, F.lds, F.tid, F.wave, F.lane);
    }
}

#define MFMA16(a, b, c) __builtin_amdgcn_mfma_f32_16x16x32_bf16((a), (b), (c), 0, 0, 0)
__device__ __forceinline__ void gla_intra_item(Frame& F, const Args& A, int item) {
    const int ch = item >> 2, h = item & 3, fr = F.lane & 15, fq = F.lane >> 4;
    const unsigned char* qpf = A.ws + WS_QP + (((size_t)0 * NCHUNK + ch) * 4 + h) * BLOB; const unsigned char* kpf = A.ws + WS_KP + (((size_t)0 * NCHUNK + ch) * 4 + h) * BLOB;
    const unsigned char* qpb = A.ws + WS_QP + (((size_t)1 * NCHUNK + ch) * 4 + h) * BLOB; const unsigned char* kpb = A.ws + WS_KP + (((size_t)1 * NCHUNK + ch) * 4 + h) * BLOB;
    bf16x8 Pf[4][2];
#pragma unroll
    for (int it = 0; it < 4; ++it) {
        f32x4 P[4];
#pragma unroll
        for (int jt = 0; jt < 4; ++jt) P[jt] = (f32x4){0.f, 0.f, 0.f, 0.f};
#pragma unroll
        for (int dirp = 0; dirp < 2; ++dirp) {
            const unsigned char* qp = dirp ? qpb : qpf; const unsigned char* kp = dirp ? kpb : kpf;
            bf16x8 kk[16], qq[4];
#pragma unroll
            for (int sd = 0; sd < 4; ++sd) qq[sd] = ldfrag(qp, it * 4 + sd, F.lane);
#pragma unroll
            for (int jt = 0; jt < 4; ++jt) if (dirp ? (jt >= it) : (jt <= it)) {
#pragma unroll
                for (int sd = 0; sd < 4; ++sd) kk[jt * 4 + sd] = ldfrag(kp, jt * 4 + sd, F.lane); }
#pragma unroll
            for (int jt = 0; jt < 4; ++jt) if (dirp ? (jt >= it) : (jt <= it)) {
                f32x4 a = (f32x4){0.f, 0.f, 0.f, 0.f};
#pragma unroll
                for (int sd = 0; sd < 4; ++sd) a = MFMA16(kk[jt * 4 + sd], qq[sd], a);
                if (jt == it) {
#pragma unroll
                    for (int r = 0; r < 4; ++r) { const int j = 4 * fq + r; const bool keep = dirp ? (j >= fr) : (j <= fr); a[r] = keep ? a[r] : 0.f; }
                }
                P[jt] += a;
            }
        }
        Pf[it][0] = pack8(P[0], P[1]); Pf[it][1] = pack8(P[2], P[3]);
    }
    const unsigned char* vt = A.ws + WS_VTP + (size_t)ch * 131072 + (size_t)(h * 16) * 2048;
    bf16_t* oi = (bf16_t*)(A.ws + WS_OI) + (size_t)(ch * 64 + fr) * DV + h * HV + 4 * fq;
#pragma unroll 1
    for (int ng = 0; ng < 4; ++ng) {
        bf16x8 va[8];
#pragma unroll
        for (int i = 0; i < 8; ++i) va[i] = ldfrag(vt, ng * 8 + i, F.lane);
#pragma unroll
        for (int n4 = 0; n4 < 4; ++n4)
#pragma unroll
            for (int it = 0; it < 4; ++it) {
                f32x4 acc = (f32x4){0.f, 0.f, 0.f, 0.f};
                acc = MFMA16(va[n4 * 2], Pf[it][0], acc); acc = MFMA16(va[n4 * 2 + 1], Pf[it][1], acc);
                u32x2 w; w.x = pk2(acc[0], acc[1]); w.y = pk2(acc[2], acc[3]);
                *(u32x2*)(oi + (size_t)(16 * it) * DV + 16 * (ng * 4 + n4)) = w;
            }
    }
}
struct ScanRegs { bf16x8 q[4], k[4], v[2][2]; f32x4 g[2]; };
__device__ __forceinline__ int scan_chunk(int b, int dir, int step) { return step >= 4 ? (256 * b + (dir ? 255 - (step - 4) : step - 4)) : (512 + 4 * b + (dir ? 3 - step : step)); }
__device__ __forceinline__ void scan_load(const Args& A, ScanRegs& R, int b, int h, int dir, int sp, int w, int step, int lane) {
    const int ch = scan_chunk(b, dir, step), fq = lane >> 4;
    const size_t bo = (((size_t)dir * NCHUNK + ch) * 4 + h) * BLOB;
    const unsigned char* qp = A.ws + WS_QP + bo; const unsigned char* ktp = A.ws + WS_KTP + bo;
    const unsigned char* vt = A.ws + WS_VTP + (size_t)ch * 131072 + (size_t)(h * 16 + 2 * sp) * 2048;
    const float* gp = (const float*)(A.ws + WS_GAM) + ((size_t)dir * NCHUNK + ch) * DK + h * HK + 32 * w + 4 * fq;
#pragma unroll
    for (int sd = 0; sd < 4; ++sd) R.q[sd] = ldfrag(qp, w * 4 + sd, lane);
#pragma unroll
    for (int m = 0; m < 2; ++m)
#pragma unroll
        for (int ks = 0; ks < 2; ++ks) R.k[m * 2 + ks] = ldfrag(ktp, (2 * w + m) * 2 + ks, lane);
#pragma unroll
    for (int s2 = 0; s2 < 2; ++s2) {
        const int o = 8 * ((lane & 15) >> 2) + 4 * s2 + (lane & 3);
        const unsigned char* vp = vt + (o >> 4) * 2048 + ((o & 15) + (lane & 48)) * 16;
        R.v[s2][0] = *(const bf16x8*)(vp); R.v[s2][1] = *(const bf16x8*)(vp + 1024); }
    R.g[0] = *(const f32x4*)(gp); R.g[1] = *(const f32x4*)(gp + 16);
}
#define LDS_ORDER() asm volatile("" ::: "memory")
__device__ __forceinline__ void scan_ds(const ScanRegs& R, f32x4 (&dS)[2][2]) {
#pragma unroll
    for (int s2 = 0; s2 < 2; ++s2)
#pragma unroll
        for (int m = 0; m < 2; ++m) { f32x4 d = (f32x4){0.f, 0.f, 0.f, 0.f}; d = MFMA16(R.k[m * 2], R.v[s2][0], d); d = MFMA16(R.k[m * 2 + 1], R.v[s2][1], d); dS[s2][m] = d; }
}
__device__ __forceinline__ void scan_step(const Args& A, const ScanRegs& R, const ScanRegs& Rn, f32x4 (&S)[2][2], f32x4 (&dS)[2][2], LAS unsigned char* xs, LAS unsigned* flags, bf16_t* O, int b, int h, int dir, int sp, int w, int step, int lane) {
    const int fr = lane & 15, fq = lane >> 4;
#pragma unroll
    for (int s2 = 0; s2 < 2; ++s2) {
        S[s2][0] = R.g[0] * (S[s2][0] + dS[s2][0]); S[s2][1] = R.g[1] * (S[s2][1] + dS[s2][1]);
        *(volatile LAS bf16x8*)(xs + ((step + 1) & 3) * 8192 + (s2 * 4 + w) * 1024 + lane * 16) = pack8(S[s2][0], S[s2][1]);
    }
    LDS_ORDER();
    if (lane == 0) *(volatile LAS unsigned*)(flags + w) = (unsigned)step + 2u;
    LDS_ORDER();
    scan_ds(Rn, dS);
    if (step >= 4) {
        { const unsigned need = (unsigned)step + 1u; unsigned spn = 0;
          for (;;) { const unsigned f = (lane < 4) ? *(volatile LAS unsigned*)(flags + lane) : need;
              if (__all((int)(f >= need))) break; if (++spn > (1u << 26)) break; }
          LDS_ORDER(); }
        const LAS unsigned char* slot = xs + (step & 3) * 8192 + lane * 16;
        bf16x8 sf[2][4];
#pragma unroll
        for (int s2 = 0; s2 < 2; ++s2)
#pragma unroll
            for (int sd = 0; sd < 4; ++sd) sf[s2][sd] = *(const LAS bf16x8*)(slot + (s2 * 4 + sd) * 1024);
        LDS_ORDER();
        const int ch = scan_chunk(b, dir, step);
        f32x4 acc0 = (f32x4){0.f, 0.f, 0.f, 0.f}, acc1 = acc0;
#pragma unroll
        for (int sd = 0; sd < 4; ++sd) { acc0 = MFMA16(sf[0][sd], R.q[sd], acc0); acc1 = MFMA16(sf[1][sd], R.q[sd], acc1); }
        u32x4 wv; wv.x = pk2(acc0[0], acc0[1]); wv.y = pk2(acc0[2], acc0[3]); wv.z = pk2(acc1[0], acc1[1]); wv.w = pk2(acc1[2], acc1[3]);
        *(u32x4*)(O + (size_t)(ch * 64 + 16 * w + fr) * DV + h * HV + 32 * sp + 8 * fq) = wv;
    }
}
__device__ __forceinline__ void gla_scan_item(Frame& F, const Args& A, int item, LAS unsigned char* xs, LAS unsigned* flags) {
    const int chain = item >> 3, sp = item & 7, b = chain >> 3, h = (chain >> 1) & 3, dir = chain & 1, w = F.wave;
    bf16_t* O = (bf16_t*)(A.ws + (dir ? WS_OB : WS_OF));
    f32x4 S[2][2], dS[2][2];
#pragma unroll
    for (int s2 = 0; s2 < 2; ++s2) { S[s2][0] = (f32x4){0.f, 0.f, 0.f, 0.f}; S[s2][1] = S[s2][0];
        *(volatile LAS bf16x8*)(xs + (s2 * 4 + w) * 1024 + F.lane * 16) = pack8(S[s2][0], S[s2][1]); }
    LDS_ORDER();
    if (F.lane == 0) *(volatile LAS unsigned*)(flags + w) = 1u;
    LDS_ORDER();
    ScanRegs Ra, Rb, Rc;
    scan_load(A, Ra, b, h, dir, sp, w, 0, F.lane);
    scan_load(A, Rb, b, h, dir, sp, w, 1, F.lane);
    scan_ds(Ra, dS);
    for (int step = 0; step < 261; step += 3) {
        scan_load(A, Rc, b, h, dir, sp, w, min(step + 2, 259), F.lane);
        scan_step(A, Ra, Rb, S, dS, xs, flags, O, b, h, dir, sp, w, step, F.lane);
        scan_load(A, Ra, b, h, dir, sp, w, min(step + 3, 259), F.lane);
        scan_step(A, Rb, Rc, S, dS, xs, flags, O, b, h, dir, sp, w, step + 1, F.lane);
        scan_load(A, Rb, b, h, dir, sp, w, min(step + 4, 259), F.lane);
        if (step + 2 < 260) scan_step(A, Rc, Ra, S, dS, xs, flags, O, b, h, dir, sp, w, step + 2, F.lane);
    }
}
__device__ __forceinline__ void ph_gla_main(Frame& F, const Args& A) {
    LAS unsigned char* xs = F.lds; LAS unsigned* flags = (LAS unsigned*)(F.lds + 32768);
    if (F.tid < 16) flags[F.tid] = 0u;
    __syncthreads();
    const int bi = blockIdx.x;
    unsigned* ctr = (unsigned*)(A.ws + WS_CTL) + 2048;
    volatile LAS int* slot = (volatile LAS int*)(F.lds + 40960);
    if (bi < 128) {
        if (F.wave < 4) gla_scan_item(F, A, ((2 * (bi & 7) + ((bi >> 3) & 1)) << 3) | ((bi >> 4) & 7), xs, flags);
        __syncthreads();
    } else {
        const int sw = (bi - 128) * NWAVES + F.wave, nsw = (F.G - 128) * NWAVES;
        for (int it = sw; it < 512 * 4; it += nsw) gla_intra_item(F, A, it);
        __syncthreads();
    }
    convert_expert_dyn(A, ctr, 2 * N_EXPERT_ITEMS, F.lds + 49152, slot, F.tid, F.wave, F.lane);
    __syncthreads();
}

__device__ __forceinline__ void ph_gla_finish(Frame& F, const Args& A) {
    const bf16_t* rp = (const bf16_t*)(A.ws + WS_R); const bf16_t* OFp = (const bf16_t*)(A.ws + WS_OF); const bf16_t* OBp = (const bf16_t*)(A.ws + WS_OB); const bf16_t* OIp = (const bf16_t*)(A.ws + WS_OI);
    bf16_t* Hh = (bf16_t*)(A.ws + WS_H);
    const f32x4 gn = *(const f32x4*)(A.in[P_GNORMG] + 4 * F.lane);
    for (int row = F.gw; row < NLAT; row += 2 * F.ngw) {
        u32x2 a[2][4], bq[2][4], ci[2][4], rr[2][4];
#pragma unroll
        for (int h2 = 0; h2 < 2; ++h2)
#pragma unroll
            for (int j = 0; j < 4; ++j) { const size_t o = (size_t)(row + h2 * F.ngw) * DV + 4 * F.lane + 256 * j;
                a[h2][j] = *(const u32x2*)(OFp + o); bq[h2][j] = *(const u32x2*)(OBp + o); ci[h2][j] = *(const u32x2*)(OIp + o); rr[h2][j] = *(const u32x2*)(rp + o); }
#pragma unroll
        for (int h2 = 0; h2 < 2; ++h2)
#pragma unroll
            for (int j = 0; j < 4; ++j) {
                const u32x2 av = a[h2][j], bv = bq[h2][j], cv = ci[h2][j], rv = rr[h2][j];
                f32x4 o; o.x = bflo(av.x) + bflo(bv.x) + bflo(cv.x); o.y = bfhi(av.x) + bfhi(bv.x) + bfhi(cv.x); o.z = bflo(av.y) + bflo(bv.y) + bflo(cv.y); o.w = bfhi(av.y) + bfhi(bv.y) + bfhi(cv.y);
                const float ss = wave_sum((o.x * o.x + o.y * o.y) + (o.z * o.z + o.w * o.w));
                const float rstd = rsqrtf(ss * (1.f / HV) + EPS);
                f32x4 r; r.x = bflo(rv.x); r.y = bfhi(rv.x); r.z = bflo(rv.y); r.w = bfhi(rv.y);
                f32x4 y;
#pragma unroll
                for (int i = 0; i < 4; ++i) y[i] = o[i] * rstd * gn[i] * silu_f(r[i]);
                u32x2 w; w.x = pk2(y.x, y.y); w.y = pk2(y.z, y.w);
                *(u32x2*)(Hh + (size_t)(row + h2 * F.ngw) * D + 4 * F.lane + 256 * j) = w;
            }
    }
}

__device__ __forceinline__ void stage_router(Frame& F, const Args& A, int l) {
    LAS float* wl = (LAS float*)F.lds;
    const float* rw = A.in[P_ROUTER] + (size_t)l * D * NE;
    for (int idx = F.tid; idx < D * NE; idx += NTHR) { const int k = idx >> 4, e = idx & 15, j = k >> 8, ln = (k & 255) >> 2, i = k & 3; wl[((((j * 4 + i) * 4 + (e >> 2)) * 64) + ln) * 4 + (e & 3)] = rw[idx]; }
    __syncthreads();
}
template <int N, int M>
__device__ __forceinline__ void rs_step(const float (&v)[N], float (&w)[N / 2], int lane) {
    const bool hi = (lane & M) != 0;
#pragma unroll
    for (int e = 0; e < N / 2; ++e) { const float mine = hi ? v[N / 2 + e] : v[e], other = hi ? v[e] : v[N / 2 + e]; w[e] = mine + __shfl_xor(other, M); }
}
__device__ __forceinline__ void ph_norm2_router(Frame& F, const Args& A, int l) {
    const float* mod = (const float*)(A.ws + WS_MOD); unsigned char* H8 = A.ws + WS_H; const bf16_t* X = (const bf16_t*)(A.ws + WS_X); float* aff = (float*)(A.ws + WS_AFF);
    const float* g = A.in[P_NORMG] + (l * 2 + 1) * D; const float* rw = A.in[P_ROUTER] + (size_t)l * D * NE;
    LAS unsigned char* WF = F.lds;
    LAS float* GS = (LAS float*)(F.lds + 65536); LAS float* SH = GS + D; LAS float* CB = SH + D; LAS float* RED = CB + 16;
    const int fr = F.lane & 15, fq = F.lane >> 4;
    const int b = (int)((blockIdx.x * NWAVES * 16) >> 14);
    const float* sh = mod + (l * 3 + b) * 6 * D + 3 * D; const float* sc = mod + (l * 3 + b) * 6 * D + 4 * D;
    u32x4 xv[32];
    if (F.gw < NLAT / 16) { const bf16_t* xr0 = X + (size_t)(F.gw * 16 + fr) * D + 8 * fq;
#pragma unroll
        for (int s = 0; s < 32; ++s) xv[s] = *(const u32x4*)(xr0 + 32 * s); }
    for (int k = F.tid; k < D; k += NTHR) { GS[k] = g[k] * (1.f + sc[k]); SH[k] = sh[k]; }
    __syncthreads();
    for (int p = F.tid; p < 32 * 64; p += NTHR) {
        const int s = p >> 6, ln = p & 63, e = ln & 15, k0 = 32 * s + 8 * (ln >> 4);
        float w[8];
#pragma unroll
        for (int i = 0; i < 8; ++i) w[i] = rw[(k0 + i) * NE + e] * GS[k0 + i];
        u32x4 hi, lo;
        hi.x = pk2(w[0], w[1]); hi.y = pk2(w[2], w[3]); hi.z = pk2(w[4], w[5]); hi.w = pk2(w[6], w[7]);
        lo.x = pk2(w[0] - bflo(hi.x), w[1] - bfhi(hi.x)); lo.y = pk2(w[2] - bflo(hi.y), w[3] - bfhi(hi.y)); lo.z = pk2(w[4] - bflo(hi.z), w[5] - bfhi(hi.z)); lo.w = pk2(w[6] - bflo(hi.w), w[7] - bfhi(hi.w));
        *(LAS u32x4*)(WF + ((s * 2 + 0) * 64 + ln) * 16) = hi; *(LAS u32x4*)(WF + ((s * 2 + 1) * 64 + ln) * 16) = lo;
    }
    { const int e = F.tid & 15, part = F.tid >> 4; float acc = 0.f;
#pragma unroll 8
      for (int i = 0; i < 32; ++i) { const int k = part * 32 + i; acc += SH[k] * rw[k * NE + e]; }
      RED[part * 16 + e] = acc; }
    __syncthreads();
    if (F.tid < 16) { float acc = 0.f;
#pragma unroll
        for (int q = 0; q < 32; ++q) acc += RED[q * 16 + F.tid];
        CB[F.tid] = acc; }
    __syncthreads();
    for (int grp = F.gw; grp < NLAT / 16; grp += F.ngw) {
        const int row0 = grp * 16, row = row0 + fr;
        if (grp != F.gw) { const bf16_t* xr = X + (size_t)row * D + 8 * fq;
#pragma unroll
            for (int s = 0; s < 32; ++s) xv[s] = *(const u32x4*)(xr + 32 * s); }
        f32x2 ss2 = (f32x2){0.f, 0.f};
        f32x4 acc = (f32x4){0.f, 0.f, 0.f, 0.f};
#pragma unroll
        for (int s = 0; s < 32; ++s) {
            const u32x4 t = xv[s];
            const f32x2 a0 = {bflo(t.x), bfhi(t.x)}, a1 = {bflo(t.y), bfhi(t.y)}, a2 = {bflo(t.z), bfhi(t.z)}, a3 = {bflo(t.w), bfhi(t.w)};
            ss2 = __builtin_elementwise_fma(a0, a0, ss2); ss2 = __builtin_elementwise_fma(a1, a1, ss2); ss2 = __builtin_elementwise_fma(a2, a2, ss2); ss2 = __builtin_elementwise_fma(a3, a3, ss2);
            const bf16x8 xb = __builtin_bit_cast(bf16x8, t);
            acc = MFMA16(*(const LAS bf16x8*)(WF + ((s * 2 + 0) * 64 + F.lane) * 16), xb, acc);
            acc = MFMA16(*(const LAS bf16x8*)(WF + ((s * 2 + 1) * 64 + F.lane) * 16), xb, acc);
            if ((s & 1) == 1) asm volatile("" ::: "memory");
        }
#pragma unroll
        for (int s = 0; s < 32; ++s) asm volatile("" : "+v"(xv[s]));
        float ss = ss2.x + ss2.y; ss += __shfl_xor(ss, 16); ss += __shfl_xor(ss, 32);
        const float rstd = rsqrtf(ss * (1.f / D) + EPS);
        float lg[4]; float mx = -3.0e38f;
#pragma unroll
        for (int r = 0; r < 4; ++r) { lg[r] = rstd * acc[r] + CB[4 * fq + r]; mx = fmaxf(mx, lg[r]); }
        mx = fmaxf(mx, __shfl_xor(mx, 16)); mx = fmaxf(mx, __shfl_xor(mx, 32));
        float ex[4], den = 0.f;
#pragma unroll
        for (int r = 0; r < 4; ++r) { ex[r] = __expf(lg[r] - mx); den += ex[r]; }
        den += __shfl_xor(den, 16); den += __shfl_xor(den, 32);
        const float inv = 1.f / den; const int t = row & (T - 1);
#pragma unroll
        for (int r = 0; r < 4; ++r) aff[((size_t)b * NE + 4 * fq + r) * T + t] = ex[r] * inv;
        unsigned char* hr = H8 + (size_t)row * D + 8 * fq;
#pragma unroll
        for (int s = 0; s < 32; ++s) {
            const u32x4 t4 = xv[s]; const int k0 = 32 * s + 8 * fq;
            const f32x4 g0 = *(const LAS f32x4*)(GS + k0), g1 = *(const LAS f32x4*)(GS + k0 + 4), h0 = *(const LAS f32x4*)(SH + k0), h1 = *(const LAS f32x4*)(SH + k0 + 4);
            f32x4 y0 = (f32x4){bflo(t4.x), bfhi(t4.x), bflo(t4.y), bfhi(t4.y)} * rstd * g0 + h0, y1 = (f32x4){bflo(t4.z), bfhi(t4.z), bflo(t4.w), bfhi(t4.w)} * rstd * g1 + h1;
            const f32x4 lim = (f32x4){448.f, 448.f, 448.f, 448.f};
            y0 = __builtin_elementwise_min(__builtin_elementwise_max(y0, -lim), lim); y1 = __builtin_elementwise_min(__builtin_elementwise_max(y1, -lim), lim);
            int w0 = __builtin_amdgcn_cvt_pk_fp8_f32(y0.x, y0.y, 0, false); w0 = __builtin_amdgcn_cvt_pk_fp8_f32(y0.z, y0.w, w0, true);
            int w1 = __builtin_amdgcn_cvt_pk_fp8_f32(y1.x, y1.y, 0, false); w1 = __builtin_amdgcn_cvt_pk_fp8_f32(y1.z, y1.w, w1, true);
            u32x2 wv; wv.x = (unsigned)w0; wv.y = (unsigned)w1;
            *(u32x2*)(hr + 32 * s) = wv;
            if ((s & 1) == 1) asm volatile("" ::: "memory");
        }
    }
    __syncthreads();
}

__device__ __forceinline__ void ph_topk(Frame& F, const Args& A) {
    LAS int* red = (LAS int*)F.lds;
    const float* aff = (const float*)(A.ws + WS_AFF); int* slot = (int*)(A.ws + WS_SLOT); int* rowlist = (int*)(A.ws + WS_ROWLIST); float* selval = (float*)(A.ws + WS_SELVAL);
    for (int item = blockIdx.x; item < NB * NE; item += F.G) {
        const int b = item / NE, e = item % NE;
        const float* a = aff + ((size_t)b * NE + e) * T + F.tid * 32;
        unsigned v[32];
#pragma unroll
        for (int q = 0; q < 8; ++q) { const u32x4 x = *(const u32x4*)(a + 4 * q); v[4 * q] = x.x; v[4 * q + 1] = x.y; v[4 * q + 2] = x.z; v[4 * q + 3] = x.w; }
        unsigned prefix = 0u; int par = 0;
        for (int bit = 30; bit >= 0; --bit) {
            const unsigned cand = prefix | (1u << bit); int cnt = 0;
#pragma unroll
            for (int i = 0; i < 32; ++i) cnt += (v[i] >= cand) ? 1 : 0;
            cnt = wave_sum_i(cnt);
            if (F.lane == 0) red[par * 16 + F.wave] = cnt;
            __syncthreads();
            int tot = 0;
#pragma unroll
            for (int w8 = 0; w8 < 8; ++w8) tot += red[par * 16 + w8];
            if (tot >= CAP) prefix = cand;
            par ^= 1;
        }
        __syncthreads();
        int mgt = 0, meq = 0;
#pragma unroll
        for (int i = 0; i < 32; ++i) { mgt += (v[i] > prefix) ? 1 : 0; meq += (v[i] == prefix) ? 1 : 0; }
        int igt = mgt, ieq = meq;
#pragma unroll
        for (int o = 1; o < 64; o <<= 1) { const int ug = __shfl_up(igt, o), ue = __shfl_up(ieq, o); if (F.lane >= o) { igt += ug; ieq += ue; } }
        if (F.lane == 63) { red[F.wave] = igt; red[16 + F.wave] = ieq; }
        __syncthreads();
        int bgt = 0, beq = 0, totgt = 0;
#pragma unroll
        for (int w8 = 0; w8 < 8; ++w8) { const int xg = red[w8], xe = red[16 + w8]; if (w8 < F.wave) { bgt += xg; beq += xe; } totgt += xg; }
        const int need_eq = CAP - totgt;
        int gtb = bgt + igt - mgt, eqb = beq + ieq - meq;
        const int t0 = F.tid * 32;
#pragma unroll
        for (int q = 0; q < 2; ++q) {
            int sl[16];
#pragma unroll
            for (int i = 0; i < 16; ++i) {
                const unsigned x = v[q * 16 + i]; const bool gt = x > prefix, eq = x == prefix; const bool sel = gt || (eq && eqb < need_eq);
                const int pos = gtb + (eqb < need_eq ? eqb : need_eq);
                sl[i] = sel ? pos : -1;
                if (sel) { rowlist[e * 4096 + b * CAP + pos] = b * T + t0 + q * 16 + i; selval[e * 4096 + b * CAP + pos] = __builtin_bit_cast(float, x); }
                gtb += gt ? 1 : 0; eqb += eq ? 1 : 0;
            }
#pragma unroll
            for (int i4 = 0; i4 < 4; ++i4) *(i32x4*)(slot + ((size_t)b * NE + e) * T + t0 + q * 16 + 4 * i4) = (i32x4){sl[4 * i4], sl[4 * i4 + 1], sl[4 * i4 + 2], sl[4 * i4 + 3]};
        }
        __syncthreads();
    }
}

__device__ __forceinline__ void ph_combine(Frame& F, const Args& A, int l) {
    const float* mod = (const float*)(A.ws + WS_MOD); bf16_t* X = (bf16_t*)(A.ws + WS_X); bf16_t* H = (bf16_t*)(A.ws + WS_H);
    const int* slot = (const int*)(A.ws + WS_SLOT); const unsigned char* ye = A.ws + WS_YE; const float* selval = (const float*)(A.ws + WS_SELVAL);
    for (int grp = F.gw; grp < NLAT / 16; grp += F.ngw) {
        const int row0 = grp * 16, b = row0 >> 14, t0 = row0 & (T - 1);
        const i32x4 sv4 = *(const i32x4*)(slot + ((size_t)b * NE + (F.lane & 15)) * T + t0 + 4 * (F.lane >> 4));
        f32x4 g2v[4], pa[4], pb[4], pc[4];
#pragma unroll
        for (int j = 0; j < 4; ++j) { const int c = 4 * F.lane + 256 * j;
            g2v[j] = *(const f32x4*)(mod + (l * 3 + b) * 6 * D + 5 * D + c);
            if (l == 0) { pa[j] = *(const f32x4*)(A.in[P_NORMG] + (1 * 2 + 0) * D + c); pb[j] = *(const f32x4*)(mod + (1 * 3 + b) * 6 * D + 0 * D + c); pc[j] = *(const f32x4*)(mod + (1 * 3 + b) * 6 * D + 1 * D + c) + 1.f; }
            else { pa[j] = *(const f32x4*)(A.in[P_FINALG] + c); pb[j] = pa[j]; pc[j] = pa[j]; } }
#pragma unroll 1
        for (int rq = 0; rq < 4; ++rq) {
#pragma unroll
          for (int rh = 0; rh < 2; ++rh) {
            unsigned mask[2]; int yrow[2][4]; float wv[2][4]; u32x2 xr[2][4]; int yv[2][4][4];
#pragma unroll
            for (int p2 = 0; p2 < 2; ++p2) {
                const int ri = 2 * rh + p2, row = row0 + 4 * rq + ri, svr = sv4[ri];
                unsigned m = (unsigned)(__ballot(svr >= 0) >> (16 * rq)) & 0xFFFFu;
                const int e0 = m ? __builtin_ctz(m) : 0;
#pragma unroll
                for (int q = 0; q < 4; ++q) { const bool valid = m != 0u; const int e = valid ? __builtin_ctz(m) : e0; m &= m - 1u;
                    const int sq = __builtin_amdgcn_readlane(svr, 16 * rq + e); yrow[p2][q] = e * 4096 + b * CAP + (sq < 0 ? 0 : sq); wv[p2][q] = valid ? selval[yrow[p2][q]] * (1.f / 32) : 0.f; }
                mask[p2] = m;
#pragma unroll
                for (int j = 0; j < 4; ++j) xr[p2][j] = *(const u32x2*)(X + (size_t)row * D + 4 * F.lane + 256 * j);
#pragma unroll
                for (int q = 0; q < 4; ++q)
#pragma unroll
                    for (int j = 0; j < 4; ++j) yv[p2][q][j] = *(const int*)(ye + (size_t)yrow[p2][q] * D + 4 * F.lane + 256 * j);
            }
#pragma unroll
            for (int p2 = 0; p2 < 2; ++p2) {
                const int ri = 2 * rh + p2, row = row0 + 4 * rq + ri, svr = sv4[ri];
                f32x4 acc[4];
#pragma unroll
                for (int j = 0; j < 4; ++j) acc[j] = (f32x4){0.f, 0.f, 0.f, 0.f};
#pragma unroll
                for (int q = 0; q < 4; ++q)
#pragma unroll
                    for (int j = 0; j < 4; ++j) { const f32x2 lo = __builtin_amdgcn_cvt_pk_f32_fp8(yv[p2][q][j], false), hi = __builtin_amdgcn_cvt_pk_f32_fp8(yv[p2][q][j], true);
                        acc[j].x += wv[p2][q] * lo.x; acc[j].y += wv[p2][q] * lo.y; acc[j].z += wv[p2][q] * hi.x; acc[j].w += wv[p2][q] * hi.y; }
                unsigned m = mask[p2];
                while (m) {
                    const int e = __builtin_ctz(m); m &= m - 1u;
                    const int sq = __builtin_amdgcn_readlane(svr, 16 * rq + e), yr_ = e * 4096 + b * CAP + sq; const float w1 = selval[yr_] * (1.f / 32);
#pragma unroll
                    for (int j = 0; j < 4; ++j) { const int y = *(const int*)(ye + (size_t)yr_ * D + 4 * F.lane + 256 * j); const f32x2 lo = __builtin_amdgcn_cvt_pk_f32_fp8(y, false), hi = __builtin_amdgcn_cvt_pk_f32_fp8(y, true);
                        acc[j].x += w1 * lo.x; acc[j].y += w1 * lo.y; acc[j].z += w1 * hi.x; acc[j].w += w1 * hi.y; }
                }
                f32x4 v[4]; float ssq = 0.f;
#pragma unroll
                for (int j = 0; j < 4; ++j) { const u32x2 t = xr[p2][j]; v[j] = (f32x4){bflo(t.x), bfhi(t.x), bflo(t.y), bfhi(t.y)} + g2v[j] * acc[j];
                    ssq += (v[j].x * v[j].x + v[j].y * v[j].y) + (v[j].z * v[j].z + v[j].w * v[j].w); }
                const float rstd = rsqrtf(wave_sum(ssq) * (1.f / D) + EPS);
                if (l == 0) {
#pragma unroll
                    for (int j = 0; j < 4; ++j) { const int c = 4 * F.lane + 256 * j;
                        u32x2 w; w.x = pk2(v[j].x, v[j].y); w.y = pk2(v[j].z, v[j].w); *(u32x2*)(X + (size_t)row * D + c) = w;
                        const f32x4 y = v[j] * rstd * pa[j] * pc[j] + pb[j];
                        u32x2 hw; hw.x = pk2(y.x, y.y); hw.y = pk2(y.z, y.w); *(u32x2*)(H + (size_t)row * D + c) = hw; }
                } else {
#pragma unroll
                    for (int j = 0; j < 4; ++j) { const int c = 4 * F.lane + 256 * j; *(f32x4*)(A.out + (size_t)row * D + c) = v[j] * rstd * pa[j]; }
                }
            }
          }
        }
    }
}

constexpr int N_PHASES = 20;
__global__ void __launch_bounds__(NTHR, 2) fwd_kernel(Args A) {
    extern __shared__ __attribute__((aligned(16))) unsigned char lds_raw[];
    Frame F;
    F.lds = (LAS unsigned char*)lds_raw;
    F.tid = threadIdx.x; F.lane = F.tid & 63; F.wave = __builtin_amdgcn_readfirstlane(F.tid >> 6);
    F.G = gridDim.x; F.gw = blockIdx.x * NWAVES + F.wave; F.ngw = F.G * NWAVES;
    const int lo = A.ph_lo, hi = A.ph_hi;
#ifdef ONLY_PH
#define IN(k) ((k) == ONLY_PH && lo <= (k) && (k) < hi)
#else
#define IN(k) (lo <= (k) && (k) < hi)
#endif
#if MK_MULTI
#define SEAM(k) do { } while (0)
#else
    cg::grid_group grid = cg::this_grid();
    volatile LAS unsigned* bst = (volatile LAS unsigned*)(F.lds + LDS_BYTES - 64);
    if (F.tid < 16) bst[F.tid] = 0u;
    __syncthreads();
    XcdBarrier xbar = xcd_barrier_post((unsigned*)(A.ws + WS_CTL) + 4096, bst);
    if (lo < 0) { __threadfence(); grid.sync(); }
#define SEAM(k) do { if (IN(k) && IN((k) + 1)) xcd_barrier(xbar); } while (0)
#endif
    const int c = blockIdx.x;
    #define H ((bf16_t*)(A.ws + WS_H))
#define X ((bf16_t*)(A.ws + WS_X))
#define mod ((const float*)(A.ws + WS_MOD))
#define MOE_GU(l) { eng::Gemm g{(const char*)(A.ws + WS_H), (const char*)(A.ws + WS_W8 + (size_t)(l) * W8_LAYER), (const int*)(A.ws + WS_ROWLIST), (size_t)4096 * D, D / 2, 16, 16, NE}; \
        eng::EpiSwiglu E{0x79797979, 0x7F7F7F7F, A.ws + WS_HID}; eng::gemm_phase(F.lds, g, E, F.G, c); }
#define MOE_DN(l) { eng::Gemm g{(const char*)(A.ws + WS_HID), (const char*)(A.ws + WS_W8 + (size_t)(l) * W8_LAYER + W8_WD), nullptr, (size_t)D * DEXP, DEXP / 2, 16, 4, NE}; g.rev = 1; \
        eng::EpiDown E{0x79797979, 0x7D7D7D7D, A.ws + WS_YE}; eng::gemm_phase(F.lds, g, E, F.G, c); }

    if (IN(0)) ph_prep(F, A);
#if MK_MULTI
    SEAM(0);
#else
    if (IN(0) && IN(1)) {
        if (F.tid == 0) { unsigned* mc = (unsigned*)(A.ws + WS_CTL) + 2050; unsigned sp = 0u; while (xb_ld(mc) < 32u && ++sp < XB_SPIN_CAP) __builtin_amdgcn_s_sleep(1);
            __builtin_amdgcn_fence(__ATOMIC_ACQUIRE, "agent"); }
        __syncthreads();
    }
#endif
    if (IN(1)) ph_norm0(F, A);
    SEAM(1);
    if (IN(2)) { eng::Gemm g{(const char*)H, (const char*)(A.ws + WS_WIN0T), nullptr, 0, D, NROW / 256, NIN0P / 256, 1};
        eng::EpiProj0 E{(bf16_t*)(A.ws + WS_QK), A.ws + WS_VTP, (bf16_t*)(A.ws + WS_R), (float*)(A.ws + WS_AFB)}; eng::gemm_phase(F.lds, g, E, F.G, c);
        if (6 * F.G + c >= (NROW / 256) * (NIN0P / 256)) convert_expert_fixed<3>(A, F.lds, F.tid, F.wave, F.lane); }
    SEAM(2);
    if (IN(3)) ph_gla_prep(F, A);
    SEAM(3);
    if (IN(4)) ph_gla_main(F, A);
    SEAM(4);
    if (IN(5)) ph_gla_finish(F, A);
    SEAM(5);
    if (IN(6)) { eng::Gemm g{(const char*)H, (const char*)(A.ws + WS_WOUT0T), nullptr, 0, D, NLAT / 256, D / 256, 1};
        eng::EpiResidT<true> E{A.in[P_X], X, mod + (0 * 3) * 6 * D + 2 * D}; eng::gemm_phase(F.lds, g, E, F.G, c); }
    SEAM(6);
    if (IN(7)) ph_norm2_router(F, A, 0);
    SEAM(7);
    if (IN(8)) ph_topk(F, A);
    SEAM(8);
    if (IN(9)) MOE_GU(0)
    SEAM(9);
    if (IN(10)) MOE_DN(0)
    SEAM(10);
    if (IN(11)) ph_combine(F, A, 0);
    SEAM(11);
    if (IN(12)) { eng::Gemm g{(const char*)H, (const char*)(A.ws + WS_WCINT), nullptr, 0, D, NLAT / 256, NCIN / 256, 1};
        g.trip = 1;
        eng::EpiConvFused E{A.ws + WS_CDUMP + (size_t)c * 131072, (bf16_t*)(A.ws + WS_H2), A.in[P_CK]}; eng::gemm_phase(F.lds, g, E, F.G, c); }
    SEAM(12);
    if (IN(14)) { eng::Gemm g{(const char*)(A.ws + WS_H2), (const char*)(A.ws + WS_WCOUTT), nullptr, 0, D, NLAT / 256, D / 256, 1};
        eng::EpiResidT<false> E{X, X, mod + (1 * 3) * 6 * D + 2 * D}; eng::gemm_phase(F.lds, g, E, F.G, c); }
    SEAM(14);
    if (IN(15)) ph_norm2_router(F, A, 1);
    SEAM(15);
    if (IN(16)) ph_topk(F, A);
    SEAM(16);
    if (IN(17)) MOE_GU(1)
    SEAM(17);
    if (IN(18)) MOE_DN(1)
    SEAM(18);
    if (IN(19)) ph_combine(F, A, 1);
#undef IN
#undef SEAM
#undef H
#undef X
#undef mod
#undef MOE_GU
#undef MOE_DN
}

extern "C" void kernel_launch(void* const* d_in, const int* in_sizes, int n_in, void* d_out, int out_size, void* d_ws, size_t ws_size, hipStream_t stream) {
    static int grid = 0;
    if (grid == 0) {
        if (n_in != 20 || in_sizes[0] != NLAT * D || out_size != NLAT * D || ws_size < WS_END) {
            fprintf(stderr, "kernel_launch: unexpected problem: n_in %d in0 %d out %d ws %zu (need %zu)\n", n_in, n_in > 0 ? in_sizes[0] : -1, out_size, ws_size, (size_t)WS_END); grid = -1; return; }
        int dev = 0, cus = 0, per_cu = 0;
        if (hipGetDevice(&dev) != hipSuccess || hipDeviceGetAttribute(&cus, hipDeviceAttributeMultiprocessorCount, dev) != hipSuccess) { grid = -1; return; }
        if (hipFuncSetAttribute((const void*)fwd_kernel, hipFuncAttributeMaxDynamicSharedMemorySize, LDS_BYTES) != hipSuccess) { fprintf(stderr, "kernel_launch: hipFuncSetAttribute failed\n"); grid = -1; return; }
        if (hipOccupancyMaxActiveBlocksPerMultiprocessor(&per_cu, (const void*)fwd_kernel, NTHR, LDS_BYTES) != hipSuccess || per_cu < 1) { fprintf(stderr, "kernel_launch: occupancy query says %d\n", per_cu); per_cu = 1; }
        (void)hipGetLastError();
        if (cus != 256) { fprintf(stderr, "kernel_launch: built for a 256-CU device (one workgroup per CU); found %d CUs\n", cus); grid = -1; return; }
        grid = cus;
    }
    if (grid < 0) return;
    Args a{};
    for (int i = 0; i < 20; ++i) a.in[i] = (const float*)d_in[i];
    a.out = (float*)d_out; a.ws = (unsigned char*)d_ws;
#if MK_MULTI
    for (int p = 0; p < N_PHASES; ++p) {
        a.ph_lo = p; a.ph_hi = p + 1;
        hipLaunchKernelGGL(fwd_kernel, dim3(grid), dim3(NTHR), LDS_BYTES, stream, a);
    }
#else
    if (hipMemsetAsync((char*)d_ws + WS_CTL, 0, 64 * 1024, stream) != hipSuccess) { fprintf(stderr, "kernel_launch: memset failed\n"); return; }
    a.ph_lo = 0; a.ph_hi = N_PHASES;
    void* kargs[] = {&a};
    hipError_t e = hipLaunchCooperativeKernel((const void*)fwd_kernel, dim3(grid), dim3(NTHR), kargs, LDS_BYTES, stream);
    if (e != hipSuccess) fprintf(stderr, "kernel_launch: cooperative launch failed: %s (grid %d)\n", hipGetErrorString(e), grid);
#endif
}
```

```cpp
#include <hip/hip_runtime.h>
#include <hip/hip_cooperative_groups.h>
#include <cstdio>
#include <cstdint>
namespace cg = cooperative_groups;

#ifndef MK_MULTI
#define MK_MULTI 0
#endif

#define LAS __attribute__((address_space(3)))
#define GAS __attribute__((address_space(1)))
typedef unsigned short bf16_t;
typedef short bf16x8 __attribute__((ext_vector_type(8)));
typedef float f32x4 __attribute__((ext_vector_type(4)));
typedef float f32x2 __attribute__((ext_vector_type(2)));
typedef unsigned u32x4 __attribute__((ext_vector_type(4)));
typedef unsigned u32x2 __attribute__((ext_vector_type(2)));
typedef int i32x4 __attribute__((ext_vector_type(4)));
typedef int i32x8 __attribute__((ext_vector_type(8)));

constexpr int D = 1024, NB = 2, T = 16384, NLAT = NB * T, CTXL = 256, NCTX = NB * CTXL, NROW = NLAT + NCTX;
constexpr int NE = 16, CAP = 2048, DEXP = 2048;
constexpr int HEADS = 4, HK = 128, HV = 256, DK = 512, DV = 1024, RANK = 16;
constexpr int NIN0 = 3104, NIN0P = 3328;
constexpr int NCIN = 3072;
constexpr float EPS = 1e-6f;
constexpr int NWAVES = 8, NTHR = 512;

constexpr size_t MiB = 1u << 20;
constexpr size_t WS_CTL = 0;
constexpr size_t WS_MOD = 1 * MiB;
constexpr size_t WS_WIN0T = 2 * MiB;
constexpr size_t WS_WOUT0T = 9 * MiB;
constexpr size_t WS_WCINT = 11 * MiB;
constexpr size_t WS_WCOUTT = 17 * MiB;
constexpr size_t WS_AFF = 19 * MiB;
constexpr size_t WS_SLOT = 21 * MiB;
constexpr size_t WS_ROWLIST = 23 * MiB;
constexpr size_t WS_ROWLIST8 = 29 * MiB;
constexpr size_t WS_SELVAL = 23 * MiB + 512 * 1024;
constexpr size_t WS_AFB = 24 * MiB;
constexpr size_t WS_W8 = 32 * MiB;
constexpr size_t W8_LAYER = 96 * MiB, W8_WD = 64 * MiB;
constexpr size_t WS_X = 224 * MiB;
constexpr size_t WS_H = 354 * MiB;
constexpr size_t WS_ARENA = 420 * MiB;
constexpr size_t WS_QK = WS_ARENA;
constexpr size_t WS_V = WS_ARENA + 65 * MiB;
constexpr size_t WS_R = WS_ARENA + 130 * MiB;
constexpr size_t WS_QP = WS_ARENA + 195 * MiB;
constexpr size_t WS_KP = WS_ARENA + 260 * MiB;
constexpr size_t WS_KTP = WS_ARENA + 325 * MiB;
constexpr size_t WS_VTP = WS_ARENA + 390 * MiB;
constexpr size_t WS_OI = WS_ARENA + 455 * MiB;
constexpr size_t WS_GAM = WS_ARENA + 519 * MiB;
constexpr size_t WS_OF = WS_QK;
constexpr size_t WS_OB = WS_V;
constexpr size_t WS_HID = WS_ARENA;
constexpr size_t WS_H8 = WS_ARENA + 260 * MiB;
constexpr size_t WS_YE = WS_ARENA + 128 * MiB;
constexpr size_t WS_H2 = WS_ARENA;
constexpr size_t WS_CDUMP = WS_ARENA + 64 * MiB;
constexpr size_t WS_END = WS_ARENA + 522 * MiB;
static_assert(WS_R - WS_QK == 130 * MiB, "EpiProj0 strides");
constexpr size_t BLOB = 16384;
constexpr int NCHUNK = NROW / 64;

__device__ __forceinline__ float wave_sum(float v) {
#define WSUM_ROR(ctrl) v += __builtin_bit_cast(float, __builtin_amdgcn_update_dpp(0, __builtin_bit_cast(int, v), ctrl, 0xF, 0xF, false))
    WSUM_ROR(0x128); WSUM_ROR(0x124); WSUM_ROR(0x122); WSUM_ROR(0x121);
#undef WSUM_ROR
    const int iv = __builtin_bit_cast(int, v);
    return (__builtin_bit_cast(float, __builtin_amdgcn_readlane(iv, 15)) + __builtin_bit_cast(float, __builtin_amdgcn_readlane(iv, 31))) +
           (__builtin_bit_cast(float, __builtin_amdgcn_readlane(iv, 47)) + __builtin_bit_cast(float, __builtin_amdgcn_readlane(iv, 63)));
}
__device__ __forceinline__ int wave_sum_i(int v) {
#pragma unroll
    for (int o = 1; o < 64; o <<= 1) v += __shfl_xor(v, o);
    return v;
}
__device__ __forceinline__ unsigned f2bf(float f) { unsigned u = __builtin_bit_cast(unsigned, f); return (u + 0x7fffu + ((u >> 16) & 1u)) >> 16; }
typedef __bf16 bf16x2_t __attribute__((ext_vector_type(2)));
__device__ __forceinline__ unsigned pk2(float lo, float hi) { const f32x2 v = {lo, hi}; return __builtin_bit_cast(unsigned, __builtin_convertvector(v, bf16x2_t)); }
__device__ __forceinline__ float bflo(unsigned u) { return __builtin_bit_cast(float, u << 16); }
__device__ __forceinline__ float bfhi(unsigned u) { return __builtin_bit_cast(float, u & 0xffff0000u); }
__device__ __forceinline__ float silu_f(float x) { return x / (1.f + __expf(-x)); }
#define LDS_WAIT() asm volatile("s_waitcnt lgkmcnt(0)" ::: "memory")


#define XB_TMO      128
#define XB_XCNT(j)  (256  + 64 * (j))
#define XB_XSUB(j)  (1280 + 64 * (j))
#define XB_XGEN(j)  (2304 + 64 * (j))
#define XB_TOP      3328
#define XB_TOPGEN   3392
#define XCD_BAR_WORDS 3456
#define XB_SPIN_CAP (1u << 22)
__device__ __forceinline__ unsigned xb_ld(unsigned* p)              { return __hip_atomic_load(p, __ATOMIC_RELAXED, __HIP_MEMORY_SCOPE_AGENT); }
__device__ __forceinline__ unsigned xb_add(unsigned* p, unsigned v) { return __hip_atomic_fetch_add(p, v, __ATOMIC_RELAXED, __HIP_MEMORY_SCOPE_AGENT); }
__device__ __forceinline__ unsigned xb_xcc_id() { return (unsigned)__builtin_amdgcn_s_getreg((3 << 11) | 20) & 0xFu; }
#define XB_SPIN(cond, bar) do { unsigned _sp = 0; while (cond) { \
    if ((++_sp & 255u) == 0u) { if (xb_ld(&(bar)[XB_TMO])) break; if (_sp > XB_SPIN_CAP) { atomicAdd(&(bar)[XB_TMO], 1u); break; } } } } while (0)
struct XcdBarrier { unsigned* bar; unsigned x; volatile LAS unsigned* st; };
__device__ __forceinline__ XcdBarrier xcd_barrier_post(unsigned* bar, volatile LAS unsigned* st) {
    XcdBarrier b; b.bar = bar; b.x = xb_xcc_id(); b.st = st;
    if (threadIdx.x == 0) (void)xb_add(&bar[XB_XCNT(b.x)], 1u);
    return b;
}
__device__ __forceinline__ void xcd_barrier_complete(unsigned* bar, unsigned x, unsigned& nloc, unsigned& nx) {
    const unsigned G = gridDim.x * gridDim.y * gridDim.z;
    unsigned sum, cnt, mine, sp = 0u;
    for (;;) {
        sum = 0u; cnt = 0u; mine = 0u;
#pragma unroll
        for (unsigned j = 0; j < 16; ++j) { const unsigned c = xb_ld(&bar[XB_XCNT(j)]); sum += c; cnt += (c > 0u) ? 1u : 0u; mine = (j == x) ? c : mine; }
        if (sum == G) break;
        __builtin_amdgcn_s_sleep(1);
        if ((++sp & 255u) == 0u) { if (xb_ld(&bar[XB_TMO])) break; if (sp > XB_SPIN_CAP) { atomicAdd(&bar[XB_TMO], 1u); break; } }
    }
    nloc = mine > 0u ? mine : 1u; nx = cnt > 0u ? cnt : 1u;
}
#define XB_SPX(j)   (3456 + 64 * (j))
#define XB_SPTOP    4480
#define XB_SPDONE   4544
__device__ __forceinline__ void xcd_split_arrive(const XcdBarrier& b) {
    asm volatile("s_waitcnt vmcnt(0)" ::: "memory");
    __syncthreads();
    if (threadIdx.x == 0) {
        unsigned* bar = b.bar;
        __builtin_amdgcn_s_waitcnt(0);
        unsigned nloc = b.st[0], nx = b.st[1];
        if (nloc == 0u) { xcd_barrier_complete(bar, b.x, nloc, nx); b.st[0] = nloc; b.st[1] = nx; }
        const unsigned old = xb_add(&bar[XB_SPX(b.x)], 1u);
        if (old + 1u == nloc) {
            __builtin_amdgcn_fence(__ATOMIC_RELEASE, "agent");
            asm volatile("s_waitcnt vmcnt(0)" ::: "memory");
            const unsigned og = xb_add(&bar[XB_SPTOP], 1u);
            if (og + 1u == nx) xb_add(&bar[XB_SPDONE], 1u);
        }
    }
}
__device__ __forceinline__ void xcd_split_wait(const XcdBarrier& b) {
    asm volatile("s_waitcnt vmcnt(0)" ::: "memory");
    __syncthreads();
    if (threadIdx.x == 0) {
        unsigned* bar = b.bar;
        __builtin_amdgcn_fence(__ATOMIC_ACQUIRE, "agent");
        XB_SPIN(xb_ld(&bar[XB_SPDONE]) == 0u, bar);
        asm volatile("s_waitcnt vmcnt(0)" ::: "memory");
    }
    __syncthreads();
}
__device__ __forceinline__ void xcd_barrier_local(const XcdBarrier& b) {
    asm volatile("s_waitcnt vmcnt(0)" ::: "memory");
    __syncthreads();
    if (threadIdx.x == 0) {
        unsigned* bar = b.bar;
        __builtin_amdgcn_s_waitcnt(0);
        const unsigned nloc = b.st[0];
        const unsigned old = xb_add(&bar[XB_XSUB(b.x)], 1u);
        const unsigned gen = old / nloc;
        __builtin_amdgcn_fence(__ATOMIC_ACQUIRE, "agent");
        if (old + 1u == (gen + 1u) * nloc) xb_add(&bar[XB_XGEN(b.x)], 1u);
        else XB_SPIN(xb_ld(&bar[XB_XGEN(b.x)]) == gen, bar);
        asm volatile("s_waitcnt vmcnt(0)" ::: "memory");
    }
    __syncthreads();
}
__device__ __forceinline__ void xcd_barrier(const XcdBarrier& b) {
    asm volatile("s_waitcnt vmcnt(0)" ::: "memory");
    __syncthreads();
    if (threadIdx.x == 0) {
        unsigned* bar = b.bar;
        __builtin_amdgcn_s_waitcnt(0);
        unsigned nloc = b.st[0], nx = b.st[1];
        if (nloc == 0u) { xcd_barrier_complete(bar, b.x, nloc, nx); b.st[0] = nloc; b.st[1] = nx; }
        const unsigned old = xb_add(&bar[XB_XSUB(b.x)], 1u);
        const unsigned gen = old / nloc;
        if (old + 1u == (gen + 1u) * nloc) {
            __builtin_amdgcn_fence(__ATOMIC_RELEASE, "agent");
            asm volatile("s_waitcnt vmcnt(0)" ::: "memory");
            const unsigned og = xb_add(&bar[XB_TOP], 1u);
            const unsigned tg = og / nx;
            __builtin_amdgcn_fence(__ATOMIC_ACQUIRE, "agent");
            if (og + 1u == (tg + 1u) * nx) xb_add(&bar[XB_TOPGEN], 1u);
            else XB_SPIN(xb_ld(&bar[XB_TOPGEN]) == tg, bar);
            xb_add(&bar[XB_XGEN(b.x)], 1u);
            asm volatile("s_waitcnt vmcnt(0)" ::: "memory");
        } else {
            __builtin_amdgcn_fence(__ATOMIC_ACQUIRE, "agent");
            XB_SPIN(xb_ld(&bar[XB_XGEN(b.x)]) == gen, bar);
            asm volatile("s_waitcnt vmcnt(0)" ::: "memory");
        }
    }
    __syncthreads();
}

namespace eng {
constexpr int BM = 256, BK = 64, HALF = 128, HTB = HALF * BK * 2, STAGE_BYTES = 8 * HTB, NXCD = 8, WGM = 8;
__host__ __device__ __forceinline__ int lds_byte(int r, int c) { const int st = (r >> 4) * 2 + (c >> 5), rr = r & 15, cc = c & 31, ob = rr * 64 + cc * 2; return st * 1024 + (ob ^ (((ob >> 9) & 1) << 5)); }
__host__ __device__ __forceinline__ void stage_rc(int b, int& R, int& C) { const int st = b / 1024, sb = b % 1024, swz = sb ^ (((sb >> 9) & 1) << 5); R = (st >> 1) * 16 + swz / 64; C = (st & 1) * 32 + (swz % 64) / 2; }
__host__ __device__ __forceinline__ int perm32(int rho) { const int n = rho >> 4, i = rho & 15; return 8 * (i >> 2) + 4 * n + (i & 3); }

struct Unit { int e, pm, pn; };
struct Gemm {
    const char* A;
    const char* Bt;
    const int* rows;
    size_t bstride;
    int K, nM, nN, ngroups;
    int rev = 0;
    int trip = 0;
};
__device__ __forceinline__ bool next_unit(const Gemm& g, int i, int G, int c, Unit& u) {
    if (g.trip == 3) {
        const int x = c & 7, r = c >> 3, li = i * 32 + r;
        if (li >= (x >= 6 ? 17 : 16) * g.nN) return false;
        const int grp = li / (8 * g.nN), w = li - grp * 8 * g.nN;
        u.e = 0;
        if (grp < 2) { u.pm = 16 * x + 8 * grp + (w & 7); u.pn = w >> 3; } else { u.pm = 128 + (x - 6); u.pn = w; }
        return true;
    }
    if (g.trip == 4) {
        const int x = c & 7, r = c >> 3, L = i * 32 + r, pe = 2 * g.nN;
        int e = L / pe; if (e >= g.ngroups) return false;
        const int w = L - e * pe;
        if (g.rev) e = g.ngroups - 1 - e;
        u.e = e; u.pm = 2 * x + (w & 1); u.pn = w >> 1; return true;
    }
    if (g.trip) {
        const int per3 = g.nM * (g.nN / 3), j = i / 3, sec = i - 3 * j; int s = j * G + c; if (s >= per3) return false;
        { const int q = per3 / NXCD, r = per3 % NXCD, xcd = s % NXCD, off = s / NXCD; s = (xcd < r ? xcd * (q + 1) : r * (q + 1) + (xcd - r) * q) + off; }
        const int ncb = g.nN / 3; u.e = 0; u.pm = s / ncb; u.pn = 3 * (s % ncb) + sec; return true;
    }
    const int per = g.nM * g.nN;
    const long L = (long)i * G + c; if (L >= (long)per * g.ngroups) return false;
    u.e = (int)(L / per); int wgid = (int)(L % per);
    if (g.rev) u.e = g.ngroups - 1 - u.e;
    { const int nwg = per, q = nwg / NXCD, r = nwg % NXCD, xcd = wgid % NXCD, off = wgid / NXCD; wgid = (xcd < r ? xcd * (q + 1) : r * (q + 1) + (xcd - r) * q) + off; }
    const int nig = WGM * g.nN, gid = wgid / nig, fm = gid * WGM, gsz = (g.nM - fm) < WGM ? (g.nM - fm) : WGM;
    u.pm = fm + ((wgid % nig) % gsz); u.pn = (wgid % nig) / gsz; return true;
}
__device__ __forceinline__ bf16x8 lo8(const i32x8& f) { return __builtin_bit_cast(bf16x8, (i32x4)__builtin_shufflevector(f, f, 0, 1, 2, 3)); }
__device__ __forceinline__ bf16x8 hi8(const i32x8& f) { return __builtin_bit_cast(bf16x8, (i32x4)__builtin_shufflevector(f, f, 4, 5, 6, 7)); }
__device__ __forceinline__ i32x8 cat8(bf16x8 lo, bf16x8 hi) { const i32x4 a = __builtin_bit_cast(i32x4, lo), b = __builtin_bit_cast(i32x4, hi); return __builtin_shufflevector(a, b, 0, 1, 2, 3, 4, 5, 6, 7); }
__device__ __forceinline__ unsigned cvt_pk_bf16(float lo, float hi) { unsigned r; asm volatile("v_cvt_pk_bf16_f32 %0, %1, %2" : "=v"(r) : "v"(lo), "v"(hi)); return r; }

#ifndef ENG_SP2
#define ENG_SP2 true
#endif
#ifndef ENG_ALIGN
#define ENG_ALIGN true
#endif
template <class Epi, bool SP2 = ENG_SP2, bool ALIGN_EPI = ENG_ALIGN>
__device__ __forceinline__ void gemm_phase(LAS unsigned char* lds, const Gemm g, const Epi& E, int G, int c) {
    int tid = threadIdx.x; asm volatile("" : "+v"(tid));
    const int wid = __builtin_amdgcn_readfirstlane(tid >> 6), lane = tid & 63, wr = wid >> 2, wc = wid & 3, fr = lane & 15, fq = lane >> 4;
    const int K = g.K, nt = K / BK;
    int R0, C0; stage_rc(tid * 16, R0, C0);
    const int Rb0 = Epi::PERM ? ((R0 & ~31) + perm32(R0 & 31)) : R0;
    unsigned voffB[2]; voffB[0] = (unsigned)(Rb0 * K + C0) * 2u; voffB[1] = (unsigned)((Rb0 + 64) * K + C0) * 2u;
    constexpr bool SW = Epi::SWAPV;
    const char* const abase = SW ? g.Bt : g.A;
    const unsigned adelta = SW ? (unsigned)(size_t)(g.A - g.Bt) : 0u;
    const unsigned dltB = SW ? (unsigned)((R0 - Rb0) * K) * 2u : 0u;
    const size_t hstepB = (size_t)HALF * K * 2;
    const unsigned ldsw = (unsigned)wid * 1024u;
    const int aoff = lds_byte(wr * 64 + fr, fq * 8), boff = lds_byte(wc * 32 + fr, fq * 8);
#define PG8_SA(b, h) (((b) * 2 + (h)) * HTB)
#define PG8_SB(b, h) ((4 + (b) * 2 + (h)) * HTB)
#define PG8_GLDS(gp, bufoff, i) __builtin_amdgcn_global_load_lds((const unsigned*)(gp), (LAS unsigned*)(lds + (bufoff) + ldsw + (i) * 8192), 16, 0, 0)
#define PG8_STAGE_B(bufoff, bp, h, kt) do { const char* _p = (bp) + (size_t)(h) * hstepB + (size_t)(kt) * 128; asm volatile("" : "+s"(_p)); PG8_GLDS(_p + (voffB[0] + (SW ? dselB : 0u)), bufoff, 0); PG8_GLDS(_p + (voffB[1] + (SW ? dselB : 0u)), bufoff, 1); } while (0)
#define PG8_STAGE_A(bufoff, v0, v1, kt) do { const char* _p = abase + (size_t)(kt) * 128; asm volatile("" : "+s"(_p)); PG8_GLDS(_p + (v0), bufoff, 0); PG8_GLDS(_p + (v1), bufoff, 1); } while (0)
#define PG8_LDA(dst, b, h) do { _Pragma("unroll") for (int m = 0; m < 4; ++m) dst[m] = cat8(*(const LAS bf16x8*)(lds + PG8_SA(b, h) + aoff + m * 2048), *(const LAS bf16x8*)(lds + PG8_SA(b, h) + aoff + m * 2048 + 1024)); } while (0)
#define PG8_LDB(dst, b, h) do { _Pragma("unroll") for (int n = 0; n < 2; ++n) dst[n] = cat8(*(const LAS bf16x8*)(lds + PG8_SB(b, h) + boff + n * 2048), *(const LAS bf16x8*)(lds + PG8_SB(b, h) + boff + n * 2048 + 1024)); } while (0)
#define PG8_MMA(ai, bj, At, Bt) do { __builtin_amdgcn_s_setprio(1); \
        if constexpr (Epi::FP8) { _Pragma("unroll") for (int m = 0; m < 4; ++m) _Pragma("unroll") for (int n = 0; n < 2; ++n) \
            asm volatile("v_mfma_scale_f32_16x16x128_f8f6f4 %0, %1, %2, %0, %3, %4 op_sel_hi:[0,0,0]" : "+v"(acc[ai][bj][m][n]) : "v"(Bt[n]), "v"(At[m]), "v"(sc_w), "v"(sc_a)); } \
        else { _Pragma("unroll") for (int m = 0; m < 4; ++m) _Pragma("unroll") for (int n = 0; n < 2; ++n) { \
            acc[ai][bj][m][n] = __builtin_amdgcn_mfma_f32_16x16x32_bf16(lo8(Bt[n]), lo8(At[m]), acc[ai][bj][m][n], 0, 0, 0); \
            acc[ai][bj][m][n] = __builtin_amdgcn_mfma_f32_16x16x32_bf16(hi8(Bt[n]), hi8(At[m]), acc[ai][bj][m][n], 0, 0, 0); } } \
        __builtin_amdgcn_s_setprio(0); } while (0)
#define PG8_WAIT_V(n) asm volatile("s_waitcnt vmcnt(" #n ")" ::: "memory")
#define PG8_WAIT_L(n) asm volatile("s_waitcnt lgkmcnt(" #n ")" ::: "memory")
#define PG8_BAR __builtin_amdgcn_s_barrier()
#define PG8_SCHED __builtin_amdgcn_sched_barrier(0)
#define PG8_ROWOFF(u, h, i) ((SW && E.swapv(u)) ? (unsigned)(((u).pn * 256 + (h) * 128 + R0 + 64 * (i)) * K + C0) * 2u : adelta + ((unsigned)(((g.rows ? g.rows[((u).e * g.nM + (u).pm) * 256 + (h) * 128 + R0 + 64 * (i)] : (((u).e * g.nM + (u).pm) * 256 + (h) * 128 + R0 + 64 * (i))) * K + C0)) * 2u))
#define PG8_BPTR(u) ((SW && E.swapv(u)) ? g.A + (size_t)(u).pm * 2 * hstepB : g.Bt + (size_t)(u).e * g.bstride + (size_t)(u).pn * 2 * hstepB)
    Unit cur, nxt; int ui = 0;
    if (!next_unit(g, 0, G, c, cur)) return;
    f32x4 acc[2][2][4][2];
#pragma unroll
    for (int a = 0; a < 2; ++a)
#pragma unroll
        for (int b = 0; b < 2; ++b)
#pragma unroll
            for (int m = 0; m < 4; ++m)
#pragma unroll
                for (int n = 0; n < 2; ++n) acc[a][b][m][n] = (f32x4){0.f, 0.f, 0.f, 0.f};
    int sc_w = E.scale_w, sc_a = E.scale_a;
    asm volatile("" : "+v"(sc_w), "+v"(sc_a));
    i32x8 At[4], B0[2], B1[2];
    unsigned c00 = PG8_ROWOFF(cur, 0, 0), c01 = PG8_ROWOFF(cur, 0, 1), c10 = PG8_ROWOFF(cur, 1, 0), c11 = PG8_ROWOFF(cur, 1, 1);
    const char* cB = PG8_BPTR(cur);
    unsigned cD = (SW && E.swapv(cur)) ? dltB : 0u, dselB = cD;
    if constexpr (SP2) {
        PG8_STAGE_B(PG8_SB(0, 0), cB, 0, 0); PG8_STAGE_B(PG8_SB(0, 1), cB, 1, 0); PG8_STAGE_A(PG8_SA(0, 0), c00, c01, 0); PG8_STAGE_A(PG8_SA(0, 1), c10, c11, 0);
        if (wr == 1) PG8_BAR;
        PG8_WAIT_V(2); PG8_BAR;
        PG8_STAGE_B(PG8_SB(1, 0), cB, 0, 1); PG8_STAGE_A(PG8_SA(1, 0), c00, c01, 1); PG8_STAGE_B(PG8_SB(1, 1), cB, 1, 1);
        PG8_WAIT_V(6); PG8_BAR;
    } else {
        PG8_STAGE_B(PG8_SB(0, 0), cB, 0, 0); PG8_STAGE_A(PG8_SA(0, 0), c00, c01, 0); PG8_STAGE_B(PG8_SB(0, 1), cB, 1, 0); PG8_STAGE_A(PG8_SA(0, 1), c10, c11, 0);
        if (wr == 1) PG8_BAR;
        PG8_WAIT_V(4); PG8_BAR;
        PG8_STAGE_B(PG8_SB(1, 0), cB, 0, 1); PG8_STAGE_A(PG8_SA(1, 0), c00, c01, 1); PG8_STAGE_B(PG8_SB(1, 1), cB, 1, 1);
        PG8_WAIT_V(6); PG8_BAR;
    }
    for (;;) {
        const bool has_next = next_unit(g, ui + 1, G, c, nxt);
        unsigned n00 = c00, n01 = c01, n10 = c10, n11 = c11; const char* nB = cB; unsigned nD = cD;
        if (has_next) { n00 = PG8_ROWOFF(nxt, 0, 0); n01 = PG8_ROWOFF(nxt, 0, 1); n10 = PG8_ROWOFF(nxt, 1, 0); n11 = PG8_ROWOFF(nxt, 1, 1);
                        nB = PG8_BPTR(nxt); nD = (SW && E.swapv(nxt)) ? dltB : 0u; }
#pragma unroll 1
        for (int t = 0; t < nt; t += 2) {
            const bool last = (t == nt - 2);
            const int kt2 = last ? 0 : t + 2, kt3 = kt2 + 1;
            const char* b2 = last ? nB : cB; dselB = last ? nD : cD;
            const unsigned s00 = last ? n00 : c00, s01 = last ? n01 : c01, s10 = last ? n10 : c10, s11 = last ? n11 : c11;
            if constexpr (SP2) {
            PG8_LDB(B0, 0, 0); PG8_LDB(B1, 0, 1); PG8_SCHED; PG8_LDA(At, 0, 0); PG8_STAGE_A(PG8_SA(1, 1), c10, c11, t + 1);
            PG8_WAIT_V(8); PG8_WAIT_L(0); PG8_BAR; PG8_MMA(0, 0, At, B0); PG8_MMA(0, 1, At, B1); PG8_BAR; PG8_SCHED;
            PG8_LDA(At, 0, 1); PG8_STAGE_B(PG8_SB(0, 0), b2, 0, kt2); PG8_STAGE_B(PG8_SB(0, 1), b2, 1, kt2); PG8_STAGE_A(PG8_SA(0, 0), s00, s01, kt2);
            PG8_WAIT_V(8); PG8_WAIT_L(0); PG8_BAR; PG8_MMA(1, 0, At, B0); PG8_MMA(1, 1, At, B1); PG8_BAR; PG8_SCHED;
            PG8_LDB(B0, 1, 0); PG8_LDB(B1, 1, 1); PG8_SCHED; PG8_LDA(At, 1, 0); PG8_STAGE_A(PG8_SA(0, 1), s10, s11, kt2);
            PG8_WAIT_V(8); PG8_WAIT_L(0); PG8_BAR; PG8_MMA(0, 0, At, B0); PG8_MMA(0, 1, At, B1); PG8_BAR; PG8_SCHED;
            PG8_LDA(At, 1, 1); PG8_STAGE_B(PG8_SB(1, 0), b2, 0, kt3); PG8_STAGE_B(PG8_SB(1, 1), b2, 1, kt3); PG8_STAGE_A(PG8_SA(1, 0), s00, s01, kt3);
            PG8_WAIT_V(8); PG8_WAIT_L(0); PG8_BAR; PG8_MMA(1, 0, At, B0); PG8_MMA(1, 1, At, B1); PG8_BAR; PG8_SCHED;
            } else {
            PG8_LDB(B0, 0, 0); PG8_SCHED; PG8_LDA(At, 0, 0); PG8_STAGE_A(PG8_SA(1, 1), c10, c11, t + 1);
            PG8_WAIT_L(8); PG8_BAR; PG8_WAIT_L(0); PG8_MMA(0, 0, At, B0); PG8_BAR; PG8_SCHED;
            PG8_LDB(B1, 0, 1); PG8_STAGE_B(PG8_SB(0, 0), b2, 0, kt2);
            PG8_BAR; PG8_WAIT_L(0); PG8_MMA(0, 1, At, B1); PG8_BAR;
            PG8_LDA(At, 0, 1); PG8_STAGE_A(PG8_SA(0, 0), s00, s01, kt2);
            PG8_BAR; PG8_WAIT_L(0); PG8_MMA(1, 0, At, B0); PG8_BAR; PG8_SCHED;
            PG8_STAGE_B(PG8_SB(0, 1), b2, 1, kt2);
            PG8_WAIT_V(6); PG8_BAR; PG8_MMA(1, 1, At, B1); PG8_BAR;
            PG8_LDB(B0, 1, 0); PG8_SCHED; PG8_LDA(At, 1, 0); PG8_STAGE_A(PG8_SA(0, 1), s10, s11, kt2);
            PG8_WAIT_L(8); PG8_BAR; PG8_WAIT_L(0); PG8_MMA(0, 0, At, B0); PG8_BAR; PG8_SCHED;
            PG8_LDB(B1, 1, 1); PG8_STAGE_B(PG8_SB(1, 0), b2, 0, kt3);
            PG8_BAR; PG8_WAIT_L(0); PG8_MMA(0, 1, At, B1); PG8_BAR;
            PG8_LDA(At, 1, 1); PG8_STAGE_A(PG8_SA(1, 0), s00, s01, kt3);
            PG8_BAR; PG8_WAIT_L(0); PG8_MMA(1, 0, At, B0); PG8_BAR; PG8_SCHED;
            PG8_STAGE_B(PG8_SB(1, 1), b2, 1, kt3);
            PG8_WAIT_V(6); PG8_BAR; PG8_MMA(1, 1, At, B1); PG8_BAR;
            }
        }
        if constexpr (Epi::FP8) {
            _Pragma("unroll") for (int a = 0; a < 2; ++a)
                asm volatile("s_nop 15\n\ts_nop 15" : "+v"(acc[a][0][0][0]), "+v"(acc[a][0][0][1]), "+v"(acc[a][0][1][0]), "+v"(acc[a][0][1][1]), "+v"(acc[a][0][2][0]), "+v"(acc[a][0][2][1]), "+v"(acc[a][0][3][0]), "+v"(acc[a][0][3][1]),
                             "+v"(acc[a][1][0][0]), "+v"(acc[a][1][0][1]), "+v"(acc[a][1][1][0]), "+v"(acc[a][1][1][1]), "+v"(acc[a][1][2][0]), "+v"(acc[a][1][2][1]), "+v"(acc[a][1][3][0]), "+v"(acc[a][1][3][1]));
        }
        if constexpr (ALIGN_EPI) { if (wr == 0) PG8_BAR; }
        E(acc, cur, wr, wc, fr, fq);
        if (!has_next) break;
#pragma unroll
        for (int a = 0; a < 2; ++a)
#pragma unroll
            for (int b = 0; b < 2; ++b)
#pragma unroll
                for (int m = 0; m < 4; ++m)
#pragma unroll
                    for (int n = 0; n < 2; ++n) acc[a][b][m][n] = (f32x4){0.f, 0.f, 0.f, 0.f};
        cur = nxt; cB = nB; cD = nD; c00 = n00; c01 = n01; c10 = n10; c11 = n11; ++ui;
        if constexpr (ALIGN_EPI) { if (wr == 1) PG8_BAR; }
    }
    PG8_WAIT_V(0);
    if constexpr (!ALIGN_EPI) { if (wr == 0) PG8_BAR; }
    PG8_BAR;
#undef PG8_SA
#undef PG8_SB
#undef PG8_GLDS
#undef PG8_STAGE_A
#undef PG8_STAGE_B
#undef PG8_LDA
#undef PG8_LDB
#undef PG8_MMA
#undef PG8_WAIT_V
#undef PG8_WAIT_L
#undef PG8_BAR
#undef PG8_SCHED
#undef PG8_ROWOFF
#undef PG8_BPTR
}

struct EpiProj0 {
    static constexpr bool FP8 = false; static constexpr int scale_w = 0, scale_a = 0;
    static constexpr bool PERM = true; static constexpr bool SWAPV = true;
    __device__ __forceinline__ bool swapv(const Unit& u) const { return u.pn >= 4 && u.pn < 8; }
    bf16_t* qk; unsigned char* vtp; bf16_t* r; float* afb;
    __device__ __forceinline__ void operator()(const f32x4 (&acc)[2][2][4][2], const Unit& u, int wr, int wc, int fr, int fq) const {
        const int row0 = u.pm * BM + wr * 64 + fr;
        if (swapv(u)) {
            unsigned char* p0 = vtp + (size_t)(4 * u.pm + (wc >> 1)) * 131072 + (size_t)((((16 * (u.pn - 4) + 4 * wr) * 2 + (wc & 1)) * 64 + fr + 16 * fq) * 16);
#pragma unroll
            for (int ai = 0; ai < 2; ++ai)
#pragma unroll
                for (int m = 0; m < 4; ++m)
#pragma unroll
                    for (int bj = 0; bj < 2; ++bj) { const f32x4 v0 = acc[ai][bj][m][0], v1 = acc[ai][bj][m][1];
                        u32x4 w; w.x = cvt_pk_bf16(v0[0], v0[1]); w.y = cvt_pk_bf16(v0[2], v0[3]); w.z = cvt_pk_bf16(v1[0], v1[1]); w.w = cvt_pk_bf16(v1[2], v1[3]);
                        *(u32x4*)(p0 + (size_t)bj * 2 * 131072 + (size_t)(8 * ai + m) * 2048) = w; }
        } else if (u.pn < 12) {
            const float sc = (u.pn < 2) ? 0.08838834764831845f : 1.f;
            bf16_t* base = qk + (size_t)(u.pn >> 3) * (size_t)(130 * MiB / 2);
            const int col0 = (u.pn & 3) * BM + wc * 32 + 8 * fq;
#pragma unroll
            for (int ai = 0; ai < 2; ++ai)
#pragma unroll
                for (int m = 0; m < 4; ++m) { bf16_t* rowp = base + (size_t)(row0 + ai * HALF + m * 16) * D + col0;
#pragma unroll
                    for (int bj = 0; bj < 2; ++bj) { const f32x4 v0 = acc[ai][bj][m][0] * sc, v1 = acc[ai][bj][m][1] * sc;
                        u32x4 w; w.x = cvt_pk_bf16(v0[0], v0[1]); w.y = cvt_pk_bf16(v0[2], v0[3]); w.z = cvt_pk_bf16(v1[0], v1[1]); w.w = cvt_pk_bf16(v1[2], v1[3]);
                        *(u32x4*)(rowp + bj * HALF) = w; } }
        } else if (wc == 0) {
#pragma unroll
            for (int ai = 0; ai < 2; ++ai)
#pragma unroll
                for (int m = 0; m < 4; ++m) { float* rowp = afb + (size_t)(row0 + ai * HALF + m * 16) * 32 + 8 * fq;
                    *(f32x4*)(rowp) = acc[ai][0][m][0]; *(f32x4*)(rowp + 4) = acc[ai][0][m][1]; }
        }
    }
};
template <bool SRC_F32>
struct EpiResidT {
    static constexpr bool FP8 = false; static constexpr int scale_w = 0, scale_a = 0;
    static constexpr bool PERM = true; static constexpr bool SWAPV = false; __device__ __forceinline__ bool swapv(const Unit&) const { return false; }
    const void* src; bf16_t* dst; const float* gate;
    __device__ __forceinline__ void operator()(const f32x4 (&acc)[2][2][4][2], const Unit& u, int wr, int wc, int fr, int fq) const {
        const int row0 = u.pm * BM + wr * 64 + fr, col0 = u.pn * BM + wc * 32 + 8 * fq;
        const int b = (u.pm * BM) >> 14;
        f32x4 gv[2][2];
#pragma unroll
        for (int bj = 0; bj < 2; ++bj)
#pragma unroll
            for (int n = 0; n < 2; ++n) gv[bj][n] = *(const f32x4*)(gate + (size_t)b * 6 * D + col0 + bj * HALF + n * 4);
#pragma unroll
        for (int ai = 0; ai < 2; ++ai) {
            f32x4 sv[4][2][2];
#pragma unroll
            for (int m = 0; m < 4; ++m)
#pragma unroll
                for (int bj = 0; bj < 2; ++bj) { const size_t off = (size_t)(row0 + ai * HALF + m * 16) * D + col0 + bj * HALF;
                    if constexpr (SRC_F32) { sv[m][bj][0] = *(const f32x4*)((const float*)src + off); sv[m][bj][1] = *(const f32x4*)((const float*)src + off + 4); }
                    else { const u32x4 t = *(const u32x4*)((const bf16_t*)src + off);
                        sv[m][bj][0] = (f32x4){bflo(t.x), bfhi(t.x), bflo(t.y), bfhi(t.y)}; sv[m][bj][1] = (f32x4){bflo(t.z), bfhi(t.z), bflo(t.w), bfhi(t.w)}; } }
            asm volatile("" ::: "memory");
#pragma unroll
            for (int m = 0; m < 4; ++m)
#pragma unroll
                for (int bj = 0; bj < 2; ++bj) { const f32x4 y0 = sv[m][bj][0] + gv[bj][0] * acc[ai][bj][m][0], y1 = sv[m][bj][1] + gv[bj][1] * acc[ai][bj][m][1];
                    u32x4 w; w.x = cvt_pk_bf16(y0[0], y0[1]); w.y = cvt_pk_bf16(y0[2], y0[3]); w.z = cvt_pk_bf16(y1[0], y1[1]); w.w = cvt_pk_bf16(y1[2], y1[3]);
                    *(u32x4*)(dst + (size_t)(row0 + ai * HALF + m * 16) * D + col0 + bj * HALF) = w; }
        }
    }
};
struct EpiBf16Plain {
    static constexpr bool FP8 = false; static constexpr int scale_w = 0, scale_a = 0;
    static constexpr bool PERM = true; static constexpr bool SWAPV = false; __device__ __forceinline__ bool swapv(const Unit&) const { return false; }
    bf16_t* O; int ldc;
    __device__ __forceinline__ void operator()(const f32x4 (&acc)[2][2][4][2], const Unit& u, int wr, int wc, int fr, int fq) const {
        const int row0 = u.pm * BM + wr * 64 + fr, col0 = u.pn * BM + wc * 32 + 8 * fq;
#pragma unroll
        for (int ai = 0; ai < 2; ++ai)
#pragma unroll
            for (int m = 0; m < 4; ++m) { bf16_t* rowp = O + (size_t)(row0 + ai * HALF + m * 16) * ldc + col0;
#pragma unroll
                for (int bj = 0; bj < 2; ++bj) { const f32x4 v0 = acc[ai][bj][m][0], v1 = acc[ai][bj][m][1];
                    u32x4 w; w.x = cvt_pk_bf16(v0[0], v0[1]); w.y = cvt_pk_bf16(v0[2], v0[3]); w.z = cvt_pk_bf16(v1[0], v1[1]); w.w = cvt_pk_bf16(v1[2], v1[3]);
                    *(u32x4*)(rowp + bj * HALF) = w; } }
    }
};
__device__ __forceinline__ float dpp_shr1(float oldv, float x) { return __builtin_bit_cast(float, __builtin_amdgcn_update_dpp(__builtin_bit_cast(int, oldv), __builtin_bit_cast(int, x), 0x111, 0xF, 0xF, false)); }
__device__ __forceinline__ float dpp_shl1(float oldv, float x) { return __builtin_bit_cast(float, __builtin_amdgcn_update_dpp(__builtin_bit_cast(int, oldv), __builtin_bit_cast(int, x), 0x101, 0xF, 0xF, false)); }
__device__ __forceinline__ float dpp_ror1(float x) { return __builtin_bit_cast(float, __builtin_amdgcn_update_dpp(0, __builtin_bit_cast(int, x), 0x121, 0xF, 0xF, false)); }
__device__ __forceinline__ float dpp_rol1(float x) { return __builtin_bit_cast(float, __builtin_amdgcn_update_dpp(0, __builtin_bit_cast(int, x), 0x12F, 0xF, 0xF, false)); }
struct EpiConvFused {
    static constexpr bool FP8 = false; static constexpr int scale_w = 0, scale_a = 0;
    static constexpr bool PERM = true; static constexpr bool SWAPV = false; __device__ __forceinline__ bool swapv(const Unit&) const { return false; }
    unsigned char* dump;
    bf16_t* O; const float* ck;
    __device__ __forceinline__ void operator()(const f32x4 (&acc)[2][2][4][2], const Unit& u, int wr, int wc, int fr, int fq) const {
        const int cb = u.pn / 3, sec = u.pn - 3 * cb, tid = threadIdx.x;
        if (sec < 2) {
            const int cc = 256 * cb + 128 * sec + wc * 32 + 8 * fq;
            unsigned char* dp = dump + (size_t)sec * 65536 + tid * 16;
#pragma unroll
            for (int n = 0; n < 2; ++n) {
                const f32x4 k0 = *(const f32x4*)(ck + cc + 4 * n), k1 = *(const f32x4*)(ck + D + cc + 4 * n), k2 = *(const f32x4*)(ck + 2 * D + cc + 4 * n);
#pragma unroll
                for (int ai = 0; ai < 2; ++ai) {
                    f32x4 y[4];
#pragma unroll
                    for (int j = 0; j < 4; ++j) {
                        float x[4];
#pragma unroll
                        for (int m = 0; m < 4; ++m) x[m] = acc[ai][0][m][n][j] * acc[ai][1][m][n][j];
#pragma unroll
                        for (int m = 0; m < 4; ++m) {
                            const float up = dpp_shr1(m > 0 ? dpp_ror1(x[m - 1]) : 0.f, x[m]);
                            const float dn = dpp_shl1(m < 3 ? dpp_rol1(x[m + 1]) : 0.f, x[m]);
                            y[m][j] = k0[j] * up + k1[j] * x[m] + k2[j] * dn; }
                    }
#pragma unroll
                    for (int m = 0; m < 4; ++m) { u32x2 w; w.x = cvt_pk_bf16(y[m][0], y[m][1]); w.y = cvt_pk_bf16(y[m][2], y[m][3]);
                        *(u32x2*)(dp + (ai * 4 + m) * 8192 + n * 8) = w; }
                }
            }
        } else {
            const int row0 = u.pm * BM + wr * 64 + fr, col0 = 256 * cb + wc * 32 + 8 * fq;
            const unsigned loff = (unsigned)tid * 16u;
#pragma unroll
            for (int ai = 0; ai < 2; ++ai) {
                u32x4 qq[4][2];
#pragma unroll
                for (int m = 0; m < 4; ++m) {
                    const unsigned char* sb = dump + (ai * 4 + m) * 8192; asm volatile("" : "+s"(sb));
                    qq[m][0] = *(const u32x4*)(sb + loff); qq[m][1] = *(const u32x4*)(sb + 65536 + loff); }
#pragma unroll
                for (int m = 0; m < 4; ++m) {
                    bf16_t* rowp = O + (size_t)(row0 + ai * HALF + m * 16) * D + col0;
#pragma unroll
                    for (int bj = 0; bj < 2; ++bj) { const f32x4 v0 = acc[ai][bj][m][0], v1 = acc[ai][bj][m][1]; const u32x4 q = qq[m][bj];
                        u32x4 w; w.x = cvt_pk_bf16(v0[0] * bflo(q.x), v0[1] * bfhi(q.x)); w.y = cvt_pk_bf16(v0[2] * bflo(q.y), v0[3] * bfhi(q.y));
                        w.z = cvt_pk_bf16(v1[0] * bflo(q.z), v1[1] * bfhi(q.z)); w.w = cvt_pk_bf16(v1[2] * bflo(q.w), v1[3] * bfhi(q.w));
                        *(u32x4*)(rowp + bj * HALF) = w; } }
                asm volatile("" ::: "memory");
            }
        }
    }
};
struct EpiSwiglu {
    static constexpr bool FP8 = true; int scale_w, scale_a;
    static constexpr bool PERM = true; static constexpr bool SWAPV = false; __device__ __forceinline__ bool swapv(const Unit&) const { return false; }
    unsigned char* hid;
    __device__ __forceinline__ void operator()(const f32x4 (&acc)[2][2][4][2], const Unit& u, int wr, int wc, int fr, int fq) const {
        const int row0 = u.e * 4096 + u.pm * BM + wr * 64 + fr, col0 = u.pn * HALF + wc * 32 + 8 * fq;
#pragma unroll
        for (int ai = 0; ai < 2; ++ai)
#pragma unroll
            for (int m = 0; m < 4; ++m) { unsigned char* rowp = hid + (size_t)(row0 + ai * HALF + m * 16) * DEXP + col0;
                float h[8];
#pragma unroll
                for (int n = 0; n < 2; ++n)
#pragma unroll
                    for (int j2 = 0; j2 < 2; ++j2) {
                        const f32x2 gt = {acc[ai][0][m][n][2 * j2], acc[ai][0][m][n][2 * j2 + 1]}, up = {acc[ai][1][m][n][2 * j2], acc[ai][1][m][n][2 * j2 + 1]};
                        const f32x2 a = gt * (f32x2){-1.4426950408889634f, -1.4426950408889634f};
                        f32x2 t; t.x = __builtin_amdgcn_exp2f(a.x); t.y = __builtin_amdgcn_exp2f(a.y);
                        const f32x2 d4 = t * (f32x2){0.25f, 0.25f} + (f32x2){0.25f, 0.25f};
                        f32x2 r4; r4.x = __builtin_amdgcn_rcpf(d4.x); r4.y = __builtin_amdgcn_rcpf(d4.y);
                        const f32x2 hv = (gt * up) * r4;
                        h[n * 4 + 2 * j2] = __builtin_amdgcn_fmed3f(hv.x, -448.f, 448.f); h[n * 4 + 2 * j2 + 1] = __builtin_amdgcn_fmed3f(hv.y, -448.f, 448.f); }
                int w0 = __builtin_amdgcn_cvt_pk_fp8_f32(h[0], h[1], 0, false); w0 = __builtin_amdgcn_cvt_pk_fp8_f32(h[2], h[3], w0, true);
                int w1 = __builtin_amdgcn_cvt_pk_fp8_f32(h[4], h[5], 0, false); w1 = __builtin_amdgcn_cvt_pk_fp8_f32(h[6], h[7], w1, true);
                u32x2 w; w.x = (unsigned)w0; w.y = (unsigned)w1;
                *(u32x2*)(rowp) = w; }
    }
};
struct EpiDown {
    static constexpr bool FP8 = true; int scale_w, scale_a;
    static constexpr bool PERM = true; static constexpr bool SWAPV = false; __device__ __forceinline__ bool swapv(const Unit&) const { return false; }
    unsigned char* ye;
    __device__ __forceinline__ void operator()(const f32x4 (&acc)[2][2][4][2], const Unit& u, int wr, int wc, int fr, int fq) const {
        const int row0 = u.e * 4096 + u.pm * BM + wr * 64 + fr, col0 = u.pn * BM + wc * 32 + 8 * fq;
#pragma unroll
        for (int ai = 0; ai < 2; ++ai)
#pragma unroll
            for (int m = 0; m < 4; ++m) { const int row = row0 + ai * HALF + m * 16; unsigned char* rowp = ye + (size_t)row * D + col0;
#pragma unroll
                for (int bj = 0; bj < 2; ++bj) { f32x4 v0 = acc[ai][bj][m][0] * 32.f, v1 = acc[ai][bj][m][1] * 32.f;
#pragma unroll
                    for (int i = 0; i < 4; ++i) { v0[i] = __builtin_amdgcn_fmed3f(v0[i], -448.f, 448.f); v1[i] = __builtin_amdgcn_fmed3f(v1[i], -448.f, 448.f); }
                    int w0 = __builtin_amdgcn_cvt_pk_fp8_f32(v0[0], v0[1], 0, false); w0 = __builtin_amdgcn_cvt_pk_fp8_f32(v0[2], v0[3], w0, true);
                    int w1 = __builtin_amdgcn_cvt_pk_fp8_f32(v1[0], v1[1], 0, false); w1 = __builtin_amdgcn_cvt_pk_fp8_f32(v1[2], v1[3], w1, true);
                    u32x2 w; w.x = (unsigned)w0; w.y = (unsigned)w1;
                    *(u32x2*)(rowp + bj * HALF) = w; } }
    }
};
}

constexpr int RING_BYTES = 131072, LDS_BYTES = 147456;
struct Args { const float* in[20]; float* out; unsigned char* ws; int ph_lo, ph_hi; };
struct Frame {
    LAS unsigned char* lds;
    int tid, lane, wave, gw, ngw, G;
};
#define P_X 0
#define P_C 1
#define P_CTX 2
#define P_CCTX 3
#define P_ADAW 4
#define P_ADAB 5
#define P_NORMG 6
#define P_GWIN 7
#define P_GWA2 8
#define P_GBA2 9
#define P_GNORMG 10
#define P_GWOUT 11
#define P_CWIN 12
#define P_CK 13
#define P_CWOUT 14
#define P_ROUTER 15
#define P_EGATE 16
#define P_EUP 17
#define P_EDOWN 18
#define P_FINALG 19

constexpr int TR_SCR = 64 * 65 * 4;
__device__ __forceinline__ void tr_item(const float* W, int ldw, int k0, int n0, bf16_t* WT, int ldo, int drow0, LAS float* scr, int lane) {
    f32x4 v[16];
#pragma unroll
    for (int i = 0; i < 16; ++i) v[i] = *(const f32x4*)(W + (size_t)(k0 + 4 * i + (lane >> 4)) * ldw + n0 + 4 * (lane & 15));
#pragma unroll
    for (int i = 0; i < 16; ++i) { LAS float* p = scr + (4 * i + (lane >> 4)) * 65 + 4 * (lane & 15); p[0] = v[i].x; p[1] = v[i].y; p[2] = v[i].z; p[3] = v[i].w; }
    LDS_WAIT(); asm volatile("" ::: "memory");
    const int c = lane & 7;
#pragma unroll
    for (int j = 0; j < 8; ++j) { const int n = (lane >> 3) + 8 * j; const LAS float* sp = scr + (8 * c) * 65 + n;
        u32x4 o; o.x = pk2(sp[0 * 65], sp[1 * 65]); o.y = pk2(sp[2 * 65], sp[3 * 65]); o.z = pk2(sp[4 * 65], sp[5 * 65]); o.w = pk2(sp[6 * 65], sp[7 * 65]);
        *(u32x4*)(WT + (size_t)(drow0 + n) * ldo + k0 + 8 * c) = o; }
    LDS_WAIT(); asm volatile("" ::: "memory");
}
__device__ __forceinline__ void tr_plain(Frame& F, const Args& A, const float* W, int K, int N, bf16_t* WT, int item, LAS float* scr) {
    const int nblk = (N + 63) / 64, kb = item / nblk, nb = item % nblk; int n0 = 64 * nb; if (n0 + 64 > N) n0 = N - 64;
    tr_item(W, N, 64 * kb, n0, WT, K, n0, scr, F.lane);
}
constexpr int TR_SCR8 = 128 * 33 * 4;
static_assert(TR_SCR8 >= TR_SCR, "per-wave scratch stride");
struct Tr8Item { const float* W; unsigned char* WT; int ldw, ldo, rowmap; };
constexpr int I8_G = (D / 128) * (DEXP / 256);
constexpr int I8_D = (DEXP / 128) * (D / 256);
constexpr int N_EXPERT_ITEMS = NE * (2 * I8_G + I8_D);
__device__ __forceinline__ Tr8Item expert_item(const Args& A, int gi) {
    const int l = gi / N_EXPERT_ITEMS, it = gi % N_EXPERT_ITEMS;
    unsigned char* wgu = A.ws + WS_W8 + (size_t)l * W8_LAYER; unsigned char* wd = wgu + W8_WD;
    constexpr int PER_E = 2 * I8_G + I8_D;
    const int e = it / PER_E; int r = it % PER_E;
    Tr8Item t;
    if (r < 2 * I8_G) {
        const int up = r / I8_G; r %= I8_G;
        const float* W = A.in[up ? P_EUP : P_EGATE] + ((size_t)l * NE + e) * D * DEXP;
        const int nblk = DEXP / 256, kb = r / nblk, nb = r % nblk, h0 = 256 * nb;
        t.W = W + (size_t)(128 * kb) * DEXP + h0; t.ldw = DEXP; t.WT = wgu + (size_t)e * 4096 * D + (size_t)(2 * h0 + 128 * up) * D + 128 * kb; t.ldo = D; t.rowmap = 1;
    } else {
        r -= 2 * I8_G;
        const float* W = A.in[P_EDOWN] + ((size_t)l * NE + e) * DEXP * D;
        const int nblk = D / 256, kb = r / nblk, nb = r % nblk;
        t.W = W + (size_t)(128 * kb) * D + 256 * nb; t.ldw = D; t.WT = wd + (size_t)e * D * DEXP + (size_t)(256 * nb) * DEXP + 128 * kb; t.ldo = DEXP; t.rowmap = 0;
    }
    return t;
}
__device__ __forceinline__ void tr8_load(const Tr8Item& t, f32x4 (&v)[16], int wave, int lane) {
#pragma unroll
    for (int i = 0; i < 16; ++i) v[i] = __builtin_nontemporal_load((const f32x4*)(t.W + (size_t)(16 * wave + i) * t.ldw + 4 * lane));
}
__device__ __forceinline__ void tr8_finish(const Tr8Item& t, const f32x4 (&v)[16], LAS unsigned char* tile, int tid, int wave, int lane) {
#pragma unroll
    for (int q = 0; q < 4; ++q) {
        int o[4];
#pragma unroll
        for (int g = 0; g < 4; ++g) { int w = __builtin_amdgcn_cvt_pk_fp8_f32(64.f * v[4 * g][q], 64.f * v[4 * g + 1][q], 0, false);
            o[g] = __builtin_amdgcn_cvt_pk_fp8_f32(64.f * v[4 * g + 2][q], 64.f * v[4 * g + 3][q], w, true); }
        u32x4 ov; ov.x = (unsigned)o[0]; ov.y = (unsigned)o[1]; ov.z = (unsigned)o[2]; ov.w = (unsigned)o[3];
        const int n = 4 * lane + q;
        *(LAS u32x4*)(tile + n * 128 + ((wave ^ (n & 7)) << 4)) = ov; }
    __syncthreads();
#pragma unroll
    for (int j = 0; j < 4; ++j) { const int p = tid + 512 * j, n = p >> 3, c = p & 7;
        const u32x4 ov = *(const LAS u32x4*)(tile + n * 128 + ((c ^ (n & 7)) << 4));
        const int drow = t.rowmap ? (256 * (n >> 7) + (n & 127)) : n;
        __builtin_nontemporal_store(ov, (u32x4*)(t.WT + (size_t)drow * t.ldo + 16 * c)); }
    __syncthreads();
}
__device__ __forceinline__ void convert_expert_dyn(const Args& A, unsigned* ctr, int end, LAS unsigned char* tile, volatile LAS int* slot, int tid, int wave, int lane) {
    if (tid == 0) { slot[0] = (int)__hip_atomic_fetch_add(ctr, 1u, __ATOMIC_RELAXED, __HIP_MEMORY_SCOPE_AGENT); slot[1] = (int)__hip_atomic_fetch_add(ctr, 1u, __ATOMIC_RELAXED, __HIP_MEMORY_SCOPE_AGENT); }
    __syncthreads();
    int ia = slot[0], ib = slot[1];
    if (ia >= end) return;
    f32x4 va[16], vb[16];
    Tr8Item ta = expert_item(A, ia), tb;
    tr8_load(ta, va, wave, lane);
    for (;;) {
        int rc = 0;
        tb = expert_item(A, min(ib, end - 1)); tr8_load(tb, vb, wave, lane);
        if (tid == 0) rc = (int)__hip_atomic_fetch_add(ctr, 1u, __ATOMIC_RELAXED, __HIP_MEMORY_SCOPE_AGENT);
        tr8_finish(ta, va, tile, tid, wave, lane);
        if (tid == 0) slot[0] = rc;
        __syncthreads();
        ia = ib; ib = slot[0];
        if (ia >= end) break;
        ta = expert_item(A, min(ib, end - 1)); tr8_load(ta, va, wave, lane);
        if (tid == 0) rc = (int)__hip_atomic_fetch_add(ctr, 1u, __ATOMIC_RELAXED, __HIP_MEMORY_SCOPE_AGENT);
        tr8_finish(tb, vb, tile, tid, wave, lane);
        if (tid == 0) slot[1] = rc;
        __syncthreads();
        ia = ib; ib = slot[1];
        if (ia >= end) break;
    }
}
template <int N>
__device__ __forceinline__ void convert_expert_fixed(const Args& A, LAS unsigned char* lds, int tid, int wave, int lane) {
    unsigned* ctr = (unsigned*)(A.ws + WS_CTL) + 2048; LAS unsigned char* tile = lds + 49152; volatile LAS int* slot = (volatile LAS int*)(lds + 40960);
    constexpr int end = 2 * N_EXPERT_ITEMS;
    __syncthreads();
    if (tid == 0) slot[0] = (int)__hip_atomic_fetch_add(ctr, (unsigned)N, __ATOMIC_RELAXED, __HIP_MEMORY_SCOPE_AGENT);
    __syncthreads();
    const int base = slot[0];
    if (base >= end) return;
    f32x4 va[16], vb[16];
    Tr8Item ta = expert_item(A, base), tb = ta;
    tr8_load(ta, va, wave, lane);
#pragma unroll
    for (int j = 0; j < N; ++j) {
        if ((j & 1) == 0) { if (j + 1 < N) { tb = expert_item(A, min(base + j + 1, end - 1)); tr8_load(tb, vb, wave, lane); } tr8_finish(ta, va, tile, tid, wave, lane); }
        else              { if (j + 1 < N) { ta = expert_item(A, min(base + j + 1, end - 1)); tr8_load(ta, va, wave, lane); } tr8_finish(tb, vb, tile, tid, wave, lane); }
    }
}

__device__ __forceinline__ void ph_prep(Frame& F, const Args& A) {
    LAS float* scr = (LAS float*)(F.lds + F.wave * TR_SCR8);
    bf16_t* win0 = (bf16_t*)(A.ws + WS_WIN0T); bf16_t* wout0 = (bf16_t*)(A.ws + WS_WOUT0T); bf16_t* wcin = (bf16_t*)(A.ws + WS_WCINT); bf16_t* wcout = (bf16_t*)(A.ws + WS_WCOUTT);
    {
        float* mod = (float*)(A.ws + WS_MOD);
        LAS float* red = (LAS float*)(F.lds + 8 * TR_SCR8);
        if ((int)blockIdx.x < 2 * 96) {
            LAS float* sl = (LAS float*)F.lds;
            for (int i = F.tid; i < 3 * D; i += NTHR) sl[i] = silu_f(i < 2 * D ? A.in[P_C][i] : A.in[P_CCTX][i - 2 * D]);
            __syncthreads();
        }
        for (int it = blockIdx.x; it < 2 * 96; it += F.G) {
            const LAS float* sl = (const LAS float*)F.lds;
            const int l = it / 96, n0 = (it % 96) * 64, kq = F.lane >> 4, c4 = F.lane & 15;
            const float* w = A.in[P_ADAW] + (size_t)l * D * 6 * D + n0 + 4 * c4;
            f32x4 a0 = (f32x4){0.f, 0.f, 0.f, 0.f}, a1 = a0, a2 = a0;
#pragma unroll
            for (int st = 0; st < 32; ++st) { const int k = F.wave * 128 + 4 * st + kq; const f32x4 wv = __builtin_nontemporal_load((const f32x4*)(w + (size_t)k * 6 * D));
                a0 += sl[k] * wv; a1 += sl[D + k] * wv; a2 += sl[2 * D + k] * wv; }
#pragma unroll
            for (int i = 0; i < 4; ++i) { a0[i] += __shfl_xor(a0[i], 16); a0[i] += __shfl_xor(a0[i], 32); a1[i] += __shfl_xor(a1[i], 16); a1[i] += __shfl_xor(a1[i], 32); a2[i] += __shfl_xor(a2[i], 16); a2[i] += __shfl_xor(a2[i], 32); }
            if (kq == 0) { *(LAS f32x4*)(red + (F.wave * 3 + 0) * 64 + 4 * c4) = a0; *(LAS f32x4*)(red + (F.wave * 3 + 1) * 64 + 4 * c4) = a1; *(LAS f32x4*)(red + (F.wave * 3 + 2) * 64 + 4 * c4) = a2; }
            __syncthreads();
            if (F.wave < 3) { const int n = n0 + F.lane; float sacc = A.in[P_ADAB][l * 6 * D + n];
#pragma unroll
                for (int w8 = 0; w8 < 8; ++w8) sacc += red[(w8 * 3 + F.wave) * 64 + F.lane];
                mod[(l * 3 + F.wave) * 6 * D + n] = sacc; }
            __syncthreads();
            if (it < 32 && F.tid == 0) { __builtin_amdgcn_fence(__ATOMIC_RELEASE, "agent"); (void)xb_add((unsigned*)(A.ws + WS_CTL) + 2050, 1u); }
        }
    }
    constexpr int I0 = (D / 64) * ((NIN0 + 63) / 64), I1 = (D / 64) * (D / 64), I2 = (D / 64) * (NCIN / 64), I3 = I1;
    for (int it = F.ngw - 1 - F.gw; it < I0 + I1 + I2 + I3; it += F.ngw) {
        int r = it;
        if (r < I0) { tr_plain(F, A, A.in[P_GWIN], D, NIN0, win0, r, scr); continue; } r -= I0;
        if (r < I1) { tr_plain(F, A, A.in[P_GWOUT], D, D, wout0, r, scr); continue; } r -= I1;
        if (r < I2) {
            constexpr int nblk = NCIN / 64; const int kb = r / nblk, n0 = 64 * (r % nblk), sct = n0 >> 10, ch = n0 & 1023, cb = ch >> 8, hf = (ch >> 7) & 1;
            const int drow0 = sct == 0 ? (3 * cb + 2) * 256 + (ch & 255) : (3 * cb + hf) * 256 + 128 * (sct - 1) + (ch & 127);
            tr_item(A.in[P_CWIN], NCIN, 64 * kb, n0, wcin, D, drow0, scr, F.lane); continue; } r -= I2;
        tr_plain(F, A, A.in[P_CWOUT], D, D, wcout, r, scr);
    }
    { u32x4* z = (u32x4*)(win0 + (size_t)NIN0 * D); const int n16 = (NIN0P - NIN0) * D * 2 / 16;
      for (int i = F.gw * 64 + F.lane; i < n16; i += F.ngw * 64) z[i] = (u32x4){0u, 0u, 0u, 0u}; }
}

__device__ __forceinline__ void ph_norm0(Frame& F, const Args& A) {
    const float* mod = (const float*)(A.ws + WS_MOD); bf16_t* H = (bf16_t*)(A.ws + WS_H);
    int scur = -1; f32x4 pg[4], p1[4], p2[4];
    const int xq = blockIdx.x & 7, lw = (int)(blockIdx.x >> 3) * NWAVES + F.wave, rbase = 4096 * xq + lw;
#define NORM0_ROW(k) ((k) < 16 ? rbase + 256 * (k) : NLAT + 256 * (xq - 6) + lw)
    for (int it = 0; it < 9; ++it) {
        const int kA = 16 - 2 * it, kB = 15 - 2 * it; const bool vA = kA < 16 || xq >= 6, vB = kB >= 0;
        const int row = vA ? NORM0_ROW(kA) : NORM0_ROW(kB), row2 = NORM0_ROW(vB ? kB : 0); const bool has2 = vA && vB;
        const float* xa = row < NLAT ? A.in[P_X] + (size_t)row * D : A.in[P_CTX] + (size_t)(row - NLAT) * D;
        const int r2c = has2 ? row2 : row;
        const float* xb = r2c < NLAT ? A.in[P_X] + (size_t)r2c * D : A.in[P_CTX] + (size_t)(r2c - NLAT) * D;
        f32x4 va[4], vb[4];
#pragma unroll
        for (int j = 0; j < 4; ++j) { va[j] = __builtin_nontemporal_load((const f32x4*)(xa + 4 * F.lane + 256 * j)); vb[j] = __builtin_nontemporal_load((const f32x4*)(xb + 4 * F.lane + 256 * j)); }
#pragma unroll
        for (int h = 0; h < 2; ++h) {
            const int r = h ? r2c : row; if (h && !has2) break;
            const int sset = r < NLAT ? (r >> 14) : 2;
            if (sset != scur) { scur = sset;
#pragma unroll
                for (int j = 0; j < 4; ++j) { const int c = 4 * F.lane + 256 * j; pg[j] = *(const f32x4*)(A.in[P_NORMG] + c);
                    p1[j] = *(const f32x4*)(mod + (0 * 3 + sset) * 6 * D + 0 * D + c); p2[j] = *(const f32x4*)(mod + (0 * 3 + sset) * 6 * D + 1 * D + c) + 1.f; } }
            float ssq = 0.f;
#pragma unroll
            for (int j = 0; j < 4; ++j) { const f32x4 v = h ? vb[j] : va[j]; ssq += (v.x * v.x + v.y * v.y) + (v.z * v.z + v.w * v.w); }
            const float rstd = rsqrtf(wave_sum(ssq) * (1.f / D) + EPS);
#pragma unroll
            for (int j = 0; j < 4; ++j) { const f32x4 v = h ? vb[j] : va[j]; const f32x4 y = v * rstd * pg[j] * p2[j] + p1[j];
                u32x2 w; w.x = pk2(y.x, y.y); w.y = pk2(y.z, y.w); *(u32x2*)(H + (size_t)r * D + 4 * F.lane + 256 * j) = w; }
        }
    }
}

__device__ __forceinline__ int jperm(int ks, int fq, int jj) { return 32 * ks + 16 * (jj >> 2) + 4 * fq + (jj & 3); }
__device__ __forceinline__ bf16x8 ldfrag(const unsigned char* blob, int blk, int lane) { return *(const bf16x8*)(blob + blk * 1024 + lane * 16); }
__device__ __forceinline__ unsigned cvtpk(float lo, float hi) { return pk2(lo, hi); }
__device__ __forceinline__ bf16x8 pack8(const f32x4& a, const f32x4& b) {
    u32x4 w; w.x = cvtpk(a[0], a[1]); w.y = cvtpk(a[2], a[3]); w.z = cvtpk(b[0], b[1]); w.w = cvtpk(b[2], b[3]);
    return __builtin_bit_cast(bf16x8, w);
}
__device__ __forceinline__ void ph_gla_prep(Frame& F, const Args& A) {
    constexpr int LSTR = 1040;
    LAS unsigned char* QS = F.lds; LAS unsigned char* KS = F.lds + 64 * LSTR;
    const bf16_t* qk = (const bf16_t*)(A.ws + WS_QK); const float* afb = (const float*)(A.ws + WS_AFB);
    float* gam = (float*)(A.ws + WS_GAM);
    const int xq = blockIdx.x & 7, rq = (int)(blockIdx.x >> 3), nit = 4 + ((xq >= 6 && rq < 8) ? 1 : 0);
#define PREP_CHUNK(it_) ((it_) < 4 ? 64 * xq + 16 * (it_) + (rq >> 1) : 512 + 4 * (xq - 6) + (rq >> 1))
    const bool has_conv = nit == 4;
    const int pre = has_conv ? ((rq >> 3) & 3) : 0;
    if (pre == 1) convert_expert_fixed<1>(A, F.lds, F.tid, F.wave, F.lane);
    else if (pre == 2) convert_expert_fixed<2>(A, F.lds, F.tid, F.wave, F.lane);
    else if (pre == 3) convert_expert_fixed<3>(A, F.lds, F.tid, F.wave, F.lane);
    __syncthreads();
    const int dir = rq & 1, d = F.tid;
    f32x2 w2[8];
#pragma unroll
    for (int r = 0; r < 8; ++r) { w2[r].x = A.in[P_GWA2][(dir * 16 + 2 * r) * DK + d]; w2[r].y = A.in[P_GWA2][(dir * 16 + 2 * r + 1) * DK + d]; }
    const float bias = A.in[P_GBA2][dir * DK + d];
    u32x4 t16[16]; f32x4 av = (f32x4){0.f, 0.f, 0.f, 0.f};
#define PREP_LOAD(it_) do { const int row0_ = PREP_CHUNK(it_) * 64; \
        _Pragma("unroll") for (int u = 0; u < 16; ++u) { const int q16 = F.tid + NTHR * u, j = q16 >> 7, cp = q16 & 127; t16[u] = *(const u32x4*)((const unsigned char*)qk + ((size_t)(row0_ + j) * D) * 2 + cp * 16); } \
        if (F.tid < 256) av = *(const f32x4*)(afb + (size_t)(row0_ + (F.tid >> 2)) * 32 + dir * 16 + 4 * (F.tid & 3)); } while (0)
    PREP_LOAD(0);
    for (int item = 0; item < nit; ++item) {
        {
            const int ch = PREP_CHUNK(item), row0 = ch * 64; (void)row0;
            LAS float* AFL = (LAS float*)(F.lds + 2 * 64 * LSTR);
            {
#pragma unroll
                for (int u = 0; u < 16; ++u) { const int q16 = F.tid + NTHR * u, j = q16 >> 7, cp = q16 & 127; *(LAS u32x4*)(((cp < 64) ? QS : KS) + j * LSTR + (cp & 63) * 16) = t16[u]; }
                if (F.tid < 256) *(LAS f32x4*)(AFL + (F.tid >> 2) * 16 + 4 * (F.tid & 3)) = av;
            }
            if (item + 1 < nit) PREP_LOAD(item + 1);
            __syncthreads();
            float cum2 = 0.f;
#pragma unroll 1
            for (int jq = 0; jq < 64; jq += 4) {
                f32x4 ar[4][4]; unsigned qv[4], kv[4];
#pragma unroll
                for (int u = 0; u < 4; ++u) { const int j = dir ? 63 - (jq + u) : jq + u;
#pragma unroll
                    for (int r4 = 0; r4 < 4; ++r4) ar[u][r4] = *(const LAS f32x4*)(AFL + j * 16 + 4 * r4); }
#pragma unroll
                for (int u = 0; u < 4; ++u) { const int j = dir ? 63 - (jq + u) : jq + u;
                    qv[u] = *(const LAS bf16_t*)(QS + j * LSTR + d * 2); kv[u] = *(const LAS bf16_t*)(KS + j * LSTR + d * 2); }
                asm volatile("" ::: "memory");
                float ls2[4];
#pragma unroll
                for (int u = 0; u < 4; ++u) {
                    f32x2 za = (f32x2){bias, 0.f}, zb = (f32x2){0.f, 0.f};
#pragma unroll
                    for (int r4 = 0; r4 < 4; ++r4) { za = __builtin_elementwise_fma((f32x2){ar[u][r4].x, ar[u][r4].y}, w2[2 * r4], za); zb = __builtin_elementwise_fma((f32x2){ar[u][r4].z, ar[u][r4].w}, w2[2 * r4 + 1], zb); }
                    const float z = (za.x + za.y) + (zb.x + zb.y);
                    const float zl = z * 1.4426950408889634f;
                    ls2[u] = fminf(zl, 0.f) - __builtin_amdgcn_logf(1.f + __builtin_amdgcn_exp2f(-fabsf(zl)));
                }
                unsigned qk2[4];
#pragma unroll
                for (int u = 0; u < 4; ++u) {
                    cum2 += ls2[u] * (1.f / 16.f);
                    const float e = __builtin_amdgcn_exp2f(cum2), ei = __builtin_amdgcn_exp2f(-cum2);
                    qk2[u] = pk2(bflo(qv[u]) * e, bflo(kv[u]) * ei);
                }
#pragma unroll
                for (int u = 0; u < 4; ++u) { const int j = dir ? 63 - (jq + u) : jq + u;
                    *(LAS bf16_t*)(QS + j * LSTR + d * 2) = (bf16_t)(qk2[u] & 0xffffu); *(LAS bf16_t*)(KS + j * LSTR + d * 2) = (bf16_t)(qk2[u] >> 16); }
            }
            const float cum = cum2 * 0.6931471805599453f;
            gam[((size_t)dir * NCHUNK + ch) * DK + d] = __expf(cum);
            __syncthreads();
            {
                const int fr = F.lane & 15, fq = F.lane >> 4;
                unsigned char* blob0 = A.ws + (((size_t)dir * NCHUNK + ch) * 4) * BLOB + (size_t)F.tid * 16;
#pragma unroll
                for (int typ = 0; typ < 2; ++typ) {
                    const LAS unsigned char* src = (typ == 0) ? QS : KS;
                    u32x4 o[8];
#pragma unroll
                    for (int i8 = 0; i8 < 8; ++i8) { const int h = i8 >> 1, blk = F.wave + 8 * (i8 & 1), it = blk >> 2, sd = blk & 3, i = 16 * it + fr, d0 = h * HK + 32 * sd + 4 * fq;
                        const u32x2 lo = *(const LAS u32x2*)(src + i * LSTR + d0 * 2), hi = *(const LAS u32x2*)(src + i * LSTR + (d0 + 16) * 2);
                        o[i8].x = lo.x; o[i8].y = lo.y; o[i8].z = hi.x; o[i8].w = hi.y; }
                    unsigned char* dst = blob0 + (typ == 0 ? WS_QP : WS_KP);
#pragma unroll
                    for (int i8 = 0; i8 < 8; ++i8) *(u32x4*)(dst + (size_t)(i8 >> 1) * BLOB + (size_t)(i8 & 1) * 8192) = o[i8];
                }
                {
                    u32x4 o[8];
#pragma unroll
                    for (int i8 = 0; i8 < 8; ++i8) { const int h = i8 >> 1, blk = F.wave + 8 * (i8 & 1), mt = blk >> 1, ks = blk & 1, dd = h * HK + 16 * mt + fr; unsigned e[8];
#pragma unroll
                        for (int jj = 0; jj < 8; ++jj) e[jj] = *(const LAS bf16_t*)(KS + jperm(ks, fq, jj) * LSTR + dd * 2);
                        o[i8].x = e[0] | (e[1] << 16); o[i8].y = e[2] | (e[3] << 16); o[i8].z = e[4] | (e[5] << 16); o[i8].w = e[6] | (e[7] << 16); }
                    unsigned char* dst = blob0 + WS_KTP;
#pragma unroll
                    for (int i8 = 0; i8 < 8; ++i8) *(u32x4*)(dst + (size_t)(i8 >> 1) * BLOB + (size_t)(i8 & 1) * 8192) = o[i8];
                }
            }
            __syncthreads();
        }
    }
#undef PREP_LOAD
#undef PREP_CHUNK
    if (has_conv) {
        if (pre == 0) convert_expert_fixed<4>(A, F.lds, F.tid, F.wave, F.lane);
        else if (pre == 1) convert_expert_fixed<3>(A, F.lds, F.tid, F.wave, F.lane);
        else if (pre == 2) convert_expert_fixed<2>(A, F.lds, F.tid, F.wave, F.lane);
        else convert_expert_fixed<1>(A, F.lds, F.tid, F.wave, F.lane);
    }
}

#define MFMA16(a, b, c) __builtin_amdgcn_mfma_f32_16x16x32_bf16((a), (b), (c), 0, 0, 0)
__device__ __forceinline__ void gla_intra_item(Frame& F, const Args& A, int item) {
    const int ch = item >> 2, h = item & 3, fr = F.lane & 15, fq = F.lane >> 4;
    const unsigned char* qpf = A.ws + WS_QP + (((size_t)0 * NCHUNK + ch) * 4 + h) * BLOB; const unsigned char* kpf = A.ws + WS_KP + (((size_t)0 * NCHUNK + ch) * 4 + h) * BLOB;
    const unsigned char* qpb = A.ws + WS_QP + (((size_t)1 * NCHUNK + ch) * 4 + h) * BLOB; const unsigned char* kpb = A.ws + WS_KP + (((size_t)1 * NCHUNK + ch) * 4 + h) * BLOB;
    bf16x8 Pf[4][2];
#pragma unroll
    for (int it = 0; it < 4; ++it) {
        f32x4 P[4];
#pragma unroll
        for (int jt = 0; jt < 4; ++jt) P[jt] = (f32x4){0.f, 0.f, 0.f, 0.f};
#pragma unroll
        for (int dirp = 0; dirp < 2; ++dirp) {
            const unsigned char* qp = dirp ? qpb : qpf; const unsigned char* kp = dirp ? kpb : kpf;
            bf16x8 kk[16], qq[4];
#pragma unroll
            for (int sd = 0; sd < 4; ++sd) qq[sd] = ldfrag(qp, it * 4 + sd, F.lane);
#pragma unroll
            for (int jt = 0; jt < 4; ++jt) if (dirp ? (jt >= it) : (jt <= it)) {
#pragma unroll
                for (int sd = 0; sd < 4; ++sd) kk[jt * 4 + sd] = ldfrag(kp, jt * 4 + sd, F.lane); }
#pragma unroll
            for (int jt = 0; jt < 4; ++jt) if (dirp ? (jt >= it) : (jt <= it)) {
                f32x4 a = (f32x4){0.f, 0.f, 0.f, 0.f};
#pragma unroll
                for (int sd = 0; sd < 4; ++sd) a = MFMA16(kk[jt * 4 + sd], qq[sd], a);
                if (jt == it) {
#pragma unroll
                    for (int r = 0; r < 4; ++r) { const int j = 4 * fq + r; const bool keep = dirp ? (j >= fr) : (j <= fr); a[r] = keep ? a[r] : 0.f; }
                }
                P[jt] += a;
            }
        }
        Pf[it][0] = pack8(P[0], P[1]); Pf[it][1] = pack8(P[2], P[3]);
    }
    const unsigned char* vt = A.ws + WS_VTP + (size_t)ch * 131072 + (size_t)(h * 16) * 2048;
    bf16_t* oi = (bf16_t*)(A.ws + WS_OI) + (size_t)(ch * 64 + fr) * DV + h * HV + 4 * fq;
#pragma unroll 1
    for (int ng = 0; ng < 4; ++ng) {
        bf16x8 va[8];
#pragma unroll
        for (int i = 0; i < 8; ++i) va[i] = ldfrag(vt, ng * 8 + i, F.lane);
#pragma unroll
        for (int n4 = 0; n4 < 4; ++n4)
#pragma unroll
            for (int it = 0; it < 4; ++it) {
                f32x4 acc = (f32x4){0.f, 0.f, 0.f, 0.f};
                acc = MFMA16(va[n4 * 2], Pf[it][0], acc); acc = MFMA16(va[n4 * 2 + 1], Pf[it][1], acc);
                u32x2 w; w.x = pk2(acc[0], acc[1]); w.y = pk2(acc[2], acc[3]);
                *(u32x2*)(oi + (size_t)(16 * it) * DV + 16 * (ng * 4 + n4)) = w;
            }
    }
}
struct ScanRegs { bf16x8 q[4], k[4], v[2][2]; f32x4 g[2]; };
__device__ __forceinline__ int scan_chunk(int b, int dir, int step) { return step >= 4 ? (256 * b + (dir ? 255 - (step - 4) : step - 4)) : (512 + 4 * b + (dir ? 3 - step : step)); }
__device__ __forceinline__ void scan_load(const Args& A, ScanRegs& R, int b, int h, int dir, int sp, int w, int step, int lane) {
    const int ch = scan_chunk(b, dir, step), fq = lane >> 4;
    const size_t bo = (((size_t)dir * NCHUNK + ch) * 4 + h) * BLOB;
    const unsigned char* qp = A.ws + WS_QP + bo; const unsigned char* ktp = A.ws + WS_KTP + bo;
    const unsigned char* vt = A.ws + WS_VTP + (size_t)ch * 131072 + (size_t)(h * 16 + 2 * sp) * 2048;
    const float* gp = (const float*)(A.ws + WS_GAM) + ((size_t)dir * NCHUNK + ch) * DK + h * HK + 32 * w + 4 * fq;
#pragma unroll
    for (int sd = 0; sd < 4; ++sd) R.q[sd] = ldfrag(qp, w * 4 + sd, lane);
#pragma unroll
    for (int m = 0; m < 2; ++m)
#pragma unroll
        for (int ks = 0; ks < 2; ++ks) R.k[m * 2 + ks] = ldfrag(ktp, (2 * w + m) * 2 + ks, lane);
#pragma unroll
    for (int s2 = 0; s2 < 2; ++s2) {
        const int o = 8 * ((lane & 15) >> 2) + 4 * s2 + (lane & 3);
        const unsigned char* vp = vt + (o >> 4) * 2048 + ((o & 15) + (lane & 48)) * 16;
        R.v[s2][0] = *(const bf16x8*)(vp); R.v[s2][1] = *(const bf16x8*)(vp + 1024); }
    R.g[0] = *(const f32x4*)(gp); R.g[1] = *(const f32x4*)(gp + 16);
}
#define LDS_ORDER() asm volatile("" ::: "memory")
__device__ __forceinline__ void scan_ds(const ScanRegs& R, f32x4 (&dS)[2][2]) {
#pragma unroll
    for (int s2 = 0; s2 < 2; ++s2)
#pragma unroll
        for (int m = 0; m < 2; ++m) { f32x4 d = (f32x4){0.f, 0.f, 0.f, 0.f}; d = MFMA16(R.k[m * 2], R.v[s2][0], d); d = MFMA16(R.k[m * 2 + 1], R.v[s2][1], d); dS[s2][m] = d; }
}
__device__ __forceinline__ void scan_step(const Args& A, const ScanRegs& R, const ScanRegs& Rn, f32x4 (&S)[2][2], f32x4 (&dS)[2][2], LAS unsigned char* xs, LAS unsigned* flags, bf16_t* O, int b, int h, int dir, int sp, int w, int step, int lane) {
    const int fr = lane & 15, fq = lane >> 4;
#pragma unroll
    for (int s2 = 0; s2 < 2; ++s2) {
        S[s2][0] = R.g[0] * (S[s2][0] + dS[s2][0]); S[s2][1] = R.g[1] * (S[s2][1] + dS[s2][1]);
        *(volatile LAS bf16x8*)(xs + ((step + 1) & 3) * 8192 + (s2 * 4 + w) * 1024 + lane * 16) = pack8(S[s2][0], S[s2][1]);
    }
    LDS_ORDER();
    if (lane == 0) *(volatile LAS unsigned*)(flags + w) = (unsigned)step + 2u;
    LDS_ORDER();
    scan_ds(Rn, dS);
    if (step >= 4) {
        { const unsigned need = (unsigned)step + 1u; unsigned spn = 0;
          for (;;) { const unsigned f = (lane < 4) ? *(volatile LAS unsigned*)(flags + lane) : need;
              if (__all((int)(f >= need))) break; if (++spn > (1u << 26)) break; }
          LDS_ORDER(); }
        const LAS unsigned char* slot = xs + (step & 3) * 8192 + lane * 16;
        bf16x8 sf[2][4];
#pragma unroll
        for (int s2 = 0; s2 < 2; ++s2)
#pragma unroll
            for (int sd = 0; sd < 4; ++sd) sf[s2][sd] = *(const LAS bf16x8*)(slot + (s2 * 4 + sd) * 1024);
        LDS_ORDER();
        const int ch = scan_chunk(b, dir, step);
        f32x4 acc0 = (f32x4){0.f, 0.f, 0.f, 0.f}, acc1 = acc0;
#pragma unroll
        for (int sd = 0; sd < 4; ++sd) { acc0 = MFMA16(sf[0][sd], R.q[sd], acc0); acc1 = MFMA16(sf[1][sd], R.q[sd], acc1); }
        u32x4 wv; wv.x = pk2(acc0[0], acc0[1]); wv.y = pk2(acc0[2], acc0[3]); wv.z = pk2(acc1[0], acc1[1]); wv.w = pk2(acc1[2], acc1[3]);
        *(u32x4*)(O + (size_t)(ch * 64 + 16 * w + fr) * DV + h * HV + 32 * sp + 8 * fq) = wv;
    }
}
__device__ __forceinline__ void gla_scan_item(Frame& F, const Args& A, int item, LAS unsigned char* xs, LAS unsigned* flags) {
    const int chain = item >> 3, sp = item & 7, b = chain >> 3, h = (chain >> 1) & 3, dir = chain & 1, w = F.wave;
    bf16_t* O = (bf16_t*)(A.ws + (dir ? WS_OB : WS_OF));
    f32x4 S[2][2], dS[2][2];
#pragma unroll
    for (int s2 = 0; s2 < 2; ++s2) { S[s2][0] = (f32x4){0.f, 0.f, 0.f, 0.f}; S[s2][1] = S[s2][0];
        *(volatile LAS bf16x8*)(xs + (s2 * 4 + w) * 1024 + F.lane * 16) = pack8(S[s2][0], S[s2][1]); }
    LDS_ORDER();
    if (F.lane == 0) *(volatile LAS unsigned*)(flags + w) = 1u;
    LDS_ORDER();
    ScanRegs Ra, Rb, Rc;
    scan_load(A, Ra, b, h, dir, sp, w, 0, F.lane);
    scan_load(A, Rb, b, h, dir, sp, w, 1, F.lane);
    scan_ds(Ra, dS);
    for (int step = 0; step < 261; step += 3) {
        scan_load(A, Rc, b, h, dir, sp, w, min(step + 2, 259), F.lane);
        scan_step(A, Ra, Rb, S, dS, xs, flags, O, b, h, dir, sp, w, step, F.lane);
        scan_load(A, Ra, b, h, dir, sp, w, min(step + 3, 259), F.lane);
        scan_step(A, Rb, Rc, S, dS, xs, flags, O, b, h, dir, sp, w, step + 1, F.lane);
        scan_load(A, Rb, b, h, dir, sp, w, min(step + 4, 259), F.lane);
        if (step + 2 < 260) scan_step(A, Rc, Ra, S, dS, xs, flags, O, b, h, dir, sp, w, step + 2, F.lane);
    }
}
__device__ __forceinline__ void ph_gla_main(Frame& F, const Args& A) {
    LAS unsigned char* xs = F.lds; LAS unsigned* flags = (LAS unsigned*)(F.lds + 32768);
    if (F.tid < 16) flags[F.tid] = 0u;
    __syncthreads();
    const int bi = blockIdx.x;
    unsigned* ctr = (unsigned*)(A.ws + WS_CTL) + 2048;
    volatile LAS int* slot = (volatile LAS int*)(F.lds + 40960);
    if (bi < 128) {
        if (F.wave < 4) gla_scan_item(F, A, ((2 * (bi & 7) + ((bi >> 3) & 1)) << 3) | ((bi >> 4) & 7), xs, flags);
        __syncthreads();
    } else {
        const int sw = (bi - 128) * NWAVES + F.wave, nsw = (F.G - 128) * NWAVES;
        for (int it = sw; it < 512 * 4; it += nsw) gla_intra_item(F, A, it);
        __syncthreads();
    }
    convert_expert_dyn(A, ctr, 2 * N_EXPERT_ITEMS, F.lds + 49152, slot, F.tid, F.wave, F.lane);
    __syncthreads();
}

__device__ __forceinline__ void ph_gla_finish(Frame& F, const Args& A) {
    const bf16_t* rp = (const bf16_t*)(A.ws + WS_R); const bf16_t* OFp = (const bf16_t*)(A.ws + WS_OF); const bf16_t* OBp = (const bf16_t*)(A.ws + WS_OB); const bf16_t* OIp = (const bf16_t*)(A.ws + WS_OI);
    bf16_t* Hh = (bf16_t*)(A.ws + WS_H);
    const f32x4 gn = *(const f32x4*)(A.in[P_GNORMG] + 4 * F.lane);
    const int fbase = 4096 * (int)(blockIdx.x & 7) + (int)(blockIdx.x >> 3) * NWAVES + F.wave;
    for (int kk = 14; kk >= 0; kk -= 2) {
        const int row = fbase + 256 * kk;
        u32x2 a[2][4], bq[2][4], ci[2][4], rr[2][4];
#pragma unroll
        for (int h2 = 0; h2 < 2; ++h2)
#pragma unroll
            for (int j = 0; j < 4; ++j) { const size_t o = (size_t)(row + (1 - h2) * 256) * DV + 4 * F.lane + 256 * j;
                a[h2][j] = __builtin_nontemporal_load((const u32x2*)(OFp + o)); bq[h2][j] = __builtin_nontemporal_load((const u32x2*)(OBp + o));
                ci[h2][j] = __builtin_nontemporal_load((const u32x2*)(OIp + o)); rr[h2][j] = __builtin_nontemporal_load((const u32x2*)(rp + o)); }
#pragma unroll
        for (int h2 = 0; h2 < 2; ++h2)
#pragma unroll
            for (int j = 0; j < 4; ++j) {
                const u32x2 av = a[h2][j], bv = bq[h2][j], cv = ci[h2][j], rv = rr[h2][j];
                f32x4 o; o.x = bflo(av.x) + bflo(bv.x) + bflo(cv.x); o.y = bfhi(av.x) + bfhi(bv.x) + bfhi(cv.x); o.z = bflo(av.y) + bflo(bv.y) + bflo(cv.y); o.w = bfhi(av.y) + bfhi(bv.y) + bfhi(cv.y);
                const float ss = wave_sum((o.x * o.x + o.y * o.y) + (o.z * o.z + o.w * o.w));
                const float rstd = rsqrtf(ss * (1.f / HV) + EPS);
                f32x4 r; r.x = bflo(rv.x); r.y = bfhi(rv.x); r.z = bflo(rv.y); r.w = bfhi(rv.y);
                f32x4 y;
#pragma unroll
                for (int i = 0; i < 4; ++i) y[i] = o[i] * rstd * gn[i] * silu_f(r[i]);
                u32x2 w; w.x = pk2(y.x, y.y); w.y = pk2(y.z, y.w);
                *(u32x2*)(Hh + (size_t)(row + (1 - h2) * 256) * D + 4 * F.lane + 256 * j) = w;
            }
    }
}

__device__ __forceinline__ void ph_norm2_router(Frame& F, const Args& A, int l) {
    const float* mod = (const float*)(A.ws + WS_MOD); unsigned char* H8 = A.ws + WS_H8; const bf16_t* X = (const bf16_t*)(A.ws + WS_X); float* aff = (float*)(A.ws + WS_AFF);
    const float* g = A.in[P_NORMG] + (l * 2 + 1) * D; const float* rw = A.in[P_ROUTER] + (size_t)l * D * NE;
    LAS unsigned char* WF = F.lds;
    LAS float* GS = (LAS float*)(F.lds + 65536); LAS float* SH = GS + D; LAS float* CB = SH + D; LAS float* RED = CB + 16;
    const int fr = F.lane & 15, fq = F.lane >> 4;
    const int grp0 = 256 * (int)(blockIdx.x & 7) + (int)(blockIdx.x >> 3) * NWAVES + F.wave;
    const int b = (int)(blockIdx.x & 7) >> 2;
    const float* sh = mod + (l * 3 + b) * 6 * D + 3 * D; const float* sc = mod + (l * 3 + b) * 6 * D + 4 * D;
    u32x4 xv[32];
    if (grp0 < NLAT / 16) { const bf16_t* xr0 = X + (size_t)(grp0 * 16 + fr) * D + 8 * fq;
#pragma unroll
        for (int s = 0; s < 32; ++s) xv[s] = *(const u32x4*)(xr0 + 32 * s); }
    for (int k = F.tid; k < D; k += NTHR) { GS[k] = g[k] * (1.f + sc[k]); SH[k] = sh[k]; }
    __syncthreads();
    for (int p = F.tid; p < 32 * 64; p += NTHR) {
        const int s = p >> 6, ln = p & 63, e = ln & 15, k0 = 32 * s + 8 * (ln >> 4);
        float w[8];
#pragma unroll
        for (int i = 0; i < 8; ++i) w[i] = rw[(k0 + i) * NE + e] * GS[k0 + i];
        u32x4 hi, lo;
        hi.x = pk2(w[0], w[1]); hi.y = pk2(w[2], w[3]); hi.z = pk2(w[4], w[5]); hi.w = pk2(w[6], w[7]);
        lo.x = pk2(w[0] - bflo(hi.x), w[1] - bfhi(hi.x)); lo.y = pk2(w[2] - bflo(hi.y), w[3] - bfhi(hi.y)); lo.z = pk2(w[4] - bflo(hi.z), w[5] - bfhi(hi.z)); lo.w = pk2(w[6] - bflo(hi.w), w[7] - bfhi(hi.w));
        *(LAS u32x4*)(WF + ((s * 2 + 0) * 64 + ln) * 16) = hi; *(LAS u32x4*)(WF + ((s * 2 + 1) * 64 + ln) * 16) = lo;
    }
    { const int e = F.tid & 15, part = F.tid >> 4; float acc = 0.f;
#pragma unroll 8
      for (int i = 0; i < 32; ++i) { const int k = part * 32 + i; acc += SH[k] * rw[k * NE + e]; }
      RED[part * 16 + e] = acc; }
    __syncthreads();
    if (F.tid < 16) { float acc = 0.f;
#pragma unroll
        for (int q = 0; q < 32; ++q) acc += RED[q * 16 + F.tid];
        CB[F.tid] = acc; }
    __syncthreads();
    for (int grp = grp0; grp < NLAT / 16; grp += F.ngw) {
        const int row0 = grp * 16, row = row0 + fr;
        if (grp != grp0) { const bf16_t* xr = X + (size_t)row * D + 8 * fq;
#pragma unroll
            for (int s = 0; s < 32; ++s) xv[s] = *(const u32x4*)(xr + 32 * s); }
        f32x2 ss2 = (f32x2){0.f, 0.f};
        f32x4 acc = (f32x4){0.f, 0.f, 0.f, 0.f};
#pragma unroll
        for (int s = 0; s < 32; ++s) {
            const u32x4 t = xv[s];
            const f32x2 a0 = {bflo(t.x), bfhi(t.x)}, a1 = {bflo(t.y), bfhi(t.y)}, a2 = {bflo(t.z), bfhi(t.z)}, a3 = {bflo(t.w), bfhi(t.w)};
            ss2 = __builtin_elementwise_fma(a0, a0, ss2); ss2 = __builtin_elementwise_fma(a1, a1, ss2); ss2 = __builtin_elementwise_fma(a2, a2, ss2); ss2 = __builtin_elementwise_fma(a3, a3, ss2);
            const bf16x8 xb = __builtin_bit_cast(bf16x8, t);
            acc = MFMA16(*(const LAS bf16x8*)(WF + ((s * 2 + 0) * 64 + F.lane) * 16), xb, acc);
            acc = MFMA16(*(const LAS bf16x8*)(WF + ((s * 2 + 1) * 64 + F.lane) * 16), xb, acc);
            if ((s & 1) == 1) asm volatile("" ::: "memory");
        }
#pragma unroll
        for (int s = 0; s < 32; ++s) asm volatile("" : "+v"(xv[s]));
        float ss = ss2.x + ss2.y; ss += __shfl_xor(ss, 16); ss += __shfl_xor(ss, 32);
        const float rstd = rsqrtf(ss * (1.f / D) + EPS);
        float lg[4]; float mx = -3.0e38f;
#pragma unroll
        for (int r = 0; r < 4; ++r) { lg[r] = rstd * acc[r] + CB[4 * fq + r]; mx = fmaxf(mx, lg[r]); }
        mx = fmaxf(mx, __shfl_xor(mx, 16)); mx = fmaxf(mx, __shfl_xor(mx, 32));
        float ex[4], den = 0.f;
#pragma unroll
        for (int r = 0; r < 4; ++r) { ex[r] = __expf(lg[r] - mx); den += ex[r]; }
        den += __shfl_xor(den, 16); den += __shfl_xor(den, 32);
        const float inv = 1.f / den; const int t = row & (T - 1);
#pragma unroll
        for (int r = 0; r < 4; ++r) aff[((size_t)b * NE + 4 * fq + r) * T + t] = ex[r] * inv;
        unsigned char* hr = H8 + (size_t)row * D + 8 * fq;
#pragma unroll
        for (int s = 0; s < 32; ++s) {
            const u32x4 t4 = xv[s]; const int k0 = 32 * s + 8 * fq;
            const f32x4 g0 = *(const LAS f32x4*)(GS + k0), g1 = *(const LAS f32x4*)(GS + k0 + 4), h0 = *(const LAS f32x4*)(SH + k0), h1 = *(const LAS f32x4*)(SH + k0 + 4);
            f32x4 y0 = (f32x4){bflo(t4.x), bfhi(t4.x), bflo(t4.y), bfhi(t4.y)} * rstd * g0 + h0, y1 = (f32x4){bflo(t4.z), bfhi(t4.z), bflo(t4.w), bfhi(t4.w)} * rstd * g1 + h1;
            const f32x4 lim = (f32x4){448.f, 448.f, 448.f, 448.f};
            y0 = __builtin_elementwise_min(__builtin_elementwise_max(y0, -lim), lim); y1 = __builtin_elementwise_min(__builtin_elementwise_max(y1, -lim), lim);
            int w0 = __builtin_amdgcn_cvt_pk_fp8_f32(y0.x, y0.y, 0, false); w0 = __builtin_amdgcn_cvt_pk_fp8_f32(y0.z, y0.w, w0, true);
            int w1 = __builtin_amdgcn_cvt_pk_fp8_f32(y1.x, y1.y, 0, false); w1 = __builtin_amdgcn_cvt_pk_fp8_f32(y1.z, y1.w, w1, true);
            u32x2 wv; wv.x = (unsigned)w0; wv.y = (unsigned)w1;
            *(u32x2*)(hr + 32 * s) = wv;
            if ((s & 1) == 1) asm volatile("" ::: "memory");
        }
    }
    __syncthreads();
}

__device__ __forceinline__ void ph_topk(Frame& F, const Args& A) {
    LAS int* red = (LAS int*)F.lds;
    const float* aff = (const float*)(A.ws + WS_AFF); int* slot = (int*)(A.ws + WS_SLOT); int* rowlist = (int*)(A.ws + WS_ROWLIST); float* selval = (float*)(A.ws + WS_SELVAL);
    const int xq = blockIdx.x & 7; rowlist = (int*)(A.ws + WS_ROWLIST8) + (size_t)xq * (NE * 4096);
    for (int item = blockIdx.x >> 3; item < NB * NE; item += F.G >> 3) {
        const int b = item / NE, e = item % NE;
        const float* a = aff + ((size_t)b * NE + e) * T + F.tid * 32;
        unsigned v[32];
#pragma unroll
        for (int q = 0; q < 8; ++q) { const u32x4 x = *(const u32x4*)(a + 4 * q); v[4 * q] = x.x; v[4 * q + 1] = x.y; v[4 * q + 2] = x.z; v[4 * q + 3] = x.w; }
        unsigned prefix = 0u; int par = 0;
        for (int bit = 29; bit >= 0; --bit) {
            const unsigned cand = prefix | (1u << bit); int cnt = 0;
#pragma unroll
            for (int i = 0; i < 32; ++i) cnt += __builtin_popcountll(__builtin_amdgcn_ballot_w64(v[i] >= cand));
            if (F.lane == 0) red[par * 16 + F.wave] = cnt;
            __syncthreads();
            int tot = 0;
#pragma unroll
            for (int w8 = 0; w8 < 8; ++w8) tot += red[par * 16 + w8];
            if (tot >= CAP) prefix = cand;
            par ^= 1;
            if (tot == CAP) break;
        }
        __syncthreads();
        int mgt = 0, meq = 0;
#pragma unroll
        for (int i = 0; i < 32; ++i) { mgt += (v[i] > prefix) ? 1 : 0; meq += (v[i] == prefix) ? 1 : 0; }
        int igt = mgt, ieq = meq;
#pragma unroll
        for (int o = 1; o < 64; o <<= 1) { const int ug = __shfl_up(igt, o), ue = __shfl_up(ieq, o); if (F.lane >= o) { igt += ug; ieq += ue; } }
        if (F.lane == 63) { red[F.wave] = igt; red[16 + F.wave] = ieq; }
        __syncthreads();
        int bgt = 0, beq = 0, totgt = 0;
#pragma unroll
        for (int w8 = 0; w8 < 8; ++w8) { const int xg = red[w8], xe = red[16 + w8]; if (w8 < F.wave) { bgt += xg; beq += xe; } totgt += xg; }
        const int need_eq = CAP - totgt;
        int gtb = bgt + igt - mgt, eqb = beq + ieq - meq;
        const int t0 = F.tid * 32;
#pragma unroll
        for (int q = 0; q < 2; ++q) {
            int sl[16];
#pragma unroll
            for (int i = 0; i < 16; ++i) {
                const unsigned x = v[q * 16 + i]; const bool gt = x > prefix, eq = x == prefix; const bool sel = gt || (eq && eqb < need_eq);
                const int pos = gtb + (eqb < need_eq ? eqb : need_eq);
                sl[i] = sel ? pos : -1;
                if (sel) { rowlist[e * 4096 + b * CAP + pos] = b * T + t0 + q * 16 + i; if (xq == 0) selval[e * 4096 + b * CAP + pos] = __builtin_bit_cast(float, x); }
                gtb += gt ? 1 : 0; eqb += eq ? 1 : 0;
            }
            if (xq == 0) { _Pragma("unroll") for (int i4 = 0; i4 < 4; ++i4) *(i32x4*)(slot + ((size_t)b * NE + e) * T + t0 + q * 16 + 4 * i4) = (i32x4){sl[4 * i4], sl[4 * i4 + 1], sl[4 * i4 + 2], sl[4 * i4 + 3]}; }
        }
        __syncthreads();
    }
}

__device__ __forceinline__ void ph_combine(Frame& F, const Args& A, int l) {
    const float* mod = (const float*)(A.ws + WS_MOD); bf16_t* X = (bf16_t*)(A.ws + WS_X); bf16_t* H = (bf16_t*)(A.ws + WS_H);
    const int* slot = (const int*)(A.ws + WS_SLOT); const unsigned char* ye = A.ws + WS_YE; const float* selval = (const float*)(A.ws + WS_SELVAL);
    for (int grp = 256 * (int)(blockIdx.x & 7) + (int)(blockIdx.x >> 3) * NWAVES + F.wave; grp < NLAT / 16; grp += F.ngw) {
        const int row0 = grp * 16, b = row0 >> 14, t0 = row0 & (T - 1);
        const i32x4 sv4 = *(const i32x4*)(slot + ((size_t)b * NE + (F.lane & 15)) * T + t0 + 4 * (F.lane >> 4));
        f32x4 g2v[4], pa[4], pb[4], pc[4];
#pragma unroll
        for (int j = 0; j < 4; ++j) { const int c = 4 * F.lane + 256 * j;
            g2v[j] = *(const f32x4*)(mod + (l * 3 + b) * 6 * D + 5 * D + c);
            if (l == 0) { pa[j] = *(const f32x4*)(A.in[P_NORMG] + (1 * 2 + 0) * D + c); pb[j] = *(const f32x4*)(mod + (1 * 3 + b) * 6 * D + 0 * D + c); pc[j] = *(const f32x4*)(mod + (1 * 3 + b) * 6 * D + 1 * D + c) + 1.f; }
            else { pa[j] = *(const f32x4*)(A.in[P_FINALG] + c); pb[j] = pa[j]; pc[j] = pa[j]; } }
#pragma unroll 1
        for (int rq = 0; rq < 4; ++rq) {
#pragma unroll
          for (int rh = 0; rh < 2; ++rh) {
            unsigned mask[2]; int yrow[2][4]; float wv[2][4]; u32x2 xr[2][4]; int yv[2][4][4];
#pragma unroll
            for (int p2 = 0; p2 < 2; ++p2) {
                const int ri = 2 * rh + p2, row = row0 + 4 * rq + ri, svr = sv4[ri];
                unsigned m = (unsigned)(__ballot(svr >= 0) >> (16 * rq)) & 0xFFFFu;
                const int e0 = m ? __builtin_ctz(m) : 0;
#pragma unroll
                for (int q = 0; q < 4; ++q) { const bool valid = m != 0u; const int e = valid ? __builtin_ctz(m) : e0; m &= m - 1u;
                    const int sq = __builtin_amdgcn_readlane(svr, 16 * rq + e); yrow[p2][q] = e * 4096 + b * CAP + (sq < 0 ? 0 : sq); wv[p2][q] = valid ? selval[yrow[p2][q]] * (1.f / 32) : 0.f; }
                mask[p2] = m;
#pragma unroll
                for (int j = 0; j < 4; ++j) xr[p2][j] = __builtin_nontemporal_load((const u32x2*)(X + (size_t)row * D + 4 * F.lane + 256 * j));
#pragma unroll
                for (int q = 0; q < 4; ++q)
#pragma unroll
                    for (int j = 0; j < 4; ++j) yv[p2][q][j] = __builtin_nontemporal_load((const int*)(ye + (size_t)yrow[p2][q] * D + 4 * F.lane + 256 * j));
            }
#pragma unroll
            for (int p2 = 0; p2 < 2; ++p2) {
                const int ri = 2 * rh + p2, row = row0 + 4 * rq + ri, svr = sv4[ri];
                f32x4 acc[4];
#pragma unroll
                for (int j = 0; j < 4; ++j) acc[j] = (f32x4){0.f, 0.f, 0.f, 0.f};
#pragma unroll
                for (int q = 0; q < 4; ++q)
#pragma unroll
                    for (int j = 0; j < 4; ++j) { const f32x2 lo = __builtin_amdgcn_cvt_pk_f32_fp8(yv[p2][q][j], false), hi = __builtin_amdgcn_cvt_pk_f32_fp8(yv[p2][q][j], true);
                        acc[j].x += wv[p2][q] * lo.x; acc[j].y += wv[p2][q] * lo.y; acc[j].z += wv[p2][q] * hi.x; acc[j].w += wv[p2][q] * hi.y; }
                unsigned m = mask[p2];
                while (m) {
                    const int e = __builtin_ctz(m); m &= m - 1u;
                    const int sq = __builtin_amdgcn_readlane(svr, 16 * rq + e), yr_ = e * 4096 + b * CAP + sq; const float w1 = selval[yr_] * (1.f / 32);
#pragma unroll
                    for (int j = 0; j < 4; ++j) { const int y = *(const int*)(ye + (size_t)yr_ * D + 4 * F.lane + 256 * j); const f32x2 lo = __builtin_amdgcn_cvt_pk_f32_fp8(y, false), hi = __builtin_amdgcn_cvt_pk_f32_fp8(y, true);
                        acc[j].x += w1 * lo.x; acc[j].y += w1 * lo.y; acc[j].z += w1 * hi.x; acc[j].w += w1 * hi.y; }
                }
                f32x4 v[4]; float ssq = 0.f;
#pragma unroll
                for (int j = 0; j < 4; ++j) { const u32x2 t = xr[p2][j]; v[j] = (f32x4){bflo(t.x), bfhi(t.x), bflo(t.y), bfhi(t.y)} + g2v[j] * acc[j];
                    ssq += (v[j].x * v[j].x + v[j].y * v[j].y) + (v[j].z * v[j].z + v[j].w * v[j].w); }
                const float rstd = rsqrtf(wave_sum(ssq) * (1.f / D) + EPS);
                if (l == 0) {
#pragma unroll
                    for (int j = 0; j < 4; ++j) { const int c = 4 * F.lane + 256 * j;
                        u32x2 w; w.x = pk2(v[j].x, v[j].y); w.y = pk2(v[j].z, v[j].w); *(u32x2*)(X + (size_t)row * D + c) = w;
                        const f32x4 y = v[j] * rstd * pa[j] * pc[j] + pb[j];
                        u32x2 hw; hw.x = pk2(y.x, y.y); hw.y = pk2(y.z, y.w); *(u32x2*)(H + (size_t)row * D + c) = hw; }
                } else {
#pragma unroll
                    for (int j = 0; j < 4; ++j) { const int c = 4 * F.lane + 256 * j; __builtin_nontemporal_store(v[j] * rstd * pa[j], (f32x4*)(A.out + (size_t)row * D + c)); }
                }
            }
          }
        }
    }
}

constexpr int N_PHASES = 20;
__global__ void __launch_bounds__(NTHR, 2) fwd_kernel(Args A) {
    extern __shared__ __attribute__((aligned(16))) unsigned char lds_raw[];
    Frame F;
    F.lds = (LAS unsigned char*)lds_raw;
    F.tid = threadIdx.x; F.lane = F.tid & 63; F.wave = __builtin_amdgcn_readfirstlane(F.tid >> 6);
    F.G = gridDim.x; F.gw = blockIdx.x * NWAVES + F.wave; F.ngw = F.G * NWAVES;
    const int lo = A.ph_lo, hi = A.ph_hi;
#ifdef ONLY_PH
#define IN(k) ((k) == ONLY_PH && lo <= (k) && (k) < hi)
#else
#define IN(k) (lo <= (k) && (k) < hi)
#endif
#if MK_MULTI
#define SEAM(k) do { } while (0)
#else
    cg::grid_group grid = cg::this_grid();
    volatile LAS unsigned* bst = (volatile LAS unsigned*)(F.lds + LDS_BYTES - 64);
    if (F.tid < 16) bst[F.tid] = 0u;
    __syncthreads();
    XcdBarrier xbar = xcd_barrier_post((unsigned*)(A.ws + WS_CTL) + 4096, bst);
    if (lo < 0) { __threadfence(); grid.sync(); }
#define SEAM(k) do { if (IN(k) && IN((k) + 1)) xcd_barrier(xbar); } while (0)
#define SEAML(k) do { if (IN(k) && IN((k) + 1)) { if (xl_ok) xcd_barrier_local(xbar); else xcd_barrier(xbar); } } while (0)
#endif
    const int c = blockIdx.x;
    #define H ((bf16_t*)(A.ws + WS_H))
#define X ((bf16_t*)(A.ws + WS_X))
#define mod ((const float*)(A.ws + WS_MOD))
#define MOE_GU(l) { eng::Gemm g{(const char*)(A.ws + WS_H8), (const char*)(A.ws + WS_W8 + (size_t)(l) * W8_LAYER), (const int*)(A.ws + WS_ROWLIST8) + (size_t)(c & 7) * (NE * 4096), (size_t)4096 * D, D / 2, 16, 16, NE}; g.trip = F.G == 256 ? 4 : 0; \
        eng::EpiSwiglu E{0x79797979, 0x7F7F7F7F, A.ws + WS_HID}; eng::gemm_phase(F.lds, g, E, F.G, c); }
#define MOE_DN(l) { eng::Gemm g{(const char*)(A.ws + WS_HID), (const char*)(A.ws + WS_W8 + (size_t)(l) * W8_LAYER + W8_WD), nullptr, (size_t)D * DEXP, DEXP / 2, 16, 4, NE}; g.rev = 1; g.trip = F.G == 256 ? 4 : 0; \
        eng::EpiDown E{0x79797979, 0x7D7D7D7D, A.ws + WS_YE}; eng::gemm_phase(F.lds, g, E, F.G, c); }

    if (F.tid == 0) ((unsigned*)(A.ws + WS_CTL))[3000 + blockIdx.x] = xb_xcc_id();
    bool xl_ok = false;
    if (IN(0)) ph_prep(F, A);
#if MK_MULTI
    if (IN(1)) ph_norm0(F, A);
#else
    xcd_split_arrive(xbar);
    if (F.tid == 0) { unsigned* mc = (unsigned*)(A.ws + WS_CTL) + 2050; unsigned sp = 0u; while (xb_ld(mc) < 32u && ++sp < XB_SPIN_CAP) __builtin_amdgcn_s_sleep(1);
        __builtin_amdgcn_fence(__ATOMIC_ACQUIRE, "agent"); asm volatile("s_waitcnt vmcnt(0)" ::: "memory"); }
    __syncthreads();
    if (IN(1)) ph_norm0(F, A);
    xcd_split_wait(xbar);
    { const unsigned* tb = (const unsigned*)(A.ws + WS_CTL) + 3000;
      int bad = 0;
      if (F.tid < (int)gridDim.x) bad = tb[F.tid] != tb[F.tid & 7];
      if (F.tid < 8) { for (int j = 0; j < F.tid; ++j) bad |= tb[F.tid] == tb[j]; }
      xl_ok = (gridDim.x == 256) && !__syncthreads_or(bad); }
#endif
    SEAML(1);
    if (IN(2)) { eng::Gemm g{(const char*)H, (const char*)(A.ws + WS_WIN0T), nullptr, 0, D, NROW / 256, NIN0P / 256, 1}; g.trip = 3;
        eng::EpiProj0 E{(bf16_t*)(A.ws + WS_QK), A.ws + WS_VTP, (bf16_t*)(A.ws + WS_R), (float*)(A.ws + WS_AFB)}; eng::gemm_phase(F.lds, g, E, F.G, c);
        if (6 * 32 + (c >> 3) >= ((c & 7) >= 6 ? 17 : 16) * (NIN0P / 256)) convert_expert_fixed<3>(A, F.lds, F.tid, F.wave, F.lane); }
    SEAML(2);
    if (IN(3)) ph_gla_prep(F, A);
    SEAM(3);
    if (IN(4)) ph_gla_main(F, A);
    SEAM(4);
    if (IN(5)) ph_gla_finish(F, A);
    SEAML(5);
    if (IN(6)) { eng::Gemm g{(const char*)H, (const char*)(A.ws + WS_WOUT0T), nullptr, 0, D, NLAT / 256, D / 256, 1};
        eng::EpiResidT<true> E{A.in[P_X], X, mod + (0 * 3) * 6 * D + 2 * D}; eng::gemm_phase(F.lds, g, E, F.G, c); }
    SEAML(6);
    if (IN(7)) ph_norm2_router(F, A, 0);
    SEAM(7);
    if (IN(8)) ph_topk(F, A);
    SEAML(8);
    if (IN(9)) MOE_GU(0)
    if (F.G == 256) SEAML(9); else SEAM(9);
    if (IN(10)) MOE_DN(0)
    SEAM(10);
    if (IN(11)) ph_combine(F, A, 0);
    SEAML(11);
    if (IN(12)) { eng::Gemm g{(const char*)H, (const char*)(A.ws + WS_WCINT), nullptr, 0, D, NLAT / 256, NCIN / 256, 1};
        g.trip = 1;
        eng::EpiConvFused E{A.ws + WS_CDUMP + (size_t)c * 131072, (bf16_t*)(A.ws + WS_H2), A.in[P_CK]}; eng::gemm_phase(F.lds, g, E, F.G, c); }
    SEAML(12);
    if (IN(14)) { eng::Gemm g{(const char*)(A.ws + WS_H2), (const char*)(A.ws + WS_WCOUTT), nullptr, 0, D, NLAT / 256, D / 256, 1};
        eng::EpiResidT<false> E{X, X, mod + (1 * 3) * 6 * D + 2 * D}; eng::gemm_phase(F.lds, g, E, F.G, c); }
    SEAML(14);
    if (IN(15)) ph_norm2_router(F, A, 1);
    SEAM(15);
    if (IN(16)) ph_topk(F, A);
    SEAML(16);
    if (IN(17)) MOE_GU(1)
    if (F.G == 256) SEAML(17); else SEAM(17);
    if (IN(18)) MOE_DN(1)
    SEAM(18);
    if (IN(19)) ph_combine(F, A, 1);
#undef IN
#undef SEAM
#undef H
#undef X
#undef mod
#undef MOE_GU
#undef MOE_DN
}

extern "C" void kernel_launch(void* const* d_in, const int* in_sizes, int n_in, void* d_out, int out_size, void* d_ws, size_t ws_size, hipStream_t stream) {
    static int grid = 0;
    if (grid == 0) {
        if (n_in != 20 || in_sizes[0] != NLAT * D || out_size != NLAT * D || ws_size < WS_END) {
            fprintf(stderr, "kernel_launch: unexpected problem: n_in %d in0 %d out %d ws %zu (need %zu)\n", n_in, n_in > 0 ? in_sizes[0] : -1, out_size, ws_size, (size_t)WS_END); grid = -1; return; }
        int dev = 0, cus = 0, per_cu = 0;
        if (hipGetDevice(&dev) != hipSuccess || hipDeviceGetAttribute(&cus, hipDeviceAttributeMultiprocessorCount, dev) != hipSuccess) { grid = -1; return; }
        if (hipFuncSetAttribute((const void*)fwd_kernel, hipFuncAttributeMaxDynamicSharedMemorySize, LDS_BYTES) != hipSuccess) { fprintf(stderr, "kernel_launch: hipFuncSetAttribute failed\n"); grid = -1; return; }
        if (hipOccupancyMaxActiveBlocksPerMultiprocessor(&per_cu, (const void*)fwd_kernel, NTHR, LDS_BYTES) != hipSuccess || per_cu < 1) { fprintf(stderr, "kernel_launch: occupancy query says %d\n", per_cu); per_cu = 1; }
        (void)hipGetLastError();
        if (cus != 256) { fprintf(stderr, "kernel_launch: built for a 256-CU device (one workgroup per CU); found %d CUs\n", cus); grid = -1; return; }
        grid = cus;
    }
    if (grid < 0) return;
    Args a{};
    for (int i = 0; i < 20; ++i) a.in[i] = (const float*)d_in[i];
    a.out = (float*)d_out; a.ws = (unsigned char*)d_ws;
#if MK_MULTI
    for (int p = 0; p < N_PHASES; ++p) {
        a.ph_lo = p; a.ph_hi = p + 1;
        hipLaunchKernelGGL(fwd_kernel, dim3(grid), dim3(NTHR), LDS_BYTES, stream, a);
    }
#else
    if (hipMemsetAsync((char*)d_ws + WS_CTL, 0, 64 * 1024, stream) != hipSuccess) { fprintf(stderr, "kernel_launch: memset failed\n"); return; }
    a.ph_lo = 0; a.ph_hi = N_PHASES;
    void* kargs[] = {&a};
    hipError_t e = hipLaunchCooperativeKernel((const void*)fwd_kernel, dim3(grid), dim3(NTHR), kargs, LDS_BYTES, stream);
    if (e != hipSuccess) fprintf(stderr, "kernel_launch: cooperative launch failed: %s (grid %d)\n", hipGetErrorString(e), grid);
#endif
}
```
